# Optimizing an MI355X kernel written in HIP

```python
import math
import jax, jax.numpy as jnp
from jax import lax
import numpy as np

D_MODEL = 1024
BATCH = 2
SEQ = 16384
DEPTH = 2
DEC_BATCH = 2
DEC_SEQ = 8192
PAST_LEN = 128

N_META = 16
GRID_W = 64
QUERY_BLOCK = 128
ROPE_THETA = 10000.0
NORM_EPS = 1e-6
A_HEADS = 8
A_KV_HEADS = 2
A_HEAD_DIM = 64
B_HEADS = 4
B_HEAD_DIM = 64
B_V_DIM = 2 * B_HEAD_DIM
C_HEADS = 4
C_NOPE = 128
C_ROPE = 64
C_V = 128
C_Q_LORA = 256
C_KV_LORA = 128
N_BRANCH = 3
MIX_W = 512
D_FF = 4 * D_MODEL
IN_SPLITS = (
    A_HEADS * A_HEAD_DIM, A_KV_HEADS * A_HEAD_DIM, A_KV_HEADS * A_HEAD_DIM,
    2 * B_HEADS * B_HEAD_DIM, 2 * B_HEADS * B_HEAD_DIM, B_HEADS * B_V_DIM,
    C_Q_LORA, C_KV_LORA, C_ROPE,
    N_BRANCH * D_MODEL,
)
IN_COLS = sum(IN_SPLITS)

kernel_name = 'hybrid_gqa_diff_mla_encoder'

F32 = jnp.float32


def rms_norm(x, g):
    xf = x.astype(F32)
    y = xf * lax.rsqrt(jnp.mean(xf * xf, axis=-1, keepdims=True) + NORM_EPS)
    return (y * g.astype(F32)).astype(x.dtype)


def rope(x, pos):
    d = x.shape[-1]
    half = d // 2
    inv = ROPE_THETA ** (-2.0 * jnp.arange(half, dtype=F32) / d)
    ang = pos[:, None] * inv[None, :]
    cos = jnp.cos(ang)[:, None, :]
    sin = jnp.sin(ang)[:, None, :]
    xf = x.astype(F32)
    x1, x2 = xf[..., :half], xf[..., half:]
    return jnp.concatenate([x1 * cos - x2 * sin, x2 * cos + x1 * sin], axis=-1).astype(x.dtype)


def axial_rope(x, row, col):
    h = x.shape[-1] // 2
    return jnp.concatenate([rope(x[..., :h], row), rope(x[..., h:], col)], axis=-1)


def token_positions(n_tokens):
    rows = n_tokens // GRID_W
    row = jnp.concatenate([jnp.full((N_META,), -1.0, F32),
                           jnp.repeat(jnp.arange(rows, dtype=F32), GRID_W)])
    col = jnp.concatenate([jnp.arange(N_META, dtype=F32),
                           jnp.tile(jnp.arange(GRID_W, dtype=F32), rows)])
    lin = jnp.arange(N_META + n_tokens, dtype=F32)
    return row, col, lin


def sweep_query_blocks(block_fn, q_args):
    head = block_fn(*[a[:, :N_META] for a in q_args])

    def split(a):
        rest = a[:, N_META:]
        nblk = rest.shape[1] // QUERY_BLOCK
        rest = rest.reshape(rest.shape[0], nblk, QUERY_BLOCK, *rest.shape[2:])
        return jnp.moveaxis(rest, 1, 0)

    body = lax.map(lambda args: block_fn(*args), tuple(split(a) for a in q_args))
    body = jnp.moveaxis(body, 0, 1)
    body = body.reshape(body.shape[0], -1, *body.shape[3:])
    return jnp.concatenate([head, body], axis=1)


def mixer_gqa(q, k, v, row, col, g_q, g_k):
    bsz, n, _ = q.shape
    grp = A_HEADS // A_KV_HEADS
    q = axial_rope(rms_norm(q.reshape(bsz, n, A_HEADS, A_HEAD_DIM), g_q), row, col)
    k = axial_rope(rms_norm(k.reshape(bsz, n, A_KV_HEADS, A_HEAD_DIM), g_k), row, col)
    v = v.reshape(bsz, n, A_KV_HEADS, A_HEAD_DIM)
    scale = A_HEAD_DIM ** -0.5

    def block(qb):
        qg = qb.reshape(qb.shape[0], qb.shape[1], A_KV_HEADS, grp, A_HEAD_DIM)
        s = jnp.einsum('bqhgd,bkhd->bhgqk', qg, k, preferred_element_type=F32) * scale
        p = jax.nn.softmax(s, axis=-1).astype(v.dtype)
        o = jnp.einsum('bhgqk,bkhd->bqhgd', p, v)
        return o.reshape(qb.shape[0], qb.shape[1], A_HEADS, A_HEAD_DIM)

    o = sweep_query_blocks(block, (q,))
    return o.reshape(bsz, n, A_HEADS * A_HEAD_DIM)


def mixer_diff(q, k, v, lin, g_q, g_k, lq1, lk1, lq2, lk2, g_sub, lam_init):
    bsz, n, _ = q.shape
    q = rms_norm(q.reshape(bsz, n, B_HEADS, 2, B_HEAD_DIM), g_q)
    k = rms_norm(k.reshape(bsz, n, B_HEADS, 2, B_HEAD_DIM), g_k)
    q1, q2 = q[..., 0, :], q[..., 1, :]
    k1, k2 = k[..., 0, :], k[..., 1, :]
    v = v.reshape(bsz, n, B_HEADS, B_V_DIM)
    lam = (jnp.exp(jnp.sum(lq1.astype(F32) * lk1.astype(F32)))
           - jnp.exp(jnp.sum(lq2.astype(F32) * lk2.astype(F32))) + lam_init)
    slopes = 2.0 ** (-8.0 * jnp.arange(1, B_HEADS + 1, dtype=F32) / B_HEADS)
    scale = B_HEAD_DIM ** -0.5

    def block(q1b, q2b, qpos):
        dist = jnp.abs(qpos[0][:, None] - lin[None, :])
        bias = -slopes[:, None, None] * dist[None]
        s1 = jnp.einsum('bqhd,bkhd->bhqk', q1b, k1, preferred_element_type=F32) * scale + bias
        s2 = jnp.einsum('bqhd,bkhd->bhqk', q2b, k2, preferred_element_type=F32) * scale + bias
        pdiff = jax.nn.softmax(s1, axis=-1) - lam * jax.nn.softmax(s2, axis=-1)
        return jnp.einsum('bhqk,bkhe->bqhe', pdiff.astype(v.dtype), v)

    o = sweep_query_blocks(block, (q1, q2, lin[None]))
    o = rms_norm(o, g_sub) * (1.0 - lam_init)
    return o.reshape(bsz, n, B_HEADS * B_V_DIM)


def mixer_mla(cq, ckv, kpe, lin, g_qa, w_qb, g_kva, w_kvb, g_q, g_k):
    bsz, n, _ = cq.shape
    q = (rms_norm(cq, g_qa) @ w_qb).reshape(bsz, n, C_HEADS, C_NOPE + C_ROPE)
    kv = (rms_norm(ckv, g_kva) @ w_kvb).reshape(bsz, n, C_HEADS, C_NOPE + C_V)
    k_nope, v = kv[..., :C_NOPE], kv[..., C_NOPE:]
    kpe = jnp.broadcast_to(kpe[:, :, None, :], (bsz, n, C_HEADS, C_ROPE))
    k = jnp.concatenate([k_nope, kpe], axis=-1)
    q = rms_norm(q, g_q)
    k = rms_norm(k, g_k)
    q = jnp.concatenate([q[..., :C_NOPE], rope(q[..., C_NOPE:], lin)], axis=-1)
    k = jnp.concatenate([k[..., :C_NOPE], rope(k[..., C_NOPE:], lin)], axis=-1)
    scale = (C_NOPE + C_ROPE) ** -0.5

    def block(qb):
        s = jnp.einsum('bqhd,bkhd->bhqk', qb, k, preferred_element_type=F32) * scale
        p = jax.nn.softmax(s, axis=-1).astype(v.dtype)
        return jnp.einsum('bhqk,bkhe->bqhe', p, v)

    o = sweep_query_blocks(block, (q,))
    return o.reshape(bsz, n, C_HEADS * C_V)


def layer(x, pos, l, p):
    row, col, lin = pos
    bsz, n, _ = x.shape
    h = rms_norm(x, p['attn_norm_g'][l])
    z = h @ p['w_in'][l]
    cuts = [int(c) for c in np.cumsum(IN_SPLITS)[:-1]]
    qa, ka, va, qb, kb, vb, cq, ckv, ckpe, gates = jnp.split(z, cuts, axis=-1)
    lam_init = 0.8 - 0.6 * math.exp(-0.3 * l)

    oa = mixer_gqa(qa, ka, va, row, col, p['a_q_norm_g'][l], p['a_k_norm_g'][l])
    ob = mixer_diff(qb, kb, vb, lin, p['b_q_norm_g'][l], p['b_k_norm_g'][l],
                    p['b_lambda_q1'][l], p['b_lambda_k1'][l], p['b_lambda_q2'][l],
                    p['b_lambda_k2'][l], p['b_subln_g'][l], lam_init)
    oc = mixer_mla(cq, ckv, ckpe, lin, p['c_q_a_norm_g'][l], p['c_w_q_b'][l],
                   p['c_kv_a_norm_g'][l], p['c_w_kv_b'][l], p['c_q_norm_g'][l], p['c_k_norm_g'][l])

    g = jax.nn.sigmoid((gates + p['b_gate'][l]).astype(F32)).astype(x.dtype)
    g = g.reshape(bsz, n, N_BRANCH, D_MODEL)
    merged = (g[:, :, 0] * (oa @ p['w_branch_a'][l])
              + g[:, :, 1] * (ob @ p['w_branch_b'][l])
              + g[:, :, 2] * (oc @ p['w_branch_c'][l]))
    x = x + merged @ p['w_out'][l]

    h2 = rms_norm(x, p['mlp_norm_g'][l])
    x = x + jnp.square(jax.nn.relu(h2 @ p['w_up'][l])) @ p['w_down'][l]
    return x


def trunk(x, meta_tokens, p):
    bsz, n_tokens, _ = x.shape
    pos = token_positions(n_tokens)
    meta = jnp.broadcast_to(meta_tokens.astype(x.dtype)[None], (bsz, N_META, D_MODEL))
    h = jnp.concatenate([meta, x], axis=1)
    for l in range(DEPTH):
        h = layer(h, pos, l, p)
    return h[:, N_META:]


def setup_inputs(seed: int = 0) -> dict:
    key = jax.random.key(seed)
    ks = jax.random.split(key, 32)

    def nrm(k, shape, scale):
        return scale * jax.random.normal(k, shape, F32)

    def gain(k, shape):
        return 1.0 + 0.02 * jax.random.normal(k, shape, F32)

    L = DEPTH
    return {
        'x_prompt': nrm(ks[0], (BATCH, SEQ, D_MODEL), 1.0),
        'x_sample': nrm(ks[1], (DEC_BATCH, DEC_SEQ, D_MODEL), 1.0),
        'meta_tokens': nrm(ks[2], (N_META, D_MODEL), 1.0),
        'attn_norm_g': gain(ks[3], (L, D_MODEL)),
        'w_in': nrm(ks[4], (L, D_MODEL, IN_COLS), D_MODEL ** -0.5),
        'b_gate': nrm(ks[5], (L, N_BRANCH * D_MODEL), 0.02),
        'a_q_norm_g': gain(ks[6], (L, A_HEAD_DIM)),
        'a_k_norm_g': gain(ks[7], (L, A_HEAD_DIM)),
        'b_q_norm_g': gain(ks[8], (L, B_HEAD_DIM)),
        'b_k_norm_g': gain(ks[9], (L, B_HEAD_DIM)),
        'b_lambda_q1': nrm(ks[10], (L, B_HEAD_DIM), 0.1),
        'b_lambda_k1': nrm(ks[11], (L, B_HEAD_DIM), 0.1),
        'b_lambda_q2': nrm(ks[12], (L, B_HEAD_DIM), 0.1),
        'b_lambda_k2': nrm(ks[13], (L, B_HEAD_DIM), 0.1),
        'b_subln_g': gain(ks[14], (L, B_V_DIM)),
        'c_q_a_norm_g': gain(ks[15], (L, C_Q_LORA)),
        'c_w_q_b': nrm(ks[16], (L, C_Q_LORA, C_HEADS * (C_NOPE + C_ROPE)), C_Q_LORA ** -0.5),
        'c_kv_a_norm_g': gain(ks[17], (L, C_KV_LORA)),
        'c_w_kv_b': nrm(ks[18], (L, C_KV_LORA, C_HEADS * (C_NOPE + C_V)), C_KV_LORA ** -0.5),
        'c_q_norm_g': gain(ks[19], (L, C_NOPE + C_ROPE)),
        'c_k_norm_g': gain(ks[20], (L, C_NOPE + C_ROPE)),
        'w_branch_a': nrm(ks[21], (L, A_HEADS * A_HEAD_DIM, D_MODEL), (A_HEADS * A_HEAD_DIM) ** -0.5),
        'w_branch_b': nrm(ks[22], (L, B_HEADS * B_V_DIM, D_MODEL), (B_HEADS * B_V_DIM) ** -0.5),
        'w_branch_c': nrm(ks[23], (L, C_HEADS * C_V, D_MODEL), (C_HEADS * C_V) ** -0.5),
        'w_out': nrm(ks[24], (L, D_MODEL, D_MODEL), D_MODEL ** -0.5),
        'mlp_norm_g': gain(ks[25], (L, D_MODEL)),
        'w_up': nrm(ks[26], (L, D_MODEL, D_FF), D_MODEL ** -0.5),
        'w_down': nrm(ks[27], (L, D_FF, D_MODEL), D_FF ** -0.5),
    }


def reference(x_prompt, x_sample, meta_tokens, attn_norm_g, w_in, b_gate,
              a_q_norm_g, a_k_norm_g, b_q_norm_g, b_k_norm_g,
              b_lambda_q1, b_lambda_k1, b_lambda_q2, b_lambda_k2, b_subln_g,
              c_q_a_norm_g, c_w_q_b, c_kv_a_norm_g, c_w_kv_b, c_q_norm_g, c_k_norm_g,
              w_branch_a, w_branch_b, w_branch_c, w_out, mlp_norm_g, w_up, w_down):
    p = dict(attn_norm_g=attn_norm_g, w_in=w_in, b_gate=b_gate,
             a_q_norm_g=a_q_norm_g, a_k_norm_g=a_k_norm_g,
             b_q_norm_g=b_q_norm_g, b_k_norm_g=b_k_norm_g,
             b_lambda_q1=b_lambda_q1, b_lambda_k1=b_lambda_k1,
             b_lambda_q2=b_lambda_q2, b_lambda_k2=b_lambda_k2, b_subln_g=b_subln_g,
             c_q_a_norm_g=c_q_a_norm_g, c_w_q_b=c_w_q_b,
             c_kv_a_norm_g=c_kv_a_norm_g, c_w_kv_b=c_w_kv_b,
             c_q_norm_g=c_q_norm_g, c_k_norm_g=c_k_norm_g,
             w_branch_a=w_branch_a, w_branch_b=w_branch_b, w_branch_c=w_branch_c,
             w_out=w_out, mlp_norm_g=mlp_norm_g, w_up=w_up, w_down=w_down)
    y_prompt = trunk(x_prompt, meta_tokens, p)
    y_sample = trunk(x_sample, meta_tokens, p)
    return (y_prompt, y_sample)
```

```cpp
#include <hip/hip_runtime.h>
#include <hip/hip_cooperative_groups.h>
#include <cstdint>
#include <cstdio>
namespace cg = cooperative_groups;
#define NOPIPE_AB 1
namespace pg8 {
#define PG8_LAS __attribute__((address_space(3)))
typedef unsigned short bf16_t;
typedef short bf16x8 __attribute__((ext_vector_type(8)));
typedef float f32x4 __attribute__((ext_vector_type(4)));
typedef unsigned u32x4 __attribute__((ext_vector_type(4)));
constexpr int BM = 256, BK = 64, HALF = 128, HTB = HALF * BK * 2  , STAGE_BYTES = 8 * HTB, NXCD = 8, WGM = 8;

__host__ __device__ __forceinline__ int lds_byte(int r, int c) { const int st = (r >> 4) * 2 + (c >> 5), rr = r & 15, cc = c & 31, ob = rr * 64 + cc * 2; return st * 1024 + (ob ^ (((ob >> 9) & 1) << 5)); }
__host__ __device__ __forceinline__ void stage_rc(int b, int& R, int& C) { const int st = b / 1024, sb = b % 1024, swz = sb ^ (((sb >> 9) & 1) << 5); R = (st >> 1) * 16 + swz / 64; C = (st & 1) * 32 + (swz % 64) / 2; }
__host__ __device__ __forceinline__ int perm32(int rho) { const int n = rho >> 4, i = rho & 15; return 8 * (i >> 2) + 4 * n + (i & 3); }

struct Unit { int pm, pn, z; };
struct Gemm { const bf16_t* A; const bf16_t* Bt; int K; size_t zsA, zsB; };

template <class Epi, class Sched, bool ALIGN_EPI = false, bool SP2 = false>
__device__ __forceinline__ void gemm_phase(PG8_LAS unsigned char* lds, const Gemm g, const Sched& S, const Epi& E, const int wv  ) {
    int tid_; asm volatile("v_mbcnt_lo_u32_b32 %0, -1, 0\n\tv_mbcnt_hi_u32_b32 %0, -1, %0" : "=v"(tid_)); tid_ += wv * 64;
    const int tid = tid_, wid = __builtin_amdgcn_readfirstlane(tid >> 6), lane = tid & 63, wr = wid >> 2, wc = wid & 3, fr = lane & 15, fq = lane >> 4;
    const int K = g.K, nt = K / BK;
    unsigned voffA[2], voffB[2];
#pragma unroll
    for (int i = 0; i < 2; ++i) { int R, C; stage_rc(tid * 16 + i * 8192, R, C); const int Rb = Epi::PERM ? ((R & ~31) + perm32(R & 31)) : R;
        voffA[i] = (unsigned)(R * K + C) * 2u; voffB[i] = (unsigned)(Rb * K + C) * 2u; }
    const size_t kstep = (size_t)(BK * 2);
    const size_t hstep = (size_t)HALF * K * 2;
    const size_t tstep = 2 * hstep;
    const unsigned ldsw = (unsigned)wid * 1024u;
    const int aoff = lds_byte(wr * 64 + fr, fq * 8), boff = lds_byte(wc * 32 + fr, fq * 8);
#define PG8_SA(b, h) (((b) * 2 + (h)) * HTB)
#define PG8_SB(b, h) ((4 + (b) * 2 + (h)) * HTB)
#define PG8_STAGE(bufoff, gbase, voff) do { _Pragma("unroll") for (int _i = 0; _i < 2; ++_i) \
        __builtin_amdgcn_global_load_lds((const unsigned*)((const char*)(gbase) + (voff)[_i]), (PG8_LAS unsigned*)(lds + (bufoff) + ldsw + _i * 8192), 16, 0, 0); } while (0)
#define PG8_LDA(dst, b, h) do { _Pragma("unroll") for (int m = 0; m < 4; ++m) _Pragma("unroll") for (int k = 0; k < 2; ++k) dst[m][k] = *(const PG8_LAS bf16x8*)(lds + PG8_SA(b, h) + aoff + m * 2048 + k * 1024); } while (0)
#define PG8_LDB(dst, b, h) do { _Pragma("unroll") for (int n = 0; n < 2; ++n) _Pragma("unroll") for (int k = 0; k < 2; ++k) dst[n][k] = *(const PG8_LAS bf16x8*)(lds + PG8_SB(b, h) + boff + n * 2048 + k * 1024); } while (0)
#define PG8_MMA(ai, bj, At, Bt) do { __builtin_amdgcn_s_setprio(1); _Pragma("unroll") for (int m = 0; m < 4; ++m) _Pragma("unroll") for (int n = 0; n < 2; ++n) _Pragma("unroll") for (int k = 0; k < 2; ++k) \
        acc[ai][bj][m][n] = __builtin_amdgcn_mfma_f32_16x16x32_bf16(Bt[n][k], At[m][k], acc[ai][bj][m][n], 0, 0, 0); __builtin_amdgcn_s_setprio(0); } while (0)
#define PG8_WAIT_V(n) asm volatile("s_waitcnt vmcnt(" #n ")" ::: "memory")
#define PG8_WAIT_L(n) asm volatile("s_waitcnt lgkmcnt(" #n ")" ::: "memory")
#define PG8_BAR __builtin_amdgcn_s_barrier()
#define PG8_SCHED __builtin_amdgcn_sched_barrier(0)
    Unit cur, nxt; int ui = 0;
    if (!S.next(0, cur)) return;
    f32x4 acc[2][2][4][2];
#pragma unroll
    for (int a = 0; a < 2; ++a)
#pragma unroll
        for (int b = 0; b < 2; ++b)
#pragma unroll
            for (int m = 0; m < 4; ++m)
#pragma unroll
                for (int n = 0; n < 2; ++n) acc[a][b][m][n] = (f32x4){0.f, 0.f, 0.f, 0.f};
    bf16x8 At[4][2], B0[2][2], B1[2][2];
    const char* cA = (const char*)(g.A + (size_t)cur.z * g.zsA) + (size_t)cur.pm * tstep; const char* cB = (const char*)(g.Bt + (size_t)cur.z * g.zsB) + (size_t)cur.pn * tstep;
    S.a_ready(cur);
    if constexpr (SP2) {
        PG8_STAGE(PG8_SB(0, 0), cB, voffB); PG8_STAGE(PG8_SB(0, 1), cB + hstep, voffB); PG8_STAGE(PG8_SA(0, 0), cA, voffA); PG8_STAGE(PG8_SA(0, 1), cA + hstep, voffA);
        if (wr == 1) PG8_BAR;
        PG8_WAIT_V(2); PG8_BAR;
        PG8_STAGE(PG8_SB(1, 0), cB + kstep, voffB); PG8_STAGE(PG8_SA(1, 0), cA + kstep, voffA); PG8_STAGE(PG8_SB(1, 1), cB + hstep + kstep, voffB);
        PG8_WAIT_V(6); PG8_BAR;
    } else {
        PG8_STAGE(PG8_SB(0, 0), cB, voffB); PG8_STAGE(PG8_SA(0, 0), cA, voffA); PG8_STAGE(PG8_SB(0, 1), cB + hstep, voffB); PG8_STAGE(PG8_SA(0, 1), cA + hstep, voffA);
        if (wr == 1) PG8_BAR;
        PG8_WAIT_V(4); PG8_BAR;
        PG8_STAGE(PG8_SB(1, 0), cB + kstep, voffB); PG8_STAGE(PG8_SA(1, 0), cA + kstep, voffA); PG8_STAGE(PG8_SB(1, 1), cB + hstep + kstep, voffB);
        PG8_WAIT_V(6); PG8_BAR;
    }
    for (;;) {
        const bool has_next = S.next(ui + 1, nxt);
        const char* nA = has_next ? (const char*)(g.A + (size_t)nxt.z * g.zsA) + (size_t)nxt.pm * tstep : cA; const char* nB = has_next ? (const char*)(g.Bt + (size_t)nxt.z * g.zsB) + (size_t)nxt.pn * tstep : cB;
        for (int t = 0; t < nt; t += 2) {
            const bool last = (t == nt - 2);
            const char* a1 = cA + (size_t)(t + 1) * kstep;
            const char* a2 = last ? nA : cA + (size_t)(t + 2) * kstep; const char* b2 = last ? nB : cB + (size_t)(t + 2) * kstep;
            const char* a3 = a2 + kstep; const char* b3 = b2 + kstep;
            if (last && has_next) S.a_ready(nxt);
            if constexpr (SP2) {
            PG8_LDB(B0, 0, 0); PG8_LDB(B1, 0, 1); PG8_SCHED; PG8_LDA(At, 0, 0); PG8_STAGE(PG8_SA(1, 1), a1 + hstep, voffA);
            PG8_WAIT_V(8); PG8_WAIT_L(0); PG8_BAR; PG8_MMA(0, 0, At, B0); PG8_MMA(0, 1, At, B1); PG8_BAR; PG8_SCHED;
            PG8_LDA(At, 0, 1); PG8_STAGE(PG8_SB(0, 0), b2, voffB); PG8_STAGE(PG8_SB(0, 1), b2 + hstep, voffB); PG8_STAGE(PG8_SA(0, 0), a2, voffA);
            PG8_WAIT_V(8); PG8_WAIT_L(0); PG8_BAR; PG8_MMA(1, 0, At, B0); PG8_MMA(1, 1, At, B1); PG8_BAR; PG8_SCHED;
            PG8_LDB(B0, 1, 0); PG8_LDB(B1, 1, 1); PG8_SCHED; PG8_LDA(At, 1, 0); PG8_STAGE(PG8_SA(0, 1), a2 + hstep, voffA);
            PG8_WAIT_V(8); PG8_WAIT_L(0); PG8_BAR; PG8_MMA(0, 0, At, B0); PG8_MMA(0, 1, At, B1); PG8_BAR; PG8_SCHED;
            PG8_LDA(At, 1, 1); PG8_STAGE(PG8_SB(1, 0), b3, voffB); PG8_STAGE(PG8_SB(1, 1), b3 + hstep, voffB); PG8_STAGE(PG8_SA(1, 0), a3, voffA);
            PG8_WAIT_V(8); PG8_WAIT_L(0); PG8_BAR; PG8_MMA(1, 0, At, B0); PG8_MMA(1, 1, At, B1); PG8_BAR; PG8_SCHED;
            } else {
            PG8_LDB(B0, 0, 0); PG8_SCHED; PG8_LDA(At, 0, 0); PG8_STAGE(PG8_SA(1, 1), a1 + hstep, voffA);
            PG8_WAIT_L(8); PG8_BAR; PG8_WAIT_L(0); PG8_MMA(0, 0, At, B0); PG8_BAR; PG8_SCHED;
            PG8_LDB(B1, 0, 1); PG8_STAGE(PG8_SB(0, 0), b2, voffB);
            PG8_BAR; PG8_WAIT_L(0); PG8_MMA(0, 1, At, B1); PG8_BAR;
            PG8_LDA(At, 0, 1); PG8_STAGE(PG8_SA(0, 0), a2, voffA);
            PG8_BAR; PG8_WAIT_L(0); PG8_MMA(1, 0, At, B0); PG8_BAR; PG8_SCHED;
            PG8_STAGE(PG8_SB(0, 1), b2 + hstep, voffB);
            PG8_WAIT_V(6); PG8_BAR; PG8_MMA(1, 1, At, B1); PG8_BAR;
            PG8_LDB(B0, 1, 0); PG8_SCHED; PG8_LDA(At, 1, 0); PG8_STAGE(PG8_SA(0, 1), a2 + hstep, voffA);
            PG8_WAIT_L(8); PG8_BAR; PG8_WAIT_L(0); PG8_MMA(0, 0, At, B0); PG8_BAR; PG8_SCHED;
            PG8_LDB(B1, 1, 1); PG8_STAGE(PG8_SB(1, 0), b3, voffB);
            PG8_BAR; PG8_WAIT_L(0); PG8_MMA(0, 1, At, B1); PG8_BAR;
            PG8_LDA(At, 1, 1); PG8_STAGE(PG8_SA(1, 0), a3, voffA);
            PG8_BAR; PG8_WAIT_L(0); PG8_MMA(1, 0, At, B0); PG8_BAR; PG8_SCHED;
            PG8_STAGE(PG8_SB(1, 1), b3 + hstep, voffB);
            PG8_WAIT_V(6); PG8_BAR; PG8_MMA(1, 1, At, B1); PG8_BAR;
            }
        }
        if constexpr (ALIGN_EPI) { if (wr == 0) PG8_BAR; }
        if constexpr (!Epi::AFTER_DRAIN) { E(acc, cur, wr, wc, fr, fq); S.done(cur); }
        if (!has_next) break;
#pragma unroll
        for (int a = 0; a < 2; ++a)
#pragma unroll
            for (int b = 0; b < 2; ++b)
#pragma unroll
                for (int m = 0; m < 4; ++m)
#pragma unroll
                    for (int n = 0; n < 2; ++n) acc[a][b][m][n] = (f32x4){0.f, 0.f, 0.f, 0.f};
        cur = nxt; cA = nA; cB = nB; ++ui;
        if constexpr (ALIGN_EPI) { if (wr == 1) PG8_BAR; }
    }
    PG8_WAIT_V(0);
    if constexpr (!ALIGN_EPI) { if (wr == 0) PG8_BAR; }
    PG8_BAR;
    if constexpr (Epi::AFTER_DRAIN) { E.fused(acc, cur, wr, wc, fr, fq, lds, wid, lane); S.done(cur); }
#undef PG8_SA
#undef PG8_SB
#undef PG8_STAGE
#undef PG8_LDA
#undef PG8_LDB
#undef PG8_MMA
#undef PG8_WAIT_V
#undef PG8_WAIT_L
#undef PG8_BAR
#undef PG8_SCHED
}
}


using pg8::bf16_t; using pg8::bf16x8; using pg8::f32x4; using pg8::u32x4;
typedef float f32x16 __attribute__((ext_vector_type(16)));
typedef unsigned u32x2 __attribute__((ext_vector_type(2)));
typedef float f32x2_t __attribute__((ext_vector_type(2)));
typedef __bf16 bf16x2_t __attribute__((ext_vector_type(2)));
#define LAS __attribute__((address_space(3)))
#define DI __device__ __forceinline__

constexpr int DM = 1024, RA = 16896;
constexpr int ZM_LD = 2816, G_LD = 3072, IN_N = 5888;
constexpr float LOG2E = 1.4426950408889634f;
constexpr size_t MiB = 1u << 20;
constexpr size_t WS_CTL = 0, CTL_BYTES = 131072;
constexpr size_t WS_W = 1 * MiB, LW_STRIDE = 34 * MiB;
constexpr size_t W_IN = 0, W_QB = W_IN + (size_t)IN_N * 1024 * 2, W_KVB = W_QB + 768 * 256 * 2, W_BR = W_KVB + 1024 * 128 * 2,
                 W_OUT = W_BR + 3 * 1024 * 512 * 2, W_UP = W_OUT + 1024 * 1024 * 2, W_DOWN = W_UP + 4096 * 1024 * 2, W_END = W_DOWN + 4096 * 1024 * 2;
static_assert(W_END <= LW_STRIDE, "weights");
constexpr size_t WS_META0 = 69 * MiB, WS_METAX = 70 * MiB, WS_XN = 74 * MiB, WS_ZM = 107 * MiB, WS_G = 198 * MiB, WS_QKV = 297 * MiB, WS_SM = 438 * MiB, WS_END = 454 * MiB;
constexpr size_t OFF_QCR = 0, OFF_KVR = 25 * MiB;
constexpr size_t OSLOT = (size_t)RA * 512;
constexpr size_t QA_O = 0, KA_O = 512ull * RA, VA_O = 640ull * RA, QB_O = 768ull * RA, KB_O = 1280ull * RA, VB_O = 1792ull * RA, QC_O = 2304ull * RA, KC_O = 3072ull * RA, VC_O = 3840ull * RA;
constexpr size_t SM_CQN = 0, SM_CKVN = 9 * MiB, SM_KPE = 14 * MiB;
constexpr int LDS_MISC = 131072, LDS_BYTES = 131072 + 256;

struct Params { const float* in[28]; float* out; unsigned char* ws; };

DI unsigned pk2(float lo, float hi) { f32x2_t v = {lo, hi}; bf16x2_t b = __builtin_convertvector(v, bf16x2_t); return __builtin_bit_cast(unsigned, b); }
DI void ld8(const bf16_t* p, float (&f)[8]) {
    const u32x4 r = *(const u32x4*)p;
#pragma unroll
    for (int i = 0; i < 4; ++i) { f[2 * i] = __uint_as_float(r[i] << 16); f[2 * i + 1] = __uint_as_float(r[i] & 0xffff0000u); }
}
DI void st8(bf16_t* p, const float (&f)[8]) { u32x4 w; w.x = pk2(f[0], f[1]); w.y = pk2(f[2], f[3]); w.z = pk2(f[4], f[5]); w.w = pk2(f[6], f[7]); *(u32x4*)p = w; }
DI int lane_fresh() { int l; asm volatile("v_mbcnt_lo_u32_b32 %0, -1, 0\n\tv_mbcnt_hi_u32_b32 %0, -1, %0" : "=v"(l)); return l; }
DI float wave_sum(float v, int lane) {
#pragma unroll
    for (int o = 1; o < 64; o <<= 1) v += __int_as_float(__builtin_amdgcn_ds_bpermute((lane ^ o) << 2, __float_as_int(v)));
    return v;
}
DI float max3f(float a, float b, float c) { float r; asm("v_max3_f32 %0, %1, %2, %3" : "=v"(r) : "v"(a), "v"(b), "v"(c)); return r; }
DI float max2f(float a, float b) { float r; asm("v_max_f32_e32 %0, %1, %2" : "=v"(r) : "v"(a), "v"(b)); return r; }
DI float fadd_s(float a, float b) { float r; asm("v_add_f32_e32 %0, %1, %2" : "=v"(r) : "v"(a), "v"(b)); return r; }
#define MX2(a, b) __builtin_amdgcn_fmed3f((a), (b), __builtin_inff())
DI float swap32_max(float v) { auto rr = __builtin_amdgcn_permlane32_swap(__float_as_uint(v), __float_as_uint(v), false, false); return __builtin_amdgcn_fmed3f(__uint_as_float(rr[0]), __uint_as_float(rr[1]), __builtin_inff()); }
DI float swap32_add(float v) { auto rr = __builtin_amdgcn_permlane32_swap(__float_as_uint(v), __float_as_uint(v), false, false); return __uint_as_float(rr[0]) + __uint_as_float(rr[1]); }
DI constexpr float inv64(int j) {
    constexpr float T[32] = {1.0f, 0.749894209f, 0.562341325f, 0.421696503f, 0.316227766f, 0.237137371f, 0.177827941f, 0.133352143f, 0.1f, 0.0749894209f, 0.0562341325f, 0.0421696503f,
                             0.0316227766f, 0.0237137371f, 0.0177827941f, 0.0133352143f, 0.01f, 0.00749894209f, 0.00562341325f, 0.00421696503f, 0.00316227766f, 0.00237137371f,
                             0.00177827941f, 0.00133352143f, 0.001f, 0.000749894209f, 0.000562341325f, 0.000421696503f, 0.000316227766f, 0.000237137371f, 0.000177827941f, 0.000133352143f};
    return T[j];
}
DI void sincos_ang(float ang, float& s, float& c) {
    double t = (double)ang * 0.15915494309189535; t -= __builtin_rint(t); const float f = (float)t;
    s = __builtin_amdgcn_sinf(f); c = __builtin_amdgcn_cosf(f);
}

struct Chunk {
    int id, nseq, seq0, tps, n;
    DI int rows_per_seq() const { return tps * 256; }
    DI int rows() const { return nseq * tps * 256; }
};
DI Chunk make_chunk(int c) { Chunk k; k.id = c; if (c < 2) { k.nseq = 1; k.seq0 = c; k.tps = 65; k.n = 16384; } else { k.nseq = 2; k.seq0 = 2; k.tps = 33; k.n = 8192; } return k; }
struct XMap {
    float* out; float* metax; const float* xp; const float* xs; const float* meta0; int seq0, tps, first;
    DI float* xw(int pt) const {
        const int hi = pt >= tps ? 1 : 0, s = seq0 + hi, lt = pt - hi * tps;
        if (lt == tps - 1) return metax + (size_t)s * 256 * DM;
        const int ob = (s < 2) ? s * 16384 : 32768 + (s - 2) * 8192;
        return out + ((size_t)ob + (size_t)lt * 256) * DM;
    }
    DI const float* xr(int pt) const {
        if (!first) return xw(pt);
        const int hi = pt >= tps ? 1 : 0, s = seq0 + hi, lt = pt - hi * tps;
        if (lt == tps - 1) return meta0;
        return (s < 2) ? xp + ((size_t)s * 16384 + (size_t)lt * 256) * DM : xs + ((size_t)(s - 2) * 8192 + (size_t)lt * 256) * DM;
    }
};

struct Sched {
    int nM, nN, nZ, nwg, G, c, ta, tps;
    DI void init(int nseq, int ta_, int tps_, int nN_, int nZ_, int G_, int c_) { ta = ta_; tps = tps_; nM = nseq * ta_; nN = nN_; nZ = nZ_; nwg = nM * nN; G = G_; c = c_; }
    DI bool next(int i, pg8::Unit& u) const {
        const int tl = (i / nZ) * G + c; if (tl >= nwg) return false;
        u.z = i % nZ;
        int wgid = tl; { const int q = nwg / pg8::NXCD, r = nwg % pg8::NXCD, xcd = wgid % pg8::NXCD, off = wgid / pg8::NXCD; wgid = (xcd < r ? xcd * (q + 1) : r * (q + 1) + (xcd - r) * q) + off; }
        const int nig = pg8::WGM * nN, gid = wgid / nig, fm = gid * pg8::WGM, gsz = (nM - fm) < pg8::WGM ? (nM - fm) : pg8::WGM;
        const int pa = fm + ((wgid % nig) % gsz); u.pn = (wgid % nig) / gsz;
        u.pm = pa >= ta ? pa - ta + tps : pa;
        return true;
    }
    DI void a_ready(const pg8::Unit&) const {}
    DI void done(const pg8::Unit&) const {}
};

template <int ACT  > struct EpiBf16 {
    static constexpr bool PERM = true, AFTER_DRAIN = false;
    bf16_t* O; int ldc;
    DI void operator()(const f32x4 (&acc)[2][2][4][2], const pg8::Unit& u, int wr, int wc, int fr_, int fq_) const {
        const int ln_ = lane_fresh(), fr = ln_ & 15, fq = ln_ >> 4;
        const int row0 = u.pm * 256 + wr * 64 + fr, col0 = u.pn * 256 + wc * 32 + 8 * fq;
#pragma unroll
        for (int ai = 0; ai < 2; ++ai)
#pragma unroll
            for (int m = 0; m < 4; ++m) { bf16_t* rowp = O + (size_t)(row0 + ai * 128 + m * 16) * ldc + col0;
#pragma unroll
                for (int bj = 0; bj < 2; ++bj) { f32x4 v0 = acc[ai][bj][m][0], v1 = acc[ai][bj][m][1];
                    if (ACT == 2) {
#pragma unroll
                        for (int k = 0; k < 4; ++k) { const float a = fmaxf(v0[k], 0.f), b = fmaxf(v1[k], 0.f); v0[k] = a * a; v1[k] = b * b; } }
                    u32x4 w; w.x = pk2(v0[0], v0[1]); w.y = pk2(v0[2], v0[3]); w.z = pk2(v1[0], v1[1]); w.w = pk2(v1[2], v1[3]);
                    *(u32x4*)(rowp + bj * 128) = w; } }
    }
};
struct EpiIn {
    static constexpr bool PERM = true, AFTER_DRAIN = false;
    bf16_t* ZM; bf16_t* G; const float* bgate;
    DI void operator()(const f32x4 (&acc)[2][2][4][2], const pg8::Unit& u, int wr, int wc, int fr_, int fq_) const {
        const int ln_ = lane_fresh(), fr = ln_ & 15, fq = ln_ >> 4;
        const bool gate = u.pn >= 11;
        const int row0 = u.pm * 256 + wr * 64 + fr, colt = gate ? (u.pn - 11) * 256 : u.pn * 256, col0 = colt + wc * 32 + 8 * fq, ld = gate ? G_LD : ZM_LD;
        bf16_t* base = gate ? G : ZM;
        f32x4 bv[2][2];
#pragma unroll
        for (int bj = 0; bj < 2; ++bj)
#pragma unroll
            for (int n = 0; n < 2; ++n) bv[bj][n] = gate ? *(const f32x4*)(bgate + col0 + bj * 128 + 4 * n) : (f32x4){0.f, 0.f, 0.f, 0.f};
#pragma unroll
        for (int ai = 0; ai < 2; ++ai)
#pragma unroll
            for (int m = 0; m < 4; ++m) { bf16_t* rowp = base + (size_t)(row0 + ai * 128 + m * 16) * ld + col0;
#pragma unroll
                for (int bj = 0; bj < 2; ++bj) { f32x4 v0 = acc[ai][bj][m][0] + bv[bj][0], v1 = acc[ai][bj][m][1] + bv[bj][1];
                    if (gate) {
#pragma unroll
                        for (int k = 0; k < 4; ++k) { v0[k] = __builtin_amdgcn_rcpf(1.f + __builtin_amdgcn_exp2f(-LOG2E * v0[k])); v1[k] = __builtin_amdgcn_rcpf(1.f + __builtin_amdgcn_exp2f(-LOG2E * v1[k])); } }
                    u32x4 w; w.x = pk2(v0[0], v0[1]); w.y = pk2(v0[2], v0[3]); w.z = pk2(v1[0], v1[1]); w.w = pk2(v1[2], v1[3]);
                    *(u32x4*)(rowp + bj * 128) = w; } }
    }
};
struct EpiBranch {
    static constexpr bool PERM = false, AFTER_DRAIN = false;
    const bf16_t* G; float* MG; bf16_t* MGb;
    DI void operator()(const f32x4 (&acc)[2][2][4][2], const pg8::Unit& u, int wr, int wc, int fr_, int fq_) const {
        const int ln_ = lane_fresh(), fr = ln_ & 15, fq = ln_ >> 4;
        const int row0 = u.pm * 256 + wr * 64 + fr, col0 = u.pn * 256 + wc * 32 + 4 * fq;
#pragma unroll
        for (int ai = 0; ai < 2; ++ai)
#pragma unroll
            for (int m = 0; m < 4; ++m) { const size_t row = (size_t)(row0 + ai * 128 + m * 16);
#pragma unroll
                for (int bj = 0; bj < 2; ++bj)
#pragma unroll
                    for (int n = 0; n < 2; ++n) { const int col = col0 + bj * 128 + n * 16;
                        const u32x2 gr = *(const u32x2*)(G + row * G_LD + u.z * 1024 + col);
                        f32x4 g; g[0] = __uint_as_float(gr.x << 16); g[1] = __uint_as_float(gr.x & 0xffff0000u); g[2] = __uint_as_float(gr.y << 16); g[3] = __uint_as_float(gr.y & 0xffff0000u);
                        f32x4 v = g * acc[ai][bj][m][n];
                        float* mp = MG + row * DM + col;
                        if (u.z > 0) v += *(const f32x4*)mp;
                        if (u.z < 2) *(f32x4*)mp = v;
                        else { u32x2 w; w.x = pk2(v[0], v[1]); w.y = pk2(v[2], v[3]); *(u32x2*)(MGb + row * DM + col) = w; } }
                asm volatile("" ::: "memory"); }
    }
};
struct EpiResid {
    static constexpr bool PERM = false, AFTER_DRAIN = false;
    XMap xm;
    DI void operator()(const f32x4 (&acc)[2][2][4][2], const pg8::Unit& u, int wr, int wc, int fr_, int fq_) const {
        const int ln_ = lane_fresh(), fr = ln_ & 15, fq = ln_ >> 4;
        const float* rd = xm.xr(u.pm); float* wp = xm.xw(u.pm);
        const int row0 = wr * 64 + fr, col0 = u.pn * 256 + wc * 32 + 4 * fq;
#pragma unroll
        for (int ai = 0; ai < 2; ++ai)
#pragma unroll
            for (int m = 0; m < 4; ++m) { const size_t off = (size_t)(row0 + ai * 128 + m * 16) * DM + col0;
#pragma unroll
                for (int bj = 0; bj < 2; ++bj)
#pragma unroll
                    for (int n = 0; n < 2; ++n) { const size_t o = off + bj * 128 + n * 16; *(f32x4*)(wp + o) = *(const f32x4*)(rd + o) + acc[ai][bj][m][n]; }
                asm volatile("" ::: "memory"); }
    }
};

DI void transpose_item(const float* W, int K, int N, bf16_t* WT, int split, int extra, LAS float* scr, int item, int lane) {
    const int nblk = N / 32, kb = item / nblk, nb = item % nblk, k0 = 64 * kb, n0 = 32 * nb;
    const int row_off = (n0 >= split) ? extra : 0;
#pragma unroll 8
    for (int i = 0; i < 32; ++i) { const int kk = 2 * i + (lane >> 5); scr[kk * 33 + (lane & 31)] = W[(size_t)(k0 + kk) * N + n0 + (lane & 31)]; }
    asm volatile("s_waitcnt lgkmcnt(0)" ::: "memory");
    const int c = lane & 7;
#pragma unroll
    for (int j = 0; j < 4; ++j) { const int n = (lane >> 3) + 8 * j; const LAS float* s = scr + (8 * c) * 33 + n;
        u32x4 o; o.x = pk2(s[0 * 33], s[1 * 33]); o.y = pk2(s[2 * 33], s[3 * 33]); o.z = pk2(s[4 * 33], s[5 * 33]); o.w = pk2(s[6 * 33], s[7 * 33]);
        *(u32x4*)(WT + (size_t)(row_off + n0 + n) * K + k0 + 8 * c) = o; }
    asm volatile("s_waitcnt lgkmcnt(0)" ::: "memory");
}
DI void prologue(const Params& p, LAS unsigned char* lds, int gw, int NGW, int wave, int lane) {
    LAS float* scr = (LAS float*)(lds + wave * 16384);
    constexpr int I_IN = 16 * 182, I_QB = 4 * 24, I_KVB = 2 * 32, I_BR = 8 * 32, I_OUT = 16 * 32, I_UP = 16 * 128, I_DN = 64 * 32;
    constexpr int PER_L = I_IN + I_QB + I_KVB + 3 * I_BR + I_OUT + I_UP + I_DN;
    for (int it = gw; it < 2 * PER_L; it += NGW) {
        const int l = it / PER_L; int r = it % PER_L;
        unsigned char* wb = p.ws + WS_W + (size_t)l * LW_STRIDE;
        if (r < I_IN) { transpose_item(p.in[4] + (size_t)l * 1024 * 5824, 1024, 5824, (bf16_t*)(wb + W_IN), 2752, 64, scr, r, lane); continue; } r -= I_IN;
        if (r < I_QB) { transpose_item(p.in[16] + (size_t)l * 256 * 768, 256, 768, (bf16_t*)(wb + W_QB), 1 << 30, 0, scr, r, lane); continue; } r -= I_QB;
        if (r < I_KVB) { transpose_item(p.in[18] + (size_t)l * 128 * 1024, 128, 1024, (bf16_t*)(wb + W_KVB), 1 << 30, 0, scr, r, lane); continue; } r -= I_KVB;
        if (r < 3 * I_BR) { const int b = r / I_BR; transpose_item(p.in[21 + b] + (size_t)l * 512 * 1024, 512, 1024, (bf16_t*)(wb + W_BR) + (size_t)b * 1024 * 512, 1 << 30, 0, scr, r % I_BR, lane); continue; } r -= 3 * I_BR;
        if (r < I_OUT) { transpose_item(p.in[24] + (size_t)l * 1024 * 1024, 1024, 1024, (bf16_t*)(wb + W_OUT), 1 << 30, 0, scr, r, lane); continue; } r -= I_OUT;
        if (r < I_UP) { transpose_item(p.in[26] + (size_t)l * 1024 * 4096, 1024, 4096, (bf16_t*)(wb + W_UP), 1 << 30, 0, scr, r, lane); continue; } r -= I_UP;
        transpose_item(p.in[27] + (size_t)l * 4096 * 1024, 4096, 1024, (bf16_t*)(wb + W_DOWN), 1 << 30, 0, scr, r, lane);
    }
    float* m0 = (float*)(p.ws + WS_META0);
    for (int r = gw; r < 256; r += NGW) { f32x4* o = (f32x4*)(m0 + (size_t)r * DM) + lane;
#pragma unroll
        for (int j = 0; j < 4; ++j) o[64 * j] = (r < 16) ? ((const f32x4*)(p.in[2] + (size_t)r * DM))[lane + 64 * j] : (f32x4){0.f, 0.f, 0.f, 0.f}; }
}

DI void norm_phase(const XMap& xm, int rows, const float* g, bf16_t* XN, int gw, int NGW, int lane) {
    for (int r = gw; r < rows; r += NGW) {
        const float* xrow = xm.xr(r >> 8) + (size_t)(r & 255) * DM;
        const f32x4* xr = (const f32x4*)xrow + lane;
        f32x4 v[4]; float s = 0.f;
#pragma unroll
        for (int j = 0; j < 4; ++j) { v[j] = xr[64 * j]; s += (v[j].x * v[j].x + v[j].y * v[j].y) + (v[j].z * v[j].z + v[j].w * v[j].w); }
        const float rs = rsqrtf(wave_sum(s, lane) * (1.f / DM) + 1e-6f);
        u32x2* o8 = (u32x2*)(XN + (size_t)r * DM) + lane;
#pragma unroll
        for (int j = 0; j < 4; ++j) { const f32x4 gg = ((const f32x4*)g)[lane + 64 * j]; u32x2 w; w.x = pk2(v[j].x * rs * gg.x, v[j].y * rs * gg.y); w.y = pk2(v[j].z * rs * gg.z, v[j].w * rs * gg.w); o8[64 * j] = w; }
    }
}

template <int W, int W0, int ROPE> DI void norm_task(const bf16_t* s0, const bf16_t* s1, const float* gain, float oscale, bf16_t* dst, float pa, float pb) {
    float ss = 0.f;
#pragma unroll 2
    for (int c = 0; c < W / 8; ++c) { float x[8]; ld8(c < W0 / 8 ? s0 + 8 * c : s1 + 8 * (c - W0 / 8), x);
#pragma unroll
        for (int e = 0; e < 8; ++e) ss += x[e] * x[e]; }
    const float rs = rsqrtf(ss * (1.f / W) + 1e-6f) * oscale;
    constexpr int NPLAIN = ROPE == 1 ? 0 : (ROPE == 2 ? 16 : W / 8);
#pragma unroll 2
    for (int c = 0; c < NPLAIN; ++c) { float x[8]; ld8(c < W0 / 8 ? s0 + 8 * c : s1 + 8 * (c - W0 / 8), x);
#pragma unroll
        for (int e = 0; e < 8; ++e) x[e] *= rs * gain[8 * c + e];
        st8(dst + 8 * c, x); }
    if constexpr (ROPE != 0) {
        constexpr int NB = ROPE == 1 ? 2 : 1, HC = ROPE == 1 ? 2 : 4, C0 = ROPE == 1 ? 0 : 16;
#pragma unroll
        for (int b = 0; b < NB; ++b) { const float pos = b ? pb : pa;
#pragma unroll
            for (int k = 0; k < HC; ++k) { const int c1 = C0 + 2 * HC * b + k, c2 = c1 + HC; float x1[8], x2[8];
                ld8(c1 < W0 / 8 ? s0 + 8 * c1 : s1 + 8 * (c1 - W0 / 8), x1); ld8(c2 < W0 / 8 ? s0 + 8 * c2 : s1 + 8 * (c2 - W0 / 8), x2);
#pragma unroll
                for (int e = 0; e < 8; ++e) { const int j = 8 * k + e; const float inv = ROPE == 1 ? inv64(2 * j) : inv64(j); float sn, cs; sincos_ang(pos * inv, sn, cs);
                    const float y1 = x1[e] * rs * gain[8 * c1 + e], y2 = x2[e] * rs * gain[8 * c2 + e]; x1[e] = y1 * cs - y2 * sn; x2[e] = y2 * cs + y1 * sn; }
                st8(dst + 8 * c1, x1); st8(dst + 8 * c2, x2); } }
    }
}
template <int W> DI void transpose_task(const bf16_t* src, bf16_t* dstT, int row) {
#pragma unroll 2
    for (int c = 0; c < W / 8; ++c) { const u32x4 r = *(const u32x4*)(src + 8 * c);
#pragma unroll
        for (int i = 0; i < 4; ++i) { dstT[(size_t)(8 * c + 2 * i) * RA + row] = (bf16_t)(r[i] & 0xffffu); dstT[(size_t)(8 * c + 2 * i + 1) * RA + row] = (bf16_t)(r[i] >> 16); } }
}
struct RowPos { float lin, row, col; };
DI RowPos row_pos(const Chunk& ck, int r) {
    const int li = r >= ck.rows_per_seq() ? r - ck.rows_per_seq() : r; RowPos p;
    if (li < ck.n) { p.lin = (float)(li + 16); p.row = (float)(li >> 6); p.col = (float)(li & 63); }
    else if (li < ck.n + 16) { p.lin = (float)(li - ck.n); p.row = -1.f; p.col = (float)(li - ck.n); }
    else { p.lin = 0.f; p.row = 0.f; p.col = 0.f; }
    return p;
}

DI void ew1_phase(const Params& p, const Chunk& ck, int l, int gw, int NGW, int lane) {
    unsigned char* ws = p.ws; asm volatile("" : "+s"(ws));
    const bf16_t* ZM = (const bf16_t*)(ws + WS_ZM); bf16_t* QKV = (bf16_t*)(ws + WS_QKV);
    bf16_t* CQN = (bf16_t*)(ws + WS_SM + SM_CQN); bf16_t* CKVN = (bf16_t*)(ws + WS_SM + SM_CKVN); bf16_t* KPE = (bf16_t*)(ws + WS_SM + SM_KPE);
    const int nrb = ck.rows() / 64; const float QS = 0.125f * LOG2E;
    for (int w = gw; w < nrb * 34; w += NGW) {
        const int rb = w / 34, task = w % 34, row = rb * 64 + lane;
        const bf16_t* z = ZM + (size_t)row * ZM_LD; const RowPos ps = row_pos(ck, row);
        if (task < 8) { const int h = task; norm_task<64, 64, 1>(z + 64 * h, z, p.in[6] + l * 64, QS, QKV + QA_O + ((size_t)h * RA + row) * 64, ps.row, ps.col); }
        else if (task < 10) { const int h = task - 8; norm_task<64, 64, 1>(z + 512 + 64 * h, z, p.in[7] + l * 64, 1.f, QKV + KA_O + ((size_t)h * RA + row) * 64, ps.row, ps.col); }
        else if (task < 12) { const int h = task - 10; transpose_task<64>(z + 640 + 64 * h, QKV + VA_O + (size_t)h * 64 * RA, row); }
        else if (task < 20) { const int hm = task - 12; norm_task<64, 64, 0>(z + 768 + 64 * hm, z, p.in[8] + l * 64, QS, QKV + QB_O + ((size_t)hm * RA + row) * 64, 0.f, 0.f); }
        else if (task < 28) { const int hm = task - 20; norm_task<64, 64, 0>(z + 1280 + 64 * hm, z, p.in[9] + l * 64, 1.f, QKV + KB_O + ((size_t)hm * RA + row) * 64, 0.f, 0.f); }
        else if (task < 32) { const int h = task - 28; transpose_task<128>(z + 1792 + 128 * h, QKV + VB_O + (size_t)h * 128 * RA, row); }
        else if (task == 32) { norm_task<256, 256, 0>(z + 2304, z, p.in[15] + l * 256, 1.f, CQN + (size_t)row * 256, 0.f, 0.f); }
        else { norm_task<128, 128, 0>(z + 2560, z, p.in[17] + l * 128, 1.f, CKVN + (size_t)row * 128, 0.f, 0.f);
#pragma unroll
            for (int c = 0; c < 8; ++c) *(u32x4*)(KPE + (size_t)row * 64 + 8 * c) = *(const u32x4*)(z + 2688 + 8 * c); }
    }
}
DI void ew2_phase(const Params& p, const Chunk& ck, int l, int gw, int NGW, int lane) {
    unsigned char* ws = p.ws; asm volatile("" : "+s"(ws));
    const bf16_t* QCR = (const bf16_t*)(ws + WS_ZM + OFF_QCR); const bf16_t* KVR = (const bf16_t*)(ws + WS_ZM + OFF_KVR); const bf16_t* KPE = (const bf16_t*)(ws + WS_SM + SM_KPE);
    bf16_t* QKV = (bf16_t*)(ws + WS_QKV);
    const int nrb = ck.rows() / 64; const float QS = 0.07216878364870322f * LOG2E;
    for (int w = gw; w < nrb * 12; w += NGW) {
        const int rb = w / 12, task = w % 12, row = rb * 64 + lane; const RowPos ps = row_pos(ck, row);
        if (task < 4) { const int h = task; norm_task<192, 192, 2>(QCR + (size_t)row * 768 + 192 * h, QCR, p.in[19] + l * 192, QS, QKV + QC_O + ((size_t)h * RA + row) * 192, ps.lin, 0.f); }
        else if (task < 8) { const int h = task - 4; norm_task<192, 128, 2>(KVR + (size_t)row * 1024 + 256 * h, KPE + (size_t)row * 64, p.in[20] + l * 192, 1.f, QKV + KC_O + ((size_t)h * RA + row) * 192, ps.lin, 0.f); }
        else { const int h = task - 8; transpose_task<128>(KVR + (size_t)row * 1024 + 256 * h + 128, QKV + VC_O + (size_t)h * 128 * RA, row); }
    }
}
DI void ew3_phase(const Params& p, const Chunk& ck, int l, bool last, int gw, int NGW, int lane) {
    unsigned char* ws = p.ws; asm volatile("" : "+s"(ws));
    bf16_t* O1 = (bf16_t*)(ws + WS_ZM) + 1 * OSLOT; const bf16_t* O2 = (const bf16_t*)(ws + WS_ZM) + 3 * OSLOT;
    const float d1 = wave_sum(p.in[10][l * 64 + lane] * p.in[11][l * 64 + lane], lane), d2 = wave_sum(p.in[12][l * 64 + lane] * p.in[13][l * 64 + lane], lane);
    int lz = l; asm volatile("" : "+s"(lz));
    const float lam_init = __uint_as_float(lz == 0 ? 0x3e4ccccdu : 0x3eb60549u)  , lam = expf(d1) - expf(d2) + lam_init, osc = 1.f - lam_init;
    const float* gs = p.in[14] + l * 128;
    const int nrb = ck.rows() / 64;
    for (int w = gw; w < nrb * 4; w += NGW) {
        const int rb = w >> 2, h = w & 3, row = rb * 64 + lane;
        if (last && (row >= ck.rows_per_seq() ? row - ck.rows_per_seq() : row) >= (ck.tps - 1) * 256) continue;
        bf16_t* a = O1 + (size_t)row * 512 + 128 * h; const bf16_t* b = O2 + (size_t)row * 512 + 128 * h;
        float ss = 0.f;
#pragma unroll 2
        for (int c = 0; c < 16; ++c) { float x[8], y[8]; ld8(a + 8 * c, x); ld8(b + 8 * c, y);
#pragma unroll
            for (int e = 0; e < 8; ++e) { const float d = x[e] - lam * y[e]; ss += d * d; } }
        const float rs = rsqrtf(ss * (1.f / 128.f) + 1e-6f) * osc;
#pragma unroll 2
        for (int c = 0; c < 16; ++c) { float x[8], y[8]; ld8(a + 8 * c, x); ld8(b + 8 * c, y);
#pragma unroll
            for (int e = 0; e < 8; ++e) x[e] = (x[e] - lam * y[e]) * rs * gs[8 * c + e];
            st8(a + 8 * c, x); }
    }
}

template <int DQK, int DV, bool ALIBI, bool PIPE>
DI void attn_unit(LAS unsigned char* lds, const bf16_t* __restrict__ Q, const bf16_t* __restrict__ K, const bf16_t* __restrict__ Vt, bf16_t* __restrict__ O, int r0, int qb, int n, float sl, const int wid) {
    constexpr bool EARLYV = true;
    constexpr bool NEGM = (DQK == 64);
    constexpr int KROW = DQK * 2 + 16, KT = 64 * KROW, VROW = 144, VT = DV * VROW, KCH = DQK / 8, NKC = 64 * KCH / 512, NVC = DV * 8 / 512, NKS = DQK / 16, NDB = DV / 32, VB0 = 2 * KT;
    typedef const __attribute__((address_space(1))) u32x4* gptr;
    const int lane = lane_fresh(), tid = wid * 64 + lane, r = lane & 31, h = lane >> 5;
    const int nk = n + 16, NT = (nk + 63) >> 6;
    const int li = qb * 256 + wid * 32 + r;
    const int qrow = r0 + li;
    const float qlin = (li < n) ? (float)(li + 16) : (li < nk ? (float)(li - n) : 0.f);
    bf16x8 qf[NKS];
#pragma unroll
    for (int ks = 0; ks < NKS; ++ks) qf[ks] = *(const bf16x8*)(Q + (size_t)qrow * DQK + ks * 16 + h * 8);
    f32x16 o[NDB];
#pragma unroll
    for (int d = 0; d < NDB; ++d)
#pragma unroll
        for (int i = 0; i < 16; ++i) o[d][i] = 0.f;
    float m = 0.f, l = 0.f; f32x16 negm, zero16;
#pragma unroll
    for (int i = 0; i < 16; ++i) { negm[i] = 0.f; zero16[i] = 0.f; }
    const bf16_t* kg0 = K + (size_t)r0 * DQK + tid * 8; const bf16_t* vg0 = Vt + (size_t)(tid >> 3) * RA + r0 + (tid & 7) * 8; const int vl0 = VB0 + (tid >> 3) * VROW + (tid & 7) * 16;
#define KL(i) ((((tid + 512 * (i)) / KCH) * KROW) + ((tid + 512 * (i)) % KCH) * 16)
#define KG(i, t) ((gptr)(kg0 + (i) * 4096 + (size_t)(t) * 64 * DQK))
#define VG(i, t) ((gptr)(vg0 + (size_t)(i) * 64 * RA + (size_t)(t) * 64))
#define VL(i) (vl0 + (i) * 64 * VROW)
    const int pr = (r & ~12) | ((r & 4) << 1) | ((r & 8) >> 1);
    const int kaddr = pr * KROW + h * 16, vaddr = VB0 + r * VROW + h * 16;
    u32x4 kst[NKC], vst[NVC], kstn[NKC], vstn[NVC];
#define QK_TILE(A0, A1, kb_) do { const int ko_ = (kb_) * KT + kaddr; \
        _Pragma("unroll") for (int kb4 = 0; kb4 < NKS; kb4 += 4) { bf16x8 kq[8]; \
            _Pragma("unroll") for (int j = 0; j < 4; ++j) { kq[2 * j] = *(const LAS bf16x8*)(lds + ko_ + (kb4 + j) * 32); kq[2 * j + 1] = *(const LAS bf16x8*)(lds + ko_ + 32 * KROW + (kb4 + j) * 32); } \
            asm volatile("" : "+v"(kq[0]), "+v"(kq[1]), "+v"(kq[2]), "+v"(kq[3]), "+v"(kq[4]), "+v"(kq[5]), "+v"(kq[6]), "+v"(kq[7]));     \
            _Pragma("unroll") for (int j = 0; j < 4; ++j) { \
                if (kb4 + j == 0) { A0 = __builtin_amdgcn_mfma_f32_32x32x16_bf16(kq[0], qf[0], NEGM ? negm : zero16, 0, 0, 0); A1 = __builtin_amdgcn_mfma_f32_32x32x16_bf16(kq[1], qf[0], NEGM ? negm : zero16, 0, 0, 0); } \
                else { A0 = __builtin_amdgcn_mfma_f32_32x32x16_bf16(kq[2 * j], qf[kb4 + j], A0, 0, 0, 0); A1 = __builtin_amdgcn_mfma_f32_32x32x16_bf16(kq[2 * j + 1], qf[kb4 + j], A1, 0, 0, 0); } } \
            __builtin_amdgcn_sched_barrier(0); } } while (0)
#pragma unroll
    for (int i = 0; i < NKC; ++i) kst[i] = *KG(i, 0);
#pragma unroll
    for (int i = 0; i < NVC; ++i) vst[i] = *VG(i, 0);
#pragma unroll
    for (int i = 0; i < NKC; ++i) *(LAS u32x4*)(lds + KL(i)) = kst[i];
#pragma unroll
    for (int i = 0; i < NVC; ++i) *(LAS u32x4*)(lds + VL(i)) = vst[i];
    if constexpr (PIPE) {
#pragma unroll
        for (int i = 0; i < NKC; ++i) kst[i] = *KG(i, 1);
#pragma unroll
        for (int i = 0; i < NKC; ++i) *(LAS u32x4*)(lds + KT + KL(i)) = kst[i];
#pragma unroll
        for (int i = 0; i < NKC; ++i) kst[i] = *KG(i, 2);
#pragma unroll
        for (int i = 0; i < NVC; ++i) vst[i] = *VG(i, 1);
    }
    __syncthreads();
    f32x16 s0, s1, n0, n1;
    if constexpr (PIPE) { QK_TILE(s0, s1, 0); __syncthreads(); }
    for (int t = 0; t < NT; ++t) {
        const int cb = t & 1;
        const bool moreV = (t + 1 < NT), moreK = PIPE ? (t + 2 < NT) : moreV;
        if constexpr (PIPE) {
            if (t + 3 < NT) {
#pragma unroll
                for (int i = 0; i < NKC; ++i) kstn[i] = *KG(i, t + 3);
            }
            if (t + 2 < NT) {
#pragma unroll
                for (int i = 0; i < NVC; ++i) vstn[i] = *VG(i, t + 2);
            }
        } else {
            if (moreK) {
#pragma unroll
                for (int i = 0; i < NKC; ++i) kst[i] = *KG(i, t + 1);
            }
            if (moreV) {
#pragma unroll
                for (int i = 0; i < NVC; ++i) vst[i] = *VG(i, t + 1);
            }
#ifdef PROBE_MEM2
            { int zo = 0; asm volatile("" : "+v"(zo));
              if (moreK) {
#pragma unroll
                for (int i = 0; i < NKC; ++i) { u32x4 d = *(KG(i, t + 1) + zo); asm volatile("" :: "v"(d)); } }
              if (moreV) {
#pragma unroll
                for (int i = 0; i < NVC; ++i) { u32x4 d = *(VG(i, t + 1) + zo); asm volatile("" :: "v"(d)); } } }
#endif
        }
        if constexpr (PIPE) { if (moreV) QK_TILE(n0, n1, cb ^ 1); }
        else QK_TILE(s0, s1, cb);
        bf16x8 vf0[8];
        if constexpr (EARLYV) {
#pragma unroll
            for (int j = 0; j < 8; ++j) vf0[j] = *(const LAS bf16x8*)(lds + cb * VT + vaddr + (j >> 2) * 32 * VROW + (j & 3) * 32);
        }
        if (t < NT - 1) {
            if constexpr (ALIBI) {
                const float qo = qlin - (float)(16 + 8 * h + t * 64);
#pragma unroll
                for (int i = 0; i < 16; ++i) { const float ci = (float)(16 * (i >> 3) + (i & 7)); s0[i] = __builtin_fmaf(-sl, __builtin_fabsf(qo - ci), s0[i]); s1[i] = __builtin_fmaf(-sl, __builtin_fabsf(qo - 32.f - ci), s1[i]); }
            }
        } else {
#pragma unroll
            for (int i = 0; i < 16; ++i) { const int kk = 16 * (i >> 3) + 8 * h + (i & 7);
                if (kk < 16) { if constexpr (ALIBI) s0[i] = __builtin_fmaf(-sl, __builtin_fabsf(qlin - (float)kk), s0[i]); } else s0[i] = -1e30f;
                s1[i] = -1e30f; }
        }
        float mx;
        { float a = MX2(s0[0], s1[0]), b = MX2(s0[1], s1[1]);
#pragma unroll
          for (int i = 2; i < 16; i += 2) { a = MX2(a, MX2(s0[i], s1[i])); b = MX2(b, MX2(s0[i + 1], s1[i + 1])); }
          mx = swap32_max(MX2(a, b)); }
        if constexpr (!NEGM) mx -= m;
        if (__builtin_expect(t == 0 || __builtin_amdgcn_ballot_w64(mx > 8.f) != 0ull, 0)) {
            const float dl = (t == 0) ? mx : fmaxf(mx, 0.f);
            m += dl;
            if constexpr (NEGM) {
#pragma unroll
                for (int i = 0; i < 16; ++i) { s0[i] -= dl; s1[i] -= dl; negm[i] = -m; } }
            if constexpr (PIPE) {
#pragma unroll
                for (int i = 0; i < 16; ++i) { n0[i] -= dl; n1[i] -= dl; } }
            if (t != 0) { const float f = __builtin_amdgcn_exp2f(-dl); l *= f;
#pragma unroll
                for (int d = 0; d < NDB; ++d)
#pragma unroll
                    for (int i = 0; i < 16; ++i) o[d][i] *= f; }
            asm volatile("" ::: "memory");
        }
        float ra = 0.f, rb = 0.f;
#pragma unroll
        for (int i = 0; i < 16; ++i) { s0[i] = __builtin_amdgcn_exp2f(NEGM ? s0[i] : s0[i] - m); s1[i] = __builtin_amdgcn_exp2f(NEGM ? s1[i] : s1[i] - m); ra += s0[i]; rb += s1[i]; }
        l += ra + rb;
        bf16x8 pf[4];
        { u32x4 w;
          w.x = pk2(s0[0], s0[1]); w.y = pk2(s0[2], s0[3]); w.z = pk2(s0[4], s0[5]); w.w = pk2(s0[6], s0[7]); pf[0] = __builtin_bit_cast(bf16x8, w);
          w.x = pk2(s0[8], s0[9]); w.y = pk2(s0[10], s0[11]); w.z = pk2(s0[12], s0[13]); w.w = pk2(s0[14], s0[15]); pf[1] = __builtin_bit_cast(bf16x8, w);
          w.x = pk2(s1[0], s1[1]); w.y = pk2(s1[2], s1[3]); w.z = pk2(s1[4], s1[5]); w.w = pk2(s1[6], s1[7]); pf[2] = __builtin_bit_cast(bf16x8, w);
          w.x = pk2(s1[8], s1[9]); w.y = pk2(s1[10], s1[11]); w.z = pk2(s1[12], s1[13]); w.w = pk2(s1[14], s1[15]); pf[3] = __builtin_bit_cast(bf16x8, w); }
#pragma unroll
        for (int d0 = 0; d0 < NDB; d0 += 2) { bf16x8 vf[8];
#pragma unroll
            for (int j = 0; j < 8; ++j) { if (EARLYV && d0 == 0) vf[j] = vf0[j]; else vf[j] = *(const LAS bf16x8*)(lds + cb * VT + vaddr + (d0 + (j >> 2)) * 32 * VROW + (j & 3) * 32); }
            asm volatile("" : "+v"(vf[0]), "+v"(vf[1]), "+v"(vf[2]), "+v"(vf[3]), "+v"(vf[4]), "+v"(vf[5]), "+v"(vf[6]), "+v"(vf[7]));
#pragma unroll
            for (int j = 0; j < 8; ++j) o[d0 + (j >> 2)] = __builtin_amdgcn_mfma_f32_32x32x16_bf16(vf[j], pf[j & 3], o[d0 + (j >> 2)], 0, 0, 0);
            __builtin_amdgcn_sched_barrier(0); }
        if (moreK) {
#pragma unroll
            for (int i = 0; i < NKC; ++i) *(LAS u32x4*)(lds + (PIPE ? cb : (cb ^ 1)) * KT + KL(i)) = kst[i];
        }
        if (moreV) {
#pragma unroll
            for (int i = 0; i < NVC; ++i) *(LAS u32x4*)(lds + (cb ^ 1) * VT + VL(i)) = vst[i];
        }
        asm volatile("s_waitcnt lgkmcnt(0)" ::: "memory"); __builtin_amdgcn_s_barrier(); asm volatile("" ::: "memory");
        if constexpr (PIPE) { s0 = n0; s1 = n1;
#pragma unroll
            for (int i = 0; i < NKC; ++i) kst[i] = kstn[i];
#pragma unroll
            for (int i = 0; i < NVC; ++i) vst[i] = vstn[i]; }
    }
    l = swap32_add(l);
    const float il = 1.f / l;
    bf16_t* orow = O + (size_t)qrow * 512;
#pragma unroll
    for (int d = 0; d < NDB; ++d)
#pragma unroll
        for (int g = 0; g < 4; ++g) { u32x2 w; w.x = pk2(o[d][4 * g] * il, o[d][4 * g + 1] * il); w.y = pk2(o[d][4 * g + 2] * il, o[d][4 * g + 3] * il);
            *(u32x2*)(orow + 32 * d + 8 * g + 4 * h) = w; }
#undef KG
#undef KL
#undef VG
#undef VL
#undef QK_TILE
}

template <int DV, bool ALIBI>
DI void attn_unit2(LAS unsigned char* lds, const bf16_t* __restrict__ Q, const bf16_t* __restrict__ K, const bf16_t* __restrict__ Vt, bf16_t* __restrict__ O, int r0, int qb, int n, float sl, const int wid) {
    constexpr int DQK = 64, KROW = DQK * 2 + 16, KT = 64 * KROW, VROW = 144, VT = DV * VROW, NVC = DV * 8 / 512, NKS = 4, NDB = DV / 32, VB0 = 2 * KT;
    typedef const __attribute__((address_space(1))) u32x4* gptr;
    const int lane = lane_fresh(), tid = wid * 64 + lane, r = lane & 31, h = lane >> 5;
    const int nk = n + 16, NT = (nk + 63) >> 6;
    const int li = qb * 256 + wid * 32 + r;
    const int qrow = r0 + li;
    const float qlin = (li < n) ? (float)(li + 16) : (li < nk ? (float)(li - n) : 0.f);
    bf16x8 qf[NKS];
#pragma unroll
    for (int ks = 0; ks < NKS; ++ks) qf[ks] = *(const bf16x8*)(Q + (size_t)qrow * DQK + ks * 16 + h * 8);
    f32x16 o[NDB];
#pragma unroll
    for (int d = 0; d < NDB; ++d)
#pragma unroll
        for (int i = 0; i < 16; ++i) o[d][i] = 0.f;
    float m = 0.f, l = 0.f; f32x16 negm;
#pragma unroll
    for (int i = 0; i < 16; ++i) negm[i] = 0.f;
    const bf16_t* kg0 = K + (size_t)r0 * DQK + tid * 8; const bf16_t* vg0 = Vt + (size_t)(tid >> 3) * RA + r0 + (tid & 7) * 8;
    const int kl0 = (tid >> 3) * KROW + (tid & 7) * 16, vl0 = VB0 + (tid >> 3) * VROW + (tid & 7) * 16;
#define KG2(t) ((gptr)(kg0 + (size_t)(t) * 64 * DQK))
#define VG2(i, t) ((gptr)(vg0 + (size_t)(i) * 64 * RA + (size_t)(t) * 64))
    const int pr = (r & ~12) | ((r & 4) << 1) | ((r & 8) >> 1);
    const int kaddr = pr * KROW + h * 16, vaddr = VB0 + r * VROW + h * 16;
    u32x4 kst, vst[NVC];
    bf16x8 kf[8];
#define LDK(kb_) do { _Pragma("unroll") for (int ks = 0; ks < 4; ++ks) { kf[2 * ks] = *(const LAS bf16x8*)(lds + (kb_) * KT + kaddr + ks * 32); kf[2 * ks + 1] = *(const LAS bf16x8*)(lds + (kb_) * KT + kaddr + 32 * KROW + ks * 32); } \
        asm volatile("" : "+v"(kf[0]), "+v"(kf[1]), "+v"(kf[2]), "+v"(kf[3]), "+v"(kf[4]), "+v"(kf[5]), "+v"(kf[6]), "+v"(kf[7])); } while (0)
#define QKM(A0, A1) do { A0 = __builtin_amdgcn_mfma_f32_32x32x16_bf16(kf[0], qf[0], negm, 0, 0, 0); A1 = __builtin_amdgcn_mfma_f32_32x32x16_bf16(kf[1], qf[0], negm, 0, 0, 0); \
        _Pragma("unroll") for (int ks = 1; ks < 4; ++ks) { A0 = __builtin_amdgcn_mfma_f32_32x32x16_bf16(kf[2 * ks], qf[ks], A0, 0, 0, 0); A1 = __builtin_amdgcn_mfma_f32_32x32x16_bf16(kf[2 * ks + 1], qf[ks], A1, 0, 0, 0); } } while (0)
#define PV2(vb_, d0_) do { bf16x8 vf[8]; \
        _Pragma("unroll") for (int j = 0; j < 8; ++j) vf[j] = *(const LAS bf16x8*)(lds + (vb_) * VT + vaddr + ((d0_) + (j >> 2)) * 32 * VROW + (j & 3) * 32); \
        asm volatile("" : "+v"(vf[0]), "+v"(vf[1]), "+v"(vf[2]), "+v"(vf[3]), "+v"(vf[4]), "+v"(vf[5]), "+v"(vf[6]), "+v"(vf[7])); \
        _Pragma("unroll") for (int j = 0; j < 8; ++j) o[(d0_) + (j >> 2)] = __builtin_amdgcn_mfma_f32_32x32x16_bf16(vf[j], pf[j & 3], o[(d0_) + (j >> 2)], 0, 0, 0); } while (0)
    kst = *KG2(0);
#pragma unroll
    for (int i = 0; i < NVC; ++i) vst[i] = *VG2(i, 0);
    *(LAS u32x4*)(lds + kl0) = kst;
#pragma unroll
    for (int i = 0; i < NVC; ++i) *(LAS u32x4*)(lds + vl0 + i * 64 * VROW) = vst[i];
    kst = *KG2(1);
    *(LAS u32x4*)(lds + KT + kl0) = kst;
    __syncthreads();
    f32x16 s0, s1, n0, n1;
    bf16x8 pf[4];
    LDK(0); QKM(s0, s1);
    __syncthreads();
    int vcur = 0;
    for (int t = 0; t < NT; ++t) {
        const int cb = t & 1;
        const bool moreV = (t + 1 < NT), moreK = (t + 2 < NT);
        const int vprev = (vcur == 0) ? 2 : vcur - 1, vnext = (vcur == 2) ? 0 : vcur + 1;
        if (moreK) kst = *KG2(t + 2);
        if (moreV) {
#pragma unroll
            for (int i = 0; i < NVC; ++i) vst[i] = *VG2(i, t + 1);
        }
#ifdef PROBE_MEM2
        { int zo = 0; asm volatile("" : "+v"(zo));
          if (moreK) { u32x4 d = *(KG2(t + 2) + zo); asm volatile("" :: "v"(d)); }
          if (moreV) {
#pragma unroll
            for (int i = 0; i < NVC; ++i) { u32x4 d = *(VG2(i, t + 1) + zo); asm volatile("" :: "v"(d)); } } }
#endif
        __builtin_amdgcn_s_setprio(1);
        if (moreV) { LDK(cb ^ 1); QKM(n0, n1); }
        if (t > 0) { PV2(vprev, 0); if constexpr (NDB == 4) PV2(vprev, 2); }
        __builtin_amdgcn_s_setprio(0);
        if (t < NT - 1) {
            if constexpr (ALIBI) {
                const float qo = qlin - (float)(16 + 8 * h + t * 64);
#pragma unroll
                for (int i = 0; i < 16; ++i) { const float ci = (float)(16 * (i >> 3) + (i & 7)); s0[i] = __builtin_fmaf(-sl, __builtin_fabsf(qo - ci), s0[i]); s1[i] = __builtin_fmaf(-sl, __builtin_fabsf(qo - 32.f - ci), s1[i]); }
            }
        } else {
#pragma unroll
            for (int i = 0; i < 16; ++i) { const int kk = 16 * (i >> 3) + 8 * h + (i & 7);
                if (kk < 16) { if constexpr (ALIBI) s0[i] = __builtin_fmaf(-sl, __builtin_fabsf(qlin - (float)kk), s0[i]); } else s0[i] = -1e30f;
                s1[i] = -1e30f; }
        }
        float mx;
        { float a = MX2(s0[0], s1[0]), b = MX2(s0[1], s1[1]);
#pragma unroll
          for (int i = 2; i < 16; i += 2) { a = MX2(a, MX2(s0[i], s1[i])); b = MX2(b, MX2(s0[i + 1], s1[i + 1])); }
          mx = swap32_max(MX2(a, b)); }
        if (__builtin_expect(t == 0 || __builtin_amdgcn_ballot_w64(mx > 8.f) != 0ull, 0)) {
            const float dl = (t == 0) ? mx : fmaxf(mx, 0.f);
            m += dl;
#pragma unroll
            for (int i = 0; i < 16; ++i) { s0[i] -= dl; s1[i] -= dl; n0[i] -= dl; n1[i] -= dl; negm[i] = -m; }
            if (t != 0) { const float f = __builtin_amdgcn_exp2f(-dl); l *= f;
#pragma unroll
                for (int d = 0; d < NDB; ++d)
#pragma unroll
                    for (int i = 0; i < 16; ++i) o[d][i] *= f; }
            asm volatile("" ::: "memory");
        }
        float ra = 0.f, rb = 0.f;
#pragma unroll
        for (int i = 0; i < 16; ++i) { s0[i] = __builtin_amdgcn_exp2f(s0[i]); s1[i] = __builtin_amdgcn_exp2f(s1[i]); ra += s0[i]; rb += s1[i]; }
        l += ra + rb;
        { u32x4 w;
          w.x = pk2(s0[0], s0[1]); w.y = pk2(s0[2], s0[3]); w.z = pk2(s0[4], s0[5]); w.w = pk2(s0[6], s0[7]); pf[0] = __builtin_bit_cast(bf16x8, w);
          w.x = pk2(s0[8], s0[9]); w.y = pk2(s0[10], s0[11]); w.z = pk2(s0[12], s0[13]); w.w = pk2(s0[14], s0[15]); pf[1] = __builtin_bit_cast(bf16x8, w);
          w.x = pk2(s1[0], s1[1]); w.y = pk2(s1[2], s1[3]); w.z = pk2(s1[4], s1[5]); w.w = pk2(s1[6], s1[7]); pf[2] = __builtin_bit_cast(bf16x8, w);
          w.x = pk2(s1[8], s1[9]); w.y = pk2(s1[10], s1[11]); w.z = pk2(s1[12], s1[13]); w.w = pk2(s1[14], s1[15]); pf[3] = __builtin_bit_cast(bf16x8, w); }
        if (moreK) *(LAS u32x4*)(lds + cb * KT + kl0) = kst;
        if (moreV) {
#pragma unroll
            for (int i = 0; i < NVC; ++i) *(LAS u32x4*)(lds + vnext * VT + vl0 + i * 64 * VROW) = vst[i];
        }
        asm volatile("s_waitcnt lgkmcnt(0)" ::: "memory"); __builtin_amdgcn_s_barrier(); asm volatile("" ::: "memory");
        s0 = n0; s1 = n1; vcur = vnext;
    }
    { const int vlast = (vcur == 0) ? 2 : vcur - 1; PV2(vlast, 0); if constexpr (NDB == 4) PV2(vlast, 2); }
    asm volatile("s_waitcnt lgkmcnt(0)" ::: "memory"); __builtin_amdgcn_s_barrier(); asm volatile("" ::: "memory");
    l = swap32_add(l);
    const float il = 1.f / l;
    bf16_t* orow = O + (size_t)qrow * 512;
#pragma unroll
    for (int d = 0; d < NDB; ++d)
#pragma unroll
        for (int g = 0; g < 4; ++g) { u32x2 w; w.x = pk2(o[d][4 * g] * il, o[d][4 * g + 1] * il); w.y = pk2(o[d][4 * g + 2] * il, o[d][4 * g + 3] * il);
            *(u32x2*)(orow + 32 * d + 8 * g + 4 * h) = w; }
#undef KG2
#undef VG2
#undef LDK
#undef QKM
#undef PV2
}
#ifdef NOPIPE_AB
#define ATTN_B attn_unit<64, 128, true, false>
#define ATTN_A attn_unit<64, 64, false, false>
#else
#define ATTN_B attn_unit<64, 128, true, false>
#define ATTN_A attn_unit2<64, false>
#endif
DI void attn_phase(const Params& p, const Chunk& ck, bool last, LAS unsigned char* lds, unsigned* q  , const int wave) {
    unsigned char* ws = p.ws; asm volatile("" : "+s"(ws));
    const bf16_t* QKV = (const bf16_t*)(ws + WS_QKV); bf16_t* OB = (bf16_t*)(ws + WS_ZM);
    const int nmeta = last ? 0 : 20 * ck.nseq, nms = (nmeta + 31) >> 5, nsuper = nms + 40;
    volatile LAS int* su = (volatile LAS int*)(lds + LDS_MISC);
    for (;;) {
        if (wave == 0 && lane_fresh() == 0) {
            const unsigned x = (unsigned)__builtin_amdgcn_s_getreg((3 << 11) | 20) & 0xFu;
            int res = -1, lin = 0;
            for (;;) {
                const unsigned idx = __hip_atomic_fetch_add(q + 64 + 16 * x, 1u, __ATOMIC_RELAXED, __HIP_MEMORY_SCOPE_AGENT);
                const unsigned slot = (idx >> 5) & 63u; lin = (int)(idx & 31u);
                unsigned* te = q + 512 + x * 64 + slot; unsigned g;
                if (lin == 0) { g = __hip_atomic_fetch_add(q, 1u, __ATOMIC_RELAXED, __HIP_MEMORY_SCOPE_AGENT); __hip_atomic_store(te, g + 1u, __ATOMIC_RELAXED, __HIP_MEMORY_SCOPE_AGENT); }
                else { while ((g = __hip_atomic_load(te, __ATOMIC_RELAXED, __HIP_MEMORY_SCOPE_AGENT)) == 0u) __builtin_amdgcn_s_sleep(2); g -= 1u; }
                if ((int)g >= nsuper) { res = -1; break; }
                if ((int)g < nms && (int)g * 32 + lin >= nmeta) continue;
                res = (int)g; break;
            }
            su[0] = res; su[1] = lin;
        }
        __syncthreads();
        const int g = su[0], lin = su[1];
        __syncthreads();
        if (g < 0) break;
        int type, hd, s, qb;
        int sh = ck.nseq - 1; asm volatile("" : "+s"(sh));
        if (g < nms) { const int mu = g * 32 + lin, jh = mu >> sh; s = mu & sh; qb = ck.tps - 1;
            if (jh < 4) { type = 0; hd = jh; } else if (jh < 12) { type = 1; hd = jh - 4; } else { type = 2; hd = jh - 12; } }
        else { const int gr = g - nms, sub = gr & 1;
            if (gr < 8) { type = 0; hd = gr >> 1; } else if (gr < 24) { type = 1; hd = (gr - 8) >> 1; } else { type = 2; hd = (gr - 24) >> 1; }
            s = sub * sh; qb = lin + (sub * 32) * (1 - sh); }
        const int r0 = s * ck.rows_per_seq();
        if (type == 0) {
            attn_unit<192, 128, false, false>(lds, QKV + QC_O + (size_t)hd * RA * 192, QKV + KC_O + (size_t)hd * RA * 192, QKV + VC_O + (size_t)hd * 128 * RA, OB + 2 * OSLOT + 128 * hd, r0, qb, ck.n, 0.f, wave);
        } else if (type == 1) { const int hh = hd >> 1;
            const float sl = LOG2E * (hh == 0 ? 0.25f : hh == 1 ? 0.0625f : hh == 2 ? 0.015625f : 0.00390625f);
            ATTN_B(lds, QKV + QB_O + (size_t)hd * RA * 64, QKV + KB_O + (size_t)hd * RA * 64, QKV + VB_O + (size_t)hh * 128 * RA, OB + ((hd & 1) ? 3 : 1) * OSLOT + 128 * hh, r0, qb, ck.n, sl, wave);
        } else { const int kv = hd >> 2;
            ATTN_A(lds, QKV + QA_O + (size_t)hd * RA * 64, QKV + KA_O + (size_t)kv * RA * 64, QKV + VA_O + (size_t)kv * 64 * RA, OB + 64 * hd, r0, qb, ck.n, 0.f, wave);
        }
    }
}

#define XB_TMO      128
#define XB_XCNT(j)  (256  + 64 * (j))
#define XB_XSUB(j)  (1280 + 64 * (j))
#define XB_XGEN(j)  (2304 + 64 * (j))
#define XB_TOP      3328
#define XB_TOPGEN   3392
#define XCD_BAR_WORDS 3456
#define XB_SPIN_CAP (1u << 22)
DI unsigned xb_ld(unsigned* p)              { return __hip_atomic_load(p, __ATOMIC_RELAXED, __HIP_MEMORY_SCOPE_AGENT); }
DI unsigned xb_add(unsigned* p, unsigned v) { return __hip_atomic_fetch_add(p, v, __ATOMIC_RELAXED, __HIP_MEMORY_SCOPE_AGENT); }
DI unsigned xb_xcc_id() { return (unsigned)__builtin_amdgcn_s_getreg((3 << 11) | 20) & 0xFu; }
#define XB_SPIN(cond, bar) do { unsigned _sp = 0; while (cond) { __builtin_amdgcn_s_sleep(1); \
    if ((++_sp & 255u) == 0u) { if (xb_ld(&(bar)[XB_TMO])) break; if (_sp > XB_SPIN_CAP) { atomicAdd(&(bar)[XB_TMO], 1u); break; } } } } while (0)
DI void xcd_barrier_complete(unsigned* bar, unsigned x, unsigned G, unsigned& nloc, unsigned& nx) {
    unsigned sum, cnt, mine, sp = 0u;
    for (;;) {
        sum = 0u; cnt = 0u; mine = 0u;
#pragma unroll
        for (unsigned j = 0; j < 16; ++j) { const unsigned c = xb_ld(&bar[XB_XCNT(j)]); sum += c; cnt += (c > 0u) ? 1u : 0u; mine = (j == x) ? c : mine; }
        if (sum == G) break;
        __builtin_amdgcn_s_sleep(1);
        if ((++sp & 255u) == 0u) { if (xb_ld(&bar[XB_TMO])) break; if (sp > XB_SPIN_CAP) { atomicAdd(&bar[XB_TMO], 1u); break; } }
    }
    nloc = mine > 0u ? mine : 1u; nx = cnt > 0u ? cnt : 1u;
}
DI void xcd_barrier(unsigned* bar, volatile LAS unsigned* st, const int wave) {
    asm volatile("s_waitcnt vmcnt(0)" ::: "memory");
    __syncthreads();
    if (wave == 0 && lane_fresh() == 0) {
        __builtin_amdgcn_s_waitcnt(0);
        const unsigned x = xb_xcc_id();
        unsigned nloc = st[0], nx = st[1];
        if (nloc == 0u) { xcd_barrier_complete(bar, x, gridDim.x, nloc, nx); st[0] = nloc; st[1] = nx; }
        const unsigned old = xb_add(&bar[XB_XSUB(x)], 1u);
        const unsigned gen = old / nloc;
        if (old + 1u == (gen + 1u) * nloc) {
            __builtin_amdgcn_fence(__ATOMIC_RELEASE, "agent");
            asm volatile("s_waitcnt vmcnt(0)" ::: "memory");
            const unsigned og = xb_add(&bar[XB_TOP], 1u);
            const unsigned tg = og / nx;
            if (og + 1u == (tg + 1u) * nx) xb_add(&bar[XB_TOPGEN], 1u);
            else XB_SPIN(xb_ld(&bar[XB_TOPGEN]) == tg, bar);
            __builtin_amdgcn_fence(__ATOMIC_ACQUIRE, "agent");
            xb_add(&bar[XB_XGEN(x)], 1u);
            asm volatile("s_waitcnt vmcnt(0)" ::: "memory");
        } else {
            XB_SPIN(xb_ld(&bar[XB_XGEN(x)]) == gen, bar);
            __builtin_amdgcn_fence(__ATOMIC_ACQUIRE, "agent");
            asm volatile("s_waitcnt vmcnt(0)" ::: "memory");
        }
    }
    __syncthreads();
}

#define GSYNC() xcd_barrier(xbar, xst, wave)
__global__ void __launch_bounds__(512) fwd_kernel(Params p) {
    extern __shared__ __attribute__((aligned(16))) unsigned char lds_raw[];
    LAS unsigned char* lds = (LAS unsigned char*)lds_raw;
    cg::grid_group grid = cg::this_grid();
    const int wave = __builtin_amdgcn_readfirstlane((int)threadIdx.x >> 6); int lane = lane_fresh();
    const int G = gridDim.x, bx = blockIdx.x, NGW = G * 8, gw = bx * 8 + wave;
#define WSP(off) ({ unsigned char* w_ = p.ws; asm volatile("" : "+s"(w_)); w_ + (off); })
#define ctl ((unsigned*)WSP(WS_CTL))
#define xbar (ctl + 1024)
    volatile LAS unsigned* xst = (volatile LAS unsigned*)(lds + LDS_MISC + 16);
    if (wave == 0 && lane == 0) { xst[0] = 0u; xst[1] = 0u; (void)xb_add(&xbar[XB_XCNT(xb_xcc_id())], 1u); }
    __syncthreads();
#define XN ((bf16_t*)WSP(WS_XN))
#define ZM ((bf16_t*)WSP(WS_ZM))
#define GB ((bf16_t*)WSP(WS_G))
#define CQN ((bf16_t*)WSP(WS_SM + SM_CQN))
#define CKVN ((bf16_t*)WSP(WS_SM + SM_CKVN))
#define QCR ((bf16_t*)WSP(WS_ZM + OFF_QCR))
#define KVR ((bf16_t*)WSP(WS_ZM + OFF_KVR))
#define MG ((float*)WSP(WS_QKV))
#define U ((bf16_t*)WSP(WS_G))

#if !defined(PH) || (PH & 1)
    prologue(p, lds, gw, NGW, wave, lane);
#endif
    grid.sync();
    for (int l = 0; l < 2; ++l) {
        const bool last = (l == 1);
#define wb (WSP(WS_W) + (size_t)l * LW_STRIDE)
        for (int c = 0; c < 3; ++c) {
            const Chunk ck = make_chunk(c);
            const int ta = last ? ck.tps - 1 : ck.tps;
            XMap xm; xm.out = p.out; xm.metax = (float*)WSP(WS_METAX); xm.xp = p.in[0]; xm.xs = p.in[1]; xm.meta0 = (const float*)WSP(WS_META0); xm.seq0 = ck.seq0; xm.tps = ck.tps; xm.first = (l == 0);
#define RELAUNDER() do { lane = lane_fresh(); } while (0)
            RELAUNDER();
#if !defined(PH) || (PH & 2)
            norm_phase(xm, ck.rows(), p.in[3] + l * DM, XN, gw, NGW, lane);
#ifdef PROBE_EW2
            RELAUNDER(); norm_phase(xm, ck.rows(), p.in[3] + l * DM, XN, gw, NGW, lane);
#endif
#endif
            GSYNC();
            { pg8::Gemm g{XN, (const bf16_t*)(wb + W_IN), 1024, 0, 0}; Sched S; S.init(ck.nseq, ck.tps, ck.tps, IN_N / 256, 1, G, bx);
              EpiIn E{ZM, GB, p.in[5] + l * 3072};
#if !defined(PH) || (PH & 4)
              pg8::gemm_phase<EpiIn, Sched, true, true>(lds, g, S, E, wave);
#endif
 }
            GSYNC();
            RELAUNDER();
#if !defined(PH) || (PH & 128)
            ew1_phase(p, ck, l, gw, NGW, lane);
#ifdef PROBE_EW2
            RELAUNDER(); ew1_phase(p, ck, l, gw, NGW, lane);
#endif
#endif
            GSYNC();
            { pg8::Gemm g{CQN, (const bf16_t*)(wb + W_QB), 256, 0, 0}; Sched S; S.init(ck.nseq, ck.tps, ck.tps, 3, 1, G, bx); EpiBf16<0> E{QCR, 768};
#if !defined(PH) || (PH & 8)
              pg8::gemm_phase<EpiBf16<0>, Sched, true, true>(lds, g, S, E, wave);
#endif
 }
            { pg8::Gemm g{CKVN, (const bf16_t*)(wb + W_KVB), 128, 0, 0}; Sched S; S.init(ck.nseq, ck.tps, ck.tps, 4, 1, G, bx); EpiBf16<0> E{KVR, 1024};
#if !defined(PH) || (PH & 8)
              pg8::gemm_phase<EpiBf16<0>, Sched, true, true>(lds, g, S, E, wave);
#endif
 }
            GSYNC();
            RELAUNDER();
#if !defined(PH) || (PH & 256)
            ew2_phase(p, ck, l, gw, NGW, lane);
#ifdef PROBE_EW2
            RELAUNDER(); ew2_phase(p, ck, l, gw, NGW, lane);
#endif
#endif
            GSYNC();
#if !defined(PH) || (PH & 1024)
            attn_phase(p, ck, last, lds, ctl + 8192 + 2048 * (l * 3 + c), wave);
#ifdef PROBE_ATTN2
            GSYNC();
            attn_phase(p, ck, last, lds, ctl + 8192 + 2048 * (6 + l * 3 + c), wave);
#endif
#endif
            GSYNC();
            RELAUNDER();
#if !defined(PH) || (PH & 512)
            ew3_phase(p, ck, l, last, gw, NGW, lane);
#endif
            GSYNC();
            { pg8::Gemm g{ZM, (const bf16_t*)(wb + W_BR), 512, OSLOT, (size_t)1024 * 512}; Sched S; S.init(ck.nseq, ta, ck.tps, 4, 3, G, bx); EpiBranch E{GB, MG, XN};
#if !defined(PH) || (PH & 16)
              pg8::gemm_phase<EpiBranch, Sched, true, true>(lds, g, S, E, wave);
#endif
 }
            GSYNC();
            { pg8::Gemm g{XN, (const bf16_t*)(wb + W_OUT), 1024, 0, 0}; Sched S; S.init(ck.nseq, ta, ck.tps, 4, 1, G, bx); EpiResid E{xm};
#if !defined(PH) || (PH & 32)
              pg8::gemm_phase<EpiResid, Sched, true, true>(lds, g, S, E, wave);
#endif
 }
            GSYNC();
            xm.first = 0;
            RELAUNDER();
#if !defined(PH) || (PH & 2)
            norm_phase(xm, ck.rows(), p.in[25] + l * DM, XN, gw, NGW, lane);
#ifdef PROBE_EW2
            RELAUNDER(); norm_phase(xm, ck.rows(), p.in[25] + l * DM, XN, gw, NGW, lane);
#endif
#endif
            GSYNC();
            { pg8::Gemm g{XN, (const bf16_t*)(wb + W_UP), 1024, 0, 0}; Sched S; S.init(ck.nseq, ta, ck.tps, 16, 1, G, bx); EpiBf16<2> E{U, 4096};
#if !defined(PH) || (PH & 64)
              pg8::gemm_phase<EpiBf16<2>, Sched, true, true>(lds, g, S, E, wave);
#endif
 }
            GSYNC();
            { pg8::Gemm g{U, (const bf16_t*)(wb + W_DOWN), 4096, 0, 0}; Sched S; S.init(ck.nseq, ta, ck.tps, 4, 1, G, bx); EpiResid E{xm};
#if !defined(PH) || (PH & 32)
              pg8::gemm_phase<EpiResid, Sched, true, true>(lds, g, S, E, wave);
#endif
 }
        }
    }
}

extern "C" void kernel_launch(void* const* d_in, const int* in_sizes, int n_in, void* d_out, int out_size, void* d_ws, size_t ws_size, hipStream_t stream) {
    static int grid_blocks = 0;
    if (grid_blocks == 0) {
        if (n_in != 28 || ws_size < WS_END) { fprintf(stderr, "kernel_launch: unexpected n_in %d / ws_size %zu (need %zu)\n", n_in, ws_size, (size_t)WS_END); grid_blocks = -1; return; }
        int dev = 0, cus = 0, per_cu = 0;
        hipGetDevice(&dev); hipDeviceGetAttribute(&cus, hipDeviceAttributeMultiprocessorCount, dev);
        hipFuncSetAttribute((const void*)fwd_kernel, hipFuncAttributeMaxDynamicSharedMemorySize, LDS_BYTES);
        hipOccupancyMaxActiveBlocksPerMultiprocessor(&per_cu, (const void*)fwd_kernel, 512, LDS_BYTES);
        if (per_cu < 1) { fprintf(stderr, "kernel_launch: occupancy query says %d blocks/CU\n", per_cu); per_cu = 1; }
        grid_blocks = cus * 1;
        (void)hipGetLastError();
    }
    if (grid_blocks < 0) return;
    hipMemsetAsync((char*)d_ws + WS_CTL, 0, CTL_BYTES, stream);
    Params p{};
    for (int i = 0; i < 28; ++i) p.in[i] = (const float*)d_in[i];
    p.out = (float*)d_out; p.ws = (unsigned char*)d_ws;
    void* args[] = {&p};
    hipError_t e = hipLaunchCooperativeKernel((const void*)fwd_kernel, dim3(grid_blocks), dim3(512), args, LDS_BYTES, stream);
    if (e != hipSuccess) fprintf(stderr, "cooperative launch failed: %s (grid %d)\n", hipGetErrorString(e), grid_blocks);
}
```

```cpp
#include <hip/hip_runtime.h>
#include <hip/hip_cooperative_groups.h>
#include <cstdint>
#include <cstdio>
namespace cg = cooperative_groups;
#define NOPIPE_AB 1
#define FLATQ 1
namespace pg8 {
#define PG8_LAS __attribute__((address_space(3)))
typedef unsigned short bf16_t;
typedef short bf16x8 __attribute__((ext_vector_type(8)));
typedef float f32x4 __attribute__((ext_vector_type(4)));
typedef unsigned u32x4 __attribute__((ext_vector_type(4)));
constexpr int BM = 256, BK = 64, HALF = 128, HTB = HALF * BK * 2  , STAGE_BYTES = 8 * HTB, NXCD = 8, WGM = 8;

__host__ __device__ __forceinline__ int lds_byte(int r, int c) { const int st = (r >> 4) * 2 + (c >> 5), rr = r & 15, cc = c & 31, ob = rr * 64 + cc * 2; return st * 1024 + (ob ^ (((ob >> 9) & 1) << 5)); }
__host__ __device__ __forceinline__ void stage_rc(int b, int& R, int& C) { const int st = b / 1024, sb = b % 1024, swz = sb ^ (((sb >> 9) & 1) << 5); R = (st >> 1) * 16 + swz / 64; C = (st & 1) * 32 + (swz % 64) / 2; }
__host__ __device__ __forceinline__ int perm32(int rho) { const int n = rho >> 4, i = rho & 15; return 8 * (i >> 2) + 4 * n + (i & 3); }

struct Unit { int pm, pn, z; };
struct Gemm { const bf16_t* A; const bf16_t* Bt; int K; size_t zsA, zsB; };

template <class Epi, class Sched, bool ALIGN_EPI = false, bool SP2 = false>
__device__ __forceinline__ void gemm_phase(PG8_LAS unsigned char* lds, const Gemm g, const Sched& S, const Epi& E, const int wv  ) {
    int tid_; asm volatile("v_mbcnt_lo_u32_b32 %0, -1, 0\n\tv_mbcnt_hi_u32_b32 %0, -1, %0" : "=v"(tid_)); tid_ += wv * 64;
    const int tid = tid_, wid = __builtin_amdgcn_readfirstlane(tid >> 6), lane = tid & 63, wr = wid >> 2, wc = wid & 3, fr = lane & 15, fq = lane >> 4;
    const int K = g.K, nt = K / BK;
    unsigned voffA[2], voffB[2];
#pragma unroll
    for (int i = 0; i < 2; ++i) { int R, C; stage_rc(tid * 16 + i * 8192, R, C); const int Rb = Epi::PERM ? ((R & ~31) + perm32(R & 31)) : R;
        voffA[i] = (unsigned)(R * K + C) * 2u; voffB[i] = (unsigned)(Rb * K + C) * 2u; }
    const size_t kstep = (size_t)(BK * 2);
    const size_t hstep = (size_t)HALF * K * 2;
    const size_t tstep = 2 * hstep;
    const unsigned ldsw = (unsigned)wid * 1024u;
    const int aoff = lds_byte(wr * 64 + fr, fq * 8), boff = lds_byte(wc * 32 + fr, fq * 8);
#define PG8_SA(b, h) (((b) * 2 + (h)) * HTB)
#define PG8_SB(b, h) ((4 + (b) * 2 + (h)) * HTB)
#define PG8_STAGE(bufoff, gbase, voff) do { _Pragma("unroll") for (int _i = 0; _i < 2; ++_i) \
        __builtin_amdgcn_global_load_lds((const unsigned*)((const char*)(gbase) + (voff)[_i]), (PG8_LAS unsigned*)(lds + (bufoff) + ldsw + _i * 8192), 16, 0, 0); } while (0)
#define PG8_LDA(dst, b, h) do { _Pragma("unroll") for (int m = 0; m < 4; ++m) _Pragma("unroll") for (int k = 0; k < 2; ++k) dst[m][k] = *(const PG8_LAS bf16x8*)(lds + PG8_SA(b, h) + aoff + m * 2048 + k * 1024); } while (0)
#define PG8_LDB(dst, b, h) do { _Pragma("unroll") for (int n = 0; n < 2; ++n) _Pragma("unroll") for (int k = 0; k < 2; ++k) dst[n][k] = *(const PG8_LAS bf16x8*)(lds + PG8_SB(b, h) + boff + n * 2048 + k * 1024); } while (0)
#define PG8_MMA(ai, bj, At, Bt) do { __builtin_amdgcn_s_setprio(1); _Pragma("unroll") for (int m = 0; m < 4; ++m) _Pragma("unroll") for (int n = 0; n < 2; ++n) _Pragma("unroll") for (int k = 0; k < 2; ++k) \
        acc[ai][bj][m][n] = __builtin_amdgcn_mfma_f32_16x16x32_bf16(Bt[n][k], At[m][k], acc[ai][bj][m][n], 0, 0, 0); __builtin_amdgcn_s_setprio(0); } while (0)
#define PG8_WAIT_V(n) asm volatile("s_waitcnt vmcnt(" #n ")" ::: "memory")
#define PG8_WAIT_L(n) asm volatile("s_waitcnt lgkmcnt(" #n ")" ::: "memory")
#define PG8_BAR __builtin_amdgcn_s_barrier()
#define PG8_SCHED __builtin_amdgcn_sched_barrier(0)
    Unit cur, nxt; int ui = 0;
    if (!S.next(0, cur)) return;
    f32x4 acc[2][2][4][2];
#pragma unroll
    for (int a = 0; a < 2; ++a)
#pragma unroll
        for (int b = 0; b < 2; ++b)
#pragma unroll
            for (int m = 0; m < 4; ++m)
#pragma unroll
                for (int n = 0; n < 2; ++n) acc[a][b][m][n] = (f32x4){0.f, 0.f, 0.f, 0.f};
    bf16x8 At[4][2], B0[2][2], B1[2][2];
    const char* cA = (const char*)(g.A + (size_t)cur.z * g.zsA) + (size_t)cur.pm * tstep; const char* cB = (const char*)(g.Bt + (size_t)cur.z * g.zsB) + (size_t)cur.pn * tstep;
    S.a_ready(cur);
    if constexpr (SP2) {
        PG8_STAGE(PG8_SB(0, 0), cB, voffB); PG8_STAGE(PG8_SB(0, 1), cB + hstep, voffB); PG8_STAGE(PG8_SA(0, 0), cA, voffA); PG8_STAGE(PG8_SA(0, 1), cA + hstep, voffA);
        if (wr == 1) PG8_BAR;
        PG8_WAIT_V(2); PG8_BAR;
        PG8_STAGE(PG8_SB(1, 0), cB + kstep, voffB); PG8_STAGE(PG8_SA(1, 0), cA + kstep, voffA); PG8_STAGE(PG8_SB(1, 1), cB + hstep + kstep, voffB);
        PG8_WAIT_V(6); PG8_BAR;
    } else {
        PG8_STAGE(PG8_SB(0, 0), cB, voffB); PG8_STAGE(PG8_SA(0, 0), cA, voffA); PG8_STAGE(PG8_SB(0, 1), cB + hstep, voffB); PG8_STAGE(PG8_SA(0, 1), cA + hstep, voffA);
        if (wr == 1) PG8_BAR;
        PG8_WAIT_V(4); PG8_BAR;
        PG8_STAGE(PG8_SB(1, 0), cB + kstep, voffB); PG8_STAGE(PG8_SA(1, 0), cA + kstep, voffA); PG8_STAGE(PG8_SB(1, 1), cB + hstep + kstep, voffB);
        PG8_WAIT_V(6); PG8_BAR;
    }
    for (;;) {
        const bool has_next = S.next(ui + 1, nxt);
        const char* nA = has_next ? (const char*)(g.A + (size_t)nxt.z * g.zsA) + (size_t)nxt.pm * tstep : cA; const char* nB = has_next ? (const char*)(g.Bt + (size_t)nxt.z * g.zsB) + (size_t)nxt.pn * tstep : cB;
        for (int t = 0; t < nt; t += 2) {
            const bool last = (t == nt - 2);
            const char* a1 = cA + (size_t)(t + 1) * kstep;
            const char* a2 = last ? nA : cA + (size_t)(t + 2) * kstep; const char* b2 = last ? nB : cB + (size_t)(t + 2) * kstep;
            const char* a3 = a2 + kstep; const char* b3 = b2 + kstep;
            if (last && has_next) S.a_ready(nxt);
            if constexpr (SP2) {
            PG8_LDB(B0, 0, 0); PG8_LDB(B1, 0, 1); PG8_SCHED; PG8_LDA(At, 0, 0); PG8_STAGE(PG8_SA(1, 1), a1 + hstep, voffA);
            PG8_WAIT_V(8); PG8_WAIT_L(0); PG8_BAR; PG8_MMA(0, 0, At, B0); PG8_MMA(0, 1, At, B1); PG8_BAR; PG8_SCHED;
            PG8_LDA(At, 0, 1); PG8_STAGE(PG8_SB(0, 0), b2, voffB); PG8_STAGE(PG8_SB(0, 1), b2 + hstep, voffB); PG8_STAGE(PG8_SA(0, 0), a2, voffA);
            PG8_WAIT_V(8); PG8_WAIT_L(0); PG8_BAR; PG8_MMA(1, 0, At, B0); PG8_MMA(1, 1, At, B1); PG8_BAR; PG8_SCHED;
            PG8_LDB(B0, 1, 0); PG8_LDB(B1, 1, 1); PG8_SCHED; PG8_LDA(At, 1, 0); PG8_STAGE(PG8_SA(0, 1), a2 + hstep, voffA);
            PG8_WAIT_V(8); PG8_WAIT_L(0); PG8_BAR; PG8_MMA(0, 0, At, B0); PG8_MMA(0, 1, At, B1); PG8_BAR; PG8_SCHED;
            PG8_LDA(At, 1, 1); PG8_STAGE(PG8_SB(1, 0), b3, voffB); PG8_STAGE(PG8_SB(1, 1), b3 + hstep, voffB); PG8_STAGE(PG8_SA(1, 0), a3, voffA);
            PG8_WAIT_V(8); PG8_WAIT_L(0); PG8_BAR; PG8_MMA(1, 0, At, B0); PG8_MMA(1, 1, At, B1); PG8_BAR; PG8_SCHED;
            } else {
            PG8_LDB(B0, 0, 0); PG8_SCHED; PG8_LDA(At, 0, 0); PG8_STAGE(PG8_SA(1, 1), a1 + hstep, voffA);
            PG8_WAIT_L(8); PG8_BAR; PG8_WAIT_L(0); PG8_MMA(0, 0, At, B0); PG8_BAR; PG8_SCHED;
            PG8_LDB(B1, 0, 1); PG8_STAGE(PG8_SB(0, 0), b2, voffB);
            PG8_BAR; PG8_WAIT_L(0); PG8_MMA(0, 1, At, B1); PG8_BAR;
            PG8_LDA(At, 0, 1); PG8_STAGE(PG8_SA(0, 0), a2, voffA);
            PG8_BAR; PG8_WAIT_L(0); PG8_MMA(1, 0, At, B0); PG8_BAR; PG8_SCHED;
            PG8_STAGE(PG8_SB(0, 1), b2 + hstep, voffB);
            PG8_WAIT_V(6); PG8_BAR; PG8_MMA(1, 1, At, B1); PG8_BAR;
            PG8_LDB(B0, 1, 0); PG8_SCHED; PG8_LDA(At, 1, 0); PG8_STAGE(PG8_SA(0, 1), a2 + hstep, voffA);
            PG8_WAIT_L(8); PG8_BAR; PG8_WAIT_L(0); PG8_MMA(0, 0, At, B0); PG8_BAR; PG8_SCHED;
            PG8_LDB(B1, 1, 1); PG8_STAGE(PG8_SB(1, 0), b3, voffB);
            PG8_BAR; PG8_WAIT_L(0); PG8_MMA(0, 1, At, B1); PG8_BAR;
            PG8_LDA(At, 1, 1); PG8_STAGE(PG8_SA(1, 0), a3, voffA);
            PG8_BAR; PG8_WAIT_L(0); PG8_MMA(1, 0, At, B0); PG8_BAR; PG8_SCHED;
            PG8_STAGE(PG8_SB(1, 1), b3 + hstep, voffB);
            PG8_WAIT_V(6); PG8_BAR; PG8_MMA(1, 1, At, B1); PG8_BAR;
            }
        }
        if constexpr (ALIGN_EPI) { if (wr == 0) PG8_BAR; }
        if constexpr (!Epi::AFTER_DRAIN) { E(acc, cur, wr, wc, fr, fq); S.done(cur); }
        if (!has_next) break;
#pragma unroll
        for (int a = 0; a < 2; ++a)
#pragma unroll
            for (int b = 0; b < 2; ++b)
#pragma unroll
                for (int m = 0; m < 4; ++m)
#pragma unroll
                    for (int n = 0; n < 2; ++n) acc[a][b][m][n] = (f32x4){0.f, 0.f, 0.f, 0.f};
        cur = nxt; cA = nA; cB = nB; ++ui;
        if constexpr (ALIGN_EPI) { if (wr == 1) PG8_BAR; }
    }
    PG8_WAIT_V(0);
    if constexpr (!ALIGN_EPI) { if (wr == 0) PG8_BAR; }
    PG8_BAR;
    if constexpr (Epi::AFTER_DRAIN) { E.fused(acc, cur, wr, wc, fr, fq, lds, wid, lane); S.done(cur); }
#undef PG8_SA
#undef PG8_SB
#undef PG8_STAGE
#undef PG8_LDA
#undef PG8_LDB
#undef PG8_MMA
#undef PG8_WAIT_V
#undef PG8_WAIT_L
#undef PG8_BAR
#undef PG8_SCHED
}
}


using pg8::bf16_t; using pg8::bf16x8; using pg8::f32x4; using pg8::u32x4;
typedef float f32x16 __attribute__((ext_vector_type(16)));
typedef unsigned u32x2 __attribute__((ext_vector_type(2)));
typedef float f32x2_t __attribute__((ext_vector_type(2)));
typedef __bf16 bf16x2_t __attribute__((ext_vector_type(2)));
#define LAS __attribute__((address_space(3)))
#define DI __device__ __forceinline__

constexpr int DM = 1024, RA = 16896;
constexpr int ZM_LD = 2816, G_LD = 3072, IN_N = 5888;
constexpr float LOG2E = 1.4426950408889634f;
constexpr size_t MiB = 1u << 20;
constexpr size_t WS_CTL = 0, CTL_BYTES = 131072;
constexpr size_t WS_W = 1 * MiB, LW_STRIDE = 34 * MiB;
constexpr size_t W_IN = 0, W_QB = W_IN + (size_t)IN_N * 1024 * 2, W_KVB = W_QB + 768 * 256 * 2, W_BR = W_KVB + 1024 * 128 * 2,
                 W_OUT = W_BR + 3 * 1024 * 512 * 2, W_UP = W_OUT + 1024 * 1024 * 2, W_DOWN = W_UP + 4096 * 1024 * 2, W_END = W_DOWN + 4096 * 1024 * 2;
static_assert(W_END <= LW_STRIDE, "weights");
constexpr size_t WS_META0 = 69 * MiB, WS_METAX = 70 * MiB, WS_XN = 74 * MiB, WS_ZM = 107 * MiB, WS_G = 198 * MiB, WS_QKV = 297 * MiB, WS_SM = 438 * MiB, WS_END = 454 * MiB;
constexpr size_t OFF_QCR = 0, OFF_KVR = 25 * MiB;
constexpr size_t OSLOT = (size_t)RA * 512;
constexpr size_t QA_O = 0, KA_O = 512ull * RA, VA_O = 640ull * RA, QB_O = 768ull * RA, KB_O = 1280ull * RA, VB_O = 1792ull * RA, QC_O = 2304ull * RA, KC_O = 3072ull * RA, VC_O = 3840ull * RA;
constexpr size_t SM_CQN = 0, SM_CKVN = 9 * MiB, SM_KPE = 14 * MiB;
constexpr int LDS_MISC = 131072, LDS_BYTES = 131072 + 256;

struct Params { const float* in[28]; float* out; unsigned char* ws; };

DI unsigned pk2(float lo, float hi) { f32x2_t v = {lo, hi}; bf16x2_t b = __builtin_convertvector(v, bf16x2_t); return __builtin_bit_cast(unsigned, b); }
DI void ld8(const bf16_t* p, float (&f)[8]) {
    const u32x4 r = *(const u32x4*)p;
#pragma unroll
    for (int i = 0; i < 4; ++i) { f[2 * i] = __uint_as_float(r[i] << 16); f[2 * i + 1] = __uint_as_float(r[i] & 0xffff0000u); }
}
DI void st8(bf16_t* p, const float (&f)[8]) { u32x4 w; w.x = pk2(f[0], f[1]); w.y = pk2(f[2], f[3]); w.z = pk2(f[4], f[5]); w.w = pk2(f[6], f[7]); *(u32x4*)p = w; }
DI int lane_fresh() { int l; asm volatile("v_mbcnt_lo_u32_b32 %0, -1, 0\n\tv_mbcnt_hi_u32_b32 %0, -1, %0" : "=v"(l)); return l; }
DI float wave_sum(float v, int lane) {
#pragma unroll
    for (int o = 1; o < 64; o <<= 1) v += __int_as_float(__builtin_amdgcn_ds_bpermute((lane ^ o) << 2, __float_as_int(v)));
    return v;
}
DI float max3f(float a, float b, float c) { float r; asm("v_max3_f32 %0, %1, %2, %3" : "=v"(r) : "v"(a), "v"(b), "v"(c)); return r; }
DI float max2f(float a, float b) { float r; asm("v_max_f32_e32 %0, %1, %2" : "=v"(r) : "v"(a), "v"(b)); return r; }
DI float fadd_s(float a, float b) { float r; asm("v_add_f32_e32 %0, %1, %2" : "=v"(r) : "v"(a), "v"(b)); return r; }
#define MX2(a, b) __builtin_amdgcn_fmed3f((a), (b), __builtin_inff())
DI float swap32_max(float v) { auto rr = __builtin_amdgcn_permlane32_swap(__float_as_uint(v), __float_as_uint(v), false, false); return __builtin_amdgcn_fmed3f(__uint_as_float(rr[0]), __uint_as_float(rr[1]), __builtin_inff()); }
DI float swap32_add(float v) { auto rr = __builtin_amdgcn_permlane32_swap(__float_as_uint(v), __float_as_uint(v), false, false); return __uint_as_float(rr[0]) + __uint_as_float(rr[1]); }
DI constexpr float inv64(int j) {
    constexpr float T[32] = {1.0f, 0.749894209f, 0.562341325f, 0.421696503f, 0.316227766f, 0.237137371f, 0.177827941f, 0.133352143f, 0.1f, 0.0749894209f, 0.0562341325f, 0.0421696503f,
                             0.0316227766f, 0.0237137371f, 0.0177827941f, 0.0133352143f, 0.01f, 0.00749894209f, 0.00562341325f, 0.00421696503f, 0.00316227766f, 0.00237137371f,
                             0.00177827941f, 0.00133352143f, 0.001f, 0.000749894209f, 0.000562341325f, 0.000421696503f, 0.000316227766f, 0.000237137371f, 0.000177827941f, 0.000133352143f};
    return T[j];
}
DI void sincos_ang(float ang, float& s, float& c) {
    double t = (double)ang * 0.15915494309189535; t -= __builtin_rint(t); const float f = (float)t;
    s = __builtin_amdgcn_sinf(f); c = __builtin_amdgcn_cosf(f);
}

struct Chunk {
    int id, nseq, seq0, tps, n;
    DI int rows_per_seq() const { return tps * 256; }
    DI int rows() const { return nseq * tps * 256; }
};
DI Chunk make_chunk(int c) { Chunk k; k.id = c; if (c < 2) { k.nseq = 1; k.seq0 = c; k.tps = 65; k.n = 16384; } else { k.nseq = 2; k.seq0 = 2; k.tps = 33; k.n = 8192; } return k; }
struct XMap {
    float* out; float* metax; const float* xp; const float* xs; const float* meta0; int seq0, tps, first;
    DI float* xw(int pt) const {
        const int hi = pt >= tps ? 1 : 0, s = seq0 + hi, lt = pt - hi * tps;
        if (lt == tps - 1) return metax + (size_t)s * 256 * DM;
        const int ob = (s < 2) ? s * 16384 : 32768 + (s - 2) * 8192;
        return out + ((size_t)ob + (size_t)lt * 256) * DM;
    }
    DI const float* xr(int pt) const {
        if (!first) return xw(pt);
        const int hi = pt >= tps ? 1 : 0, s = seq0 + hi, lt = pt - hi * tps;
        if (lt == tps - 1) return metax + (size_t)s * 256 * DM;
        return (s < 2) ? xp + ((size_t)s * 16384 + (size_t)lt * 256) * DM : xs + ((size_t)(s - 2) * 8192 + (size_t)lt * 256) * DM;
    }
};

struct Sched {
    int nM, nN, nZ, nwg, G, c, ta, tps;
    DI void init(int nseq, int ta_, int tps_, int nN_, int nZ_, int G_, int c_) { ta = ta_; tps = tps_; nM = nseq * ta_; nN = nN_; nZ = nZ_; nwg = nM * nN; G = G_; c = c_; }
    DI bool next(int i, pg8::Unit& u) const {
        const int tl = (i / nZ) * G + c; if (tl >= nwg) return false;
        u.z = i % nZ;
        int wgid = tl; { const int q = nwg / pg8::NXCD, r = nwg % pg8::NXCD, xcd = wgid % pg8::NXCD, off = wgid / pg8::NXCD; wgid = (xcd < r ? xcd * (q + 1) : r * (q + 1) + (xcd - r) * q) + off; }
        const int nig = pg8::WGM * nN, gid = wgid / nig, fm = gid * pg8::WGM, gsz = (nM - fm) < pg8::WGM ? (nM - fm) : pg8::WGM;
        const int pa = fm + ((wgid % nig) % gsz); u.pn = (wgid % nig) / gsz;
        u.pm = pa >= ta ? pa - ta + tps : pa;
        return true;
    }
    DI void a_ready(const pg8::Unit&) const {}
    DI void done(const pg8::Unit&) const {}
};

template <int ACT  > struct EpiBf16 {
    static constexpr bool PERM = true, AFTER_DRAIN = false;
    bf16_t* O; int ldc;
    DI void operator()(const f32x4 (&acc)[2][2][4][2], const pg8::Unit& u, int wr, int wc, int fr_, int fq_) const {
        const int ln_ = lane_fresh(), fr = ln_ & 15, fq = ln_ >> 4;
        const int row0 = u.pm * 256 + wr * 64 + fr, col0 = u.pn * 256 + wc * 32 + 8 * fq;
#pragma unroll
        for (int ai = 0; ai < 2; ++ai)
#pragma unroll
            for (int m = 0; m < 4; ++m) { bf16_t* rowp = O + (size_t)(row0 + ai * 128 + m * 16) * ldc + col0;
#pragma unroll
                for (int bj = 0; bj < 2; ++bj) { f32x4 v0 = acc[ai][bj][m][0], v1 = acc[ai][bj][m][1];
                    if (ACT == 2) {
#pragma unroll
                        for (int k = 0; k < 4; ++k) { const float a = fmaxf(v0[k], 0.f), b = fmaxf(v1[k], 0.f); v0[k] = a * a; v1[k] = b * b; } }
                    u32x4 w; w.x = pk2(v0[0], v0[1]); w.y = pk2(v0[2], v0[3]); w.z = pk2(v1[0], v1[1]); w.w = pk2(v1[2], v1[3]);
                    *(u32x4*)(rowp + bj * 128) = w; } }
    }
};
struct EpiIn {
    static constexpr bool PERM = true, AFTER_DRAIN = false;
    bf16_t* ZM; bf16_t* G; const float* bgate;
    DI void operator()(const f32x4 (&acc)[2][2][4][2], const pg8::Unit& u, int wr, int wc, int fr_, int fq_) const {
        const int ln_ = lane_fresh(), fr = ln_ & 15, fq = ln_ >> 4;
        const bool gate = u.pn >= 11;
        const int row0 = u.pm * 256 + wr * 64 + fr, colt = gate ? (u.pn - 11) * 256 : u.pn * 256, col0 = colt + wc * 32 + 8 * fq, ld = gate ? G_LD : ZM_LD;
        bf16_t* base = gate ? G : ZM;
        f32x4 bv[2][2];
#pragma unroll
        for (int bj = 0; bj < 2; ++bj)
#pragma unroll
            for (int n = 0; n < 2; ++n) bv[bj][n] = gate ? *(const f32x4*)(bgate + col0 + bj * 128 + 4 * n) : (f32x4){0.f, 0.f, 0.f, 0.f};
#pragma unroll
        for (int ai = 0; ai < 2; ++ai)
#pragma unroll
            for (int m = 0; m < 4; ++m) { bf16_t* rowp = base + (size_t)(row0 + ai * 128 + m * 16) * ld + col0;
#pragma unroll
                for (int bj = 0; bj < 2; ++bj) { f32x4 v0 = acc[ai][bj][m][0] + bv[bj][0], v1 = acc[ai][bj][m][1] + bv[bj][1];
                    if (gate) {
#pragma unroll
                        for (int k = 0; k < 4; ++k) { v0[k] = __builtin_amdgcn_rcpf(1.f + __builtin_amdgcn_exp2f(-LOG2E * v0[k])); v1[k] = __builtin_amdgcn_rcpf(1.f + __builtin_amdgcn_exp2f(-LOG2E * v1[k])); } }
                    u32x4 w; w.x = pk2(v0[0], v0[1]); w.y = pk2(v0[2], v0[3]); w.z = pk2(v1[0], v1[1]); w.w = pk2(v1[2], v1[3]);
                    *(u32x4*)(rowp + bj * 128) = w; } }
    }
};
struct EpiBranch {
    static constexpr bool PERM = false, AFTER_DRAIN = false;
    const bf16_t* G; float* MG; bf16_t* MGb;
    DI void operator()(const f32x4 (&acc)[2][2][4][2], const pg8::Unit& u, int wr, int wc, int fr_, int fq_) const {
        const int ln_ = lane_fresh(), fr = ln_ & 15, fq = ln_ >> 4;
        const int row0 = u.pm * 256 + wr * 64 + fr, col0 = u.pn * 256 + wc * 32 + 4 * fq;
#pragma unroll
        for (int ai = 0; ai < 2; ++ai)
#pragma unroll
            for (int m = 0; m < 4; ++m) { const size_t row = (size_t)(row0 + ai * 128 + m * 16);
#pragma unroll
                for (int bj = 0; bj < 2; ++bj)
#pragma unroll
                    for (int n = 0; n < 2; ++n) { const int col = col0 + bj * 128 + n * 16;
                        const u32x2 gr = *(const u32x2*)(G + row * G_LD + u.z * 1024 + col);
                        f32x4 g; g[0] = __uint_as_float(gr.x << 16); g[1] = __uint_as_float(gr.x & 0xffff0000u); g[2] = __uint_as_float(gr.y << 16); g[3] = __uint_as_float(gr.y & 0xffff0000u);
                        f32x4 v = g * acc[ai][bj][m][n];
                        float* mp = MG + row * DM + col;
                        if (u.z > 0) v += *(const f32x4*)mp;
                        if (u.z < 2) *(f32x4*)mp = v;
                        else { u32x2 w; w.x = pk2(v[0], v[1]); w.y = pk2(v[2], v[3]); *(u32x2*)(MGb + row * DM + col) = w; } }
                asm volatile("" ::: "memory"); }
    }
};
struct EpiResid {
    static constexpr bool PERM = false, AFTER_DRAIN = false;
    XMap xm;
    DI void operator()(const f32x4 (&acc)[2][2][4][2], const pg8::Unit& u, int wr, int wc, int fr_, int fq_) const {
        const int ln_ = lane_fresh(), fr = ln_ & 15, fq = ln_ >> 4;
        const float* rd = xm.xr(u.pm); float* wp = xm.xw(u.pm);
        const int row0 = wr * 64 + fr, col0 = u.pn * 256 + wc * 32 + 4 * fq;
#pragma unroll
        for (int ai = 0; ai < 2; ++ai)
#pragma unroll
            for (int m = 0; m < 4; ++m) { const size_t off = (size_t)(row0 + ai * 128 + m * 16) * DM + col0;
#pragma unroll
                for (int bj = 0; bj < 2; ++bj)
#pragma unroll
                    for (int n = 0; n < 2; ++n) { const size_t o = off + bj * 128 + n * 16; *(f32x4*)(wp + o) = *(const f32x4*)(rd + o) + acc[ai][bj][m][n]; }
                asm volatile("" ::: "memory"); }
    }
};

DI void transpose_item(const float* W, int K, int N, bf16_t* WT, int split, int extra, LAS float* scr, int item, int lane) {
    const int nblk = N / 32, kb = item / nblk, nb = item % nblk, k0 = 64 * kb, n0 = 32 * nb;
    const int row_off = (n0 >= split) ? extra : 0;
#pragma unroll 8
    for (int i = 0; i < 32; ++i) { const int kk = 2 * i + (lane >> 5); scr[kk * 33 + (lane & 31)] = W[(size_t)(k0 + kk) * N + n0 + (lane & 31)]; }
    asm volatile("s_waitcnt lgkmcnt(0)" ::: "memory");
    const int c = lane & 7;
#pragma unroll
    for (int j = 0; j < 4; ++j) { const int n = (lane >> 3) + 8 * j; const LAS float* s = scr + (8 * c) * 33 + n;
        u32x4 o; o.x = pk2(s[0 * 33], s[1 * 33]); o.y = pk2(s[2 * 33], s[3 * 33]); o.z = pk2(s[4 * 33], s[5 * 33]); o.w = pk2(s[6 * 33], s[7 * 33]);
        *(u32x4*)(WT + (size_t)(row_off + n0 + n) * K + k0 + 8 * c) = o; }
    asm volatile("s_waitcnt lgkmcnt(0)" ::: "memory");
}
DI void prologue(const Params& p, LAS unsigned char* lds, int gw, int NGW, int wave, int lane) {
    LAS float* scr = (LAS float*)(lds + wave * 16384);
    constexpr int I_IN = 16 * 182, I_QB = 4 * 24, I_KVB = 2 * 32, I_BR = 8 * 32, I_OUT = 16 * 32, I_UP = 16 * 128, I_DN = 64 * 32;
    constexpr int PER_L = I_IN + I_QB + I_KVB + 3 * I_BR + I_OUT + I_UP + I_DN;
    for (int it = gw; it < 2 * PER_L; it += NGW) {
        const int l = it / PER_L; int r = it % PER_L;
        unsigned char* wb = p.ws + WS_W + (size_t)l * LW_STRIDE;
        if (r < I_IN) { transpose_item(p.in[4] + (size_t)l * 1024 * 5824, 1024, 5824, (bf16_t*)(wb + W_IN), 2752, 64, scr, r, lane); continue; } r -= I_IN;
        if (r < I_QB) { transpose_item(p.in[16] + (size_t)l * 256 * 768, 256, 768, (bf16_t*)(wb + W_QB), 1 << 30, 0, scr, r, lane); continue; } r -= I_QB;
        if (r < I_KVB) { transpose_item(p.in[18] + (size_t)l * 128 * 1024, 128, 1024, (bf16_t*)(wb + W_KVB), 1 << 30, 0, scr, r, lane); continue; } r -= I_KVB;
        if (r < 3 * I_BR) { const int b = r / I_BR; transpose_item(p.in[21 + b] + (size_t)l * 512 * 1024, 512, 1024, (bf16_t*)(wb + W_BR) + (size_t)b * 1024 * 512, 1 << 30, 0, scr, r % I_BR, lane); continue; } r -= 3 * I_BR;
        if (r < I_OUT) { transpose_item(p.in[24] + (size_t)l * 1024 * 1024, 1024, 1024, (bf16_t*)(wb + W_OUT), 1 << 30, 0, scr, r, lane); continue; } r -= I_OUT;
        if (r < I_UP) { transpose_item(p.in[26] + (size_t)l * 1024 * 4096, 1024, 4096, (bf16_t*)(wb + W_UP), 1 << 30, 0, scr, r, lane); continue; } r -= I_UP;
        transpose_item(p.in[27] + (size_t)l * 4096 * 1024, 4096, 1024, (bf16_t*)(wb + W_DOWN), 1 << 30, 0, scr, r, lane);
    }
    { float* mx0 = (float*)(p.ws + WS_METAX);
      for (int r = gw; r < 4 * 256; r += NGW) { const int rr = r & 255; f32x4* o = (f32x4*)(mx0 + (size_t)r * DM) + lane;
#pragma unroll
        for (int j = 0; j < 4; ++j) o[64 * j] = (rr < 16) ? ((const f32x4*)(p.in[2] + (size_t)rr * DM))[lane + 64 * j] : (f32x4){0.f, 0.f, 0.f, 0.f}; } }
    float* m0 = (float*)(p.ws + WS_META0);
    for (int r = gw; r < 256; r += NGW) { f32x4* o = (f32x4*)(m0 + (size_t)r * DM) + lane;
#pragma unroll
        for (int j = 0; j < 4; ++j) o[64 * j] = (r < 16) ? ((const f32x4*)(p.in[2] + (size_t)r * DM))[lane + 64 * j] : (f32x4){0.f, 0.f, 0.f, 0.f}; }
}

DI void norm_phase(const XMap& xm, int rows, const float* g, bf16_t* XN, int gw, int NGW, int lane) {
    for (int r = gw; r < rows; r += NGW) {
        const float* xrow = xm.xr(r >> 8) + (size_t)(r & 255) * DM;
        const f32x4* xr = (const f32x4*)xrow + lane;
        f32x4 v[4]; float s = 0.f;
#pragma unroll
        for (int j = 0; j < 4; ++j) { v[j] = xr[64 * j]; s += (v[j].x * v[j].x + v[j].y * v[j].y) + (v[j].z * v[j].z + v[j].w * v[j].w); }
        const float rs = rsqrtf(wave_sum(s, lane) * (1.f / DM) + 1e-6f);
        u32x2* o8 = (u32x2*)(XN + (size_t)r * DM) + lane;
#pragma unroll
        for (int j = 0; j < 4; ++j) { const f32x4 gg = ((const f32x4*)g)[lane + 64 * j]; u32x2 w; w.x = pk2(v[j].x * rs * gg.x, v[j].y * rs * gg.y); w.y = pk2(v[j].z * rs * gg.z, v[j].w * rs * gg.w); o8[64 * j] = w; }
    }
}

template <int W, int W0, int ROPE> DI void norm_task(const bf16_t* s0, const bf16_t* s1, const float* gain, float oscale, bf16_t* dst, float pa, float pb) {
    float ss = 0.f;
#pragma unroll 2
    for (int c = 0; c < W / 8; ++c) { float x[8]; ld8(c < W0 / 8 ? s0 + 8 * c : s1 + 8 * (c - W0 / 8), x);
#pragma unroll
        for (int e = 0; e < 8; ++e) ss += x[e] * x[e]; }
    const float rs = rsqrtf(ss * (1.f / W) + 1e-6f) * oscale;
    constexpr int NPLAIN = ROPE == 1 ? 0 : (ROPE == 2 ? 16 : W / 8);
#pragma unroll 2
    for (int c = 0; c < NPLAIN; ++c) { float x[8]; ld8(c < W0 / 8 ? s0 + 8 * c : s1 + 8 * (c - W0 / 8), x);
#pragma unroll
        for (int e = 0; e < 8; ++e) x[e] *= rs * gain[8 * c + e];
        st8(dst + 8 * c, x); }
    if constexpr (ROPE != 0) {
        constexpr int NB = ROPE == 1 ? 2 : 1, HC = ROPE == 1 ? 2 : 4, C0 = ROPE == 1 ? 0 : 16;
#pragma unroll
        for (int b = 0; b < NB; ++b) { const float pos = b ? pb : pa;
#pragma unroll
            for (int k = 0; k < HC; ++k) { const int c1 = C0 + 2 * HC * b + k, c2 = c1 + HC; float x1[8], x2[8];
                ld8(c1 < W0 / 8 ? s0 + 8 * c1 : s1 + 8 * (c1 - W0 / 8), x1); ld8(c2 < W0 / 8 ? s0 + 8 * c2 : s1 + 8 * (c2 - W0 / 8), x2);
#pragma unroll
                for (int e = 0; e < 8; ++e) { const int j = 8 * k + e; const float inv = ROPE == 1 ? inv64(2 * j) : inv64(j); float sn, cs; sincos_ang(pos * inv, sn, cs);
                    const float y1 = x1[e] * rs * gain[8 * c1 + e], y2 = x2[e] * rs * gain[8 * c2 + e]; x1[e] = y1 * cs - y2 * sn; x2[e] = y2 * cs + y1 * sn; }
                st8(dst + 8 * c1, x1); st8(dst + 8 * c2, x2); } }
    }
}
template <int W> DI void transpose_task(const bf16_t* src, bf16_t* dstT, int row) {
#pragma unroll 2
    for (int c = 0; c < W / 8; ++c) { const u32x4 r = *(const u32x4*)(src + 8 * c);
#pragma unroll
        for (int i = 0; i < 4; ++i) { dstT[(size_t)(8 * c + 2 * i) * RA + row] = (bf16_t)(r[i] & 0xffffu); dstT[(size_t)(8 * c + 2 * i + 1) * RA + row] = (bf16_t)(r[i] >> 16); } }
}
struct RowPos { float lin, row, col; };
DI RowPos row_pos(const Chunk& ck, int r) {
    const int li = r >= ck.rows_per_seq() ? r - ck.rows_per_seq() : r; RowPos p;
    if (li < ck.n) { p.lin = (float)(li + 16); p.row = (float)(li >> 6); p.col = (float)(li & 63); }
    else if (li < ck.n + 16) { p.lin = (float)(li - ck.n); p.row = -1.f; p.col = (float)(li - ck.n); }
    else { p.lin = 0.f; p.row = 0.f; p.col = 0.f; }
    return p;
}

DI void ew1_phase(const Params& p, const Chunk& ck, int l, int gw, int NGW, int lane) {
    unsigned char* ws = p.ws; asm volatile("" : "+s"(ws));
    const bf16_t* ZM = (const bf16_t*)(ws + WS_ZM); bf16_t* QKV = (bf16_t*)(ws + WS_QKV);
    bf16_t* CQN = (bf16_t*)(ws + WS_SM + SM_CQN); bf16_t* CKVN = (bf16_t*)(ws + WS_SM + SM_CKVN); bf16_t* KPE = (bf16_t*)(ws + WS_SM + SM_KPE);
    const int nrb = ck.rows() / 64; const float QS = 0.125f * LOG2E;
    for (int w = gw; w < nrb * 34; w += NGW) {
        const int rb = w / 34, task = w % 34, row = rb * 64 + lane;
        const bf16_t* z = ZM + (size_t)row * ZM_LD; const RowPos ps = row_pos(ck, row);
        if (task < 8) { const int h = task; norm_task<64, 64, 1>(z + 64 * h, z, p.in[6] + l * 64, QS, QKV + QA_O + ((size_t)h * RA + row) * 64, ps.row, ps.col); }
        else if (task < 10) { const int h = task - 8; norm_task<64, 64, 1>(z + 512 + 64 * h, z, p.in[7] + l * 64, 1.f, QKV + KA_O + ((size_t)h * RA + row) * 64, ps.row, ps.col); }
        else if (task < 12) { const int h = task - 10; transpose_task<64>(z + 640 + 64 * h, QKV + VA_O + (size_t)h * 64 * RA, row); }
        else if (task < 20) { const int hm = task - 12; norm_task<64, 64, 0>(z + 768 + 64 * hm, z, p.in[8] + l * 64, QS, QKV + QB_O + ((size_t)hm * RA + row) * 64, 0.f, 0.f); }
        else if (task < 28) { const int hm = task - 20; norm_task<64, 64, 0>(z + 1280 + 64 * hm, z, p.in[9] + l * 64, 1.f, QKV + KB_O + ((size_t)hm * RA + row) * 64, 0.f, 0.f); }
        else if (task < 32) { const int h = task - 28; transpose_task<128>(z + 1792 + 128 * h, QKV + VB_O + (size_t)h * 128 * RA, row); }
        else if (task == 32) { norm_task<256, 256, 0>(z + 2304, z, p.in[15] + l * 256, 1.f, CQN + (size_t)row * 256, 0.f, 0.f); }
        else { norm_task<128, 128, 0>(z + 2560, z, p.in[17] + l * 128, 1.f, CKVN + (size_t)row * 128, 0.f, 0.f);
#pragma unroll
            for (int c = 0; c < 8; ++c) *(u32x4*)(KPE + (size_t)row * 64 + 8 * c) = *(const u32x4*)(z + 2688 + 8 * c); }
    }
}
DI void ew2_phase(const Params& p, const Chunk& ck, int l, int gw, int NGW, int lane) {
    unsigned char* ws = p.ws; asm volatile("" : "+s"(ws));
    const bf16_t* QCR = (const bf16_t*)(ws + WS_ZM + OFF_QCR); const bf16_t* KVR = (const bf16_t*)(ws + WS_ZM + OFF_KVR); const bf16_t* KPE = (const bf16_t*)(ws + WS_SM + SM_KPE);
    bf16_t* QKV = (bf16_t*)(ws + WS_QKV);
    const int nrb = ck.rows() / 64; const float QS = 0.07216878364870322f * LOG2E;
    for (int w = gw; w < nrb * 12; w += NGW) {
        const int rb = w / 12, task = w % 12, row = rb * 64 + lane; const RowPos ps = row_pos(ck, row);
        if (task < 4) { const int h = task; norm_task<192, 192, 2>(QCR + (size_t)row * 768 + 192 * h, QCR, p.in[19] + l * 192, QS, QKV + QC_O + ((size_t)h * RA + row) * 192, ps.lin, 0.f); }
        else if (task < 8) { const int h = task - 4; norm_task<192, 128, 2>(KVR + (size_t)row * 1024 + 256 * h, KPE + (size_t)row * 64, p.in[20] + l * 192, 1.f, QKV + KC_O + ((size_t)h * RA + row) * 192, ps.lin, 0.f); }
        else { const int h = task - 8; transpose_task<128>(KVR + (size_t)row * 1024 + 256 * h + 128, QKV + VC_O + (size_t)h * 128 * RA, row); }
    }
}
DI void ew3_phase(const Params& p, const Chunk& ck, int l, bool last, int gw, int NGW, int lane) {
    unsigned char* ws = p.ws; asm volatile("" : "+s"(ws));
    bf16_t* O1 = (bf16_t*)(ws + WS_ZM) + 1 * OSLOT; const bf16_t* O2 = (const bf16_t*)(ws + WS_ZM) + 3 * OSLOT;
    const float d1 = wave_sum(p.in[10][l * 64 + lane] * p.in[11][l * 64 + lane], lane), d2 = wave_sum(p.in[12][l * 64 + lane] * p.in[13][l * 64 + lane], lane);
    int lz = l; asm volatile("" : "+s"(lz));
    const float lam_init = __uint_as_float(lz == 0 ? 0x3e4ccccdu : 0x3eb60549u)  , lam = expf(d1) - expf(d2) + lam_init, osc = 1.f - lam_init;
    const float* gs = p.in[14] + l * 128;
    const int nrb = ck.rows() / 64;
    for (int w = gw; w < nrb * 4; w += NGW) {
        const int rb = w >> 2, h = w & 3, row = rb * 64 + lane;
        if (last && (row >= ck.rows_per_seq() ? row - ck.rows_per_seq() : row) >= (ck.tps - 1) * 256) continue;
        bf16_t* a = O1 + (size_t)row * 512 + 128 * h; const bf16_t* b = O2 + (size_t)row * 512 + 128 * h;
        float ss = 0.f;
#pragma unroll 2
        for (int c = 0; c < 16; ++c) { float x[8], y[8]; ld8(a + 8 * c, x); ld8(b + 8 * c, y);
#pragma unroll
            for (int e = 0; e < 8; ++e) { const float d = x[e] - lam * y[e]; ss += d * d; } }
        const float rs = rsqrtf(ss * (1.f / 128.f) + 1e-6f) * osc;
#pragma unroll 2
        for (int c = 0; c < 16; ++c) { float x[8], y[8]; ld8(a + 8 * c, x); ld8(b + 8 * c, y);
#pragma unroll
            for (int e = 0; e < 8; ++e) x[e] = (x[e] - lam * y[e]) * rs * gs[8 * c + e];
            st8(a + 8 * c, x); }
    }
}

template <int DQK, int DV, bool ALIBI, bool PIPE>
DI void attn_unit(LAS unsigned char* lds, const bf16_t* __restrict__ Q, const bf16_t* __restrict__ K, const bf16_t* __restrict__ Vt, bf16_t* __restrict__ O, int r0, int qb, int n, float sl, const int wid) {
    constexpr bool EARLYV = true;
    constexpr bool NEGM = (DQK == 64);
    constexpr int KROW = DQK * 2 + 16, KT = 64 * KROW, VROW = 144, VT = DV * VROW, KCH = DQK / 8, NKC = 64 * KCH / 512, NVC = DV * 8 / 512, NKS = DQK / 16, NDB = DV / 32, VB0 = 2 * KT;
    typedef const __attribute__((address_space(1))) u32x4* gptr;
    const int lane = lane_fresh(), tid = wid * 64 + lane, r = lane & 31, h = lane >> 5;
    const int nk = n + 16, NT = (nk + 63) >> 6;
    const int li = qb * 256 + wid * 32 + r;
    const bool active = (qb * 256 + wid * 32) < nk;
    const int qrow = r0 + li;
    const float qlin = (li < n) ? (float)(li + 16) : (li < nk ? (float)(li - n) : 0.f);
    bf16x8 qf[NKS];
#pragma unroll
    for (int ks = 0; ks < NKS; ++ks) qf[ks] = *(const bf16x8*)(Q + (size_t)qrow * DQK + ks * 16 + h * 8);
    f32x16 o[NDB];
#pragma unroll
    for (int d = 0; d < NDB; ++d)
#pragma unroll
        for (int i = 0; i < 16; ++i) o[d][i] = 0.f;
    float m = 0.f, l = 0.f; f32x16 negm, zero16;
#pragma unroll
    for (int i = 0; i < 16; ++i) { negm[i] = 0.f; zero16[i] = 0.f; }
    const bf16_t* kg0 = K + (size_t)r0 * DQK + tid * 8; const bf16_t* vg0 = Vt + (size_t)(tid >> 3) * RA + r0 + (tid & 7) * 8; const int vl0 = VB0 + (tid >> 3) * VROW + (tid & 7) * 16;
#define KL(i) ((((tid + 512 * (i)) / KCH) * KROW) + ((tid + 512 * (i)) % KCH) * 16)
#define KG(i, t) ((gptr)(kg0 + (i) * 4096 + (size_t)(t) * 64 * DQK))
#define VG(i, t) ((gptr)(vg0 + (size_t)(i) * 64 * RA + (size_t)(t) * 64))
#define VL(i) (vl0 + (i) * 64 * VROW)
    const int pr = (r & ~12) | ((r & 4) << 1) | ((r & 8) >> 1);
    const int kaddr = pr * KROW + h * 16, vaddr = VB0 + r * VROW + h * 16;
    u32x4 kst[NKC], vst[NVC], kstn[NKC], vstn[NVC];
#define QK_TILE(A0, A1, kb_) do { const int ko_ = (kb_) * KT + kaddr; \
        _Pragma("unroll") for (int kb4 = 0; kb4 < NKS; kb4 += 4) { bf16x8 kq[8]; \
            _Pragma("unroll") for (int j = 0; j < 4; ++j) { kq[2 * j] = *(const LAS bf16x8*)(lds + ko_ + (kb4 + j) * 32); kq[2 * j + 1] = *(const LAS bf16x8*)(lds + ko_ + 32 * KROW + (kb4 + j) * 32); } \
            asm volatile("" : "+v"(kq[0]), "+v"(kq[1]), "+v"(kq[2]), "+v"(kq[3]), "+v"(kq[4]), "+v"(kq[5]), "+v"(kq[6]), "+v"(kq[7]));     \
            _Pragma("unroll") for (int j = 0; j < 4; ++j) { \
                if (kb4 + j == 0) { A0 = __builtin_amdgcn_mfma_f32_32x32x16_bf16(kq[0], qf[0], NEGM ? negm : zero16, 0, 0, 0); A1 = __builtin_amdgcn_mfma_f32_32x32x16_bf16(kq[1], qf[0], NEGM ? negm : zero16, 0, 0, 0); } \
                else { A0 = __builtin_amdgcn_mfma_f32_32x32x16_bf16(kq[2 * j], qf[kb4 + j], A0, 0, 0, 0); A1 = __builtin_amdgcn_mfma_f32_32x32x16_bf16(kq[2 * j + 1], qf[kb4 + j], A1, 0, 0, 0); } } \
            __builtin_amdgcn_sched_barrier(0); } } while (0)
#pragma unroll
    for (int i = 0; i < NKC; ++i) kst[i] = *KG(i, 0);
#pragma unroll
    for (int i = 0; i < NVC; ++i) vst[i] = *VG(i, 0);
#pragma unroll
    for (int i = 0; i < NKC; ++i) *(LAS u32x4*)(lds + KL(i)) = kst[i];
#pragma unroll
    for (int i = 0; i < NVC; ++i) *(LAS u32x4*)(lds + VL(i)) = vst[i];
    if constexpr (PIPE) {
#pragma unroll
        for (int i = 0; i < NKC; ++i) kst[i] = *KG(i, 1);
#pragma unroll
        for (int i = 0; i < NKC; ++i) *(LAS u32x4*)(lds + KT + KL(i)) = kst[i];
#pragma unroll
        for (int i = 0; i < NKC; ++i) kst[i] = *KG(i, 2);
#pragma unroll
        for (int i = 0; i < NVC; ++i) vst[i] = *VG(i, 1);
    }
    __syncthreads();
    f32x16 s0, s1, n0, n1;
    if constexpr (PIPE) { QK_TILE(s0, s1, 0); __syncthreads(); }
    for (int t = 0; t < NT; ++t) {
        const int cb = t & 1;
        const bool moreV = (t + 1 < NT), moreK = PIPE ? (t + 2 < NT) : moreV;
        if constexpr (PIPE) {
            if (t + 3 < NT) {
#pragma unroll
                for (int i = 0; i < NKC; ++i) kstn[i] = *KG(i, t + 3);
            }
            if (t + 2 < NT) {
#pragma unroll
                for (int i = 0; i < NVC; ++i) vstn[i] = *VG(i, t + 2);
            }
        } else {
            if (moreK) {
#pragma unroll
                for (int i = 0; i < NKC; ++i) kst[i] = *KG(i, t + 1);
            }
            if (moreV) {
#pragma unroll
                for (int i = 0; i < NVC; ++i) vst[i] = *VG(i, t + 1);
            }
#ifdef PROBE_MEM2
            { int zo = 0; asm volatile("" : "+v"(zo));
              if (moreK) {
#pragma unroll
                for (int i = 0; i < NKC; ++i) { u32x4 d = *(KG(i, t + 1) + zo); asm volatile("" :: "v"(d)); } }
              if (moreV) {
#pragma unroll
                for (int i = 0; i < NVC; ++i) { u32x4 d = *(VG(i, t + 1) + zo); asm volatile("" :: "v"(d)); } } }
#endif
        }
        if (active) {
        if constexpr (PIPE) { if (moreV) QK_TILE(n0, n1, cb ^ 1); }
        else QK_TILE(s0, s1, cb);
        bf16x8 vf0[8];
        if constexpr (EARLYV) {
#pragma unroll
            for (int j = 0; j < 8; ++j) vf0[j] = *(const LAS bf16x8*)(lds + cb * VT + vaddr + (j >> 2) * 32 * VROW + (j & 3) * 32);
        }
        if (t < NT - 1) {
            if constexpr (ALIBI) {
                const float qo = qlin - (float)(16 + 8 * h + t * 64);
#pragma unroll
                for (int i = 0; i < 16; ++i) { const float ci = (float)(16 * (i >> 3) + (i & 7)); s0[i] = __builtin_fmaf(-sl, __builtin_fabsf(qo - ci), s0[i]); s1[i] = __builtin_fmaf(-sl, __builtin_fabsf(qo - 32.f - ci), s1[i]); }
            }
        } else {
#pragma unroll
            for (int i = 0; i < 16; ++i) { const int kk = 16 * (i >> 3) + 8 * h + (i & 7);
                if (kk < 16) { if constexpr (ALIBI) s0[i] = __builtin_fmaf(-sl, __builtin_fabsf(qlin - (float)kk), s0[i]); } else s0[i] = -1e30f;
                s1[i] = -1e30f; }
        }
        float mx;
        { float a = MX2(s0[0], s1[0]), b = MX2(s0[1], s1[1]);
#pragma unroll
          for (int i = 2; i < 16; i += 2) { a = MX2(a, MX2(s0[i], s1[i])); b = MX2(b, MX2(s0[i + 1], s1[i + 1])); }
          mx = swap32_max(MX2(a, b)); }
        if constexpr (!NEGM) mx -= m;
        if (__builtin_expect(t == 0 || __builtin_amdgcn_ballot_w64(mx > 8.f) != 0ull, 0)) {
            const float dl = (t == 0) ? mx : fmaxf(mx, 0.f);
            m += dl;
            if constexpr (NEGM) {
#pragma unroll
                for (int i = 0; i < 16; ++i) { s0[i] -= dl; s1[i] -= dl; negm[i] = -m; } }
            if constexpr (PIPE) {
#pragma unroll
                for (int i = 0; i < 16; ++i) { n0[i] -= dl; n1[i] -= dl; } }
            if (t != 0) { const float f = __builtin_amdgcn_exp2f(-dl); l *= f;
#pragma unroll
                for (int d = 0; d < NDB; ++d)
#pragma unroll
                    for (int i = 0; i < 16; ++i) o[d][i] *= f; }
            asm volatile("" ::: "memory");
        }
        float ra = 0.f, rb = 0.f;
#pragma unroll
        for (int i = 0; i < 16; ++i) { s0[i] = __builtin_amdgcn_exp2f(NEGM ? s0[i] : s0[i] - m); s1[i] = __builtin_amdgcn_exp2f(NEGM ? s1[i] : s1[i] - m); ra += s0[i]; rb += s1[i]; }
        l += ra + rb;
        bf16x8 pf[4];
        { u32x4 w;
          w.x = pk2(s0[0], s0[1]); w.y = pk2(s0[2], s0[3]); w.z = pk2(s0[4], s0[5]); w.w = pk2(s0[6], s0[7]); pf[0] = __builtin_bit_cast(bf16x8, w);
          w.x = pk2(s0[8], s0[9]); w.y = pk2(s0[10], s0[11]); w.z = pk2(s0[12], s0[13]); w.w = pk2(s0[14], s0[15]); pf[1] = __builtin_bit_cast(bf16x8, w);
          w.x = pk2(s1[0], s1[1]); w.y = pk2(s1[2], s1[3]); w.z = pk2(s1[4], s1[5]); w.w = pk2(s1[6], s1[7]); pf[2] = __builtin_bit_cast(bf16x8, w);
          w.x = pk2(s1[8], s1[9]); w.y = pk2(s1[10], s1[11]); w.z = pk2(s1[12], s1[13]); w.w = pk2(s1[14], s1[15]); pf[3] = __builtin_bit_cast(bf16x8, w); }
#pragma unroll
        for (int d0 = 0; d0 < NDB; d0 += 2) { bf16x8 vf[8];
#pragma unroll
            for (int j = 0; j < 8; ++j) { if (EARLYV && d0 == 0) vf[j] = vf0[j]; else vf[j] = *(const LAS bf16x8*)(lds + cb * VT + vaddr + (d0 + (j >> 2)) * 32 * VROW + (j & 3) * 32); }
            asm volatile("" : "+v"(vf[0]), "+v"(vf[1]), "+v"(vf[2]), "+v"(vf[3]), "+v"(vf[4]), "+v"(vf[5]), "+v"(vf[6]), "+v"(vf[7]));
#pragma unroll
            for (int j = 0; j < 8; ++j) o[d0 + (j >> 2)] = __builtin_amdgcn_mfma_f32_32x32x16_bf16(vf[j], pf[j & 3], o[d0 + (j >> 2)], 0, 0, 0);
            __builtin_amdgcn_sched_barrier(0); }
        }
        if (moreK) {
#pragma unroll
            for (int i = 0; i < NKC; ++i) *(LAS u32x4*)(lds + (PIPE ? cb : (cb ^ 1)) * KT + KL(i)) = kst[i];
        }
        if (moreV) {
#pragma unroll
            for (int i = 0; i < NVC; ++i) *(LAS u32x4*)(lds + (cb ^ 1) * VT + VL(i)) = vst[i];
        }
        asm volatile("s_waitcnt lgkmcnt(0)" ::: "memory"); __builtin_amdgcn_s_barrier(); asm volatile("" ::: "memory");
        if constexpr (PIPE) { s0 = n0; s1 = n1;
#pragma unroll
            for (int i = 0; i < NKC; ++i) kst[i] = kstn[i];
#pragma unroll
            for (int i = 0; i < NVC; ++i) vst[i] = vstn[i]; }
    }
    l = swap32_add(l);
    const float il = 1.f / l;
    bf16_t* orow = O + (size_t)qrow * 512;
    if (active)
#pragma unroll
    for (int d = 0; d < NDB; ++d)
#pragma unroll
        for (int g = 0; g < 4; ++g) { u32x2 w; w.x = pk2(o[d][4 * g] * il, o[d][4 * g + 1] * il); w.y = pk2(o[d][4 * g + 2] * il, o[d][4 * g + 3] * il);
            *(u32x2*)(orow + 32 * d + 8 * g + 4 * h) = w; }
#undef KG
#undef KL
#undef VG
#undef VL
#undef QK_TILE
}

template <int DV, bool ALIBI>
DI void attn_unit2(LAS unsigned char* lds, const bf16_t* __restrict__ Q, const bf16_t* __restrict__ K, const bf16_t* __restrict__ Vt, bf16_t* __restrict__ O, int r0, int qb, int n, float sl, const int wid) {
    constexpr int DQK = 64, KROW = DQK * 2 + 16, KT = 64 * KROW, VROW = 144, VT = DV * VROW, NVC = DV * 8 / 512, NKS = 4, NDB = DV / 32, VB0 = 2 * KT;
    typedef const __attribute__((address_space(1))) u32x4* gptr;
    const int lane = lane_fresh(), tid = wid * 64 + lane, r = lane & 31, h = lane >> 5;
    const int nk = n + 16, NT = (nk + 63) >> 6;
    const int li = qb * 256 + wid * 32 + r;
    const int qrow = r0 + li;
    const float qlin = (li < n) ? (float)(li + 16) : (li < nk ? (float)(li - n) : 0.f);
    bf16x8 qf[NKS];
#pragma unroll
    for (int ks = 0; ks < NKS; ++ks) qf[ks] = *(const bf16x8*)(Q + (size_t)qrow * DQK + ks * 16 + h * 8);
    f32x16 o[NDB];
#pragma unroll
    for (int d = 0; d < NDB; ++d)
#pragma unroll
        for (int i = 0; i < 16; ++i) o[d][i] = 0.f;
    float m = 0.f, l = 0.f; f32x16 negm;
#pragma unroll
    for (int i = 0; i < 16; ++i) negm[i] = 0.f;
    const bf16_t* kg0 = K + (size_t)r0 * DQK + tid * 8; const bf16_t* vg0 = Vt + (size_t)(tid >> 3) * RA + r0 + (tid & 7) * 8;
    const int kl0 = (tid >> 3) * KROW + (tid & 7) * 16, vl0 = VB0 + (tid >> 3) * VROW + (tid & 7) * 16;
#define KG2(t) ((gptr)(kg0 + (size_t)(t) * 64 * DQK))
#define VG2(i, t) ((gptr)(vg0 + (size_t)(i) * 64 * RA + (size_t)(t) * 64))
    const int pr = (r & ~12) | ((r & 4) << 1) | ((r & 8) >> 1);
    const int kaddr = pr * KROW + h * 16, vaddr = VB0 + r * VROW + h * 16;
    u32x4 kst, vst[NVC];
    bf16x8 kf[8];
#define LDK(kb_) do { _Pragma("unroll") for (int ks = 0; ks < 4; ++ks) { kf[2 * ks] = *(const LAS bf16x8*)(lds + (kb_) * KT + kaddr + ks * 32); kf[2 * ks + 1] = *(const LAS bf16x8*)(lds + (kb_) * KT + kaddr + 32 * KROW + ks * 32); } \
        asm volatile("" : "+v"(kf[0]), "+v"(kf[1]), "+v"(kf[2]), "+v"(kf[3]), "+v"(kf[4]), "+v"(kf[5]), "+v"(kf[6]), "+v"(kf[7])); } while (0)
#define QKM(A0, A1) do { A0 = __builtin_amdgcn_mfma_f32_32x32x16_bf16(kf[0], qf[0], negm, 0, 0, 0); A1 = __builtin_amdgcn_mfma_f32_32x32x16_bf16(kf[1], qf[0], negm, 0, 0, 0); \
        _Pragma("unroll") for (int ks = 1; ks < 4; ++ks) { A0 = __builtin_amdgcn_mfma_f32_32x32x16_bf16(kf[2 * ks], qf[ks], A0, 0, 0, 0); A1 = __builtin_amdgcn_mfma_f32_32x32x16_bf16(kf[2 * ks + 1], qf[ks], A1, 0, 0, 0); } } while (0)
#define PV2(vb_, d0_) do { bf16x8 vf[8]; \
        _Pragma("unroll") for (int j = 0; j < 8; ++j) vf[j] = *(const LAS bf16x8*)(lds + (vb_) * VT + vaddr + ((d0_) + (j >> 2)) * 32 * VROW + (j & 3) * 32); \
        asm volatile("" : "+v"(vf[0]), "+v"(vf[1]), "+v"(vf[2]), "+v"(vf[3]), "+v"(vf[4]), "+v"(vf[5]), "+v"(vf[6]), "+v"(vf[7])); \
        _Pragma("unroll") for (int j = 0; j < 8; ++j) o[(d0_) + (j >> 2)] = __builtin_amdgcn_mfma_f32_32x32x16_bf16(vf[j], pf[j & 3], o[(d0_) + (j >> 2)], 0, 0, 0); } while (0)
    kst = *KG2(0);
#pragma unroll
    for (int i = 0; i < NVC; ++i) vst[i] = *VG2(i, 0);
    *(LAS u32x4*)(lds + kl0) = kst;
#pragma unroll
    for (int i = 0; i < NVC; ++i) *(LAS u32x4*)(lds + vl0 + i * 64 * VROW) = vst[i];
    kst = *KG2(1);
    *(LAS u32x4*)(lds + KT + kl0) = kst;
    __syncthreads();
    f32x16 s0, s1, n0, n1;
    bf16x8 pf[4];
    LDK(0); QKM(s0, s1);
    __syncthreads();
    int vcur = 0;
    for (int t = 0; t < NT; ++t) {
        const int cb = t & 1;
        const bool moreV = (t + 1 < NT), moreK = (t + 2 < NT);
        const int vprev = (vcur == 0) ? 2 : vcur - 1, vnext = (vcur == 2) ? 0 : vcur + 1;
        if (moreK) kst = *KG2(t + 2);
        if (moreV) {
#pragma unroll
            for (int i = 0; i < NVC; ++i) vst[i] = *VG2(i, t + 1);
        }
#ifdef PROBE_MEM2
        { int zo = 0; asm volatile("" : "+v"(zo));
          if (moreK) { u32x4 d = *(KG2(t + 2) + zo); asm volatile("" :: "v"(d)); }
          if (moreV) {
#pragma unroll
            for (int i = 0; i < NVC; ++i) { u32x4 d = *(VG2(i, t + 1) + zo); asm volatile("" :: "v"(d)); } } }
#endif
        __builtin_amdgcn_s_setprio(1);
        if (moreV) { LDK(cb ^ 1); QKM(n0, n1); }
        if (t > 0) { PV2(vprev, 0); if constexpr (NDB == 4) PV2(vprev, 2); }
        __builtin_amdgcn_s_setprio(0);
        if (t < NT - 1) {
            if constexpr (ALIBI) {
                const float qo = qlin - (float)(16 + 8 * h + t * 64);
#pragma unroll
                for (int i = 0; i < 16; ++i) { const float ci = (float)(16 * (i >> 3) + (i & 7)); s0[i] = __builtin_fmaf(-sl, __builtin_fabsf(qo - ci), s0[i]); s1[i] = __builtin_fmaf(-sl, __builtin_fabsf(qo - 32.f - ci), s1[i]); }
            }
        } else {
#pragma unroll
            for (int i = 0; i < 16; ++i) { const int kk = 16 * (i >> 3) + 8 * h + (i & 7);
                if (kk < 16) { if constexpr (ALIBI) s0[i] = __builtin_fmaf(-sl, __builtin_fabsf(qlin - (float)kk), s0[i]); } else s0[i] = -1e30f;
                s1[i] = -1e30f; }
        }
        float mx;
        { float a = MX2(s0[0], s1[0]), b = MX2(s0[1], s1[1]);
#pragma unroll
          for (int i = 2; i < 16; i += 2) { a = MX2(a, MX2(s0[i], s1[i])); b = MX2(b, MX2(s0[i + 1], s1[i + 1])); }
          mx = swap32_max(MX2(a, b)); }
        if (__builtin_expect(t == 0 || __builtin_amdgcn_ballot_w64(mx > 8.f) != 0ull, 0)) {
            const float dl = (t == 0) ? mx : fmaxf(mx, 0.f);
            m += dl;
#pragma unroll
            for (int i = 0; i < 16; ++i) { s0[i] -= dl; s1[i] -= dl; n0[i] -= dl; n1[i] -= dl; negm[i] = -m; }
            if (t != 0) { const float f = __builtin_amdgcn_exp2f(-dl); l *= f;
#pragma unroll
                for (int d = 0; d < NDB; ++d)
#pragma unroll
                    for (int i = 0; i < 16; ++i) o[d][i] *= f; }
            asm volatile("" ::: "memory");
        }
        float ra = 0.f, rb = 0.f;
#pragma unroll
        for (int i = 0; i < 16; ++i) { s0[i] = __builtin_amdgcn_exp2f(s0[i]); s1[i] = __builtin_amdgcn_exp2f(s1[i]); ra += s0[i]; rb += s1[i]; }
        l += ra + rb;
        { u32x4 w;
          w.x = pk2(s0[0], s0[1]); w.y = pk2(s0[2], s0[3]); w.z = pk2(s0[4], s0[5]); w.w = pk2(s0[6], s0[7]); pf[0] = __builtin_bit_cast(bf16x8, w);
          w.x = pk2(s0[8], s0[9]); w.y = pk2(s0[10], s0[11]); w.z = pk2(s0[12], s0[13]); w.w = pk2(s0[14], s0[15]); pf[1] = __builtin_bit_cast(bf16x8, w);
          w.x = pk2(s1[0], s1[1]); w.y = pk2(s1[2], s1[3]); w.z = pk2(s1[4], s1[5]); w.w = pk2(s1[6], s1[7]); pf[2] = __builtin_bit_cast(bf16x8, w);
          w.x = pk2(s1[8], s1[9]); w.y = pk2(s1[10], s1[11]); w.z = pk2(s1[12], s1[13]); w.w = pk2(s1[14], s1[15]); pf[3] = __builtin_bit_cast(bf16x8, w); }
        if (moreK) *(LAS u32x4*)(lds + cb * KT + kl0) = kst;
        if (moreV) {
#pragma unroll
            for (int i = 0; i < NVC; ++i) *(LAS u32x4*)(lds + vnext * VT + vl0 + i * 64 * VROW) = vst[i];
        }
        asm volatile("s_waitcnt lgkmcnt(0)" ::: "memory"); __builtin_amdgcn_s_barrier(); asm volatile("" ::: "memory");
        s0 = n0; s1 = n1; vcur = vnext;
    }
    { const int vlast = (vcur == 0) ? 2 : vcur - 1; PV2(vlast, 0); if constexpr (NDB == 4) PV2(vlast, 2); }
    asm volatile("s_waitcnt lgkmcnt(0)" ::: "memory"); __builtin_amdgcn_s_barrier(); asm volatile("" ::: "memory");
    l = swap32_add(l);
    const float il = 1.f / l;
    bf16_t* orow = O + (size_t)qrow * 512;
#pragma unroll
    for (int d = 0; d < NDB; ++d)
#pragma unroll
        for (int g = 0; g < 4; ++g) { u32x2 w; w.x = pk2(o[d][4 * g] * il, o[d][4 * g + 1] * il); w.y = pk2(o[d][4 * g + 2] * il, o[d][4 * g + 3] * il);
            *(u32x2*)(orow + 32 * d + 8 * g + 4 * h) = w; }
#undef KG2
#undef VG2
#undef LDK
#undef QKM
#undef PV2
}


template <int DQK, int DV, bool ALIBI>
DI void attn_unit_s(LAS unsigned char* lds, const bf16_t* __restrict__ Q, const bf16_t* __restrict__ K, const bf16_t* __restrict__ Vt, bf16_t* __restrict__ O, int r0, int qb, int n, float sl, const int wid) {
    constexpr bool NEGM = (DQK == 64);
    constexpr int KROW = DQK * 2 + 16, KT = 64 * KROW, VROW = 144, VT = DV * VROW, KCH = DQK / 8, NKC = 64 * KCH / 512, NVC = DV * 8 / 512, NKS = DQK / 16, NDB = DV / 32, VB0 = 2 * KT;
    typedef const __attribute__((address_space(1))) u32x4* gptr;
#define LBAR() do { asm volatile("s_waitcnt lgkmcnt(0)" ::: "memory"); __builtin_amdgcn_s_barrier(); asm volatile("" ::: "memory"); } while (0)
#ifdef GRP_ODD
    const int grp_ = wid & 1;
#else
    const int grp_ = wid >> 2;
#endif
    const int lane = lane_fresh(), tid = wid * 64 + lane, r = lane & 31, h = lane >> 5, grp = grp_;
    const int nk = n + 16, NT = (nk + 63) >> 6;
    const int li = qb * 256 + wid * 32 + r;
    const int qrow = r0 + li;
    const float qlin = (li < n) ? (float)(li + 16) : (li < nk ? (float)(li - n) : 0.f);
    bf16x8 qf[NKS];
#pragma unroll
    for (int ks = 0; ks < NKS; ++ks) qf[ks] = *(const bf16x8*)(Q + (size_t)qrow * DQK + ks * 16 + h * 8);
    f32x16 o[NDB];
#pragma unroll
    for (int d = 0; d < NDB; ++d)
#pragma unroll
        for (int i = 0; i < 16; ++i) o[d][i] = 0.f;
    float m = 0.f, l = 0.f; f32x16 negm, zero16;
#pragma unroll
    for (int i = 0; i < 16; ++i) { negm[i] = 0.f; zero16[i] = 0.f; }
    const bf16_t* kg0 = K + (size_t)r0 * DQK + tid * 8; const bf16_t* vg0 = Vt + (size_t)(tid >> 3) * RA + r0 + (tid & 7) * 8; const int vl0 = VB0 + (tid >> 3) * VROW + (tid & 7) * 16;
#define KL(i) ((((tid + 512 * (i)) / KCH) * KROW) + ((tid + 512 * (i)) % KCH) * 16)
#define KG(i, t) ((gptr)(kg0 + (i) * 4096 + (size_t)(t) * 64 * DQK))
#define VG(i, t) ((gptr)(vg0 + (size_t)(i) * 64 * RA + (size_t)(t) * 64))
#define VL(i) (vl0 + (i) * 64 * VROW)
    const int pr = (r & ~12) | ((r & 4) << 1) | ((r & 8) >> 1);
    const int kaddr = pr * KROW + h * 16, vaddr = VB0 + r * VROW + h * 16;
    u32x4 kst[NKC], vst[NVC];
#pragma unroll
    for (int i = 0; i < NKC; ++i) kst[i] = *KG(i, 0);
#pragma unroll
    for (int i = 0; i < NKC; ++i) *(LAS u32x4*)(lds + KL(i)) = kst[i];
#pragma unroll
    for (int i = 0; i < NKC; ++i) kst[i] = *KG(i, 1);
#pragma unroll
    for (int i = 0; i < NVC; ++i) vst[i] = *VG(i, 0);
    __syncthreads();
    if (grp == 1) LBAR();
    f32x16 s0, s1; bf16x8 pf[4];
    for (int t = 0; t < NT; ++t) {
        const int cb = t & 1;
        { const int ko_ = cb * KT + kaddr;
#pragma unroll
          for (int kb4 = 0; kb4 < NKS; kb4 += 4) { bf16x8 kq[8];
#pragma unroll
            for (int j = 0; j < 4; ++j) { kq[2 * j] = *(const LAS bf16x8*)(lds + ko_ + (kb4 + j) * 32); kq[2 * j + 1] = *(const LAS bf16x8*)(lds + ko_ + 32 * KROW + (kb4 + j) * 32); }
            asm volatile("" : "+v"(kq[0]), "+v"(kq[1]), "+v"(kq[2]), "+v"(kq[3]), "+v"(kq[4]), "+v"(kq[5]), "+v"(kq[6]), "+v"(kq[7]));
#pragma unroll
            for (int j = 0; j < 4; ++j) {
                if (kb4 + j == 0) { s0 = __builtin_amdgcn_mfma_f32_32x32x16_bf16(kq[0], qf[0], NEGM ? negm : zero16, 0, 0, 0); s1 = __builtin_amdgcn_mfma_f32_32x32x16_bf16(kq[1], qf[0], NEGM ? negm : zero16, 0, 0, 0); }
                else { s0 = __builtin_amdgcn_mfma_f32_32x32x16_bf16(kq[2 * j], qf[kb4 + j], s0, 0, 0, 0); s1 = __builtin_amdgcn_mfma_f32_32x32x16_bf16(kq[2 * j + 1], qf[kb4 + j], s1, 0, 0, 0); } }
            __builtin_amdgcn_sched_barrier(0); } }
        if (t > 0) {
#pragma unroll
            for (int d0 = 0; d0 < NDB; d0 += 2) { bf16x8 vf[8];
#pragma unroll
                for (int j = 0; j < 8; ++j) vf[j] = *(const LAS bf16x8*)(lds + (cb ^ 1) * VT + vaddr + (d0 + (j >> 2)) * 32 * VROW + (j & 3) * 32);
                asm volatile("" : "+v"(vf[0]), "+v"(vf[1]), "+v"(vf[2]), "+v"(vf[3]), "+v"(vf[4]), "+v"(vf[5]), "+v"(vf[6]), "+v"(vf[7]));
#pragma unroll
                for (int j = 0; j < 8; ++j) o[d0 + (j >> 2)] = __builtin_amdgcn_mfma_f32_32x32x16_bf16(vf[j], pf[j & 3], o[d0 + (j >> 2)], 0, 0, 0);
                __builtin_amdgcn_sched_barrier(0); }
        }
        if (t + 1 < NT) {
#pragma unroll
            for (int i = 0; i < NKC; ++i) *(LAS u32x4*)(lds + (cb ^ 1) * KT + KL(i)) = kst[i];
        }
#pragma unroll
        for (int i = 0; i < NVC; ++i) *(LAS u32x4*)(lds + cb * VT + VL(i)) = vst[i];
        LBAR();
        if (t + 2 < NT) {
#pragma unroll
            for (int i = 0; i < NKC; ++i) kst[i] = *KG(i, t + 2);
        }
        if (t + 1 < NT) {
#pragma unroll
            for (int i = 0; i < NVC; ++i) vst[i] = *VG(i, t + 1);
        }
        if (t < NT - 1) {
            if constexpr (ALIBI) {
                const float qo = qlin - (float)(16 + 8 * h + t * 64);
#pragma unroll
                for (int i = 0; i < 16; ++i) { const float ci = (float)(16 * (i >> 3) + (i & 7)); s0[i] = __builtin_fmaf(-sl, __builtin_fabsf(qo - ci), s0[i]); s1[i] = __builtin_fmaf(-sl, __builtin_fabsf(qo - 32.f - ci), s1[i]); }
            }
        } else {
#pragma unroll
            for (int i = 0; i < 16; ++i) { const int kk = 16 * (i >> 3) + 8 * h + (i & 7);
                if (kk < 16) { if constexpr (ALIBI) s0[i] = __builtin_fmaf(-sl, __builtin_fabsf(qlin - (float)kk), s0[i]); } else s0[i] = -1e30f;
                s1[i] = -1e30f; }
        }
        float mx;
        { float a = MX2(s0[0], s1[0]), b = MX2(s0[1], s1[1]);
#pragma unroll
          for (int i = 2; i < 16; i += 2) { a = MX2(a, MX2(s0[i], s1[i])); b = MX2(b, MX2(s0[i + 1], s1[i + 1])); }
          mx = swap32_max(MX2(a, b)); }
        if constexpr (!NEGM) mx -= m;
        if (__builtin_expect(t == 0 || __builtin_amdgcn_ballot_w64(mx > 8.f) != 0ull, 0)) {
            const float dl = (t == 0) ? mx : fmaxf(mx, 0.f);
            m += dl;
            if constexpr (NEGM) {
#pragma unroll
                for (int i = 0; i < 16; ++i) { s0[i] -= dl; s1[i] -= dl; negm[i] = -m; } }
            if (t != 0) { const float f = __builtin_amdgcn_exp2f(-dl); l *= f;
#pragma unroll
                for (int d = 0; d < NDB; ++d)
#pragma unroll
                    for (int i = 0; i < 16; ++i) o[d][i] *= f; }
            asm volatile("" ::: "memory");
        }
        float ra = 0.f, rb = 0.f;
#pragma unroll
        for (int i = 0; i < 16; ++i) { s0[i] = __builtin_amdgcn_exp2f(NEGM ? s0[i] : s0[i] - m); s1[i] = __builtin_amdgcn_exp2f(NEGM ? s1[i] : s1[i] - m); ra += s0[i]; rb += s1[i]; }
        l += ra + rb;
        { u32x4 w;
          w.x = pk2(s0[0], s0[1]); w.y = pk2(s0[2], s0[3]); w.z = pk2(s0[4], s0[5]); w.w = pk2(s0[6], s0[7]); pf[0] = __builtin_bit_cast(bf16x8, w);
          w.x = pk2(s0[8], s0[9]); w.y = pk2(s0[10], s0[11]); w.z = pk2(s0[12], s0[13]); w.w = pk2(s0[14], s0[15]); pf[1] = __builtin_bit_cast(bf16x8, w);
          w.x = pk2(s1[0], s1[1]); w.y = pk2(s1[2], s1[3]); w.z = pk2(s1[4], s1[5]); w.w = pk2(s1[6], s1[7]); pf[2] = __builtin_bit_cast(bf16x8, w);
          w.x = pk2(s1[8], s1[9]); w.y = pk2(s1[10], s1[11]); w.z = pk2(s1[12], s1[13]); w.w = pk2(s1[14], s1[15]); pf[3] = __builtin_bit_cast(bf16x8, w); }
        LBAR();
    }
    { const int vb = (NT - 1) & 1;
#pragma unroll
      for (int d0 = 0; d0 < NDB; d0 += 2) { bf16x8 vf[8];
#pragma unroll
        for (int j = 0; j < 8; ++j) vf[j] = *(const LAS bf16x8*)(lds + vb * VT + vaddr + (d0 + (j >> 2)) * 32 * VROW + (j & 3) * 32);
        asm volatile("" : "+v"(vf[0]), "+v"(vf[1]), "+v"(vf[2]), "+v"(vf[3]), "+v"(vf[4]), "+v"(vf[5]), "+v"(vf[6]), "+v"(vf[7]));
#pragma unroll
        for (int j = 0; j < 8; ++j) o[d0 + (j >> 2)] = __builtin_amdgcn_mfma_f32_32x32x16_bf16(vf[j], pf[j & 3], o[d0 + (j >> 2)], 0, 0, 0); } }
    if (grp == 0) LBAR();
    LBAR();
    l = swap32_add(l);
    const float il = 1.f / l;
    bf16_t* orow = O + (size_t)qrow * 512;
#pragma unroll
    for (int d = 0; d < NDB; ++d)
#pragma unroll
        for (int g = 0; g < 4; ++g) { u32x2 w; w.x = pk2(o[d][4 * g] * il, o[d][4 * g + 1] * il); w.y = pk2(o[d][4 * g + 2] * il, o[d][4 * g + 3] * il);
            *(u32x2*)(orow + 32 * d + 8 * g + 4 * h) = w; }
#undef KG
#undef KL
#undef VG
#undef VL
#undef LBAR
}

DI void attn_unit_a64(LAS unsigned char* lds, const bf16_t* __restrict__ Q, const bf16_t* __restrict__ K, const bf16_t* __restrict__ Vt, bf16_t* __restrict__ O, int r0, int qb, int n, int seqrows, const int wid) {
    constexpr int DQK = 64, KROW = 144, KT = 64 * KROW, VROW = 144, VT = 64 * VROW, VB0 = 2 * KT;
    typedef const __attribute__((address_space(1))) u32x4* gptr;
    const int lane = lane_fresh(), tid = wid * 64 + lane, r = lane & 31, h = lane >> 5;
    const int nk = n + 16, NT = (nk + 63) >> 6;
    const int li0 = qb * 512 + wid * 64 + r, li1 = li0 + 32;
    bf16x8 qf0[4], qf1[4];
#pragma unroll
    for (int ks = 0; ks < 4; ++ks) { qf0[ks] = *(const bf16x8*)(Q + (size_t)(r0 + li0) * DQK + ks * 16 + h * 8); qf1[ks] = *(const bf16x8*)(Q + (size_t)(r0 + li1) * DQK + ks * 16 + h * 8); }
    f32x16 oa0, oa1, ob0, ob1, zero16;
#pragma unroll
    for (int i = 0; i < 16; ++i) { oa0[i] = 0.f; oa1[i] = 0.f; ob0[i] = 0.f; ob1[i] = 0.f; zero16[i] = 0.f; }
    float ma = 0.f, mb = 0.f, la = 0.f, lb = 0.f;
    const bf16_t* kg0 = K + (size_t)r0 * DQK + tid * 8; const bf16_t* vg0 = Vt + (size_t)(tid >> 3) * RA + r0 + (tid & 7) * 8;
    const int kl0 = (tid >> 3) * KROW + (tid & 7) * 16, vl0 = VB0 + (tid >> 3) * VROW + (tid & 7) * 16;
    const int pr = (r & ~12) | ((r & 4) << 1) | ((r & 8) >> 1);
    const int kaddr = pr * KROW + h * 16, vaddr = VB0 + r * VROW + h * 16;
    u32x4 kst, vst;
    kst = *(gptr)kg0; vst = *(gptr)vg0;
    *(LAS u32x4*)(lds + kl0) = kst; *(LAS u32x4*)(lds + vl0) = vst;
    __syncthreads();
#define SOFTMAX64(S0, S1, M, L, OX0, OX1) do { \
        if (t == NT - 1) { _Pragma("unroll") for (int i = 0; i < 16; ++i) { if (i >= 8) S0[i] = -1e30f; S1[i] = -1e30f; } } \
        float a_ = MX2(S0[0], S1[0]), b_ = MX2(S0[1], S1[1]); \
        _Pragma("unroll") for (int i = 2; i < 16; i += 2) { a_ = MX2(a_, MX2(S0[i], S1[i])); b_ = MX2(b_, MX2(S0[i + 1], S1[i + 1])); } \
        const float mx_ = swap32_max(MX2(a_, b_)) - M; \
        if (__builtin_expect(t == 0 || __builtin_amdgcn_ballot_w64(mx_ > 8.f) != 0ull, 0)) { \
            const float dl_ = (t == 0) ? mx_ : fmaxf(mx_, 0.f); M += dl_; \
            if (t != 0) { const float f_ = __builtin_amdgcn_exp2f(-dl_); L *= f_; _Pragma("unroll") for (int i = 0; i < 16; ++i) { OX0[i] *= f_; OX1[i] *= f_; } } \
            asm volatile("" ::: "memory"); } \
        float ra_ = 0.f, rb_ = 0.f; \
        _Pragma("unroll") for (int i = 0; i < 16; ++i) { S0[i] = __builtin_amdgcn_exp2f(S0[i] - M); S1[i] = __builtin_amdgcn_exp2f(S1[i] - M); ra_ += S0[i]; rb_ += S1[i]; } \
        L += ra_ + rb_; \
        u32x4 w_; \
        w_.x = pk2(S0[0], S0[1]); w_.y = pk2(S0[2], S0[3]); w_.z = pk2(S0[4], S0[5]); w_.w = pk2(S0[6], S0[7]); pf[0] = __builtin_bit_cast(bf16x8, w_); \
        w_.x = pk2(S0[8], S0[9]); w_.y = pk2(S0[10], S0[11]); w_.z = pk2(S0[12], S0[13]); w_.w = pk2(S0[14], S0[15]); pf[1] = __builtin_bit_cast(bf16x8, w_); \
        w_.x = pk2(S1[0], S1[1]); w_.y = pk2(S1[2], S1[3]); w_.z = pk2(S1[4], S1[5]); w_.w = pk2(S1[6], S1[7]); pf[2] = __builtin_bit_cast(bf16x8, w_); \
        w_.x = pk2(S1[8], S1[9]); w_.y = pk2(S1[10], S1[11]); w_.z = pk2(S1[12], S1[13]); w_.w = pk2(S1[14], S1[15]); pf[3] = __builtin_bit_cast(bf16x8, w_); } while (0)
    for (int t = 0; t < NT; ++t) {
        const int cb = t & 1; const bool more = (t + 1 < NT);
        if (more) { kst = *(gptr)(kg0 + (size_t)(t + 1) * 64 * DQK); vst = *(gptr)(vg0 + (size_t)(t + 1) * 64); }
        bf16x8 kq[8];
#pragma unroll
        for (int j = 0; j < 4; ++j) { kq[2 * j] = *(const LAS bf16x8*)(lds + cb * KT + kaddr + j * 32); kq[2 * j + 1] = *(const LAS bf16x8*)(lds + cb * KT + kaddr + 32 * KROW + j * 32); }
        asm volatile("" : "+v"(kq[0]), "+v"(kq[1]), "+v"(kq[2]), "+v"(kq[3]), "+v"(kq[4]), "+v"(kq[5]), "+v"(kq[6]), "+v"(kq[7]));
        f32x16 sa0, sa1, sb0, sb1;
        sa0 = __builtin_amdgcn_mfma_f32_32x32x16_bf16(kq[0], qf0[0], zero16, 0, 0, 0); sa1 = __builtin_amdgcn_mfma_f32_32x32x16_bf16(kq[1], qf0[0], zero16, 0, 0, 0);
#pragma unroll
        for (int j = 1; j < 4; ++j) { sa0 = __builtin_amdgcn_mfma_f32_32x32x16_bf16(kq[2 * j], qf0[j], sa0, 0, 0, 0); sa1 = __builtin_amdgcn_mfma_f32_32x32x16_bf16(kq[2 * j + 1], qf0[j], sa1, 0, 0, 0); }
        sb0 = __builtin_amdgcn_mfma_f32_32x32x16_bf16(kq[0], qf1[0], zero16, 0, 0, 0); sb1 = __builtin_amdgcn_mfma_f32_32x32x16_bf16(kq[1], qf1[0], zero16, 0, 0, 0);
#pragma unroll
        for (int j = 1; j < 4; ++j) { sb0 = __builtin_amdgcn_mfma_f32_32x32x16_bf16(kq[2 * j], qf1[j], sb0, 0, 0, 0); sb1 = __builtin_amdgcn_mfma_f32_32x32x16_bf16(kq[2 * j + 1], qf1[j], sb1, 0, 0, 0); }
        bf16x8 vf[8];
#pragma unroll
        for (int j = 0; j < 8; ++j) vf[j] = *(const LAS bf16x8*)(lds + cb * VT + vaddr + (j >> 2) * 32 * VROW + (j & 3) * 32);
        bf16x8 pf[4];
        SOFTMAX64(sa0, sa1, ma, la, oa0, oa1);
        asm volatile("" : "+v"(vf[0]), "+v"(vf[1]), "+v"(vf[2]), "+v"(vf[3]), "+v"(vf[4]), "+v"(vf[5]), "+v"(vf[6]), "+v"(vf[7]));
#pragma unroll
        for (int j = 0; j < 4; ++j) { oa0 = __builtin_amdgcn_mfma_f32_32x32x16_bf16(vf[j], pf[j], oa0, 0, 0, 0); oa1 = __builtin_amdgcn_mfma_f32_32x32x16_bf16(vf[4 + j], pf[j], oa1, 0, 0, 0); }
        SOFTMAX64(sb0, sb1, mb, lb, ob0, ob1);
#pragma unroll
        for (int j = 0; j < 4; ++j) { ob0 = __builtin_amdgcn_mfma_f32_32x32x16_bf16(vf[j], pf[j], ob0, 0, 0, 0); ob1 = __builtin_amdgcn_mfma_f32_32x32x16_bf16(vf[4 + j], pf[j], ob1, 0, 0, 0); }
        if (more) { *(LAS u32x4*)(lds + (cb ^ 1) * KT + kl0) = kst; *(LAS u32x4*)(lds + (cb ^ 1) * VT + vl0) = vst; }
        asm volatile("s_waitcnt lgkmcnt(0)" ::: "memory"); __builtin_amdgcn_s_barrier(); asm volatile("" ::: "memory");
    }
#undef SOFTMAX64
    la = swap32_add(la); lb = swap32_add(lb);
    const float ia = 1.f / la, ib = 1.f / lb;
    if (li0 < seqrows) { bf16_t* orow = O + (size_t)(r0 + li0) * 512;
#pragma unroll
        for (int g = 0; g < 4; ++g) { u32x2 w; w.x = pk2(oa0[4 * g] * ia, oa0[4 * g + 1] * ia); w.y = pk2(oa0[4 * g + 2] * ia, oa0[4 * g + 3] * ia); *(u32x2*)(orow + 8 * g + 4 * h) = w;
            w.x = pk2(oa1[4 * g] * ia, oa1[4 * g + 1] * ia); w.y = pk2(oa1[4 * g + 2] * ia, oa1[4 * g + 3] * ia); *(u32x2*)(orow + 32 + 8 * g + 4 * h) = w; } }
    if (li1 < seqrows) { bf16_t* orow = O + (size_t)(r0 + li1) * 512;
#pragma unroll
        for (int g = 0; g < 4; ++g) { u32x2 w; w.x = pk2(ob0[4 * g] * ib, ob0[4 * g + 1] * ib); w.y = pk2(ob0[4 * g + 2] * ib, ob0[4 * g + 3] * ib); *(u32x2*)(orow + 8 * g + 4 * h) = w;
            w.x = pk2(ob1[4 * g] * ib, ob1[4 * g + 1] * ib); w.y = pk2(ob1[4 * g + 2] * ib, ob1[4 * g + 3] * ib); *(u32x2*)(orow + 32 + 8 * g + 4 * h) = w; } }
}

#if defined(STAGGER) && !defined(STAGGER_NOC)
#define ATTN_C attn_unit_s<192, 128, false>
#else
#define ATTN_C attn_unit<192, 128, false, false>
#endif
#if defined(STAGGER)
#define ATTN_B attn_unit_s<64, 128, true>
#define ATTN_A attn_unit_s<64, 64, false>
#elif defined(NOPIPE_AB)
#define ATTN_B attn_unit<64, 128, true, false>
#define ATTN_A attn_unit<64, 64, false, false>
#else
#define ATTN_B attn_unit<64, 128, true, false>
#define ATTN_A attn_unit2<64, false>
#endif
DI void attn_phase(const Params& p, const Chunk& ck, bool last, LAS unsigned char* lds, unsigned* q  , const int wave) {
    unsigned char* ws = p.ws; asm volatile("" : "+s"(ws));
    const bf16_t* QKV = (const bf16_t*)(ws + WS_QKV); bf16_t* OB = (bf16_t*)(ws + WS_ZM);
#if defined(PROBE_DUPC)
    constexpr int NDUP = 8, DUP0 = 0;
#elif defined(PROBE_DUPB)
    constexpr int NDUP = 16, DUP0 = 8;
#elif defined(PROBE_DUPA)
    constexpr int NDUP = 16, DUP0 = 24;
#else
    constexpr int NDUP = 0, DUP0 = 0;
#endif
    const int nmeta = last ? 0 : 20 * ck.nseq, nms = (nmeta + 7) >> 3, nsuper = nms + 40 + NDUP;
    volatile LAS int* su = (volatile LAS int*)(lds + LDS_MISC);
    for (;;) {
        if (wave == 0 && lane_fresh() == 0) {
#ifdef FLATQ
            const unsigned x = 0u;
#else
            const unsigned x = (unsigned)__builtin_amdgcn_s_getreg((3 << 11) | 20) & 0xFu;
#endif
            int res = -1, lin = 0;
            for (;;) {
                const unsigned idx = __hip_atomic_fetch_add(q + 64 + 16 * x, 1u, __ATOMIC_RELAXED, __HIP_MEMORY_SCOPE_AGENT);
                const unsigned slot = (idx >> 5) & 63u; lin = (int)(idx & 31u);
                unsigned* te = q + 512 + x * 64 + slot; unsigned g;
                if (lin == 0) { g = __hip_atomic_fetch_add(q, 1u, __ATOMIC_RELAXED, __HIP_MEMORY_SCOPE_AGENT); __hip_atomic_store(te, g + 1u, __ATOMIC_RELAXED, __HIP_MEMORY_SCOPE_AGENT); }
                else { while ((g = __hip_atomic_load(te, __ATOMIC_RELAXED, __HIP_MEMORY_SCOPE_AGENT)) == 0u) __builtin_amdgcn_s_sleep(2); g -= 1u; }
                if ((int)g >= nsuper) { res = -1; break; }
                if ((int)g < nms && (lin >= 8 || (int)g * 8 + lin >= nmeta)) continue;
#ifdef A64
                if ((int)g >= nms + 24) {
                    const int sub_ = ((int)g - nms) & 1;
                    if (ck.nseq == 1 ? (sub_ == 1) : (lin >= 16)) continue; }
#endif
                res = (int)g; break;
            }
            su[0] = res; su[1] = lin;
        }
        __syncthreads();
        const int g = su[0], lin = su[1];
        __syncthreads();
        if (g < 0) break;
        int type, hd, s, qb;
        int sh = ck.nseq - 1; asm volatile("" : "+s"(sh));
        if (g < nms) { const int mu = g * 8 + lin, jh = mu >> sh; s = mu & sh; qb = ck.tps - 1;
            if (jh < 4) { type = 0; hd = jh; } else if (jh < 12) { type = 1; hd = jh - 4; } else { type = 2; hd = jh - 12; } }
        else { const int gr0 = g - nms, gr = gr0 >= 40 ? gr0 - 40 + DUP0 : gr0, sub = gr & 1;
            if (gr < 8) { type = 0; hd = gr >> 1; } else if (gr < 24) { type = 1; hd = (gr - 8) >> 1; } else { type = 2; hd = (gr - 24) >> 1; }
            s = sub * sh; qb = lin + (sub * 32) * (1 - sh); }
        const int r0 = s * ck.rows_per_seq();
        if (type == 0) {
            ATTN_C(lds, QKV + QC_O + (size_t)hd * RA * 192, QKV + KC_O + (size_t)hd * RA * 192, QKV + VC_O + (size_t)hd * 128 * RA, OB + 2 * OSLOT + 128 * hd, r0, qb, ck.n, 0.f, wave);
        } else if (type == 1) { const int hh = hd >> 1;
            const float sl = LOG2E * (hh == 0 ? 0.25f : hh == 1 ? 0.0625f : hh == 2 ? 0.015625f : 0.00390625f);
            ATTN_B(lds, QKV + QB_O + (size_t)hd * RA * 64, QKV + KB_O + (size_t)hd * RA * 64, QKV + VB_O + (size_t)hh * 128 * RA, OB + ((hd & 1) ? 3 : 1) * OSLOT + 128 * hh, r0, qb, ck.n, sl, wave);
        } else { const int kv = hd >> 2;
#ifdef A64
            const int qb5 = (g < nms) ? (ck.n >> 9) : lin;
            attn_unit_a64(lds, QKV + QA_O + (size_t)hd * RA * 64, QKV + KA_O + (size_t)kv * RA * 64, QKV + VA_O + (size_t)kv * 64 * RA, OB + 64 * hd, r0, qb5, ck.n, ck.rows_per_seq(), wave);
#else
            ATTN_A(lds, QKV + QA_O + (size_t)hd * RA * 64, QKV + KA_O + (size_t)kv * RA * 64, QKV + VA_O + (size_t)kv * 64 * RA, OB + 64 * hd, r0, qb, ck.n, 0.f, wave);
#endif
        }
    }
}

#define XB_TMO      128
#define XB_XCNT(j)  (256  + 64 * (j))
#define XB_XSUB(j)  (1280 + 64 * (j))
#define XB_XGEN(j)  (2304 + 64 * (j))
#define XB_TOP      3328
#define XB_TOPGEN   3392
#define XCD_BAR_WORDS 3456
#define XB_SPIN_CAP (1u << 22)
DI unsigned xb_ld(unsigned* p)              { return __hip_atomic_load(p, __ATOMIC_RELAXED, __HIP_MEMORY_SCOPE_AGENT); }
DI unsigned xb_add(unsigned* p, unsigned v) { return __hip_atomic_fetch_add(p, v, __ATOMIC_RELAXED, __HIP_MEMORY_SCOPE_AGENT); }
DI unsigned xb_xcc_id() { return (unsigned)__builtin_amdgcn_s_getreg((3 << 11) | 20) & 0xFu; }
#define XB_SPIN(cond, bar) do { unsigned _sp = 0; while (cond) { __builtin_amdgcn_s_sleep(1); \
    if ((++_sp & 255u) == 0u) { if (xb_ld(&(bar)[XB_TMO])) break; if (_sp > XB_SPIN_CAP) { atomicAdd(&(bar)[XB_TMO], 1u); break; } } } } while (0)
DI void xcd_barrier_complete(unsigned* bar, unsigned x, unsigned G, unsigned& nloc, unsigned& nx) {
    unsigned sum, cnt, mine, sp = 0u;
    for (;;) {
        sum = 0u; cnt = 0u; mine = 0u;
#pragma unroll
        for (unsigned j = 0; j < 16; ++j) { const unsigned c = xb_ld(&bar[XB_XCNT(j)]); sum += c; cnt += (c > 0u) ? 1u : 0u; mine = (j == x) ? c : mine; }
        if (sum == G) break;
        __builtin_amdgcn_s_sleep(1);
        if ((++sp & 255u) == 0u) { if (xb_ld(&bar[XB_TMO])) break; if (sp > XB_SPIN_CAP) { atomicAdd(&bar[XB_TMO], 1u); break; } }
    }
    nloc = mine > 0u ? mine : 1u; nx = cnt > 0u ? cnt : 1u;
}
DI void xcd_barrier(unsigned* bar, volatile LAS unsigned* st, const int wave) {
    asm volatile("s_waitcnt vmcnt(0)" ::: "memory");
    __syncthreads();
    if (wave == 0 && lane_fresh() == 0) {
        __builtin_amdgcn_s_waitcnt(0);
        const unsigned x = xb_xcc_id();
        unsigned nloc = st[0], nx = st[1];
        if (nloc == 0u) { xcd_barrier_complete(bar, x, gridDim.x, nloc, nx); st[0] = nloc; st[1] = nx; }
        const unsigned old = xb_add(&bar[XB_XSUB(x)], 1u);
        const unsigned gen = old / nloc;
        if (old + 1u == (gen + 1u) * nloc) {
            __builtin_amdgcn_fence(__ATOMIC_RELEASE, "agent");
            asm volatile("s_waitcnt vmcnt(0)" ::: "memory");
            const unsigned og = xb_add(&bar[XB_TOP], 1u);
            const unsigned tg = og / nx;
            if (og + 1u == (tg + 1u) * nx) xb_add(&bar[XB_TOPGEN], 1u);
            else XB_SPIN(xb_ld(&bar[XB_TOPGEN]) == tg, bar);
            __builtin_amdgcn_fence(__ATOMIC_ACQUIRE, "agent");
            xb_add(&bar[XB_XGEN(x)], 1u);
            asm volatile("s_waitcnt vmcnt(0)" ::: "memory");
        } else {
            XB_SPIN(xb_ld(&bar[XB_XGEN(x)]) == gen, bar);
            __builtin_amdgcn_fence(__ATOMIC_ACQUIRE, "agent");
            asm volatile("s_waitcnt vmcnt(0)" ::: "memory");
        }
    }
    __syncthreads();
}


#define SK_LOOP(ACC, AP, BP, KK) do { _Pragma("unroll") for (int k0_ = 0; k0_ < (KK); k0_ += 32) { \
        const bf16x8 a_ = *(const bf16x8*)((AP) + k0_), b_ = *(const bf16x8*)((BP) + k0_); ACC = __builtin_amdgcn_mfma_f32_16x16x32_bf16(a_, b_, ACC, 0, 0, 0); } } while (0)
DI void skinny_phase(int which  , const Params& p, const Chunk& ck, const XMap& xm, const unsigned char* wbl, int gw, int NGW, int lane) {
    unsigned char* ws = p.ws; asm volatile("" : "+s"(ws));
    const int row = lane & 15, quad = lane >> 4;
    if (which == 0) {
        const bf16_t* OB = (const bf16_t*)(ws + WS_ZM); const bf16_t* G = (const bf16_t*)(ws + WS_G); bf16_t* MGb = (bf16_t*)(ws + WS_XN);
        for (int it = gw; it < ck.nseq * 64; it += NGW) {
            const int s = it >> 6, tile = it & 63, R0 = (s * ck.tps + ck.tps - 1) * 256, col = tile * 16 + row;
            f32x4 sum = {0.f, 0.f, 0.f, 0.f};
#pragma unroll 1
            for (int z = 0; z < 3; ++z) { f32x4 a = {0.f, 0.f, 0.f, 0.f};
                const bf16_t* ap = OB + (size_t)z * OSLOT + (size_t)(R0 + row) * 512 + quad * 8; const bf16_t* bp = (const bf16_t*)(wbl + W_BR) + (size_t)z * 1024 * 512 + (size_t)col * 512 + quad * 8;
                SK_LOOP(a, ap, bp, 512);
#pragma unroll
                for (int j = 0; j < 4; ++j) { const float g = __uint_as_float((unsigned)G[(size_t)(R0 + quad * 4 + j) * G_LD + z * 1024 + col] << 16); sum[j] += g * a[j]; } }
#pragma unroll
            for (int j = 0; j < 4; ++j) MGb[(size_t)(R0 + quad * 4 + j) * DM + col] = (bf16_t)(pk2(sum[j], 0.f) & 0xffffu);
        }
    } else if (which == 2) {
        const bf16_t* XNp = (const bf16_t*)(ws + WS_XN); bf16_t* U_ = (bf16_t*)(ws + WS_G);
        for (int it = gw; it < ck.nseq * 256; it += NGW) {
            const int s = it >> 8, tile = it & 255, R0 = (s * ck.tps + ck.tps - 1) * 256, col = tile * 16 + row;
            f32x4 acc = {0.f, 0.f, 0.f, 0.f};
            const bf16_t* ap = XNp + (size_t)(R0 + row) * 1024 + quad * 8; const bf16_t* bp = (const bf16_t*)(wbl + W_UP) + (size_t)col * 1024 + quad * 8;
#pragma unroll 1
            for (int kh = 0; kh < 2; ++kh) SK_LOOP(acc, ap + kh * 512, bp + kh * 512, 512);
#pragma unroll
            for (int j = 0; j < 4; ++j) { const float v = fmaxf(acc[j], 0.f); U_[(size_t)(R0 + quad * 4 + j) * 4096 + col] = (bf16_t)(pk2(v * v, 0.f) & 0xffffu); }
        }
    } else {
        const int K = (which == 1) ? 1024 : 4096, nkc = K >> 9;
        const bf16_t* A = (which == 1) ? (const bf16_t*)(ws + WS_XN) : (const bf16_t*)(ws + WS_G);
        const bf16_t* W = (const bf16_t*)(wbl + (which == 1 ? W_OUT : W_DOWN));
        for (int it = gw; it < ck.nseq * 64 * nkc; it += NGW) {
            const int kc = it % nkc, rem = it / nkc, s = rem >> 6, tile = rem & 63, pt = s * ck.tps + ck.tps - 1, R0 = pt * 256, col = tile * 16 + row;
            f32x4 acc = {0.f, 0.f, 0.f, 0.f};
            const bf16_t* ap = A + (size_t)(R0 + row) * K + kc * 512 + quad * 8; const bf16_t* bp = W + (size_t)col * K + kc * 512 + quad * 8;
            SK_LOOP(acc, ap, bp, 512);
            float* wp = xm.xw(pt);
#pragma unroll
            for (int j = 0; j < 4; ++j) atomicAdd(wp + (size_t)(quad * 4 + j) * DM + col, acc[j]);
        }
    }
}

#define GSYNC() xcd_barrier(xbar, xst, wave)
__global__ void __launch_bounds__(512) fwd_kernel(Params p) {
    extern __shared__ __attribute__((aligned(16))) unsigned char lds_raw[];
    LAS unsigned char* lds = (LAS unsigned char*)lds_raw;
    cg::grid_group grid = cg::this_grid();
    const int wave = __builtin_amdgcn_readfirstlane((int)threadIdx.x >> 6); int lane = lane_fresh();
    const int G = gridDim.x, bx = blockIdx.x, NGW = G * 8, gw = bx * 8 + wave;
#define WSP(off) ({ unsigned char* w_ = p.ws; asm volatile("" : "+s"(w_)); w_ + (off); })
#define ctl ((unsigned*)WSP(WS_CTL))
#define xbar (ctl + 1024)
    volatile LAS unsigned* xst = (volatile LAS unsigned*)(lds + LDS_MISC + 16);
    if (wave == 0 && lane == 0) { xst[0] = 0u; xst[1] = 0u; (void)xb_add(&xbar[XB_XCNT(xb_xcc_id())], 1u); }
    __syncthreads();
#define XN ((bf16_t*)WSP(WS_XN))
#define ZM ((bf16_t*)WSP(WS_ZM))
#define GB ((bf16_t*)WSP(WS_G))
#define CQN ((bf16_t*)WSP(WS_SM + SM_CQN))
#define CKVN ((bf16_t*)WSP(WS_SM + SM_CKVN))
#define QCR ((bf16_t*)WSP(WS_ZM + OFF_QCR))
#define KVR ((bf16_t*)WSP(WS_ZM + OFF_KVR))
#define MG ((float*)WSP(WS_QKV))
#define U ((bf16_t*)WSP(WS_G))

#if !defined(PH) || (PH & 1)
    prologue(p, lds, gw, NGW, wave, lane);
#ifdef PROBE_PRO2
    prologue(p, lds, gw, NGW, wave, lane);
#endif
#endif
    grid.sync();
    for (int l = 0; l < 2; ++l) {
        const bool last = (l == 1);
#define wb (WSP(WS_W) + (size_t)l * LW_STRIDE)
        for (int c = 0; c < 3; ++c) {
            const Chunk ck = make_chunk(c);
            const int ta = ck.tps - 1;
            XMap xm; xm.out = p.out; xm.metax = (float*)WSP(WS_METAX); xm.xp = p.in[0]; xm.xs = p.in[1]; xm.meta0 = (const float*)WSP(WS_META0); xm.seq0 = ck.seq0; xm.tps = ck.tps; xm.first = (l == 0);
#define RELAUNDER() do { lane = lane_fresh(); } while (0)
            RELAUNDER();
#if !defined(PH) || (PH & 2)
            norm_phase(xm, ck.rows(), p.in[3] + l * DM, XN, gw, NGW, lane);
#ifdef PROBE_EW2
            RELAUNDER(); norm_phase(xm, ck.rows(), p.in[3] + l * DM, XN, gw, NGW, lane);
#endif
#endif
            GSYNC();
            { pg8::Gemm g{XN, (const bf16_t*)(wb + W_IN), 1024, 0, 0}; Sched S; S.init(ck.nseq, ck.tps, ck.tps, IN_N / 256, 1, G, bx);
              EpiIn E{ZM, GB, p.in[5] + l * 3072};
#if !defined(PH) || (PH & 4)
              pg8::gemm_phase<EpiIn, Sched, true, true>(lds, g, S, E, wave);
#ifdef PROBE_IN2
              pg8::gemm_phase<EpiIn, Sched, true, true>(lds, g, S, E, wave);
#endif
#endif
 }
            GSYNC();
            RELAUNDER();
#if !defined(PH) || (PH & 128)
            ew1_phase(p, ck, l, gw, NGW, lane);
#ifdef PROBE_EW2
            RELAUNDER(); ew1_phase(p, ck, l, gw, NGW, lane);
#endif
#endif
            GSYNC();
            { pg8::Gemm g{CQN, (const bf16_t*)(wb + W_QB), 256, 0, 0}; Sched S; S.init(ck.nseq, ck.tps, ck.tps, 3, 1, G, bx); EpiBf16<0> E{QCR, 768};
#if !defined(PH) || (PH & 8)
              pg8::gemm_phase<EpiBf16<0>, Sched, true, true>(lds, g, S, E, wave);
#endif
 }
            { pg8::Gemm g{CKVN, (const bf16_t*)(wb + W_KVB), 128, 0, 0}; Sched S; S.init(ck.nseq, ck.tps, ck.tps, 4, 1, G, bx); EpiBf16<0> E{KVR, 1024};
#if !defined(PH) || (PH & 8)
              pg8::gemm_phase<EpiBf16<0>, Sched, true, true>(lds, g, S, E, wave);
#endif
 }
            GSYNC();
            RELAUNDER();
#if !defined(PH) || (PH & 256)
            ew2_phase(p, ck, l, gw, NGW, lane);
#ifdef PROBE_EW2
            RELAUNDER(); ew2_phase(p, ck, l, gw, NGW, lane);
#endif
#endif
            GSYNC();
#if !defined(PH) || (PH & 1024)
            attn_phase(p, ck, last, lds, ctl + 8192 + 2048 * (l * 3 + c), wave);
#ifdef PROBE_ATTN2
            GSYNC();
            attn_phase(p, ck, last, lds, ctl + 8192 + 2048 * (6 + l * 3 + c), wave);
#endif
#endif
            GSYNC();
            RELAUNDER();
#if !defined(PH) || (PH & 512)
            ew3_phase(p, ck, l, last, gw, NGW, lane);
#endif
            GSYNC();
            { pg8::Gemm g{ZM, (const bf16_t*)(wb + W_BR), 512, OSLOT, (size_t)1024 * 512}; Sched S; S.init(ck.nseq, ta, ck.tps, 4, 3, G, bx); EpiBranch E{GB, MG, XN};
#if !defined(PH) || (PH & 16)
              pg8::gemm_phase<EpiBranch, Sched, true, true>(lds, g, S, E, wave);
#ifdef PROBE_BR2
              pg8::gemm_phase<EpiBranch, Sched, true, true>(lds, g, S, E, wave);
#endif
#endif
 }
            if (!last) { RELAUNDER(); skinny_phase(0, p, ck, xm, wb, gw, NGW, lane); }
            GSYNC();
            { pg8::Gemm g{XN, (const bf16_t*)(wb + W_OUT), 1024, 0, 0}; Sched S; S.init(ck.nseq, ta, ck.tps, 4, 1, G, bx); EpiResid E{xm};
#if !defined(PH) || (PH & 32)
              pg8::gemm_phase<EpiResid, Sched, true, true>(lds, g, S, E, wave);
#endif
 }
            if (!last) { RELAUNDER(); skinny_phase(1, p, ck, xm, wb, gw, NGW, lane); }
            GSYNC();
            xm.first = 0;
            RELAUNDER();
#if !defined(PH) || (PH & 2)
            norm_phase(xm, ck.rows(), p.in[25] + l * DM, XN, gw, NGW, lane);
#ifdef PROBE_EW2
            RELAUNDER(); norm_phase(xm, ck.rows(), p.in[25] + l * DM, XN, gw, NGW, lane);
#endif
#endif
            GSYNC();
            { pg8::Gemm g{XN, (const bf16_t*)(wb + W_UP), 1024, 0, 0}; Sched S; S.init(ck.nseq, ta, ck.tps, 16, 1, G, bx); EpiBf16<2> E{U, 4096};
#if !defined(PH) || (PH & 64)
              pg8::gemm_phase<EpiBf16<2>, Sched, true, true>(lds, g, S, E, wave);
#ifdef PROBE_UP2
              pg8::gemm_phase<EpiBf16<2>, Sched, true, true>(lds, g, S, E, wave);
#endif
#endif
 }
            if (!last) { RELAUNDER(); skinny_phase(2, p, ck, xm, wb, gw, NGW, lane); }
            GSYNC();
            { pg8::Gemm g{U, (const bf16_t*)(wb + W_DOWN), 4096, 0, 0}; Sched S; S.init(ck.nseq, ta, ck.tps, 4, 1, G, bx); EpiResid E{xm};
#if !defined(PH) || (PH & 32)
              pg8::gemm_phase<EpiResid, Sched, true, true>(lds, g, S, E, wave);
#endif
 }
            if (!last) { RELAUNDER(); skinny_phase(3, p, ck, xm, wb, gw, NGW, lane); }
        }
    }
}

extern "C" void kernel_launch(void* const* d_in, const int* in_sizes, int n_in, void* d_out, int out_size, void* d_ws, size_t ws_size, hipStream_t stream) {
    static int grid_blocks = 0;
    if (grid_blocks == 0) {
        if (n_in != 28 || ws_size < WS_END) { fprintf(stderr, "kernel_launch: unexpected n_in %d / ws_size %zu (need %zu)\n", n_in, ws_size, (size_t)WS_END); grid_blocks = -1; return; }
        int dev = 0, cus = 0, per_cu = 0;
        hipGetDevice(&dev); hipDeviceGetAttribute(&cus, hipDeviceAttributeMultiprocessorCount, dev);
        hipFuncSetAttribute((const void*)fwd_kernel, hipFuncAttributeMaxDynamicSharedMemorySize, LDS_BYTES);
        hipOccupancyMaxActiveBlocksPerMultiprocessor(&per_cu, (const void*)fwd_kernel, 512, LDS_BYTES);
        if (per_cu < 1) { fprintf(stderr, "kernel_launch: occupancy query says %d blocks/CU\n", per_cu); per_cu = 1; }
        grid_blocks = cus * 1;
        (void)hipGetLastError();
    }
    if (grid_blocks < 0) return;
    hipMemsetAsync((char*)d_ws + WS_CTL, 0, CTL_BYTES, stream);
    Params p{};
    for (int i = 0; i < 28; ++i) p.in[i] = (const float*)d_in[i];
    p.out = (float*)d_out; p.ws = (unsigned char*)d_ws;
    void* args[] = {&p};
    hipError_t e = hipLaunchCooperativeKernel((const void*)fwd_kernel, dim3(grid_blocks), dim3(512), args, LDS_BYTES, stream);
    if (e != hipSuccess) fprintf(stderr, "cooperative launch failed: %s (grid %d)\n", hipGetErrorString(e), grid_blocks);
}
```

```cpp
#include <hip/hip_runtime.h>
#include <hip/hip_cooperative_groups.h>
#include <cstdint>
#include <cstdio>
namespace cg = cooperative_groups;
#define NOPIPE_AB 1
#define FLATQ 1
namespace pg8 {
#define PG8_LAS __attribute__((address_space(3)))
typedef unsigned short bf16_t;
typedef short bf16x8 __attribute__((ext_vector_type(8)));
typedef float f32x4 __attribute__((ext_vector_type(4)));
typedef unsigned u32x4 __attribute__((ext_vector_type(4)));
constexpr int BM = 256, BK = 64, HALF = 128, HTB = HALF * BK * 2  , STAGE_BYTES = 8 * HTB, NXCD = 8, WGM = 8;

__host__ __device__ __forceinline__ int lds_byte(int r, int c) { const int st = (r >> 4) * 2 + (c >> 5), rr = r & 15, cc = c & 31, ob = rr * 64 + cc * 2; return st * 1024 + (ob ^ (((ob >> 9) & 1) << 5)); }
__host__ __device__ __forceinline__ void stage_rc(int b, int& R, int& C) { const int st = b / 1024, sb = b % 1024, swz = sb ^ (((sb >> 9) & 1) << 5); R = (st >> 1) * 16 + swz / 64; C = (st & 1) * 32 + (swz % 64) / 2; }
__host__ __device__ __forceinline__ int perm32(int rho) { const int n = rho >> 4, i = rho & 15; return 8 * (i >> 2) + 4 * n + (i & 3); }

struct Unit { int pm, pn, z; };
struct Gemm { const bf16_t* A; const bf16_t* Bt; int K; size_t zsA, zsB; };

template <class Epi, class Sched, bool ALIGN_EPI = false, bool SP2 = false>
__device__ __forceinline__ void gemm_phase(PG8_LAS unsigned char* lds, const Gemm g, const Sched& S, const Epi& E, const int wv  ) {
    int tid_; asm volatile("v_mbcnt_lo_u32_b32 %0, -1, 0\n\tv_mbcnt_hi_u32_b32 %0, -1, %0" : "=v"(tid_)); tid_ += wv * 64;
    const int tid = tid_, wid = __builtin_amdgcn_readfirstlane(tid >> 6), lane = tid & 63, wr = wid >> 2, wc = wid & 3, fr = lane & 15, fq = lane >> 4;
    const int K = g.K, nt = K / BK;
    unsigned voffA[2], voffB[2];
#pragma unroll
    for (int i = 0; i < 2; ++i) { int R, C; stage_rc(tid * 16 + i * 8192, R, C); const int Rb = Epi::PERM ? ((R & ~31) + perm32(R & 31)) : R;
        voffA[i] = (unsigned)(R * K + C) * 2u; voffB[i] = (unsigned)(Rb * K + C) * 2u; }
    const size_t kstep = (size_t)(BK * 2);
    const size_t hstep = (size_t)HALF * K * 2;
    const size_t tstep = 2 * hstep;
    const unsigned ldsw = (unsigned)wid * 1024u;
    const int aoff = lds_byte(wr * 64 + fr, fq * 8), boff = lds_byte(wc * 32 + fr, fq * 8);
#define PG8_SA(b, h) (((b) * 2 + (h)) * HTB)
#define PG8_SB(b, h) ((4 + (b) * 2 + (h)) * HTB)
#define PG8_STAGE(bufoff, gbase, voff) do { _Pragma("unroll") for (int _i = 0; _i < 2; ++_i) \
        __builtin_amdgcn_global_load_lds((const unsigned*)((const char*)(gbase) + (voff)[_i]), (PG8_LAS unsigned*)(lds + (bufoff) + ldsw + _i * 8192), 16, 0, 0); } while (0)
#define PG8_LDA(dst, b, h) do { _Pragma("unroll") for (int m = 0; m < 4; ++m) _Pragma("unroll") for (int k = 0; k < 2; ++k) dst[m][k] = *(const PG8_LAS bf16x8*)(lds + PG8_SA(b, h) + aoff + m * 2048 + k * 1024); } while (0)
#define PG8_LDB(dst, b, h) do { _Pragma("unroll") for (int n = 0; n < 2; ++n) _Pragma("unroll") for (int k = 0; k < 2; ++k) dst[n][k] = *(const PG8_LAS bf16x8*)(lds + PG8_SB(b, h) + boff + n * 2048 + k * 1024); } while (0)
#define PG8_MMA(ai, bj, At, Bt) do { __builtin_amdgcn_s_setprio(1); _Pragma("unroll") for (int m = 0; m < 4; ++m) _Pragma("unroll") for (int n = 0; n < 2; ++n) _Pragma("unroll") for (int k = 0; k < 2; ++k) \
        acc[ai][bj][m][n] = __builtin_amdgcn_mfma_f32_16x16x32_bf16(Bt[n][k], At[m][k], acc[ai][bj][m][n], 0, 0, 0); __builtin_amdgcn_s_setprio(0); } while (0)
#define PG8_WAIT_V(n) asm volatile("s_waitcnt vmcnt(" #n ")" ::: "memory")
#define PG8_WAIT_L(n) asm volatile("s_waitcnt lgkmcnt(" #n ")" ::: "memory")
#define PG8_BAR __builtin_amdgcn_s_barrier()
#define PG8_SCHED __builtin_amdgcn_sched_barrier(0)
    Unit cur, nxt; int ui = 0;
    if (!S.next(0, cur)) return;
    f32x4 acc[2][2][4][2];
#pragma unroll
    for (int a = 0; a < 2; ++a)
#pragma unroll
        for (int b = 0; b < 2; ++b)
#pragma unroll
            for (int m = 0; m < 4; ++m)
#pragma unroll
                for (int n = 0; n < 2; ++n) acc[a][b][m][n] = (f32x4){0.f, 0.f, 0.f, 0.f};
    bf16x8 At[4][2], B0[2][2], B1[2][2];
    const char* cA = (const char*)(g.A + (size_t)cur.z * g.zsA) + (size_t)cur.pm * tstep; const char* cB = (const char*)(g.Bt + (size_t)cur.z * g.zsB) + (size_t)cur.pn * tstep;
    S.a_ready(cur);
    if constexpr (SP2) {
        PG8_STAGE(PG8_SB(0, 0), cB, voffB); PG8_STAGE(PG8_SB(0, 1), cB + hstep, voffB); PG8_STAGE(PG8_SA(0, 0), cA, voffA); PG8_STAGE(PG8_SA(0, 1), cA + hstep, voffA);
        if (wr == 1) PG8_BAR;
        PG8_WAIT_V(2); PG8_BAR;
        PG8_STAGE(PG8_SB(1, 0), cB + kstep, voffB); PG8_STAGE(PG8_SA(1, 0), cA + kstep, voffA); PG8_STAGE(PG8_SB(1, 1), cB + hstep + kstep, voffB);
        PG8_WAIT_V(6); PG8_BAR;
    } else {
        PG8_STAGE(PG8_SB(0, 0), cB, voffB); PG8_STAGE(PG8_SA(0, 0), cA, voffA); PG8_STAGE(PG8_SB(0, 1), cB + hstep, voffB); PG8_STAGE(PG8_SA(0, 1), cA + hstep, voffA);
        if (wr == 1) PG8_BAR;
        PG8_WAIT_V(4); PG8_BAR;
        PG8_STAGE(PG8_SB(1, 0), cB + kstep, voffB); PG8_STAGE(PG8_SA(1, 0), cA + kstep, voffA); PG8_STAGE(PG8_SB(1, 1), cB + hstep + kstep, voffB);
        PG8_WAIT_V(6); PG8_BAR;
    }
    for (;;) {
        const bool has_next = S.next(ui + 1, nxt);
        const char* nA = has_next ? (const char*)(g.A + (size_t)nxt.z * g.zsA) + (size_t)nxt.pm * tstep : cA; const char* nB = has_next ? (const char*)(g.Bt + (size_t)nxt.z * g.zsB) + (size_t)nxt.pn * tstep : cB;
        for (int t = 0; t < nt; t += 2) {
            const bool last = (t == nt - 2);
            const char* a1 = cA + (size_t)(t + 1) * kstep;
            const char* a2 = last ? nA : cA + (size_t)(t + 2) * kstep; const char* b2 = last ? nB : cB + (size_t)(t + 2) * kstep;
            const char* a3 = a2 + kstep; const char* b3 = b2 + kstep;
            if (last && has_next) S.a_ready(nxt);
            if constexpr (SP2) {
            PG8_LDB(B0, 0, 0); PG8_LDB(B1, 0, 1); PG8_SCHED; PG8_LDA(At, 0, 0); PG8_STAGE(PG8_SA(1, 1), a1 + hstep, voffA);
            PG8_WAIT_V(8); PG8_WAIT_L(0); PG8_BAR; PG8_MMA(0, 0, At, B0); PG8_MMA(0, 1, At, B1); PG8_BAR; PG8_SCHED;
            PG8_LDA(At, 0, 1); PG8_STAGE(PG8_SB(0, 0), b2, voffB); PG8_STAGE(PG8_SB(0, 1), b2 + hstep, voffB); PG8_STAGE(PG8_SA(0, 0), a2, voffA);
            PG8_WAIT_V(8); PG8_WAIT_L(0); PG8_BAR; PG8_MMA(1, 0, At, B0); PG8_MMA(1, 1, At, B1); PG8_BAR; PG8_SCHED;
            PG8_LDB(B0, 1, 0); PG8_LDB(B1, 1, 1); PG8_SCHED; PG8_LDA(At, 1, 0); PG8_STAGE(PG8_SA(0, 1), a2 + hstep, voffA);
            PG8_WAIT_V(8); PG8_WAIT_L(0); PG8_BAR; PG8_MMA(0, 0, At, B0); PG8_MMA(0, 1, At, B1); PG8_BAR; PG8_SCHED;
            PG8_LDA(At, 1, 1); PG8_STAGE(PG8_SB(1, 0), b3, voffB); PG8_STAGE(PG8_SB(1, 1), b3 + hstep, voffB); PG8_STAGE(PG8_SA(1, 0), a3, voffA);
            PG8_WAIT_V(8); PG8_WAIT_L(0); PG8_BAR; PG8_MMA(1, 0, At, B0); PG8_MMA(1, 1, At, B1); PG8_BAR; PG8_SCHED;
            } else {
            PG8_LDB(B0, 0, 0); PG8_SCHED; PG8_LDA(At, 0, 0); PG8_STAGE(PG8_SA(1, 1), a1 + hstep, voffA);
            PG8_WAIT_L(8); PG8_BAR; PG8_WAIT_L(0); PG8_MMA(0, 0, At, B0); PG8_BAR; PG8_SCHED;
            PG8_LDB(B1, 0, 1); PG8_STAGE(PG8_SB(0, 0), b2, voffB);
            PG8_BAR; PG8_WAIT_L(0); PG8_MMA(0, 1, At, B1); PG8_BAR;
            PG8_LDA(At, 0, 1); PG8_STAGE(PG8_SA(0, 0), a2, voffA);
            PG8_BAR; PG8_WAIT_L(0); PG8_MMA(1, 0, At, B0); PG8_BAR; PG8_SCHED;
            PG8_STAGE(PG8_SB(0, 1), b2 + hstep, voffB);
            PG8_WAIT_V(6); PG8_BAR; PG8_MMA(1, 1, At, B1); PG8_BAR;
            PG8_LDB(B0, 1, 0); PG8_SCHED; PG8_LDA(At, 1, 0); PG8_STAGE(PG8_SA(0, 1), a2 + hstep, voffA);
            PG8_WAIT_L(8); PG8_BAR; PG8_WAIT_L(0); PG8_MMA(0, 0, At, B0); PG8_BAR; PG8_SCHED;
            PG8_LDB(B1, 1, 1); PG8_STAGE(PG8_SB(1, 0), b3, voffB);
            PG8_BAR; PG8_WAIT_L(0); PG8_MMA(0, 1, At, B1); PG8_BAR;
            PG8_LDA(At, 1, 1); PG8_STAGE(PG8_SA(1, 0), a3, voffA);
            PG8_BAR; PG8_WAIT_L(0); PG8_MMA(1, 0, At, B0); PG8_BAR; PG8_SCHED;
            PG8_STAGE(PG8_SB(1, 1), b3 + hstep, voffB);
            PG8_WAIT_V(6); PG8_BAR; PG8_MMA(1, 1, At, B1); PG8_BAR;
            }
        }
        if constexpr (ALIGN_EPI) { if (wr == 0) PG8_BAR; }
        if constexpr (!Epi::AFTER_DRAIN) { E(acc, cur, wr, wc, fr, fq); S.done(cur); }
        if (!has_next) break;
#pragma unroll
        for (int a = 0; a < 2; ++a)
#pragma unroll
            for (int b = 0; b < 2; ++b)
#pragma unroll
                for (int m = 0; m < 4; ++m)
#pragma unroll
                    for (int n = 0; n < 2; ++n) acc[a][b][m][n] = (f32x4){0.f, 0.f, 0.f, 0.f};
        cur = nxt; cA = nA; cB = nB; ++ui;
        if constexpr (ALIGN_EPI) { if (wr == 1) PG8_BAR; }
    }
    PG8_WAIT_V(0);
    if constexpr (!ALIGN_EPI) { if (wr == 0) PG8_BAR; }
    PG8_BAR;
    if constexpr (Epi::AFTER_DRAIN) { E.fused(acc, cur, wr, wc, fr, fq, lds, wid, lane); S.done(cur); }
#undef PG8_SA
#undef PG8_SB
#undef PG8_STAGE
#undef PG8_LDA
#undef PG8_LDB
#undef PG8_MMA
#undef PG8_WAIT_V
#undef PG8_WAIT_L
#undef PG8_BAR
#undef PG8_SCHED
}
}


using pg8::bf16_t; using pg8::bf16x8; using pg8::f32x4; using pg8::u32x4;
typedef float f32x16 __attribute__((ext_vector_type(16)));
typedef unsigned u32x2 __attribute__((ext_vector_type(2)));
typedef float f32x2_t __attribute__((ext_vector_type(2)));
typedef __bf16 bf16x2_t __attribute__((ext_vector_type(2)));
#define LAS __attribute__((address_space(3)))
#define DI __device__ __forceinline__

constexpr int DM = 1024, RA = 16896;
constexpr int ZM_LD = 2816, G_LD = 3072, IN_N = 5888;
constexpr float LOG2E = 1.4426950408889634f;
constexpr size_t MiB = 1u << 20;
constexpr size_t WS_CTL = 0, CTL_BYTES = 131072;
constexpr size_t WS_W = 1 * MiB, LW_STRIDE = 34 * MiB;
constexpr size_t W_IN = 0, W_QB = W_IN + (size_t)IN_N * 1024 * 2, W_KVB = W_QB + 768 * 256 * 2, W_BR = W_KVB + 1024 * 128 * 2,
                 W_OUT = W_BR + 3 * 1024 * 512 * 2, W_UP = W_OUT + 1024 * 1024 * 2, W_DOWN = W_UP + 4096 * 1024 * 2, W_END = W_DOWN + 4096 * 1024 * 2;
static_assert(W_END <= LW_STRIDE, "weights");
constexpr size_t WS_META0 = 69 * MiB, WS_METAX = 70 * MiB, WS_XN = 74 * MiB, WS_ZM = 107 * MiB, WS_G = 198 * MiB, WS_QKV = 297 * MiB, WS_SM = 438 * MiB, WS_END = 454 * MiB;
constexpr size_t OFF_QCR = 0, OFF_KVR = 25 * MiB;
constexpr size_t OSLOT = (size_t)RA * 512;
constexpr size_t QA_O = 0, KA_O = 512ull * RA, VA_O = 640ull * RA, QB_O = 768ull * RA, KB_O = 1280ull * RA, VB_O = 1792ull * RA, QC_O = 2304ull * RA, KC_O = 3072ull * RA, VC_O = 3840ull * RA;
constexpr size_t SM_CQN = 0, SM_CKVN = 9 * MiB, SM_KPE = 14 * MiB;
constexpr int LDS_MISC = 131072, LDS_BYTES = 131072 + 256;

struct Params { const float* in[28]; float* out; unsigned char* ws; };

DI unsigned pk2(float lo, float hi) { f32x2_t v = {lo, hi}; bf16x2_t b = __builtin_convertvector(v, bf16x2_t); return __builtin_bit_cast(unsigned, b); }
DI void ld8(const bf16_t* p, float (&f)[8]) {
    const u32x4 r = *(const u32x4*)p;
#pragma unroll
    for (int i = 0; i < 4; ++i) { f[2 * i] = __uint_as_float(r[i] << 16); f[2 * i + 1] = __uint_as_float(r[i] & 0xffff0000u); }
}
DI void st8(bf16_t* p, const float (&f)[8]) { u32x4 w; w.x = pk2(f[0], f[1]); w.y = pk2(f[2], f[3]); w.z = pk2(f[4], f[5]); w.w = pk2(f[6], f[7]); *(u32x4*)p = w; }
DI int lane_fresh() { int l; asm volatile("v_mbcnt_lo_u32_b32 %0, -1, 0\n\tv_mbcnt_hi_u32_b32 %0, -1, %0" : "=v"(l)); return l; }
DI float wave_sum(float v, int lane) {
#pragma unroll
    for (int o = 1; o < 64; o <<= 1) v += __int_as_float(__builtin_amdgcn_ds_bpermute((lane ^ o) << 2, __float_as_int(v)));
    return v;
}
DI float max3f(float a, float b, float c) { float r; asm("v_max3_f32 %0, %1, %2, %3" : "=v"(r) : "v"(a), "v"(b), "v"(c)); return r; }
DI float max2f(float a, float b) { float r; asm("v_max_f32_e32 %0, %1, %2" : "=v"(r) : "v"(a), "v"(b)); return r; }
DI float fadd_s(float a, float b) { float r; asm("v_add_f32_e32 %0, %1, %2" : "=v"(r) : "v"(a), "v"(b)); return r; }
#define MX2(a, b) __builtin_amdgcn_fmed3f((a), (b), __builtin_inff())
DI float swap32_max(float v) { auto rr = __builtin_amdgcn_permlane32_swap(__float_as_uint(v), __float_as_uint(v), false, false); return __builtin_amdgcn_fmed3f(__uint_as_float(rr[0]), __uint_as_float(rr[1]), __builtin_inff()); }
DI float swap32_add(float v) { auto rr = __builtin_amdgcn_permlane32_swap(__float_as_uint(v), __float_as_uint(v), false, false); return __uint_as_float(rr[0]) + __uint_as_float(rr[1]); }
DI constexpr float inv64(int j) {
    constexpr float T[32] = {1.0f, 0.749894209f, 0.562341325f, 0.421696503f, 0.316227766f, 0.237137371f, 0.177827941f, 0.133352143f, 0.1f, 0.0749894209f, 0.0562341325f, 0.0421696503f,
                             0.0316227766f, 0.0237137371f, 0.0177827941f, 0.0133352143f, 0.01f, 0.00749894209f, 0.00562341325f, 0.00421696503f, 0.00316227766f, 0.00237137371f,
                             0.00177827941f, 0.00133352143f, 0.001f, 0.000749894209f, 0.000562341325f, 0.000421696503f, 0.000316227766f, 0.000237137371f, 0.000177827941f, 0.000133352143f};
    return T[j];
}
DI void sincos_ang(float ang, float& s, float& c) {
    double t = (double)ang * 0.15915494309189535; t -= __builtin_rint(t); const float f = (float)t;
    s = __builtin_amdgcn_sinf(f); c = __builtin_amdgcn_cosf(f);
}

struct Chunk {
    int id, nseq, seq0, tps, n;
    DI int rows_per_seq() const { return tps * 256; }
    DI int rows() const { return nseq * tps * 256; }
};
DI Chunk make_chunk(int c) { Chunk k; k.id = c; if (c < 2) { k.nseq = 1; k.seq0 = c; k.tps = 65; k.n = 16384; } else { k.nseq = 2; k.seq0 = 2; k.tps = 33; k.n = 8192; } return k; }
struct XMap {
    float* out; float* metax; const float* xp; const float* xs; const float* meta0; int seq0, tps, first;
    DI float* xw(int pt) const {
        const int hi = pt >= tps ? 1 : 0, s = seq0 + hi, lt = pt - hi * tps;
        if (lt == tps - 1) return metax + (size_t)s * 256 * DM;
        const int ob = (s < 2) ? s * 16384 : 32768 + (s - 2) * 8192;
        return out + ((size_t)ob + (size_t)lt * 256) * DM;
    }
    DI const float* xr(int pt) const {
        if (!first) return xw(pt);
        const int hi = pt >= tps ? 1 : 0, s = seq0 + hi, lt = pt - hi * tps;
        if (lt == tps - 1) return metax + (size_t)s * 256 * DM;
        return (s < 2) ? xp + ((size_t)s * 16384 + (size_t)lt * 256) * DM : xs + ((size_t)(s - 2) * 8192 + (size_t)lt * 256) * DM;
    }
};

struct Sched {
    int nM, nN, nZ, nwg, G, c, ta, tps;
    DI void init(int nseq, int ta_, int tps_, int nN_, int nZ_, int G_, int c_) { ta = ta_; tps = tps_; nM = nseq * ta_; nN = nN_; nZ = nZ_; nwg = nM * nN; G = G_; c = c_; }
    DI bool next(int i, pg8::Unit& u) const {
        const int tl = (i / nZ) * G + c; if (tl >= nwg) return false;
        u.z = i % nZ;
        int wgid = tl; { const int q = nwg / pg8::NXCD, r = nwg % pg8::NXCD, xcd = wgid % pg8::NXCD, off = wgid / pg8::NXCD; wgid = (xcd < r ? xcd * (q + 1) : r * (q + 1) + (xcd - r) * q) + off; }
        const int nig = pg8::WGM * nN, gid = wgid / nig, fm = gid * pg8::WGM, gsz = (nM - fm) < pg8::WGM ? (nM - fm) : pg8::WGM;
        const int pa = fm + ((wgid % nig) % gsz); u.pn = (wgid % nig) / gsz;
        u.pm = pa >= ta ? pa - ta + tps : pa;
        return true;
    }
    DI void a_ready(const pg8::Unit&) const {}
    DI void done(const pg8::Unit&) const {}
};

template <int ACT  > struct EpiBf16 {
    static constexpr bool PERM = true, AFTER_DRAIN = false;
    bf16_t* O; int ldc;
    DI void operator()(const f32x4 (&acc)[2][2][4][2], const pg8::Unit& u, int wr, int wc, int fr_, int fq_) const {
        const int ln_ = lane_fresh(), fr = ln_ & 15, fq = ln_ >> 4;
        const int row0 = u.pm * 256 + wr * 64 + fr, col0 = u.pn * 256 + wc * 32 + 8 * fq;
#pragma unroll
        for (int ai = 0; ai < 2; ++ai)
#pragma unroll
            for (int m = 0; m < 4; ++m) { bf16_t* rowp = O + (size_t)(row0 + ai * 128 + m * 16) * ldc + col0;
#pragma unroll
                for (int bj = 0; bj < 2; ++bj) { f32x4 v0 = acc[ai][bj][m][0], v1 = acc[ai][bj][m][1];
                    if (ACT == 2) {
#pragma unroll
                        for (int k = 0; k < 4; ++k) { const float a = fmaxf(v0[k], 0.f), b = fmaxf(v1[k], 0.f); v0[k] = a * a; v1[k] = b * b; } }
                    u32x4 w; w.x = pk2(v0[0], v0[1]); w.y = pk2(v0[2], v0[3]); w.z = pk2(v1[0], v1[1]); w.w = pk2(v1[2], v1[3]);
                    *(u32x4*)(rowp + bj * 128) = w; } }
    }
};
struct EpiIn {
    static constexpr bool PERM = true, AFTER_DRAIN = false;
    bf16_t* ZM; bf16_t* G; const float* bgate;
    DI void operator()(const f32x4 (&acc)[2][2][4][2], const pg8::Unit& u, int wr, int wc, int fr_, int fq_) const {
        const int ln_ = lane_fresh(), fr = ln_ & 15, fq = ln_ >> 4;
        const bool gate = u.pn >= 11;
        const int row0 = u.pm * 256 + wr * 64 + fr, colt = gate ? (u.pn - 11) * 256 : u.pn * 256, col0 = colt + wc * 32 + 8 * fq, ld = gate ? G_LD : ZM_LD;
        bf16_t* base = gate ? G : ZM;
        f32x4 bv[2][2];
#pragma unroll
        for (int bj = 0; bj < 2; ++bj)
#pragma unroll
            for (int n = 0; n < 2; ++n) bv[bj][n] = gate ? *(const f32x4*)(bgate + col0 + bj * 128 + 4 * n) : (f32x4){0.f, 0.f, 0.f, 0.f};
#pragma unroll
        for (int ai = 0; ai < 2; ++ai)
#pragma unroll
            for (int m = 0; m < 4; ++m) { bf16_t* rowp = base + (size_t)(row0 + ai * 128 + m * 16) * ld + col0;
#pragma unroll
                for (int bj = 0; bj < 2; ++bj) { f32x4 v0 = acc[ai][bj][m][0] + bv[bj][0], v1 = acc[ai][bj][m][1] + bv[bj][1];
                    if (gate) {
#pragma unroll
                        for (int k = 0; k < 4; ++k) { v0[k] = __builtin_amdgcn_rcpf(1.f + __builtin_amdgcn_exp2f(-LOG2E * v0[k])); v1[k] = __builtin_amdgcn_rcpf(1.f + __builtin_amdgcn_exp2f(-LOG2E * v1[k])); } }
                    u32x4 w; w.x = pk2(v0[0], v0[1]); w.y = pk2(v0[2], v0[3]); w.z = pk2(v1[0], v1[1]); w.w = pk2(v1[2], v1[3]);
                    *(u32x4*)(rowp + bj * 128) = w; } }
    }
};
struct EpiBranch {
    static constexpr bool PERM = false, AFTER_DRAIN = false;
    const bf16_t* G; float* MG; bf16_t* MGb;
    DI void operator()(const f32x4 (&acc)[2][2][4][2], const pg8::Unit& u, int wr, int wc, int fr_, int fq_) const {
        const int ln_ = lane_fresh(), fr = ln_ & 15, fq = ln_ >> 4;
        const int row0 = u.pm * 256 + wr * 64 + fr, col0 = u.pn * 256 + wc * 32 + 4 * fq;
#pragma unroll
        for (int ai = 0; ai < 2; ++ai)
#pragma unroll
            for (int m = 0; m < 4; ++m) { const size_t row = (size_t)(row0 + ai * 128 + m * 16);
#pragma unroll
                for (int bj = 0; bj < 2; ++bj)
#pragma unroll
                    for (int n = 0; n < 2; ++n) { const int col = col0 + bj * 128 + n * 16;
                        const u32x2 gr = *(const u32x2*)(G + row * G_LD + u.z * 1024 + col);
                        f32x4 g; g[0] = __uint_as_float(gr.x << 16); g[1] = __uint_as_float(gr.x & 0xffff0000u); g[2] = __uint_as_float(gr.y << 16); g[3] = __uint_as_float(gr.y & 0xffff0000u);
                        f32x4 v = g * acc[ai][bj][m][n];
                        float* mp = MG + row * DM + col;
                        if (u.z > 0) v += *(const f32x4*)mp;
                        if (u.z < 2) *(f32x4*)mp = v;
                        else { u32x2 w; w.x = pk2(v[0], v[1]); w.y = pk2(v[2], v[3]); *(u32x2*)(MGb + row * DM + col) = w; } }
                asm volatile("" ::: "memory"); }
    }
};
struct EpiResid {
    static constexpr bool PERM = false, AFTER_DRAIN = false;
    XMap xm;
    DI void operator()(const f32x4 (&acc)[2][2][4][2], const pg8::Unit& u, int wr, int wc, int fr_, int fq_) const {
        const int ln_ = lane_fresh(), fr = ln_ & 15, fq = ln_ >> 4;
        const float* rd = xm.xr(u.pm); float* wp = xm.xw(u.pm);
        const int row0 = wr * 64 + fr, col0 = u.pn * 256 + wc * 32 + 4 * fq;
#pragma unroll
        for (int ai = 0; ai < 2; ++ai)
#pragma unroll
            for (int m = 0; m < 4; ++m) { const size_t off = (size_t)(row0 + ai * 128 + m * 16) * DM + col0;
#pragma unroll
                for (int bj = 0; bj < 2; ++bj)
#pragma unroll
                    for (int n = 0; n < 2; ++n) { const size_t o = off + bj * 128 + n * 16; *(f32x4*)(wp + o) = *(const f32x4*)(rd + o) + acc[ai][bj][m][n]; }
                asm volatile("" ::: "memory"); }
    }
};

DI void transpose_item(const float* W, int K, int N, bf16_t* WT, int split, int extra, LAS float* scr, int item, int lane) {
    const int nblk = N / 32, kb = item / nblk, nb = item % nblk, k0 = 64 * kb, n0 = 32 * nb;
    const int row_off = (n0 >= split) ? extra : 0;
#pragma unroll 8
    for (int i = 0; i < 32; ++i) { const int kk = 2 * i + (lane >> 5); scr[kk * 33 + (lane & 31)] = W[(size_t)(k0 + kk) * N + n0 + (lane & 31)]; }
    asm volatile("s_waitcnt lgkmcnt(0)" ::: "memory");
    const int c = lane & 7;
#pragma unroll
    for (int j = 0; j < 4; ++j) { const int n = (lane >> 3) + 8 * j; const LAS float* s = scr + (8 * c) * 33 + n;
        u32x4 o; o.x = pk2(s[0 * 33], s[1 * 33]); o.y = pk2(s[2 * 33], s[3 * 33]); o.z = pk2(s[4 * 33], s[5 * 33]); o.w = pk2(s[6 * 33], s[7 * 33]);
        *(u32x4*)(WT + (size_t)(row_off + n0 + n) * K + k0 + 8 * c) = o; }
    asm volatile("s_waitcnt lgkmcnt(0)" ::: "memory");
}
DI void prologue(const Params& p, LAS unsigned char* lds, int gw, int NGW, int wave, int lane) {
    LAS float* scr = (LAS float*)(lds + wave * 16384);
    constexpr int I_IN = 16 * 182, I_QB = 4 * 24, I_KVB = 2 * 32, I_BR = 8 * 32, I_OUT = 16 * 32, I_UP = 16 * 128, I_DN = 64 * 32;
    constexpr int PER_L = I_IN + I_QB + I_KVB + 3 * I_BR + I_OUT + I_UP + I_DN;
    for (int it = gw; it < 2 * PER_L; it += NGW) {
        const int l = it / PER_L; int r = it % PER_L;
        unsigned char* wb = p.ws + WS_W + (size_t)l * LW_STRIDE;
        if (r < I_IN) { transpose_item(p.in[4] + (size_t)l * 1024 * 5824, 1024, 5824, (bf16_t*)(wb + W_IN), 2752, 64, scr, r, lane); continue; } r -= I_IN;
        if (r < I_QB) { transpose_item(p.in[16] + (size_t)l * 256 * 768, 256, 768, (bf16_t*)(wb + W_QB), 1 << 30, 0, scr, r, lane); continue; } r -= I_QB;
        if (r < I_KVB) { transpose_item(p.in[18] + (size_t)l * 128 * 1024, 128, 1024, (bf16_t*)(wb + W_KVB), 1 << 30, 0, scr, r, lane); continue; } r -= I_KVB;
        if (r < 3 * I_BR) { const int b = r / I_BR; transpose_item(p.in[21 + b] + (size_t)l * 512 * 1024, 512, 1024, (bf16_t*)(wb + W_BR) + (size_t)b * 1024 * 512, 1 << 30, 0, scr, r % I_BR, lane); continue; } r -= 3 * I_BR;
        if (r < I_OUT) { transpose_item(p.in[24] + (size_t)l * 1024 * 1024, 1024, 1024, (bf16_t*)(wb + W_OUT), 1 << 30, 0, scr, r, lane); continue; } r -= I_OUT;
        if (r < I_UP) { transpose_item(p.in[26] + (size_t)l * 1024 * 4096, 1024, 4096, (bf16_t*)(wb + W_UP), 1 << 30, 0, scr, r, lane); continue; } r -= I_UP;
        transpose_item(p.in[27] + (size_t)l * 4096 * 1024, 4096, 1024, (bf16_t*)(wb + W_DOWN), 1 << 30, 0, scr, r, lane);
    }
    { float* mx0 = (float*)(p.ws + WS_METAX);
      for (int r = gw; r < 4 * 256; r += NGW) { const int rr = r & 255; f32x4* o = (f32x4*)(mx0 + (size_t)r * DM) + lane;
#pragma unroll
        for (int j = 0; j < 4; ++j) o[64 * j] = (rr < 16) ? ((const f32x4*)(p.in[2] + (size_t)rr * DM))[lane + 64 * j] : (f32x4){0.f, 0.f, 0.f, 0.f}; } }
    float* m0 = (float*)(p.ws + WS_META0);
    for (int r = gw; r < 256; r += NGW) { f32x4* o = (f32x4*)(m0 + (size_t)r * DM) + lane;
#pragma unroll
        for (int j = 0; j < 4; ++j) o[64 * j] = (r < 16) ? ((const f32x4*)(p.in[2] + (size_t)r * DM))[lane + 64 * j] : (f32x4){0.f, 0.f, 0.f, 0.f}; }
}

DI void norm_phase(const XMap& xm, int rows, const float* g, bf16_t* XN, int gw, int NGW, int lane) {
    for (int r = gw; r < rows; r += NGW) {
        const float* xrow = xm.xr(r >> 8) + (size_t)(r & 255) * DM;
        const f32x4* xr = (const f32x4*)xrow + lane;
        f32x4 v[4]; float s = 0.f;
#pragma unroll
        for (int j = 0; j < 4; ++j) { v[j] = xr[64 * j]; s += (v[j].x * v[j].x + v[j].y * v[j].y) + (v[j].z * v[j].z + v[j].w * v[j].w); }
        const float rs = rsqrtf(wave_sum(s, lane) * (1.f / DM) + 1e-6f);
        u32x2* o8 = (u32x2*)(XN + (size_t)r * DM) + lane;
#pragma unroll
        for (int j = 0; j < 4; ++j) { const f32x4 gg = ((const f32x4*)g)[lane + 64 * j]; u32x2 w; w.x = pk2(v[j].x * rs * gg.x, v[j].y * rs * gg.y); w.y = pk2(v[j].z * rs * gg.z, v[j].w * rs * gg.w); o8[64 * j] = w; }
    }
}

template <int W, int W0, int ROPE> DI void norm_task(const bf16_t* s0, const bf16_t* s1, const float* gain, float oscale, bf16_t* dst, float pa, float pb) {
    float ss = 0.f;
#pragma unroll 2
    for (int c = 0; c < W / 8; ++c) { float x[8]; ld8(c < W0 / 8 ? s0 + 8 * c : s1 + 8 * (c - W0 / 8), x);
#pragma unroll
        for (int e = 0; e < 8; ++e) ss += x[e] * x[e]; }
    const float rs = rsqrtf(ss * (1.f / W) + 1e-6f) * oscale;
    constexpr int NPLAIN = ROPE == 1 ? 0 : (ROPE == 2 ? 16 : W / 8);
#pragma unroll 2
    for (int c = 0; c < NPLAIN; ++c) { float x[8]; ld8(c < W0 / 8 ? s0 + 8 * c : s1 + 8 * (c - W0 / 8), x);
#pragma unroll
        for (int e = 0; e < 8; ++e) x[e] *= rs * gain[8 * c + e];
        st8(dst + 8 * c, x); }
    if constexpr (ROPE != 0) {
        constexpr int NB = ROPE == 1 ? 2 : 1, HC = ROPE == 1 ? 2 : 4, C0 = ROPE == 1 ? 0 : 16;
#pragma unroll
        for (int b = 0; b < NB; ++b) { const float pos = b ? pb : pa;
#pragma unroll
            for (int k = 0; k < HC; ++k) { const int c1 = C0 + 2 * HC * b + k, c2 = c1 + HC; float x1[8], x2[8];
                ld8(c1 < W0 / 8 ? s0 + 8 * c1 : s1 + 8 * (c1 - W0 / 8), x1); ld8(c2 < W0 / 8 ? s0 + 8 * c2 : s1 + 8 * (c2 - W0 / 8), x2);
#pragma unroll
                for (int e = 0; e < 8; ++e) { const int j = 8 * k + e; const float inv = ROPE == 1 ? inv64(2 * j) : inv64(j); float sn, cs; sincos_ang(pos * inv, sn, cs);
                    const float y1 = x1[e] * rs * gain[8 * c1 + e], y2 = x2[e] * rs * gain[8 * c2 + e]; x1[e] = y1 * cs - y2 * sn; x2[e] = y2 * cs + y1 * sn; }
                st8(dst + 8 * c1, x1); st8(dst + 8 * c2, x2); } }
    }
}
template <int W> DI void transpose_task(const bf16_t* src, bf16_t* dstT, int row) {
#pragma unroll 2
    for (int c = 0; c < W / 8; ++c) { const u32x4 r = *(const u32x4*)(src + 8 * c);
#pragma unroll
        for (int i = 0; i < 4; ++i) { dstT[(size_t)(8 * c + 2 * i) * RA + row] = (bf16_t)(r[i] & 0xffffu); dstT[(size_t)(8 * c + 2 * i + 1) * RA + row] = (bf16_t)(r[i] >> 16); } }
}
struct RowPos { float lin, row, col; };
DI RowPos row_pos(const Chunk& ck, int r) {
    const int li = r >= ck.rows_per_seq() ? r - ck.rows_per_seq() : r; RowPos p;
    if (li < ck.n) { p.lin = (float)(li + 16); p.row = (float)(li >> 6); p.col = (float)(li & 63); }
    else if (li < ck.n + 16) { p.lin = (float)(li - ck.n); p.row = -1.f; p.col = (float)(li - ck.n); }
    else { p.lin = 0.f; p.row = 0.f; p.col = 0.f; }
    return p;
}

DI void ew1_phase(const Params& p, const Chunk& ck, int l, int gw, int NGW, int lane) {
    unsigned char* ws = p.ws; asm volatile("" : "+s"(ws));
    const bf16_t* ZM = (const bf16_t*)(ws + WS_ZM); bf16_t* QKV = (bf16_t*)(ws + WS_QKV);
    bf16_t* CQN = (bf16_t*)(ws + WS_SM + SM_CQN); bf16_t* CKVN = (bf16_t*)(ws + WS_SM + SM_CKVN); bf16_t* KPE = (bf16_t*)(ws + WS_SM + SM_KPE);
    const int nrb = ck.rows() / 64; const float QS = 0.125f * LOG2E;
    for (int w = gw; w < nrb * 34; w += NGW) {
        const int rb = w / 34, task = w % 34, row = rb * 64 + lane;
        const bf16_t* z = ZM + (size_t)row * ZM_LD; const RowPos ps = row_pos(ck, row);
        if (task < 8) { const int h = task; norm_task<64, 64, 1>(z + 64 * h, z, p.in[6] + l * 64, QS, QKV + QA_O + ((size_t)h * RA + row) * 64, ps.row, ps.col); }
        else if (task < 10) { const int h = task - 8; norm_task<64, 64, 1>(z + 512 + 64 * h, z, p.in[7] + l * 64, 1.f, QKV + KA_O + ((size_t)h * RA + row) * 64, ps.row, ps.col); }
        else if (task < 12) { const int h = task - 10; transpose_task<64>(z + 640 + 64 * h, QKV + VA_O + (size_t)h * 64 * RA, row); }
        else if (task < 20) { const int hm = task - 12; norm_task<64, 64, 0>(z + 768 + 64 * hm, z, p.in[8] + l * 64, QS, QKV + QB_O + ((size_t)hm * RA + row) * 64, 0.f, 0.f); }
        else if (task < 28) { const int hm = task - 20; norm_task<64, 64, 0>(z + 1280 + 64 * hm, z, p.in[9] + l * 64, 1.f, QKV + KB_O + ((size_t)hm * RA + row) * 64, 0.f, 0.f); }
        else if (task < 32) { const int h = task - 28; transpose_task<128>(z + 1792 + 128 * h, QKV + VB_O + (size_t)h * 128 * RA, row); }
        else if (task == 32) { norm_task<256, 256, 0>(z + 2304, z, p.in[15] + l * 256, 1.f, CQN + (size_t)row * 256, 0.f, 0.f); }
        else { norm_task<128, 128, 0>(z + 2560, z, p.in[17] + l * 128, 1.f, CKVN + (size_t)row * 128, 0.f, 0.f);
#pragma unroll
            for (int c = 0; c < 8; ++c) *(u32x4*)(KPE + (size_t)row * 64 + 8 * c) = *(const u32x4*)(z + 2688 + 8 * c); }
    }
}
DI void ew2_phase(const Params& p, const Chunk& ck, int l, int gw, int NGW, int lane) {
    unsigned char* ws = p.ws; asm volatile("" : "+s"(ws));
    const bf16_t* QCR = (const bf16_t*)(ws + WS_ZM + OFF_QCR); const bf16_t* KVR = (const bf16_t*)(ws + WS_ZM + OFF_KVR); const bf16_t* KPE = (const bf16_t*)(ws + WS_SM + SM_KPE);
    bf16_t* QKV = (bf16_t*)(ws + WS_QKV);
    const int nrb = ck.rows() / 64; const float QS = 0.07216878364870322f * LOG2E;
    for (int w = gw; w < nrb * 12; w += NGW) {
        const int rb = w / 12, task = w % 12, row = rb * 64 + lane; const RowPos ps = row_pos(ck, row);
        if (task < 4) { const int h = task; norm_task<192, 192, 2>(QCR + (size_t)row * 768 + 192 * h, QCR, p.in[19] + l * 192, QS, QKV + QC_O + ((size_t)h * RA + row) * 192, ps.lin, 0.f); }
        else if (task < 8) { const int h = task - 4; norm_task<192, 128, 2>(KVR + (size_t)row * 1024 + 256 * h, KPE + (size_t)row * 64, p.in[20] + l * 192, 1.f, QKV + KC_O + ((size_t)h * RA + row) * 192, ps.lin, 0.f); }
        else { const int h = task - 8; transpose_task<128>(KVR + (size_t)row * 1024 + 256 * h + 128, QKV + VC_O + (size_t)h * 128 * RA, row); }
    }
}
DI void ew3_phase(const Params& p, const Chunk& ck, int l, bool last, int gw, int NGW, int lane) {
    unsigned char* ws = p.ws; asm volatile("" : "+s"(ws));
    bf16_t* O1 = (bf16_t*)(ws + WS_ZM) + 1 * OSLOT; const bf16_t* O2 = (const bf16_t*)(ws + WS_ZM) + 3 * OSLOT;
    const float d1 = wave_sum(p.in[10][l * 64 + lane] * p.in[11][l * 64 + lane], lane), d2 = wave_sum(p.in[12][l * 64 + lane] * p.in[13][l * 64 + lane], lane);
    int lz = l; asm volatile("" : "+s"(lz));
    const float lam_init = __uint_as_float(lz == 0 ? 0x3e4ccccdu : 0x3eb60549u)  , lam = expf(d1) - expf(d2) + lam_init, osc = 1.f - lam_init;
    const float* gs = p.in[14] + l * 128;
    const int nrb = ck.rows() / 64;
    for (int w = gw; w < nrb * 4; w += NGW) {
        const int rb = w >> 2, h = w & 3, row = rb * 64 + lane;
        if (last && (row >= ck.rows_per_seq() ? row - ck.rows_per_seq() : row) >= (ck.tps - 1) * 256) continue;
        bf16_t* a = O1 + (size_t)row * 512 + 128 * h; const bf16_t* b = O2 + (size_t)row * 512 + 128 * h;
        float ss = 0.f;
#pragma unroll 2
        for (int c = 0; c < 16; ++c) { float x[8], y[8]; ld8(a + 8 * c, x); ld8(b + 8 * c, y);
#pragma unroll
            for (int e = 0; e < 8; ++e) { const float d = x[e] - lam * y[e]; ss += d * d; } }
        const float rs = rsqrtf(ss * (1.f / 128.f) + 1e-6f) * osc;
#pragma unroll 2
        for (int c = 0; c < 16; ++c) { float x[8], y[8]; ld8(a + 8 * c, x); ld8(b + 8 * c, y);
#pragma unroll
            for (int e = 0; e < 8; ++e) x[e] = (x[e] - lam * y[e]) * rs * gs[8 * c + e];
            st8(a + 8 * c, x); }
    }
}

template <int DQK, int DV, bool ALIBI, bool PIPE>
DI void attn_unit(LAS unsigned char* lds, const bf16_t* __restrict__ Q, const bf16_t* __restrict__ K, const bf16_t* __restrict__ Vt, bf16_t* __restrict__ O, int r0, int qb, int n, float sl, const int wid) {
    constexpr bool EARLYV = true;
    constexpr bool NEGM = (DQK == 64);
    constexpr int KROW = DQK * 2 + 16, KT = 64 * KROW, VROW = 144, VT = DV * VROW, KCH = DQK / 8, NKC = 64 * KCH / 512, NVC = DV * 8 / 512, NKS = DQK / 16, NDB = DV / 32, VB0 = 2 * KT;
    typedef const __attribute__((address_space(1))) u32x4* gptr;
    const int lane = lane_fresh(), tid = wid * 64 + lane, r = lane & 31, h = lane >> 5;
    const int nk = n + 16, NT = (nk + 63) >> 6;
    const int li = qb * 256 + wid * 32 + r;
    const int tq = ALIBI ? ((4 * qb + 3 < NT - 1) ? 4 * qb + 3 : NT - 1) : -1;
#define TILE(j) ((j) <= tq ? tq - (j) : (j))
    const bool active = (qb * 256 + wid * 32) < nk;
    const int qrow = r0 + li;
    const float qlin = (li < n) ? (float)(li + 16) : (li < nk ? (float)(li - n) : 0.f);
    bf16x8 qf[NKS];
#pragma unroll
    for (int ks = 0; ks < NKS; ++ks) qf[ks] = *(const bf16x8*)(Q + (size_t)qrow * DQK + ks * 16 + h * 8);
    f32x16 o[NDB];
#pragma unroll
    for (int d = 0; d < NDB; ++d)
#pragma unroll
        for (int i = 0; i < 16; ++i) o[d][i] = 0.f;
    float m = 0.f, l = 0.f; f32x16 negm, zero16;
#pragma unroll
    for (int i = 0; i < 16; ++i) { negm[i] = 0.f; zero16[i] = 0.f; }
    const bf16_t* kg0 = K + (size_t)r0 * DQK + tid * 8; const bf16_t* vg0 = Vt + (size_t)(tid >> 3) * RA + r0 + (tid & 7) * 8; const int vl0 = VB0 + (tid >> 3) * VROW + (tid & 7) * 16;
#define KL(i) ((((tid + 512 * (i)) / KCH) * KROW) + ((tid + 512 * (i)) % KCH) * 16)
#define KG(i, t) ((gptr)(kg0 + (i) * 4096 + (size_t)(t) * 64 * DQK))
#define VG(i, t) ((gptr)(vg0 + (size_t)(i) * 64 * RA + (size_t)(t) * 64))
#define VL(i) (vl0 + (i) * 64 * VROW)
    const int pr = (r & ~12) | ((r & 4) << 1) | ((r & 8) >> 1);
    const int kaddr = pr * KROW + h * 16, vaddr = VB0 + r * VROW + h * 16;
    u32x4 kst[NKC], vst[NVC], kstn[NKC], vstn[NVC];
#define QK_TILE(A0, A1, kb_) do { const int ko_ = (kb_) * KT + kaddr; \
        _Pragma("unroll") for (int kb4 = 0; kb4 < NKS; kb4 += 4) { bf16x8 kq[8]; \
            _Pragma("unroll") for (int j = 0; j < 4; ++j) { kq[2 * j] = *(const LAS bf16x8*)(lds + ko_ + (kb4 + j) * 32); kq[2 * j + 1] = *(const LAS bf16x8*)(lds + ko_ + 32 * KROW + (kb4 + j) * 32); } \
            asm volatile("" : "+v"(kq[0]), "+v"(kq[1]), "+v"(kq[2]), "+v"(kq[3]), "+v"(kq[4]), "+v"(kq[5]), "+v"(kq[6]), "+v"(kq[7]));     \
            _Pragma("unroll") for (int j = 0; j < 4; ++j) { \
                if (kb4 + j == 0) { A0 = __builtin_amdgcn_mfma_f32_32x32x16_bf16(kq[0], qf[0], NEGM ? negm : zero16, 0, 0, 0); A1 = __builtin_amdgcn_mfma_f32_32x32x16_bf16(kq[1], qf[0], NEGM ? negm : zero16, 0, 0, 0); } \
                else { A0 = __builtin_amdgcn_mfma_f32_32x32x16_bf16(kq[2 * j], qf[kb4 + j], A0, 0, 0, 0); A1 = __builtin_amdgcn_mfma_f32_32x32x16_bf16(kq[2 * j + 1], qf[kb4 + j], A1, 0, 0, 0); } } \
            __builtin_amdgcn_sched_barrier(0); } } while (0)
#pragma unroll
    for (int i = 0; i < NKC; ++i) kst[i] = *KG(i, TILE(0));
#pragma unroll
    for (int i = 0; i < NVC; ++i) vst[i] = *VG(i, TILE(0));
#pragma unroll
    for (int i = 0; i < NKC; ++i) *(LAS u32x4*)(lds + KL(i)) = kst[i];
#pragma unroll
    for (int i = 0; i < NVC; ++i) *(LAS u32x4*)(lds + VL(i)) = vst[i];
    if constexpr (PIPE) {
#pragma unroll
        for (int i = 0; i < NKC; ++i) kst[i] = *KG(i, 1);
#pragma unroll
        for (int i = 0; i < NKC; ++i) *(LAS u32x4*)(lds + KT + KL(i)) = kst[i];
#pragma unroll
        for (int i = 0; i < NKC; ++i) kst[i] = *KG(i, 2);
#pragma unroll
        for (int i = 0; i < NVC; ++i) vst[i] = *VG(i, 1);
    }
    __syncthreads();
    f32x16 s0, s1, n0, n1;
    if constexpr (PIPE) { QK_TILE(s0, s1, 0); __syncthreads(); }
    for (int jt = 0; jt < NT; ++jt) {
        const int t = PIPE ? jt : TILE(jt), tn = TILE(jt + 1);
        const int cb = jt & 1;
        const bool moreV = (jt + 1 < NT), moreK = PIPE ? (jt + 2 < NT) : moreV;
        if constexpr (PIPE) {
            if (t + 3 < NT) {
#pragma unroll
                for (int i = 0; i < NKC; ++i) kstn[i] = *KG(i, t + 3);
            }
            if (t + 2 < NT) {
#pragma unroll
                for (int i = 0; i < NVC; ++i) vstn[i] = *VG(i, t + 2);
            }
        } else {
            if (moreK) {
#pragma unroll
                for (int i = 0; i < NKC; ++i) kst[i] = *KG(i, tn);
            }
            if (moreV) {
#pragma unroll
                for (int i = 0; i < NVC; ++i) vst[i] = *VG(i, tn);
            }
#ifdef PROBE_MEM2
            { int zo = 0; asm volatile("" : "+v"(zo));
              if (moreK) {
#pragma unroll
                for (int i = 0; i < NKC; ++i) { u32x4 d = *(KG(i, t + 1) + zo); asm volatile("" :: "v"(d)); } }
              if (moreV) {
#pragma unroll
                for (int i = 0; i < NVC; ++i) { u32x4 d = *(VG(i, t + 1) + zo); asm volatile("" :: "v"(d)); } } }
#endif
        }
        if (active) {
        if constexpr (PIPE) { if (moreV) QK_TILE(n0, n1, cb ^ 1); }
        else QK_TILE(s0, s1, cb);
        bf16x8 vf0[8];
        if constexpr (EARLYV) {
#pragma unroll
            for (int j = 0; j < 8; ++j) vf0[j] = *(const LAS bf16x8*)(lds + cb * VT + vaddr + (j >> 2) * 32 * VROW + (j & 3) * 32);
        }
        if (t < NT - 1) {
            if constexpr (ALIBI) {
                const float qo = qlin - (float)(16 + 8 * h + t * 64);
#pragma unroll
                for (int i = 0; i < 16; ++i) { const float ci = (float)(16 * (i >> 3) + (i & 7)); s0[i] = __builtin_fmaf(-sl, __builtin_fabsf(qo - ci), s0[i]); s1[i] = __builtin_fmaf(-sl, __builtin_fabsf(qo - 32.f - ci), s1[i]); }
            }
        } else {
#pragma unroll
            for (int i = 0; i < 16; ++i) { const int kk = 16 * (i >> 3) + 8 * h + (i & 7);
                if (kk < 16) { if constexpr (ALIBI) s0[i] = __builtin_fmaf(-sl, __builtin_fabsf(qlin - (float)kk), s0[i]); } else s0[i] = -1e30f;
                s1[i] = -1e30f; }
        }
        float mx;
        { float a = MX2(s0[0], s1[0]), b = MX2(s0[1], s1[1]);
#pragma unroll
          for (int i = 2; i < 16; i += 2) { a = MX2(a, MX2(s0[i], s1[i])); b = MX2(b, MX2(s0[i + 1], s1[i + 1])); }
          mx = swap32_max(MX2(a, b)); }
        if constexpr (!NEGM) mx -= m;
        if (__builtin_expect(jt == 0 || __builtin_amdgcn_ballot_w64(mx > 8.f) != 0ull, 0)) {
            const float dl = (jt == 0) ? mx : fmaxf(mx, 0.f);
            m += dl;
            if constexpr (NEGM) {
#pragma unroll
                for (int i = 0; i < 16; ++i) { s0[i] -= dl; s1[i] -= dl; negm[i] = -m; } }
            if constexpr (PIPE) {
#pragma unroll
                for (int i = 0; i < 16; ++i) { n0[i] -= dl; n1[i] -= dl; } }
            if (jt != 0) { const float f = __builtin_amdgcn_exp2f(-dl); l *= f;
#pragma unroll
                for (int d = 0; d < NDB; ++d)
#pragma unroll
                    for (int i = 0; i < 16; ++i) o[d][i] *= f; }
            asm volatile("" ::: "memory");
        }
        float ra = 0.f, rb = 0.f;
#pragma unroll
        for (int i = 0; i < 16; ++i) { s0[i] = __builtin_amdgcn_exp2f(NEGM ? s0[i] : s0[i] - m); s1[i] = __builtin_amdgcn_exp2f(NEGM ? s1[i] : s1[i] - m); ra += s0[i]; rb += s1[i]; }
        l += ra + rb;
        bf16x8 pf[4];
        { u32x4 w;
          w.x = pk2(s0[0], s0[1]); w.y = pk2(s0[2], s0[3]); w.z = pk2(s0[4], s0[5]); w.w = pk2(s0[6], s0[7]); pf[0] = __builtin_bit_cast(bf16x8, w);
          w.x = pk2(s0[8], s0[9]); w.y = pk2(s0[10], s0[11]); w.z = pk2(s0[12], s0[13]); w.w = pk2(s0[14], s0[15]); pf[1] = __builtin_bit_cast(bf16x8, w);
          w.x = pk2(s1[0], s1[1]); w.y = pk2(s1[2], s1[3]); w.z = pk2(s1[4], s1[5]); w.w = pk2(s1[6], s1[7]); pf[2] = __builtin_bit_cast(bf16x8, w);
          w.x = pk2(s1[8], s1[9]); w.y = pk2(s1[10], s1[11]); w.z = pk2(s1[12], s1[13]); w.w = pk2(s1[14], s1[15]); pf[3] = __builtin_bit_cast(bf16x8, w); }
#pragma unroll
        for (int d0 = 0; d0 < NDB; d0 += 2) { bf16x8 vf[8];
#pragma unroll
            for (int j = 0; j < 8; ++j) { if (EARLYV && d0 == 0) vf[j] = vf0[j]; else vf[j] = *(const LAS bf16x8*)(lds + cb * VT + vaddr + (d0 + (j >> 2)) * 32 * VROW + (j & 3) * 32); }
            asm volatile("" : "+v"(vf[0]), "+v"(vf[1]), "+v"(vf[2]), "+v"(vf[3]), "+v"(vf[4]), "+v"(vf[5]), "+v"(vf[6]), "+v"(vf[7]));
#pragma unroll
            for (int j = 0; j < 8; ++j) o[d0 + (j >> 2)] = __builtin_amdgcn_mfma_f32_32x32x16_bf16(vf[j], pf[j & 3], o[d0 + (j >> 2)], 0, 0, 0);
            __builtin_amdgcn_sched_barrier(0); }
        }
        if (moreK) {
#pragma unroll
            for (int i = 0; i < NKC; ++i) *(LAS u32x4*)(lds + (PIPE ? cb : (cb ^ 1)) * KT + KL(i)) = kst[i];
        }
        if (moreV) {
#pragma unroll
            for (int i = 0; i < NVC; ++i) *(LAS u32x4*)(lds + (cb ^ 1) * VT + VL(i)) = vst[i];
        }
        asm volatile("s_waitcnt lgkmcnt(0)" ::: "memory"); __builtin_amdgcn_s_barrier(); asm volatile("" ::: "memory");
        if constexpr (PIPE) { s0 = n0; s1 = n1;
#pragma unroll
            for (int i = 0; i < NKC; ++i) kst[i] = kstn[i];
#pragma unroll
            for (int i = 0; i < NVC; ++i) vst[i] = vstn[i]; }
    }
    l = swap32_add(l);
    const float il = 1.f / l;
    bf16_t* orow = O + (size_t)qrow * 512;
    if (active)
#pragma unroll
    for (int d = 0; d < NDB; ++d)
#pragma unroll
        for (int g = 0; g < 4; ++g) { u32x2 w; w.x = pk2(o[d][4 * g] * il, o[d][4 * g + 1] * il); w.y = pk2(o[d][4 * g + 2] * il, o[d][4 * g + 3] * il);
            *(u32x2*)(orow + 32 * d + 8 * g + 4 * h) = w; }
#undef KG
#undef KL
#undef VG
#undef VL
#undef QK_TILE
#undef TILE
}

template <int DV, bool ALIBI>
DI void attn_unit2(LAS unsigned char* lds, const bf16_t* __restrict__ Q, const bf16_t* __restrict__ K, const bf16_t* __restrict__ Vt, bf16_t* __restrict__ O, int r0, int qb, int n, float sl, const int wid) {
    constexpr int DQK = 64, KROW = DQK * 2 + 16, KT = 64 * KROW, VROW = 144, VT = DV * VROW, NVC = DV * 8 / 512, NKS = 4, NDB = DV / 32, VB0 = 2 * KT;
    typedef const __attribute__((address_space(1))) u32x4* gptr;
    const int lane = lane_fresh(), tid = wid * 64 + lane, r = lane & 31, h = lane >> 5;
    const int nk = n + 16, NT = (nk + 63) >> 6;
    const int li = qb * 256 + wid * 32 + r;
    const int qrow = r0 + li;
    const float qlin = (li < n) ? (float)(li + 16) : (li < nk ? (float)(li - n) : 0.f);
    bf16x8 qf[NKS];
#pragma unroll
    for (int ks = 0; ks < NKS; ++ks) qf[ks] = *(const bf16x8*)(Q + (size_t)qrow * DQK + ks * 16 + h * 8);
    f32x16 o[NDB];
#pragma unroll
    for (int d = 0; d < NDB; ++d)
#pragma unroll
        for (int i = 0; i < 16; ++i) o[d][i] = 0.f;
    float m = 0.f, l = 0.f; f32x16 negm;
#pragma unroll
    for (int i = 0; i < 16; ++i) negm[i] = 0.f;
    const bf16_t* kg0 = K + (size_t)r0 * DQK + tid * 8; const bf16_t* vg0 = Vt + (size_t)(tid >> 3) * RA + r0 + (tid & 7) * 8;
    const int kl0 = (tid >> 3) * KROW + (tid & 7) * 16, vl0 = VB0 + (tid >> 3) * VROW + (tid & 7) * 16;
#define KG2(t) ((gptr)(kg0 + (size_t)(t) * 64 * DQK))
#define VG2(i, t) ((gptr)(vg0 + (size_t)(i) * 64 * RA + (size_t)(t) * 64))
    const int pr = (r & ~12) | ((r & 4) << 1) | ((r & 8) >> 1);
    const int kaddr = pr * KROW + h * 16, vaddr = VB0 + r * VROW + h * 16;
    u32x4 kst, vst[NVC];
    bf16x8 kf[8];
#define LDK(kb_) do { _Pragma("unroll") for (int ks = 0; ks < 4; ++ks) { kf[2 * ks] = *(const LAS bf16x8*)(lds + (kb_) * KT + kaddr + ks * 32); kf[2 * ks + 1] = *(const LAS bf16x8*)(lds + (kb_) * KT + kaddr + 32 * KROW + ks * 32); } \
        asm volatile("" : "+v"(kf[0]), "+v"(kf[1]), "+v"(kf[2]), "+v"(kf[3]), "+v"(kf[4]), "+v"(kf[5]), "+v"(kf[6]), "+v"(kf[7])); } while (0)
#define QKM(A0, A1) do { A0 = __builtin_amdgcn_mfma_f32_32x32x16_bf16(kf[0], qf[0], negm, 0, 0, 0); A1 = __builtin_amdgcn_mfma_f32_32x32x16_bf16(kf[1], qf[0], negm, 0, 0, 0); \
        _Pragma("unroll") for (int ks = 1; ks < 4; ++ks) { A0 = __builtin_amdgcn_mfma_f32_32x32x16_bf16(kf[2 * ks], qf[ks], A0, 0, 0, 0); A1 = __builtin_amdgcn_mfma_f32_32x32x16_bf16(kf[2 * ks + 1], qf[ks], A1, 0, 0, 0); } } while (0)
#define PV2(vb_, d0_) do { bf16x8 vf[8]; \
        _Pragma("unroll") for (int j = 0; j < 8; ++j) vf[j] = *(const LAS bf16x8*)(lds + (vb_) * VT + vaddr + ((d0_) + (j >> 2)) * 32 * VROW + (j & 3) * 32); \
        asm volatile("" : "+v"(vf[0]), "+v"(vf[1]), "+v"(vf[2]), "+v"(vf[3]), "+v"(vf[4]), "+v"(vf[5]), "+v"(vf[6]), "+v"(vf[7])); \
        _Pragma("unroll") for (int j = 0; j < 8; ++j) o[(d0_) + (j >> 2)] = __builtin_amdgcn_mfma_f32_32x32x16_bf16(vf[j], pf[j & 3], o[(d0_) + (j >> 2)], 0, 0, 0); } while (0)
    kst = *KG2(0);
#pragma unroll
    for (int i = 0; i < NVC; ++i) vst[i] = *VG2(i, 0);
    *(LAS u32x4*)(lds + kl0) = kst;
#pragma unroll
    for (int i = 0; i < NVC; ++i) *(LAS u32x4*)(lds + vl0 + i * 64 * VROW) = vst[i];
    kst = *KG2(1);
    *(LAS u32x4*)(lds + KT + kl0) = kst;
    __syncthreads();
    f32x16 s0, s1, n0, n1;
    bf16x8 pf[4];
    LDK(0); QKM(s0, s1);
    __syncthreads();
    int vcur = 0;
    for (int t = 0; t < NT; ++t) {
        const int cb = t & 1;
        const bool moreV = (t + 1 < NT), moreK = (t + 2 < NT);
        const int vprev = (vcur == 0) ? 2 : vcur - 1, vnext = (vcur == 2) ? 0 : vcur + 1;
        if (moreK) kst = *KG2(t + 2);
        if (moreV) {
#pragma unroll
            for (int i = 0; i < NVC; ++i) vst[i] = *VG2(i, t + 1);
        }
#ifdef PROBE_MEM2
        { int zo = 0; asm volatile("" : "+v"(zo));
          if (moreK) { u32x4 d = *(KG2(t + 2) + zo); asm volatile("" :: "v"(d)); }
          if (moreV) {
#pragma unroll
            for (int i = 0; i < NVC; ++i) { u32x4 d = *(VG2(i, t + 1) + zo); asm volatile("" :: "v"(d)); } } }
#endif
        __builtin_amdgcn_s_setprio(1);
        if (moreV) { LDK(cb ^ 1); QKM(n0, n1); }
        if (t > 0) { PV2(vprev, 0); if constexpr (NDB == 4) PV2(vprev, 2); }
        __builtin_amdgcn_s_setprio(0);
        if (t < NT - 1) {
            if constexpr (ALIBI) {
                const float qo = qlin - (float)(16 + 8 * h + t * 64);
#pragma unroll
                for (int i = 0; i < 16; ++i) { const float ci = (float)(16 * (i >> 3) + (i & 7)); s0[i] = __builtin_fmaf(-sl, __builtin_fabsf(qo - ci), s0[i]); s1[i] = __builtin_fmaf(-sl, __builtin_fabsf(qo - 32.f - ci), s1[i]); }
            }
        } else {
#pragma unroll
            for (int i = 0; i < 16; ++i) { const int kk = 16 * (i >> 3) + 8 * h + (i & 7);
                if (kk < 16) { if constexpr (ALIBI) s0[i] = __builtin_fmaf(-sl, __builtin_fabsf(qlin - (float)kk), s0[i]); } else s0[i] = -1e30f;
                s1[i] = -1e30f; }
        }
        float mx;
        { float a = MX2(s0[0], s1[0]), b = MX2(s0[1], s1[1]);
#pragma unroll
          for (int i = 2; i < 16; i += 2) { a = MX2(a, MX2(s0[i], s1[i])); b = MX2(b, MX2(s0[i + 1], s1[i + 1])); }
          mx = swap32_max(MX2(a, b)); }
        if (__builtin_expect(t == 0 || __builtin_amdgcn_ballot_w64(mx > 8.f) != 0ull, 0)) {
            const float dl = (t == 0) ? mx : fmaxf(mx, 0.f);
            m += dl;
#pragma unroll
            for (int i = 0; i < 16; ++i) { s0[i] -= dl; s1[i] -= dl; n0[i] -= dl; n1[i] -= dl; negm[i] = -m; }
            if (t != 0) { const float f = __builtin_amdgcn_exp2f(-dl); l *= f;
#pragma unroll
                for (int d = 0; d < NDB; ++d)
#pragma unroll
                    for (int i = 0; i < 16; ++i) o[d][i] *= f; }
            asm volatile("" ::: "memory");
        }
        float ra = 0.f, rb = 0.f;
#pragma unroll
        for (int i = 0; i < 16; ++i) { s0[i] = __builtin_amdgcn_exp2f(s0[i]); s1[i] = __builtin_amdgcn_exp2f(s1[i]); ra += s0[i]; rb += s1[i]; }
        l += ra + rb;
        { u32x4 w;
          w.x = pk2(s0[0], s0[1]); w.y = pk2(s0[2], s0[3]); w.z = pk2(s0[4], s0[5]); w.w = pk2(s0[6], s0[7]); pf[0] = __builtin_bit_cast(bf16x8, w);
          w.x = pk2(s0[8], s0[9]); w.y = pk2(s0[10], s0[11]); w.z = pk2(s0[12], s0[13]); w.w = pk2(s0[14], s0[15]); pf[1] = __builtin_bit_cast(bf16x8, w);
          w.x = pk2(s1[0], s1[1]); w.y = pk2(s1[2], s1[3]); w.z = pk2(s1[4], s1[5]); w.w = pk2(s1[6], s1[7]); pf[2] = __builtin_bit_cast(bf16x8, w);
          w.x = pk2(s1[8], s1[9]); w.y = pk2(s1[10], s1[11]); w.z = pk2(s1[12], s1[13]); w.w = pk2(s1[14], s1[15]); pf[3] = __builtin_bit_cast(bf16x8, w); }
        if (moreK) *(LAS u32x4*)(lds + cb * KT + kl0) = kst;
        if (moreV) {
#pragma unroll
            for (int i = 0; i < NVC; ++i) *(LAS u32x4*)(lds + vnext * VT + vl0 + i * 64 * VROW) = vst[i];
        }
        asm volatile("s_waitcnt lgkmcnt(0)" ::: "memory"); __builtin_amdgcn_s_barrier(); asm volatile("" ::: "memory");
        s0 = n0; s1 = n1; vcur = vnext;
    }
    { const int vlast = (vcur == 0) ? 2 : vcur - 1; PV2(vlast, 0); if constexpr (NDB == 4) PV2(vlast, 2); }
    asm volatile("s_waitcnt lgkmcnt(0)" ::: "memory"); __builtin_amdgcn_s_barrier(); asm volatile("" ::: "memory");
    l = swap32_add(l);
    const float il = 1.f / l;
    bf16_t* orow = O + (size_t)qrow * 512;
#pragma unroll
    for (int d = 0; d < NDB; ++d)
#pragma unroll
        for (int g = 0; g < 4; ++g) { u32x2 w; w.x = pk2(o[d][4 * g] * il, o[d][4 * g + 1] * il); w.y = pk2(o[d][4 * g + 2] * il, o[d][4 * g + 3] * il);
            *(u32x2*)(orow + 32 * d + 8 * g + 4 * h) = w; }
#undef KG2
#undef VG2
#undef LDK
#undef QKM
#undef PV2
}


template <int DQK, int DV, bool ALIBI>
DI void attn_unit_s(LAS unsigned char* lds, const bf16_t* __restrict__ Q, const bf16_t* __restrict__ K, const bf16_t* __restrict__ Vt, bf16_t* __restrict__ O, int r0, int qb, int n, float sl, const int wid) {
    constexpr bool NEGM = (DQK == 64);
    constexpr int KROW = DQK * 2 + 16, KT = 64 * KROW, VROW = 144, VT = DV * VROW, KCH = DQK / 8, NKC = 64 * KCH / 512, NVC = DV * 8 / 512, NKS = DQK / 16, NDB = DV / 32, VB0 = 2 * KT;
    typedef const __attribute__((address_space(1))) u32x4* gptr;
#define LBAR() do { asm volatile("s_waitcnt lgkmcnt(0)" ::: "memory"); __builtin_amdgcn_s_barrier(); asm volatile("" ::: "memory"); } while (0)
#ifdef GRP_ODD
    const int grp_ = wid & 1;
#else
    const int grp_ = wid >> 2;
#endif
    const int lane = lane_fresh(), tid = wid * 64 + lane, r = lane & 31, h = lane >> 5, grp = grp_;
    const int nk = n + 16, NT = (nk + 63) >> 6;
    const int li = qb * 256 + wid * 32 + r;
    const int qrow = r0 + li;
    const float qlin = (li < n) ? (float)(li + 16) : (li < nk ? (float)(li - n) : 0.f);
    bf16x8 qf[NKS];
#pragma unroll
    for (int ks = 0; ks < NKS; ++ks) qf[ks] = *(const bf16x8*)(Q + (size_t)qrow * DQK + ks * 16 + h * 8);
    f32x16 o[NDB];
#pragma unroll
    for (int d = 0; d < NDB; ++d)
#pragma unroll
        for (int i = 0; i < 16; ++i) o[d][i] = 0.f;
    float m = 0.f, l = 0.f; f32x16 negm, zero16;
#pragma unroll
    for (int i = 0; i < 16; ++i) { negm[i] = 0.f; zero16[i] = 0.f; }
    const bf16_t* kg0 = K + (size_t)r0 * DQK + tid * 8; const bf16_t* vg0 = Vt + (size_t)(tid >> 3) * RA + r0 + (tid & 7) * 8; const int vl0 = VB0 + (tid >> 3) * VROW + (tid & 7) * 16;
#define KL(i) ((((tid + 512 * (i)) / KCH) * KROW) + ((tid + 512 * (i)) % KCH) * 16)
#define KG(i, t) ((gptr)(kg0 + (i) * 4096 + (size_t)(t) * 64 * DQK))
#define VG(i, t) ((gptr)(vg0 + (size_t)(i) * 64 * RA + (size_t)(t) * 64))
#define VL(i) (vl0 + (i) * 64 * VROW)
    const int pr = (r & ~12) | ((r & 4) << 1) | ((r & 8) >> 1);
    const int kaddr = pr * KROW + h * 16, vaddr = VB0 + r * VROW + h * 16;
    u32x4 kst[NKC], vst[NVC];
#pragma unroll
    for (int i = 0; i < NKC; ++i) kst[i] = *KG(i, 0);
#pragma unroll
    for (int i = 0; i < NKC; ++i) *(LAS u32x4*)(lds + KL(i)) = kst[i];
#pragma unroll
    for (int i = 0; i < NKC; ++i) kst[i] = *KG(i, 1);
#pragma unroll
    for (int i = 0; i < NVC; ++i) vst[i] = *VG(i, 0);
    __syncthreads();
    if (grp == 1) LBAR();
    f32x16 s0, s1; bf16x8 pf[4];
    for (int t = 0; t < NT; ++t) {
        const int cb = t & 1;
        { const int ko_ = cb * KT + kaddr;
#pragma unroll
          for (int kb4 = 0; kb4 < NKS; kb4 += 4) { bf16x8 kq[8];
#pragma unroll
            for (int j = 0; j < 4; ++j) { kq[2 * j] = *(const LAS bf16x8*)(lds + ko_ + (kb4 + j) * 32); kq[2 * j + 1] = *(const LAS bf16x8*)(lds + ko_ + 32 * KROW + (kb4 + j) * 32); }
            asm volatile("" : "+v"(kq[0]), "+v"(kq[1]), "+v"(kq[2]), "+v"(kq[3]), "+v"(kq[4]), "+v"(kq[5]), "+v"(kq[6]), "+v"(kq[7]));
#pragma unroll
            for (int j = 0; j < 4; ++j) {
                if (kb4 + j == 0) { s0 = __builtin_amdgcn_mfma_f32_32x32x16_bf16(kq[0], qf[0], NEGM ? negm : zero16, 0, 0, 0); s1 = __builtin_amdgcn_mfma_f32_32x32x16_bf16(kq[1], qf[0], NEGM ? negm : zero16, 0, 0, 0); }
                else { s0 = __builtin_amdgcn_mfma_f32_32x32x16_bf16(kq[2 * j], qf[kb4 + j], s0, 0, 0, 0); s1 = __builtin_amdgcn_mfma_f32_32x32x16_bf16(kq[2 * j + 1], qf[kb4 + j], s1, 0, 0, 0); } }
            __builtin_amdgcn_sched_barrier(0); } }
        if (t > 0) {
#pragma unroll
            for (int d0 = 0; d0 < NDB; d0 += 2) { bf16x8 vf[8];
#pragma unroll
                for (int j = 0; j < 8; ++j) vf[j] = *(const LAS bf16x8*)(lds + (cb ^ 1) * VT + vaddr + (d0 + (j >> 2)) * 32 * VROW + (j & 3) * 32);
                asm volatile("" : "+v"(vf[0]), "+v"(vf[1]), "+v"(vf[2]), "+v"(vf[3]), "+v"(vf[4]), "+v"(vf[5]), "+v"(vf[6]), "+v"(vf[7]));
#pragma unroll
                for (int j = 0; j < 8; ++j) o[d0 + (j >> 2)] = __builtin_amdgcn_mfma_f32_32x32x16_bf16(vf[j], pf[j & 3], o[d0 + (j >> 2)], 0, 0, 0);
                __builtin_amdgcn_sched_barrier(0); }
        }
        if (t + 1 < NT) {
#pragma unroll
            for (int i = 0; i < NKC; ++i) *(LAS u32x4*)(lds + (cb ^ 1) * KT + KL(i)) = kst[i];
        }
#pragma unroll
        for (int i = 0; i < NVC; ++i) *(LAS u32x4*)(lds + cb * VT + VL(i)) = vst[i];
        LBAR();
        if (t + 2 < NT) {
#pragma unroll
            for (int i = 0; i < NKC; ++i) kst[i] = *KG(i, t + 2);
        }
        if (t + 1 < NT) {
#pragma unroll
            for (int i = 0; i < NVC; ++i) vst[i] = *VG(i, t + 1);
        }
        if (t < NT - 1) {
            if constexpr (ALIBI) {
                const float qo = qlin - (float)(16 + 8 * h + t * 64);
#pragma unroll
                for (int i = 0; i < 16; ++i) { const float ci = (float)(16 * (i >> 3) + (i & 7)); s0[i] = __builtin_fmaf(-sl, __builtin_fabsf(qo - ci), s0[i]); s1[i] = __builtin_fmaf(-sl, __builtin_fabsf(qo - 32.f - ci), s1[i]); }
            }
        } else {
#pragma unroll
            for (int i = 0; i < 16; ++i) { const int kk = 16 * (i >> 3) + 8 * h + (i & 7);
                if (kk < 16) { if constexpr (ALIBI) s0[i] = __builtin_fmaf(-sl, __builtin_fabsf(qlin - (float)kk), s0[i]); } else s0[i] = -1e30f;
                s1[i] = -1e30f; }
        }
        float mx;
        { float a = MX2(s0[0], s1[0]), b = MX2(s0[1], s1[1]);
#pragma unroll
          for (int i = 2; i < 16; i += 2) { a = MX2(a, MX2(s0[i], s1[i])); b = MX2(b, MX2(s0[i + 1], s1[i + 1])); }
          mx = swap32_max(MX2(a, b)); }
        if constexpr (!NEGM) mx -= m;
        if (__builtin_expect(t == 0 || __builtin_amdgcn_ballot_w64(mx > 8.f) != 0ull, 0)) {
            const float dl = (t == 0) ? mx : fmaxf(mx, 0.f);
            m += dl;
            if constexpr (NEGM) {
#pragma unroll
                for (int i = 0; i < 16; ++i) { s0[i] -= dl; s1[i] -= dl; negm[i] = -m; } }
            if (t != 0) { const float f = __builtin_amdgcn_exp2f(-dl); l *= f;
#pragma unroll
                for (int d = 0; d < NDB; ++d)
#pragma unroll
                    for (int i = 0; i < 16; ++i) o[d][i] *= f; }
            asm volatile("" ::: "memory");
        }
        float ra = 0.f, rb = 0.f;
#pragma unroll
        for (int i = 0; i < 16; ++i) { s0[i] = __builtin_amdgcn_exp2f(NEGM ? s0[i] : s0[i] - m); s1[i] = __builtin_amdgcn_exp2f(NEGM ? s1[i] : s1[i] - m); ra += s0[i]; rb += s1[i]; }
        l += ra + rb;
        { u32x4 w;
          w.x = pk2(s0[0], s0[1]); w.y = pk2(s0[2], s0[3]); w.z = pk2(s0[4], s0[5]); w.w = pk2(s0[6], s0[7]); pf[0] = __builtin_bit_cast(bf16x8, w);
          w.x = pk2(s0[8], s0[9]); w.y = pk2(s0[10], s0[11]); w.z = pk2(s0[12], s0[13]); w.w = pk2(s0[14], s0[15]); pf[1] = __builtin_bit_cast(bf16x8, w);
          w.x = pk2(s1[0], s1[1]); w.y = pk2(s1[2], s1[3]); w.z = pk2(s1[4], s1[5]); w.w = pk2(s1[6], s1[7]); pf[2] = __builtin_bit_cast(bf16x8, w);
          w.x = pk2(s1[8], s1[9]); w.y = pk2(s1[10], s1[11]); w.z = pk2(s1[12], s1[13]); w.w = pk2(s1[14], s1[15]); pf[3] = __builtin_bit_cast(bf16x8, w); }
        LBAR();
    }
    { const int vb = (NT - 1) & 1;
#pragma unroll
      for (int d0 = 0; d0 < NDB; d0 += 2) { bf16x8 vf[8];
#pragma unroll
        for (int j = 0; j < 8; ++j) vf[j] = *(const LAS bf16x8*)(lds + vb * VT + vaddr + (d0 + (j >> 2)) * 32 * VROW + (j & 3) * 32);
        asm volatile("" : "+v"(vf[0]), "+v"(vf[1]), "+v"(vf[2]), "+v"(vf[3]), "+v"(vf[4]), "+v"(vf[5]), "+v"(vf[6]), "+v"(vf[7]));
#pragma unroll
        for (int j = 0; j < 8; ++j) o[d0 + (j >> 2)] = __builtin_amdgcn_mfma_f32_32x32x16_bf16(vf[j], pf[j & 3], o[d0 + (j >> 2)], 0, 0, 0); } }
    if (grp == 0) LBAR();
    LBAR();
    l = swap32_add(l);
    const float il = 1.f / l;
    bf16_t* orow = O + (size_t)qrow * 512;
#pragma unroll
    for (int d = 0; d < NDB; ++d)
#pragma unroll
        for (int g = 0; g < 4; ++g) { u32x2 w; w.x = pk2(o[d][4 * g] * il, o[d][4 * g + 1] * il); w.y = pk2(o[d][4 * g + 2] * il, o[d][4 * g + 3] * il);
            *(u32x2*)(orow + 32 * d + 8 * g + 4 * h) = w; }
#undef KG
#undef KL
#undef VG
#undef VL
#undef LBAR
}

DI void attn_unit_a64(LAS unsigned char* lds, const bf16_t* __restrict__ Q, const bf16_t* __restrict__ K, const bf16_t* __restrict__ Vt, bf16_t* __restrict__ O, int r0, int qb, int n, int seqrows, const int wid) {
    constexpr int DQK = 64, KROW = 144, KT = 64 * KROW, VROW = 144, VT = 64 * VROW, VB0 = 2 * KT;
    typedef const __attribute__((address_space(1))) u32x4* gptr;
    const int lane = lane_fresh(), tid = wid * 64 + lane, r = lane & 31, h = lane >> 5;
    const int nk = n + 16, NT = (nk + 63) >> 6;
    const int li0 = qb * 512 + wid * 64 + r, li1 = li0 + 32;
    bf16x8 qf0[4], qf1[4];
#pragma unroll
    for (int ks = 0; ks < 4; ++ks) { qf0[ks] = *(const bf16x8*)(Q + (size_t)(r0 + li0) * DQK + ks * 16 + h * 8); qf1[ks] = *(const bf16x8*)(Q + (size_t)(r0 + li1) * DQK + ks * 16 + h * 8); }
    f32x16 oa0, oa1, ob0, ob1, zero16;
#pragma unroll
    for (int i = 0; i < 16; ++i) { oa0[i] = 0.f; oa1[i] = 0.f; ob0[i] = 0.f; ob1[i] = 0.f; zero16[i] = 0.f; }
    float ma = 0.f, mb = 0.f, la = 0.f, lb = 0.f;
    const bf16_t* kg0 = K + (size_t)r0 * DQK + tid * 8; const bf16_t* vg0 = Vt + (size_t)(tid >> 3) * RA + r0 + (tid & 7) * 8;
    const int kl0 = (tid >> 3) * KROW + (tid & 7) * 16, vl0 = VB0 + (tid >> 3) * VROW + (tid & 7) * 16;
    const int pr = (r & ~12) | ((r & 4) << 1) | ((r & 8) >> 1);
    const int kaddr = pr * KROW + h * 16, vaddr = VB0 + r * VROW + h * 16;
    u32x4 kst, vst;
    kst = *(gptr)kg0; vst = *(gptr)vg0;
    *(LAS u32x4*)(lds + kl0) = kst; *(LAS u32x4*)(lds + vl0) = vst;
    __syncthreads();
#define SOFTMAX64(S0, S1, M, L, OX0, OX1) do { \
        if (t == NT - 1) { _Pragma("unroll") for (int i = 0; i < 16; ++i) { if (i >= 8) S0[i] = -1e30f; S1[i] = -1e30f; } } \
        float a_ = MX2(S0[0], S1[0]), b_ = MX2(S0[1], S1[1]); \
        _Pragma("unroll") for (int i = 2; i < 16; i += 2) { a_ = MX2(a_, MX2(S0[i], S1[i])); b_ = MX2(b_, MX2(S0[i + 1], S1[i + 1])); } \
        const float mx_ = swap32_max(MX2(a_, b_)) - M; \
        if (__builtin_expect(t == 0 || __builtin_amdgcn_ballot_w64(mx_ > 8.f) != 0ull, 0)) { \
            const float dl_ = (t == 0) ? mx_ : fmaxf(mx_, 0.f); M += dl_; \
            if (t != 0) { const float f_ = __builtin_amdgcn_exp2f(-dl_); L *= f_; _Pragma("unroll") for (int i = 0; i < 16; ++i) { OX0[i] *= f_; OX1[i] *= f_; } } \
            asm volatile("" ::: "memory"); } \
        float ra_ = 0.f, rb_ = 0.f; \
        _Pragma("unroll") for (int i = 0; i < 16; ++i) { S0[i] = __builtin_amdgcn_exp2f(S0[i] - M); S1[i] = __builtin_amdgcn_exp2f(S1[i] - M); ra_ += S0[i]; rb_ += S1[i]; } \
        L += ra_ + rb_; \
        u32x4 w_; \
        w_.x = pk2(S0[0], S0[1]); w_.y = pk2(S0[2], S0[3]); w_.z = pk2(S0[4], S0[5]); w_.w = pk2(S0[6], S0[7]); pf[0] = __builtin_bit_cast(bf16x8, w_); \
        w_.x = pk2(S0[8], S0[9]); w_.y = pk2(S0[10], S0[11]); w_.z = pk2(S0[12], S0[13]); w_.w = pk2(S0[14], S0[15]); pf[1] = __builtin_bit_cast(bf16x8, w_); \
        w_.x = pk2(S1[0], S1[1]); w_.y = pk2(S1[2], S1[3]); w_.z = pk2(S1[4], S1[5]); w_.w = pk2(S1[6], S1[7]); pf[2] = __builtin_bit_cast(bf16x8, w_); \
        w_.x = pk2(S1[8], S1[9]); w_.y = pk2(S1[10], S1[11]); w_.z = pk2(S1[12], S1[13]); w_.w = pk2(S1[14], S1[15]); pf[3] = __builtin_bit_cast(bf16x8, w_); } while (0)
    for (int t = 0; t < NT; ++t) {
        const int cb = t & 1; const bool more = (t + 1 < NT);
        if (more) { kst = *(gptr)(kg0 + (size_t)(t + 1) * 64 * DQK); vst = *(gptr)(vg0 + (size_t)(t + 1) * 64); }
        bf16x8 kq[8];
#pragma unroll
        for (int j = 0; j < 4; ++j) { kq[2 * j] = *(const LAS bf16x8*)(lds + cb * KT + kaddr + j * 32); kq[2 * j + 1] = *(const LAS bf16x8*)(lds + cb * KT + kaddr + 32 * KROW + j * 32); }
        asm volatile("" : "+v"(kq[0]), "+v"(kq[1]), "+v"(kq[2]), "+v"(kq[3]), "+v"(kq[4]), "+v"(kq[5]), "+v"(kq[6]), "+v"(kq[7]));
        f32x16 sa0, sa1, sb0, sb1;
        sa0 = __builtin_amdgcn_mfma_f32_32x32x16_bf16(kq[0], qf0[0], zero16, 0, 0, 0); sa1 = __builtin_amdgcn_mfma_f32_32x32x16_bf16(kq[1], qf0[0], zero16, 0, 0, 0);
#pragma unroll
        for (int j = 1; j < 4; ++j) { sa0 = __builtin_amdgcn_mfma_f32_32x32x16_bf16(kq[2 * j], qf0[j], sa0, 0, 0, 0); sa1 = __builtin_amdgcn_mfma_f32_32x32x16_bf16(kq[2 * j + 1], qf0[j], sa1, 0, 0, 0); }
        sb0 = __builtin_amdgcn_mfma_f32_32x32x16_bf16(kq[0], qf1[0], zero16, 0, 0, 0); sb1 = __builtin_amdgcn_mfma_f32_32x32x16_bf16(kq[1], qf1[0], zero16, 0, 0, 0);
#pragma unroll
        for (int j = 1; j < 4; ++j) { sb0 = __builtin_amdgcn_mfma_f32_32x32x16_bf16(kq[2 * j], qf1[j], sb0, 0, 0, 0); sb1 = __builtin_amdgcn_mfma_f32_32x32x16_bf16(kq[2 * j + 1], qf1[j], sb1, 0, 0, 0); }
        bf16x8 vf[8];
#pragma unroll
        for (int j = 0; j < 8; ++j) vf[j] = *(const LAS bf16x8*)(lds + cb * VT + vaddr + (j >> 2) * 32 * VROW + (j & 3) * 32);
        bf16x8 pf[4];
        SOFTMAX64(sa0, sa1, ma, la, oa0, oa1);
        asm volatile("" : "+v"(vf[0]), "+v"(vf[1]), "+v"(vf[2]), "+v"(vf[3]), "+v"(vf[4]), "+v"(vf[5]), "+v"(vf[6]), "+v"(vf[7]));
#pragma unroll
        for (int j = 0; j < 4; ++j) { oa0 = __builtin_amdgcn_mfma_f32_32x32x16_bf16(vf[j], pf[j], oa0, 0, 0, 0); oa1 = __builtin_amdgcn_mfma_f32_32x32x16_bf16(vf[4 + j], pf[j], oa1, 0, 0, 0); }
        SOFTMAX64(sb0, sb1, mb, lb, ob0, ob1);
#pragma unroll
        for (int j = 0; j < 4; ++j) { ob0 = __builtin_amdgcn_mfma_f32_32x32x16_bf16(vf[j], pf[j], ob0, 0, 0, 0); ob1 = __builtin_amdgcn_mfma_f32_32x32x16_bf16(vf[4 + j], pf[j], ob1, 0, 0, 0); }
        if (more) { *(LAS u32x4*)(lds + (cb ^ 1) * KT + kl0) = kst; *(LAS u32x4*)(lds + (cb ^ 1) * VT + vl0) = vst; }
        asm volatile("s_waitcnt lgkmcnt(0)" ::: "memory"); __builtin_amdgcn_s_barrier(); asm volatile("" ::: "memory");
    }
#undef SOFTMAX64
    la = swap32_add(la); lb = swap32_add(lb);
    const float ia = 1.f / la, ib = 1.f / lb;
    if (li0 < seqrows) { bf16_t* orow = O + (size_t)(r0 + li0) * 512;
#pragma unroll
        for (int g = 0; g < 4; ++g) { u32x2 w; w.x = pk2(oa0[4 * g] * ia, oa0[4 * g + 1] * ia); w.y = pk2(oa0[4 * g + 2] * ia, oa0[4 * g + 3] * ia); *(u32x2*)(orow + 8 * g + 4 * h) = w;
            w.x = pk2(oa1[4 * g] * ia, oa1[4 * g + 1] * ia); w.y = pk2(oa1[4 * g + 2] * ia, oa1[4 * g + 3] * ia); *(u32x2*)(orow + 32 + 8 * g + 4 * h) = w; } }
    if (li1 < seqrows) { bf16_t* orow = O + (size_t)(r0 + li1) * 512;
#pragma unroll
        for (int g = 0; g < 4; ++g) { u32x2 w; w.x = pk2(ob0[4 * g] * ib, ob0[4 * g + 1] * ib); w.y = pk2(ob0[4 * g + 2] * ib, ob0[4 * g + 3] * ib); *(u32x2*)(orow + 8 * g + 4 * h) = w;
            w.x = pk2(ob1[4 * g] * ib, ob1[4 * g + 1] * ib); w.y = pk2(ob1[4 * g + 2] * ib, ob1[4 * g + 3] * ib); *(u32x2*)(orow + 32 + 8 * g + 4 * h) = w; } }
}

#if defined(STAGGER) && !defined(STAGGER_NOC)
#define ATTN_C attn_unit_s<192, 128, false>
#else
#define ATTN_C attn_unit<192, 128, false, false>
#endif
#if defined(STAGGER)
#define ATTN_B attn_unit_s<64, 128, true>
#define ATTN_A attn_unit_s<64, 64, false>
#elif defined(NOPIPE_AB)
#define ATTN_B attn_unit<64, 128, true, false>
#define ATTN_A attn_unit<64, 64, false, false>
#else
#define ATTN_B attn_unit<64, 128, true, false>
#define ATTN_A attn_unit2<64, false>
#endif
DI void attn_phase(const Params& p, const Chunk& ck, bool last, LAS unsigned char* lds, unsigned* q  , const int wave) {
    unsigned char* ws = p.ws; asm volatile("" : "+s"(ws));
    const bf16_t* QKV = (const bf16_t*)(ws + WS_QKV); bf16_t* OB = (bf16_t*)(ws + WS_ZM);
#if defined(PROBE_DUPC)
    constexpr int NDUP = 8, DUP0 = 0;
#elif defined(PROBE_DUPB)
    constexpr int NDUP = 16, DUP0 = 8;
#elif defined(PROBE_DUPA)
    constexpr int NDUP = 16, DUP0 = 24;
#else
    constexpr int NDUP = 0, DUP0 = 0;
#endif
    const int nmeta = last ? 0 : 20 * ck.nseq, nms = (nmeta + 7) >> 3, nsuper = nms + 40 + NDUP;
    volatile LAS int* su = (volatile LAS int*)(lds + LDS_MISC);
    for (;;) {
        if (wave == 0 && lane_fresh() == 0) {
#ifdef FLATQ
            const unsigned x = 0u;
#else
            const unsigned x = (unsigned)__builtin_amdgcn_s_getreg((3 << 11) | 20) & 0xFu;
#endif
            int res = -1, lin = 0;
            for (;;) {
                const unsigned idx = __hip_atomic_fetch_add(q + 64 + 16 * x, 1u, __ATOMIC_RELAXED, __HIP_MEMORY_SCOPE_AGENT);
                const unsigned slot = (idx >> 5) & 63u; lin = (int)(idx & 31u);
                unsigned* te = q + 512 + x * 64 + slot; unsigned g;
                if (lin == 0) { g = __hip_atomic_fetch_add(q, 1u, __ATOMIC_RELAXED, __HIP_MEMORY_SCOPE_AGENT); __hip_atomic_store(te, g + 1u, __ATOMIC_RELAXED, __HIP_MEMORY_SCOPE_AGENT); }
                else { while ((g = __hip_atomic_load(te, __ATOMIC_RELAXED, __HIP_MEMORY_SCOPE_AGENT)) == 0u) __builtin_amdgcn_s_sleep(2); g -= 1u; }
                if ((int)g >= nsuper) { res = -1; break; }
                if ((int)g < nms && (lin >= 8 || (int)g * 8 + lin >= nmeta)) continue;
#ifdef A64
                if ((int)g >= nms + 24) {
                    const int sub_ = ((int)g - nms) & 1;
                    if (ck.nseq == 1 ? (sub_ == 1) : (lin >= 16)) continue; }
#endif
                res = (int)g; break;
            }
            su[0] = res; su[1] = lin;
        }
        __syncthreads();
        const int g = su[0], lin = su[1];
        __syncthreads();
        if (g < 0) break;
        int type, hd, s, qb;
        int sh = ck.nseq - 1; asm volatile("" : "+s"(sh));
        if (g < nms) { const int mu = g * 8 + lin, jh = mu >> sh; s = mu & sh; qb = ck.tps - 1;
            if (jh < 4) { type = 0; hd = jh; } else if (jh < 12) { type = 1; hd = jh - 4; } else { type = 2; hd = jh - 12; } }
        else { const int gr0 = g - nms, gr = gr0 >= 40 ? gr0 - 40 + DUP0 : gr0, sub = gr & 1;
            if (gr < 8) { type = 0; hd = gr >> 1; } else if (gr < 24) { type = 1; hd = (gr - 8) >> 1; } else { type = 2; hd = (gr - 24) >> 1; }
            s = sub * sh; qb = lin + (sub * 32) * (1 - sh); }
        const int r0 = s * ck.rows_per_seq();
        if (type == 0) {
            ATTN_C(lds, QKV + QC_O + (size_t)hd * RA * 192, QKV + KC_O + (size_t)hd * RA * 192, QKV + VC_O + (size_t)hd * 128 * RA, OB + 2 * OSLOT + 128 * hd, r0, qb, ck.n, 0.f, wave);
        } else if (type == 1) { const int hh = hd >> 1;
            const float sl = LOG2E * (hh == 0 ? 0.25f : hh == 1 ? 0.0625f : hh == 2 ? 0.015625f : 0.00390625f);
            ATTN_B(lds, QKV + QB_O + (size_t)hd * RA * 64, QKV + KB_O + (size_t)hd * RA * 64, QKV + VB_O + (size_t)hh * 128 * RA, OB + ((hd & 1) ? 3 : 1) * OSLOT + 128 * hh, r0, qb, ck.n, sl, wave);
        } else { const int kv = hd >> 2;
#ifdef A64
            const int qb5 = (g < nms) ? (ck.n >> 9) : lin;
            attn_unit_a64(lds, QKV + QA_O + (size_t)hd * RA * 64, QKV + KA_O + (size_t)kv * RA * 64, QKV + VA_O + (size_t)kv * 64 * RA, OB + 64 * hd, r0, qb5, ck.n, ck.rows_per_seq(), wave);
#else
            ATTN_A(lds, QKV + QA_O + (size_t)hd * RA * 64, QKV + KA_O + (size_t)kv * RA * 64, QKV + VA_O + (size_t)kv * 64 * RA, OB + 64 * hd, r0, qb, ck.n, 0.f, wave);
#endif
        }
    }
}

#define XB_TMO      128
#define XB_XCNT(j)  (256  + 64 * (j))
#define XB_XSUB(j)  (1280 + 64 * (j))
#define XB_XGEN(j)  (2304 + 64 * (j))
#define XB_TOP      3328
#define XB_TOPGEN   3392
#define XCD_BAR_WORDS 3456
#define XB_SPIN_CAP (1u << 22)
DI unsigned xb_ld(unsigned* p)              { return __hip_atomic_load(p, __ATOMIC_RELAXED, __HIP_MEMORY_SCOPE_AGENT); }
DI unsigned xb_add(unsigned* p, unsigned v) { return __hip_atomic_fetch_add(p, v, __ATOMIC_RELAXED, __HIP_MEMORY_SCOPE_AGENT); }
DI unsigned xb_xcc_id() { return (unsigned)__builtin_amdgcn_s_getreg((3 << 11) | 20) & 0xFu; }
#define XB_SPIN(cond, bar) do { unsigned _sp = 0; while (cond) { __builtin_amdgcn_s_sleep(1); \
    if ((++_sp & 255u) == 0u) { if (xb_ld(&(bar)[XB_TMO])) break; if (_sp > XB_SPIN_CAP) { atomicAdd(&(bar)[XB_TMO], 1u); break; } } } } while (0)
DI void xcd_barrier_complete(unsigned* bar, unsigned x, unsigned G, unsigned& nloc, unsigned& nx) {
    unsigned sum, cnt, mine, sp = 0u;
    for (;;) {
        sum = 0u; cnt = 0u; mine = 0u;
#pragma unroll
        for (unsigned j = 0; j < 16; ++j) { const unsigned c = xb_ld(&bar[XB_XCNT(j)]); sum += c; cnt += (c > 0u) ? 1u : 0u; mine = (j == x) ? c : mine; }
        if (sum == G) break;
        __builtin_amdgcn_s_sleep(1);
        if ((++sp & 255u) == 0u) { if (xb_ld(&bar[XB_TMO])) break; if (sp > XB_SPIN_CAP) { atomicAdd(&bar[XB_TMO], 1u); break; } }
    }
    nloc = mine > 0u ? mine : 1u; nx = cnt > 0u ? cnt : 1u;
}
DI void xcd_barrier(unsigned* bar, volatile LAS unsigned* st, const int wave) {
    asm volatile("s_waitcnt vmcnt(0)" ::: "memory");
    __syncthreads();
    if (wave == 0 && lane_fresh() == 0) {
        __builtin_amdgcn_s_waitcnt(0);
        const unsigned x = xb_xcc_id();
        unsigned nloc = st[0], nx = st[1];
        if (nloc == 0u) { xcd_barrier_complete(bar, x, gridDim.x, nloc, nx); st[0] = nloc; st[1] = nx; }
        const unsigned old = xb_add(&bar[XB_XSUB(x)], 1u);
        const unsigned gen = old / nloc;
        if (old + 1u == (gen + 1u) * nloc) {
            __builtin_amdgcn_fence(__ATOMIC_RELEASE, "agent");
            asm volatile("s_waitcnt vmcnt(0)" ::: "memory");
            const unsigned og = xb_add(&bar[XB_TOP], 1u);
            const unsigned tg = og / nx;
            if (og + 1u == (tg + 1u) * nx) xb_add(&bar[XB_TOPGEN], 1u);
            else XB_SPIN(xb_ld(&bar[XB_TOPGEN]) == tg, bar);
            __builtin_amdgcn_fence(__ATOMIC_ACQUIRE, "agent");
            xb_add(&bar[XB_XGEN(x)], 1u);
            asm volatile("s_waitcnt vmcnt(0)" ::: "memory");
        } else {
            XB_SPIN(xb_ld(&bar[XB_XGEN(x)]) == gen, bar);
            __builtin_amdgcn_fence(__ATOMIC_ACQUIRE, "agent");
            asm volatile("s_waitcnt vmcnt(0)" ::: "memory");
        }
    }
    __syncthreads();
}


#define SK_LOOP(ACC, AP, BP, KK) do { _Pragma("unroll") for (int k0_ = 0; k0_ < (KK); k0_ += 32) { \
        const bf16x8 a_ = *(const bf16x8*)((AP) + k0_), b_ = *(const bf16x8*)((BP) + k0_); ACC = __builtin_amdgcn_mfma_f32_16x16x32_bf16(a_, b_, ACC, 0, 0, 0); } } while (0)
DI void skinny_phase(int which  , const Params& p, const Chunk& ck, const XMap& xm, const unsigned char* wbl, int gw, int NGW, int lane) {
    unsigned char* ws = p.ws; asm volatile("" : "+s"(ws));
    const int row = lane & 15, quad = lane >> 4;
    if (which == 0) {
        const bf16_t* OB = (const bf16_t*)(ws + WS_ZM); const bf16_t* G = (const bf16_t*)(ws + WS_G); bf16_t* MGb = (bf16_t*)(ws + WS_XN);
        for (int it = gw; it < ck.nseq * 64; it += NGW) {
            const int s = it >> 6, tile = it & 63, R0 = (s * ck.tps + ck.tps - 1) * 256, col = tile * 16 + row;
            f32x4 sum = {0.f, 0.f, 0.f, 0.f};
#pragma unroll 1
            for (int z = 0; z < 3; ++z) { f32x4 a = {0.f, 0.f, 0.f, 0.f};
                const bf16_t* ap = OB + (size_t)z * OSLOT + (size_t)(R0 + row) * 512 + quad * 8; const bf16_t* bp = (const bf16_t*)(wbl + W_BR) + (size_t)z * 1024 * 512 + (size_t)col * 512 + quad * 8;
                SK_LOOP(a, ap, bp, 512);
#pragma unroll
                for (int j = 0; j < 4; ++j) { const float g = __uint_as_float((unsigned)G[(size_t)(R0 + quad * 4 + j) * G_LD + z * 1024 + col] << 16); sum[j] += g * a[j]; } }
#pragma unroll
            for (int j = 0; j < 4; ++j) MGb[(size_t)(R0 + quad * 4 + j) * DM + col] = (bf16_t)(pk2(sum[j], 0.f) & 0xffffu);
        }
    } else if (which == 2) {
        const bf16_t* XNp = (const bf16_t*)(ws + WS_XN); bf16_t* U_ = (bf16_t*)(ws + WS_G);
        for (int it = gw; it < ck.nseq * 256; it += NGW) {
            const int s = it >> 8, tile = it & 255, R0 = (s * ck.tps + ck.tps - 1) * 256, col = tile * 16 + row;
            f32x4 acc = {0.f, 0.f, 0.f, 0.f};
            const bf16_t* ap = XNp + (size_t)(R0 + row) * 1024 + quad * 8; const bf16_t* bp = (const bf16_t*)(wbl + W_UP) + (size_t)col * 1024 + quad * 8;
#pragma unroll 1
            for (int kh = 0; kh < 2; ++kh) SK_LOOP(acc, ap + kh * 512, bp + kh * 512, 512);
#pragma unroll
            for (int j = 0; j < 4; ++j) { const float v = fmaxf(acc[j], 0.f); U_[(size_t)(R0 + quad * 4 + j) * 4096 + col] = (bf16_t)(pk2(v * v, 0.f) & 0xffffu); }
        }
    } else {
        const int K = (which == 1) ? 1024 : 4096, nkc = K >> 9;
        const bf16_t* A = (which == 1) ? (const bf16_t*)(ws + WS_XN) : (const bf16_t*)(ws + WS_G);
        const bf16_t* W = (const bf16_t*)(wbl + (which == 1 ? W_OUT : W_DOWN));
        for (int it = gw; it < ck.nseq * 64 * nkc; it += NGW) {
            const int kc = it % nkc, rem = it / nkc, s = rem >> 6, tile = rem & 63, pt = s * ck.tps + ck.tps - 1, R0 = pt * 256, col = tile * 16 + row;
            f32x4 acc = {0.f, 0.f, 0.f, 0.f};
            const bf16_t* ap = A + (size_t)(R0 + row) * K + kc * 512 + quad * 8; const bf16_t* bp = W + (size_t)col * K + kc * 512 + quad * 8;
            SK_LOOP(acc, ap, bp, 512);
            float* wp = xm.xw(pt);
#pragma unroll
            for (int j = 0; j < 4; ++j) atomicAdd(wp + (size_t)(quad * 4 + j) * DM + col, acc[j]);
        }
    }
}

#define GSYNC() xcd_barrier(xbar, xst, wave)
__global__ void __launch_bounds__(512) fwd_kernel(Params p) {
    extern __shared__ __attribute__((aligned(16))) unsigned char lds_raw[];
    LAS unsigned char* lds = (LAS unsigned char*)lds_raw;
    cg::grid_group grid = cg::this_grid();
    const int wave = __builtin_amdgcn_readfirstlane((int)threadIdx.x >> 6); int lane = lane_fresh();
    const int G = gridDim.x, bx = blockIdx.x, NGW = G * 8, gw = bx * 8 + wave;
#define WSP(off) ({ unsigned char* w_ = p.ws; asm volatile("" : "+s"(w_)); w_ + (off); })
#define ctl ((unsigned*)WSP(WS_CTL))
#define xbar (ctl + 1024)
    volatile LAS unsigned* xst = (volatile LAS unsigned*)(lds + LDS_MISC + 16);
    if (wave == 0 && lane == 0) { xst[0] = 0u; xst[1] = 0u; (void)xb_add(&xbar[XB_XCNT(xb_xcc_id())], 1u); }
    __syncthreads();
#define XN ((bf16_t*)WSP(WS_XN))
#define ZM ((bf16_t*)WSP(WS_ZM))
#define GB ((bf16_t*)WSP(WS_G))
#define CQN ((bf16_t*)WSP(WS_SM + SM_CQN))
#define CKVN ((bf16_t*)WSP(WS_SM + SM_CKVN))
#define QCR ((bf16_t*)WSP(WS_ZM + OFF_QCR))
#define KVR ((bf16_t*)WSP(WS_ZM + OFF_KVR))
#define MG ((float*)WSP(WS_QKV))
#define U ((bf16_t*)WSP(WS_G))

#if !defined(PH) || (PH & 1)
    prologue(p, lds, gw, NGW, wave, lane);
#ifdef PROBE_PRO2
    prologue(p, lds, gw, NGW, wave, lane);
#endif
#endif
    grid.sync();
    for (int l = 0; l < 2; ++l) {
        const bool last = (l == 1);
#define wb (WSP(WS_W) + (size_t)l * LW_STRIDE)
        for (int c = 0; c < 3; ++c) {
            const Chunk ck = make_chunk(c);
            const int ta = ck.tps - 1;
            XMap xm; xm.out = p.out; xm.metax = (float*)WSP(WS_METAX); xm.xp = p.in[0]; xm.xs = p.in[1]; xm.meta0 = (const float*)WSP(WS_META0); xm.seq0 = ck.seq0; xm.tps = ck.tps; xm.first = (l == 0);
#define RELAUNDER() do { lane = lane_fresh(); } while (0)
            RELAUNDER();
#if !defined(PH) || (PH & 2)
            norm_phase(xm, ck.rows(), p.in[3] + l * DM, XN, gw, NGW, lane);
#ifdef PROBE_EW2
            RELAUNDER(); norm_phase(xm, ck.rows(), p.in[3] + l * DM, XN, gw, NGW, lane);
#endif
#endif
            GSYNC();
            { pg8::Gemm g{XN, (const bf16_t*)(wb + W_IN), 1024, 0, 0}; Sched S; S.init(ck.nseq, ck.tps, ck.tps, IN_N / 256, 1, G, bx);
              EpiIn E{ZM, GB, p.in[5] + l * 3072};
#if !defined(PH) || (PH & 4)
              pg8::gemm_phase<EpiIn, Sched, true, true>(lds, g, S, E, wave);
#ifdef PROBE_IN2
              pg8::gemm_phase<EpiIn, Sched, true, true>(lds, g, S, E, wave);
#endif
#endif
 }
            GSYNC();
            RELAUNDER();
#if !defined(PH) || (PH & 128)
            ew1_phase(p, ck, l, gw, NGW, lane);
#ifdef PROBE_EW2
            RELAUNDER(); ew1_phase(p, ck, l, gw, NGW, lane);
#endif
#endif
            GSYNC();
            { pg8::Gemm g{CQN, (const bf16_t*)(wb + W_QB), 256, 0, 0}; Sched S; S.init(ck.nseq, ck.tps, ck.tps, 3, 1, G, bx); EpiBf16<0> E{QCR, 768};
#if !defined(PH) || (PH & 8)
              pg8::gemm_phase<EpiBf16<0>, Sched, true, true>(lds, g, S, E, wave);
#endif
 }
            { pg8::Gemm g{CKVN, (const bf16_t*)(wb + W_KVB), 128, 0, 0}; Sched S; S.init(ck.nseq, ck.tps, ck.tps, 4, 1, G, bx); EpiBf16<0> E{KVR, 1024};
#if !defined(PH) || (PH & 8)
              pg8::gemm_phase<EpiBf16<0>, Sched, true, true>(lds, g, S, E, wave);
#endif
 }
            GSYNC();
            RELAUNDER();
#if !defined(PH) || (PH & 256)
            ew2_phase(p, ck, l, gw, NGW, lane);
#ifdef PROBE_EW2
            RELAUNDER(); ew2_phase(p, ck, l, gw, NGW, lane);
#endif
#endif
            GSYNC();
#if !defined(PH) || (PH & 1024)
            attn_phase(p, ck, last, lds, ctl + 8192 + 2048 * (l * 3 + c), wave);
#ifdef PROBE_ATTN2
            GSYNC();
            attn_phase(p, ck, last, lds, ctl + 8192 + 2048 * (6 + l * 3 + c), wave);
#endif
#endif
            GSYNC();
            RELAUNDER();
#if !defined(PH) || (PH & 512)
            ew3_phase(p, ck, l, last, gw, NGW, lane);
#endif
            GSYNC();
            { pg8::Gemm g{ZM, (const bf16_t*)(wb + W_BR), 512, OSLOT, (size_t)1024 * 512}; Sched S; S.init(ck.nseq, ta, ck.tps, 4, 3, G, bx); EpiBranch E{GB, MG, XN};
#if !defined(PH) || (PH & 16)
              pg8::gemm_phase<EpiBranch, Sched, true, true>(lds, g, S, E, wave);
#ifdef PROBE_BR2
              pg8::gemm_phase<EpiBranch, Sched, true, true>(lds, g, S, E, wave);
#endif
#endif
 }
            if (!last) { RELAUNDER(); skinny_phase(0, p, ck, xm, wb, gw, NGW, lane); }
            GSYNC();
            { pg8::Gemm g{XN, (const bf16_t*)(wb + W_OUT), 1024, 0, 0}; Sched S; S.init(ck.nseq, ta, ck.tps, 4, 1, G, bx); EpiResid E{xm};
#if !defined(PH) || (PH & 32)
              pg8::gemm_phase<EpiResid, Sched, true, true>(lds, g, S, E, wave);
#endif
 }
            if (!last) { RELAUNDER(); skinny_phase(1, p, ck, xm, wb, gw, NGW, lane); }
            GSYNC();
            xm.first = 0;
            RELAUNDER();
#if !defined(PH) || (PH & 2)
            norm_phase(xm, ck.rows(), p.in[25] + l * DM, XN, gw, NGW, lane);
#ifdef PROBE_EW2
            RELAUNDER(); norm_phase(xm, ck.rows(), p.in[25] + l * DM, XN, gw, NGW, lane);
#endif
#endif
            GSYNC();
            { pg8::Gemm g{XN, (const bf16_t*)(wb + W_UP), 1024, 0, 0}; Sched S; S.init(ck.nseq, ta, ck.tps, 16, 1, G, bx); EpiBf16<2> E{U, 4096};
#if !defined(PH) || (PH & 64)
              pg8::gemm_phase<EpiBf16<2>, Sched, true, true>(lds, g, S, E, wave);
#ifdef PROBE_UP2
              pg8::gemm_phase<EpiBf16<2>, Sched, true, true>(lds, g, S, E, wave);
#endif
#endif
 }
            if (!last) { RELAUNDER(); skinny_phase(2, p, ck, xm, wb, gw, NGW, lane); }
            GSYNC();
            { pg8::Gemm g{U, (const bf16_t*)(wb + W_DOWN), 4096, 0, 0}; Sched S; S.init(ck.nseq, ta, ck.tps, 4, 1, G, bx); EpiResid E{xm};
#if !defined(PH) || (PH & 32)
              pg8::gemm_phase<EpiResid, Sched, true, true>(lds, g, S, E, wave);
#endif
 }
            if (!last) { RELAUNDER(); skinny_phase(3, p, ck, xm, wb, gw, NGW, lane); }
        }
    }
}

extern "C" void kernel_launch(void* const* d_in, const int* in_sizes, int n_in, void* d_out, int out_size, void* d_ws, size_t ws_size, hipStream_t stream) {
    static int grid_blocks = 0;
    if (grid_blocks == 0) {
        if (n_in != 28 || ws_size < WS_END) { fprintf(stderr, "kernel_launch: unexpected n_in %d / ws_size %zu (need %zu)\n", n_in, ws_size, (size_t)WS_END); grid_blocks = -1; return; }
        int dev = 0, cus = 0, per_cu = 0;
        hipGetDevice(&dev); hipDeviceGetAttribute(&cus, hipDeviceAttributeMultiprocessorCount, dev);
        hipFuncSetAttribute((const void*)fwd_kernel, hipFuncAttributeMaxDynamicSharedMemorySize, LDS_BYTES);
        hipOccupancyMaxActiveBlocksPerMultiprocessor(&per_cu, (const void*)fwd_kernel, 512, LDS_BYTES);
        if (per_cu < 1) { fprintf(stderr, "kernel_launch: occupancy query says %d blocks/CU\n", per_cu); per_cu = 1; }
        grid_blocks = cus * 1;
        (void)hipGetLastError();
    }
    if (grid_blocks < 0) return;
    hipMemsetAsync((char*)d_ws + WS_CTL, 0, CTL_BYTES, stream);
    Params p{};
    for (int i = 0; i < 28; ++i) p.in[i] = (const float*)d_in[i];
    p.out = (float*)d_out; p.ws = (unsigned char*)d_ws;
    void* args[] = {&p};
    hipError_t e = hipLaunchCooperativeKernel((const void*)fwd_kernel, dim3(grid_blocks), dim3(512), args, LDS_BYTES, stream);
    if (e != hipSuccess) fprintf(stderr, "cooperative launch failed: %s (grid %d)\n", hipGetErrorString(e), grid_blocks);
}
```

```cpp
#include <hip/hip_runtime.h>
#include <hip/hip_cooperative_groups.h>
#include <cstdint>
#include <cstdio>
namespace cg = cooperative_groups;
#define NOPIPE_AB 1
#define FLATQ 1
namespace pg8 {
#define PG8_LAS __attribute__((address_space(3)))
typedef unsigned short bf16_t;
typedef short bf16x8 __attribute__((ext_vector_type(8)));
typedef float f32x4 __attribute__((ext_vector_type(4)));
typedef unsigned u32x4 __attribute__((ext_vector_type(4)));
constexpr int BM = 256, BK = 64, HALF = 128, HTB = HALF * BK * 2  , STAGE_BYTES = 8 * HTB, NXCD = 8, WGM = 8;

__host__ __device__ __forceinline__ int lds_byte(int r, int c) { const int st = (r >> 4) * 2 + (c >> 5), rr = r & 15, cc = c & 31, ob = rr * 64 + cc * 2; return st * 1024 + (ob ^ (((ob >> 9) & 1) << 5)); }
__host__ __device__ __forceinline__ void stage_rc(int b, int& R, int& C) { const int st = b / 1024, sb = b % 1024, swz = sb ^ (((sb >> 9) & 1) << 5); R = (st >> 1) * 16 + swz / 64; C = (st & 1) * 32 + (swz % 64) / 2; }
__host__ __device__ __forceinline__ int perm32(int rho) { const int n = rho >> 4, i = rho & 15; return 8 * (i >> 2) + 4 * n + (i & 3); }

struct Unit { int pm, pn, z; };
struct Gemm { const bf16_t* A; const bf16_t* Bt; int K; size_t zsA, zsB; };

template <class Epi, class Sched, bool ALIGN_EPI = false, bool SP2 = false>
__device__ __forceinline__ void gemm_phase(PG8_LAS unsigned char* lds, const Gemm g, const Sched& S, const Epi& E, const int wv  ) {
    int tid_; asm volatile("v_mbcnt_lo_u32_b32 %0, -1, 0\n\tv_mbcnt_hi_u32_b32 %0, -1, %0" : "=v"(tid_)); tid_ += wv * 64;
    const int tid = tid_, wid = __builtin_amdgcn_readfirstlane(tid >> 6), lane = tid & 63, wr = wid >> 2, wc = wid & 3, fr = lane & 15, fq = lane >> 4;
    const int K = g.K, nt = K / BK;
    unsigned voffA[2], voffB[2];
#pragma unroll
    for (int i = 0; i < 2; ++i) { int R, C; stage_rc(tid * 16 + i * 8192, R, C); const int Rb = Epi::PERM ? ((R & ~31) + perm32(R & 31)) : R;
        voffA[i] = (unsigned)(R * K + C) * 2u; voffB[i] = (unsigned)(Rb * K + C) * 2u; }
    const size_t kstep = (size_t)(BK * 2);
    const size_t hstep = (size_t)HALF * K * 2;
    const size_t tstep = 2 * hstep;
    const unsigned ldsw = (unsigned)wid * 1024u;
    const int aoff = lds_byte(wr * 64 + fr, fq * 8), boff = lds_byte(wc * 32 + fr, fq * 8);
#define PG8_SA(b, h) (((b) * 2 + (h)) * HTB)
#define PG8_SB(b, h) ((4 + (b) * 2 + (h)) * HTB)
#define PG8_STAGE(bufoff, gbase, voff) do { _Pragma("unroll") for (int _i = 0; _i < 2; ++_i) \
        __builtin_amdgcn_global_load_lds((const unsigned*)((const char*)(gbase) + (voff)[_i]), (PG8_LAS unsigned*)(lds + (bufoff) + ldsw + _i * 8192), 16, 0, 0); } while (0)
#define PG8_LDA(dst, b, h) do { _Pragma("unroll") for (int m = 0; m < 4; ++m) _Pragma("unroll") for (int k = 0; k < 2; ++k) dst[m][k] = *(const PG8_LAS bf16x8*)(lds + PG8_SA(b, h) + aoff + m * 2048 + k * 1024); } while (0)
#define PG8_LDB(dst, b, h) do { _Pragma("unroll") for (int n = 0; n < 2; ++n) _Pragma("unroll") for (int k = 0; k < 2; ++k) dst[n][k] = *(const PG8_LAS bf16x8*)(lds + PG8_SB(b, h) + boff + n * 2048 + k * 1024); } while (0)
#define PG8_MMA(ai, bj, At, Bt) do { __builtin_amdgcn_s_setprio(1); _Pragma("unroll") for (int m = 0; m < 4; ++m) _Pragma("unroll") for (int n = 0; n < 2; ++n) _Pragma("unroll") for (int k = 0; k < 2; ++k) \
        acc[ai][bj][m][n] = __builtin_amdgcn_mfma_f32_16x16x32_bf16(Bt[n][k], At[m][k], acc[ai][bj][m][n], 0, 0, 0); __builtin_amdgcn_s_setprio(0); } while (0)
#define PG8_WAIT_V(n) asm volatile("s_waitcnt vmcnt(" #n ")" ::: "memory")
#define PG8_WAIT_L(n) asm volatile("s_waitcnt lgkmcnt(" #n ")" ::: "memory")
#define PG8_BAR __builtin_amdgcn_s_barrier()
#define PG8_SCHED __builtin_amdgcn_sched_barrier(0)
    Unit cur, nxt; int ui = 0;
    if (!S.next(0, cur)) return;
    f32x4 acc[2][2][4][2];
#pragma unroll
    for (int a = 0; a < 2; ++a)
#pragma unroll
        for (int b = 0; b < 2; ++b)
#pragma unroll
            for (int m = 0; m < 4; ++m)
#pragma unroll
                for (int n = 0; n < 2; ++n) acc[a][b][m][n] = (f32x4){0.f, 0.f, 0.f, 0.f};
    bf16x8 At[4][2], B0[2][2], B1[2][2];
    const char* cA = (const char*)(g.A + (size_t)cur.z * g.zsA) + (size_t)cur.pm * tstep; const char* cB = (const char*)(g.Bt + (size_t)cur.z * g.zsB) + (size_t)cur.pn * tstep;
    S.a_ready(cur);
    if constexpr (SP2) {
        PG8_STAGE(PG8_SB(0, 0), cB, voffB); PG8_STAGE(PG8_SB(0, 1), cB + hstep, voffB); PG8_STAGE(PG8_SA(0, 0), cA, voffA); PG8_STAGE(PG8_SA(0, 1), cA + hstep, voffA);
        if (wr == 1) PG8_BAR;
        PG8_WAIT_V(2); PG8_BAR;
        PG8_STAGE(PG8_SB(1, 0), cB + kstep, voffB); PG8_STAGE(PG8_SA(1, 0), cA + kstep, voffA); PG8_STAGE(PG8_SB(1, 1), cB + hstep + kstep, voffB);
        PG8_WAIT_V(6); PG8_BAR;
    } else {
        PG8_STAGE(PG8_SB(0, 0), cB, voffB); PG8_STAGE(PG8_SA(0, 0), cA, voffA); PG8_STAGE(PG8_SB(0, 1), cB + hstep, voffB); PG8_STAGE(PG8_SA(0, 1), cA + hstep, voffA);
        if (wr == 1) PG8_BAR;
        PG8_WAIT_V(4); PG8_BAR;
        PG8_STAGE(PG8_SB(1, 0), cB + kstep, voffB); PG8_STAGE(PG8_SA(1, 0), cA + kstep, voffA); PG8_STAGE(PG8_SB(1, 1), cB + hstep + kstep, voffB);
        PG8_WAIT_V(6); PG8_BAR;
    }
    for (;;) {
        const bool has_next = S.next(ui + 1, nxt);
        const char* nA = has_next ? (const char*)(g.A + (size_t)nxt.z * g.zsA) + (size_t)nxt.pm * tstep : cA; const char* nB = has_next ? (const char*)(g.Bt + (size_t)nxt.z * g.zsB) + (size_t)nxt.pn * tstep : cB;
        for (int t = 0; t < nt; t += 2) {
            const bool last = (t == nt - 2);
            const char* a1 = cA + (size_t)(t + 1) * kstep;
            const char* a2 = last ? nA : cA + (size_t)(t + 2) * kstep; const char* b2 = last ? nB : cB + (size_t)(t + 2) * kstep;
            const char* a3 = a2 + kstep; const char* b3 = b2 + kstep;
            if (last && has_next) S.a_ready(nxt);
            if constexpr (SP2) {
            PG8_LDB(B0, 0, 0); PG8_LDB(B1, 0, 1); PG8_SCHED; PG8_LDA(At, 0, 0); PG8_STAGE(PG8_SA(1, 1), a1 + hstep, voffA);
            PG8_WAIT_V(8); PG8_WAIT_L(0); PG8_BAR; PG8_MMA(0, 0, At, B0); PG8_MMA(0, 1, At, B1); PG8_BAR; PG8_SCHED;
            PG8_LDA(At, 0, 1); PG8_STAGE(PG8_SB(0, 0), b2, voffB); PG8_STAGE(PG8_SB(0, 1), b2 + hstep, voffB); PG8_STAGE(PG8_SA(0, 0), a2, voffA);
            PG8_WAIT_V(8); PG8_WAIT_L(0); PG8_BAR; PG8_MMA(1, 0, At, B0); PG8_MMA(1, 1, At, B1); PG8_BAR; PG8_SCHED;
            PG8_LDB(B0, 1, 0); PG8_LDB(B1, 1, 1); PG8_SCHED; PG8_LDA(At, 1, 0); PG8_STAGE(PG8_SA(0, 1), a2 + hstep, voffA);
            PG8_WAIT_V(8); PG8_WAIT_L(0); PG8_BAR; PG8_MMA(0, 0, At, B0); PG8_MMA(0, 1, At, B1); PG8_BAR; PG8_SCHED;
            PG8_LDA(At, 1, 1); PG8_STAGE(PG8_SB(1, 0), b3, voffB); PG8_STAGE(PG8_SB(1, 1), b3 + hstep, voffB); PG8_STAGE(PG8_SA(1, 0), a3, voffA);
            PG8_WAIT_V(8); PG8_WAIT_L(0); PG8_BAR; PG8_MMA(1, 0, At, B0); PG8_MMA(1, 1, At, B1); PG8_BAR; PG8_SCHED;
            } else {
            PG8_LDB(B0, 0, 0); PG8_SCHED; PG8_LDA(At, 0, 0); PG8_STAGE(PG8_SA(1, 1), a1 + hstep, voffA);
            PG8_WAIT_L(8); PG8_BAR; PG8_WAIT_L(0); PG8_MMA(0, 0, At, B0); PG8_BAR; PG8_SCHED;
            PG8_LDB(B1, 0, 1); PG8_STAGE(PG8_SB(0, 0), b2, voffB);
            PG8_BAR; PG8_WAIT_L(0); PG8_MMA(0, 1, At, B1); PG8_BAR;
            PG8_LDA(At, 0, 1); PG8_STAGE(PG8_SA(0, 0), a2, voffA);
            PG8_BAR; PG8_WAIT_L(0); PG8_MMA(1, 0, At, B0); PG8_BAR; PG8_SCHED;
            PG8_STAGE(PG8_SB(0, 1), b2 + hstep, voffB);
            PG8_WAIT_V(6); PG8_BAR; PG8_MMA(1, 1, At, B1); PG8_BAR;
            PG8_LDB(B0, 1, 0); PG8_SCHED; PG8_LDA(At, 1, 0); PG8_STAGE(PG8_SA(0, 1), a2 + hstep, voffA);
            PG8_WAIT_L(8); PG8_BAR; PG8_WAIT_L(0); PG8_MMA(0, 0, At, B0); PG8_BAR; PG8_SCHED;
            PG8_LDB(B1, 1, 1); PG8_STAGE(PG8_SB(1, 0), b3, voffB);
            PG8_BAR; PG8_WAIT_L(0); PG8_MMA(0, 1, At, B1); PG8_BAR;
            PG8_LDA(At, 1, 1); PG8_STAGE(PG8_SA(1, 0), a3, voffA);
            PG8_BAR; PG8_WAIT_L(0); PG8_MMA(1, 0, At, B0); PG8_BAR; PG8_SCHED;
            PG8_STAGE(PG8_SB(1, 1), b3 + hstep, voffB);
            PG8_WAIT_V(6); PG8_BAR; PG8_MMA(1, 1, At, B1); PG8_BAR;
            }
        }
        if constexpr (ALIGN_EPI) { if (wr == 0) PG8_BAR; }
        if constexpr (!Epi::AFTER_DRAIN) { E(acc, cur, wr, wc, fr, fq); S.done(cur); }
        if (!has_next) break;
#pragma unroll
        for (int a = 0; a < 2; ++a)
#pragma unroll
            for (int b = 0; b < 2; ++b)
#pragma unroll
                for (int m = 0; m < 4; ++m)
#pragma unroll
                    for (int n = 0; n < 2; ++n) acc[a][b][m][n] = (f32x4){0.f, 0.f, 0.f, 0.f};
        cur = nxt; cA = nA; cB = nB; ++ui;
        if constexpr (ALIGN_EPI) { if (wr == 1) PG8_BAR; }
    }
    PG8_WAIT_V(0);
    if constexpr (!ALIGN_EPI) { if (wr == 0) PG8_BAR; }
    PG8_BAR;
    if constexpr (Epi::AFTER_DRAIN) { E.fused(acc, cur, wr, wc, fr, fq, lds, wid, lane); S.done(cur); }
#undef PG8_SA
#undef PG8_SB
#undef PG8_STAGE
#undef PG8_LDA
#undef PG8_LDB
#undef PG8_MMA
#undef PG8_WAIT_V
#undef PG8_WAIT_L
#undef PG8_BAR
#undef PG8_SCHED
}
}


using pg8::bf16_t; using pg8::bf16x8; using pg8::f32x4; using pg8::u32x4;
typedef float f32x16 __attribute__((ext_vector_type(16)));
typedef unsigned u32x2 __attribute__((ext_vector_type(2)));
typedef float f32x2_t __attribute__((ext_vector_type(2)));
typedef __bf16 bf16x2_t __attribute__((ext_vector_type(2)));
#define LAS __attribute__((address_space(3)))
#define DI __device__ __forceinline__

constexpr int DM = 1024, RA = 16896;
constexpr int ZM_LD = 2816, G_LD = 3072, IN_N = 5888;
constexpr float LOG2E = 1.4426950408889634f;
constexpr size_t MiB = 1u << 20;
constexpr size_t WS_CTL = 0, CTL_BYTES = 131072;
constexpr size_t WS_W = 1 * MiB, LW_STRIDE = 34 * MiB;
constexpr size_t W_IN = 0, W_QB = W_IN + (size_t)IN_N * 1024 * 2, W_KVB = W_QB + 768 * 256 * 2, W_BR = W_KVB + 1024 * 128 * 2,
                 W_OUT = W_BR + 3 * 1024 * 512 * 2, W_UP = W_OUT + 1024 * 1024 * 2, W_DOWN = W_UP + 4096 * 1024 * 2, W_END = W_DOWN + 4096 * 1024 * 2;
static_assert(W_END <= LW_STRIDE, "weights");
constexpr size_t WS_META0 = 69 * MiB, WS_METAX = 70 * MiB, WS_XN = 74 * MiB, WS_ZM = 107 * MiB, WS_G = 198 * MiB, WS_QKV = 297 * MiB, WS_SM = 438 * MiB, WS_END = 454 * MiB;
constexpr size_t OFF_QCR = 0, OFF_KVR = 25 * MiB;
constexpr size_t OSLOT = (size_t)RA * 512;
constexpr size_t QA_O = 0, KA_O = 512ull * RA, VA_O = 640ull * RA, QB_O = 768ull * RA, KB_O = 1280ull * RA, VB_O = 1792ull * RA, QC_O = 2304ull * RA, KC_O = 3072ull * RA, VC_O = 3840ull * RA;
constexpr size_t SM_CQN = 0, SM_CKVN = 9 * MiB, SM_KPE = 14 * MiB;
constexpr int LDS_MISC = 131072, LDS_BYTES = 131072 + 256;

struct Params { const float* in[28]; float* out; unsigned char* ws; };

DI unsigned pk2(float lo, float hi) { f32x2_t v = {lo, hi}; bf16x2_t b = __builtin_convertvector(v, bf16x2_t); return __builtin_bit_cast(unsigned, b); }
DI void ld8(const bf16_t* p, float (&f)[8]) {
    const u32x4 r = *(const u32x4*)p;
#pragma unroll
    for (int i = 0; i < 4; ++i) { f[2 * i] = __uint_as_float(r[i] << 16); f[2 * i + 1] = __uint_as_float(r[i] & 0xffff0000u); }
}
DI void st8(bf16_t* p, const float (&f)[8]) { u32x4 w; w.x = pk2(f[0], f[1]); w.y = pk2(f[2], f[3]); w.z = pk2(f[4], f[5]); w.w = pk2(f[6], f[7]); *(u32x4*)p = w; }
DI int lane_fresh() { int l; asm volatile("v_mbcnt_lo_u32_b32 %0, -1, 0\n\tv_mbcnt_hi_u32_b32 %0, -1, %0" : "=v"(l)); return l; }
DI float wave_sum(float v, int lane) {
#pragma unroll
    for (int o = 1; o < 64; o <<= 1) v += __int_as_float(__builtin_amdgcn_ds_bpermute((lane ^ o) << 2, __float_as_int(v)));
    return v;
}
DI float max3f(float a, float b, float c) { float r; asm("v_max3_f32 %0, %1, %2, %3" : "=v"(r) : "v"(a), "v"(b), "v"(c)); return r; }
DI float max2f(float a, float b) { float r; asm("v_max_f32_e32 %0, %1, %2" : "=v"(r) : "v"(a), "v"(b)); return r; }
DI float fadd_s(float a, float b) { float r; asm("v_add_f32_e32 %0, %1, %2" : "=v"(r) : "v"(a), "v"(b)); return r; }
#define MX2(a, b) __builtin_amdgcn_fmed3f((a), (b), __builtin_inff())
DI float swap32_max(float v) { auto rr = __builtin_amdgcn_permlane32_swap(__float_as_uint(v), __float_as_uint(v), false, false); return __builtin_amdgcn_fmed3f(__uint_as_float(rr[0]), __uint_as_float(rr[1]), __builtin_inff()); }
DI float swap32_add(float v) { auto rr = __builtin_amdgcn_permlane32_swap(__float_as_uint(v), __float_as_uint(v), false, false); return __uint_as_float(rr[0]) + __uint_as_float(rr[1]); }
DI constexpr float inv64(int j) {
    constexpr float T[32] = {1.0f, 0.749894209f, 0.562341325f, 0.421696503f, 0.316227766f, 0.237137371f, 0.177827941f, 0.133352143f, 0.1f, 0.0749894209f, 0.0562341325f, 0.0421696503f,
                             0.0316227766f, 0.0237137371f, 0.0177827941f, 0.0133352143f, 0.01f, 0.00749894209f, 0.00562341325f, 0.00421696503f, 0.00316227766f, 0.00237137371f,
                             0.00177827941f, 0.00133352143f, 0.001f, 0.000749894209f, 0.000562341325f, 0.000421696503f, 0.000316227766f, 0.000237137371f, 0.000177827941f, 0.000133352143f};
    return T[j];
}
DI void sincos_ang(float ang, float& s, float& c) {
    double t = (double)ang * 0.15915494309189535; t -= __builtin_rint(t); const float f = (float)t;
    s = __builtin_amdgcn_sinf(f); c = __builtin_amdgcn_cosf(f);
}

struct Chunk {
    int id, nseq, seq0, tps, n;
    DI int rows_per_seq() const { return tps * 256; }
    DI int rows() const { return nseq * tps * 256; }
};
DI Chunk make_chunk(int c) { Chunk k; k.id = c; if (c < 2) { k.nseq = 1; k.seq0 = c; k.tps = 65; k.n = 16384; } else { k.nseq = 2; k.seq0 = 2; k.tps = 33; k.n = 8192; } return k; }
struct XMap {
    float* out; float* metax; const float* xp; const float* xs; const float* meta0; int seq0, tps, first;
    DI float* xw(int pt) const {
        const int hi = pt >= tps ? 1 : 0, s = seq0 + hi, lt = pt - hi * tps;
        if (lt == tps - 1) return metax + (size_t)s * 256 * DM;
        const int ob = (s < 2) ? s * 16384 : 32768 + (s - 2) * 8192;
        return out + ((size_t)ob + (size_t)lt * 256) * DM;
    }
    DI const float* xr(int pt) const {
        if (!first) return xw(pt);
        const int hi = pt >= tps ? 1 : 0, s = seq0 + hi, lt = pt - hi * tps;
        if (lt == tps - 1) return metax + (size_t)s * 256 * DM;
        return (s < 2) ? xp + ((size_t)s * 16384 + (size_t)lt * 256) * DM : xs + ((size_t)(s - 2) * 8192 + (size_t)lt * 256) * DM;
    }
};

struct Sched {
    int nM, nN, nZ, nwg, G, c, ta, tps;
    DI void init(int nseq, int ta_, int tps_, int nN_, int nZ_, int G_, int c_) { ta = ta_; tps = tps_; nM = nseq * ta_; nN = nN_; nZ = nZ_; nwg = nM * nN; G = G_; c = c_; }
    DI bool next(int i, pg8::Unit& u) const {
        const int tl = (i / nZ) * G + c; if (tl >= nwg) return false;
        u.z = i % nZ;
        int wgid = tl; { const int q = nwg / pg8::NXCD, r = nwg % pg8::NXCD, xcd = wgid % pg8::NXCD, off = wgid / pg8::NXCD; wgid = (xcd < r ? xcd * (q + 1) : r * (q + 1) + (xcd - r) * q) + off; }
        const int nig = pg8::WGM * nN, gid = wgid / nig, fm = gid * pg8::WGM, gsz = (nM - fm) < pg8::WGM ? (nM - fm) : pg8::WGM;
        const int pa = fm + ((wgid % nig) % gsz); u.pn = (wgid % nig) / gsz;
        u.pm = pa >= ta ? pa - ta + tps : pa;
        return true;
    }
    DI void a_ready(const pg8::Unit&) const {}
    DI void done(const pg8::Unit&) const {}
};

template <int ACT  > struct EpiBf16 {
    static constexpr bool PERM = true, AFTER_DRAIN = false;
    bf16_t* O; int ldc;
    DI void operator()(const f32x4 (&acc)[2][2][4][2], const pg8::Unit& u, int wr, int wc, int fr_, int fq_) const {
        const int ln_ = lane_fresh(), fr = ln_ & 15, fq = ln_ >> 4;
        const int row0 = u.pm * 256 + wr * 64 + fr, col0 = u.pn * 256 + wc * 32 + 8 * fq;
#pragma unroll
        for (int ai = 0; ai < 2; ++ai)
#pragma unroll
            for (int m = 0; m < 4; ++m) { bf16_t* rowp = O + (size_t)(row0 + ai * 128 + m * 16) * ldc + col0;
#pragma unroll
                for (int bj = 0; bj < 2; ++bj) { f32x4 v0 = acc[ai][bj][m][0], v1 = acc[ai][bj][m][1];
                    if (ACT == 2) {
#pragma unroll
                        for (int k = 0; k < 4; ++k) { const float a = fmaxf(v0[k], 0.f), b = fmaxf(v1[k], 0.f); v0[k] = a * a; v1[k] = b * b; } }
                    u32x4 w; w.x = pk2(v0[0], v0[1]); w.y = pk2(v0[2], v0[3]); w.z = pk2(v1[0], v1[1]); w.w = pk2(v1[2], v1[3]);
                    *(u32x4*)(rowp + bj * 128) = w; } }
    }
};
struct EpiIn {
    static constexpr bool PERM = true, AFTER_DRAIN = false;
    bf16_t* ZM; bf16_t* G; const float* bgate;
    DI void operator()(const f32x4 (&acc)[2][2][4][2], const pg8::Unit& u, int wr, int wc, int fr_, int fq_) const {
        const int ln_ = lane_fresh(), fr = ln_ & 15, fq = ln_ >> 4;
        const bool gate = u.pn >= 11;
        const int row0 = u.pm * 256 + wr * 64 + fr, colt = gate ? (u.pn - 11) * 256 : u.pn * 256, col0 = colt + wc * 32 + 8 * fq, ld = gate ? G_LD : ZM_LD;
        bf16_t* base = gate ? G : ZM;
        f32x4 bv[2][2];
#pragma unroll
        for (int bj = 0; bj < 2; ++bj)
#pragma unroll
            for (int n = 0; n < 2; ++n) bv[bj][n] = gate ? *(const f32x4*)(bgate + col0 + bj * 128 + 4 * n) : (f32x4){0.f, 0.f, 0.f, 0.f};
#pragma unroll
        for (int ai = 0; ai < 2; ++ai)
#pragma unroll
            for (int m = 0; m < 4; ++m) { bf16_t* rowp = base + (size_t)(row0 + ai * 128 + m * 16) * ld + col0;
#pragma unroll
                for (int bj = 0; bj < 2; ++bj) { f32x4 v0 = acc[ai][bj][m][0] + bv[bj][0], v1 = acc[ai][bj][m][1] + bv[bj][1];
                    if (gate) {
#pragma unroll
                        for (int k = 0; k < 4; ++k) { v0[k] = __builtin_amdgcn_rcpf(1.f + __builtin_amdgcn_exp2f(-LOG2E * v0[k])); v1[k] = __builtin_amdgcn_rcpf(1.f + __builtin_amdgcn_exp2f(-LOG2E * v1[k])); } }
                    u32x4 w; w.x = pk2(v0[0], v0[1]); w.y = pk2(v0[2], v0[3]); w.z = pk2(v1[0], v1[1]); w.w = pk2(v1[2], v1[3]);
                    *(u32x4*)(rowp + bj * 128) = w; } }
    }
};
struct EpiBranch {
    static constexpr bool PERM = false, AFTER_DRAIN = false;
    const bf16_t* G; float* MG; bf16_t* MGb;
    DI void operator()(const f32x4 (&acc)[2][2][4][2], const pg8::Unit& u, int wr, int wc, int fr_, int fq_) const {
        const int ln_ = lane_fresh(), fr = ln_ & 15, fq = ln_ >> 4;
        const int row0 = u.pm * 256 + wr * 64 + fr, col0 = u.pn * 256 + wc * 32 + 4 * fq;
#pragma unroll
        for (int ai = 0; ai < 2; ++ai)
#pragma unroll
            for (int m = 0; m < 4; ++m) { const size_t row = (size_t)(row0 + ai * 128 + m * 16);
#pragma unroll
                for (int bj = 0; bj < 2; ++bj)
#pragma unroll
                    for (int n = 0; n < 2; ++n) { const int col = col0 + bj * 128 + n * 16;
                        const u32x2 gr = *(const u32x2*)(G + row * G_LD + u.z * 1024 + col);
                        f32x4 g; g[0] = __uint_as_float(gr.x << 16); g[1] = __uint_as_float(gr.x & 0xffff0000u); g[2] = __uint_as_float(gr.y << 16); g[3] = __uint_as_float(gr.y & 0xffff0000u);
                        f32x4 v = g * acc[ai][bj][m][n];
                        float* mp = MG + row * DM + col;
                        if (u.z > 0) v += *(const f32x4*)mp;
                        if (u.z < 2) *(f32x4*)mp = v;
                        else { u32x2 w; w.x = pk2(v[0], v[1]); w.y = pk2(v[2], v[3]); *(u32x2*)(MGb + row * DM + col) = w; } }
                asm volatile("" ::: "memory"); }
    }
};
struct EpiResid {
    static constexpr bool PERM = false, AFTER_DRAIN = false;
    XMap xm;
    DI void operator()(const f32x4 (&acc)[2][2][4][2], const pg8::Unit& u, int wr, int wc, int fr_, int fq_) const {
        const int ln_ = lane_fresh(), fr = ln_ & 15, fq = ln_ >> 4;
        const float* rd = xm.xr(u.pm); float* wp = xm.xw(u.pm);
        const int row0 = wr * 64 + fr, col0 = u.pn * 256 + wc * 32 + 4 * fq;
#pragma unroll
        for (int ai = 0; ai < 2; ++ai)
#pragma unroll
            for (int m = 0; m < 4; ++m) { const size_t off = (size_t)(row0 + ai * 128 + m * 16) * DM + col0;
#pragma unroll
                for (int bj = 0; bj < 2; ++bj)
#pragma unroll
                    for (int n = 0; n < 2; ++n) { const size_t o = off + bj * 128 + n * 16; *(f32x4*)(wp + o) = *(const f32x4*)(rd + o) + acc[ai][bj][m][n]; }
                asm volatile("" ::: "memory"); }
    }
};

DI void transpose_item(const float* W, int K, int N, bf16_t* WT, int split, int extra, LAS float* scr, int item, int lane) {
    const int nblk = N / 32, kb = item / nblk, nb = item % nblk, k0 = 64 * kb, n0 = 32 * nb;
    const int row_off = (n0 >= split) ? extra : 0;
#pragma unroll 8
    for (int i = 0; i < 32; ++i) { const int kk = 2 * i + (lane >> 5); scr[kk * 33 + (lane & 31)] = W[(size_t)(k0 + kk) * N + n0 + (lane & 31)]; }
    asm volatile("s_waitcnt lgkmcnt(0)" ::: "memory");
    const int c = lane & 7;
#pragma unroll
    for (int j = 0; j < 4; ++j) { const int n = (lane >> 3) + 8 * j; const LAS float* s = scr + (8 * c) * 33 + n;
        u32x4 o; o.x = pk2(s[0 * 33], s[1 * 33]); o.y = pk2(s[2 * 33], s[3 * 33]); o.z = pk2(s[4 * 33], s[5 * 33]); o.w = pk2(s[6 * 33], s[7 * 33]);
        *(u32x4*)(WT + (size_t)(row_off + n0 + n) * K + k0 + 8 * c) = o; }
    asm volatile("s_waitcnt lgkmcnt(0)" ::: "memory");
}
DI void prologue(const Params& p, LAS unsigned char* lds, int gw, int NGW, int wave, int lane) {
    LAS float* scr = (LAS float*)(lds + wave * 16384);
    constexpr int I_IN = 16 * 182, I_QB = 4 * 24, I_KVB = 2 * 32, I_BR = 8 * 32, I_OUT = 16 * 32, I_UP = 16 * 128, I_DN = 64 * 32;
    constexpr int PER_L = I_IN + I_QB + I_KVB + 3 * I_BR + I_OUT + I_UP + I_DN;
    for (int it = gw; it < 2 * PER_L; it += NGW) {
        const int l = it / PER_L; int r = it % PER_L;
        unsigned char* wb = p.ws + WS_W + (size_t)l * LW_STRIDE;
        if (r < I_IN) { transpose_item(p.in[4] + (size_t)l * 1024 * 5824, 1024, 5824, (bf16_t*)(wb + W_IN), 2752, 64, scr, r, lane); continue; } r -= I_IN;
        if (r < I_QB) { transpose_item(p.in[16] + (size_t)l * 256 * 768, 256, 768, (bf16_t*)(wb + W_QB), 1 << 30, 0, scr, r, lane); continue; } r -= I_QB;
        if (r < I_KVB) { transpose_item(p.in[18] + (size_t)l * 128 * 1024, 128, 1024, (bf16_t*)(wb + W_KVB), 1 << 30, 0, scr, r, lane); continue; } r -= I_KVB;
        if (r < 3 * I_BR) { const int b = r / I_BR; transpose_item(p.in[21 + b] + (size_t)l * 512 * 1024, 512, 1024, (bf16_t*)(wb + W_BR) + (size_t)b * 1024 * 512, 1 << 30, 0, scr, r % I_BR, lane); continue; } r -= 3 * I_BR;
        if (r < I_OUT) { transpose_item(p.in[24] + (size_t)l * 1024 * 1024, 1024, 1024, (bf16_t*)(wb + W_OUT), 1 << 30, 0, scr, r, lane); continue; } r -= I_OUT;
        if (r < I_UP) { transpose_item(p.in[26] + (size_t)l * 1024 * 4096, 1024, 4096, (bf16_t*)(wb + W_UP), 1 << 30, 0, scr, r, lane); continue; } r -= I_UP;
        transpose_item(p.in[27] + (size_t)l * 4096 * 1024, 4096, 1024, (bf16_t*)(wb + W_DOWN), 1 << 30, 0, scr, r, lane);
    }
    { float* mx0 = (float*)(p.ws + WS_METAX);
      for (int r = gw; r < 4 * 256; r += NGW) { const int rr = r & 255; f32x4* o = (f32x4*)(mx0 + (size_t)r * DM) + lane;
#pragma unroll
        for (int j = 0; j < 4; ++j) o[64 * j] = (rr < 16) ? ((const f32x4*)(p.in[2] + (size_t)rr * DM))[lane + 64 * j] : (f32x4){0.f, 0.f, 0.f, 0.f}; } }
    float* m0 = (float*)(p.ws + WS_META0);
    for (int r = gw; r < 256; r += NGW) { f32x4* o = (f32x4*)(m0 + (size_t)r * DM) + lane;
#pragma unroll
        for (int j = 0; j < 4; ++j) o[64 * j] = (r < 16) ? ((const f32x4*)(p.in[2] + (size_t)r * DM))[lane + 64 * j] : (f32x4){0.f, 0.f, 0.f, 0.f}; }
}

DI void norm_phase(const XMap& xm, int rows, const float* g, bf16_t* XN, int gw, int NGW, int lane) {
    for (int r = gw; r < rows; r += NGW) {
        const float* xrow = xm.xr(r >> 8) + (size_t)(r & 255) * DM;
        const f32x4* xr = (const f32x4*)xrow + lane;
        f32x4 v[4]; float s = 0.f;
#pragma unroll
        for (int j = 0; j < 4; ++j) { v[j] = xr[64 * j]; s += (v[j].x * v[j].x + v[j].y * v[j].y) + (v[j].z * v[j].z + v[j].w * v[j].w); }
        const float rs = rsqrtf(wave_sum(s, lane) * (1.f / DM) + 1e-6f);
        u32x2* o8 = (u32x2*)(XN + (size_t)r * DM) + lane;
#pragma unroll
        for (int j = 0; j < 4; ++j) { const f32x4 gg = ((const f32x4*)g)[lane + 64 * j]; u32x2 w; w.x = pk2(v[j].x * rs * gg.x, v[j].y * rs * gg.y); w.y = pk2(v[j].z * rs * gg.z, v[j].w * rs * gg.w); o8[64 * j] = w; }
    }
}

template <int W, int W0, int ROPE> DI void norm_task(const bf16_t* s0, const bf16_t* s1, const float* gain, float oscale, bf16_t* dst, float pa, float pb) {
    float ss = 0.f;
#pragma unroll 2
    for (int c = 0; c < W / 8; ++c) { float x[8]; ld8(c < W0 / 8 ? s0 + 8 * c : s1 + 8 * (c - W0 / 8), x);
#pragma unroll
        for (int e = 0; e < 8; ++e) ss += x[e] * x[e]; }
    const float rs = rsqrtf(ss * (1.f / W) + 1e-6f) * oscale;
    constexpr int NPLAIN = ROPE == 1 ? 0 : (ROPE == 2 ? 16 : W / 8);
#pragma unroll 2
    for (int c = 0; c < NPLAIN; ++c) { float x[8]; ld8(c < W0 / 8 ? s0 + 8 * c : s1 + 8 * (c - W0 / 8), x);
#pragma unroll
        for (int e = 0; e < 8; ++e) x[e] *= rs * gain[8 * c + e];
        st8(dst + 8 * c, x); }
    if constexpr (ROPE != 0) {
        constexpr int NB = ROPE == 1 ? 2 : 1, HC = ROPE == 1 ? 2 : 4, C0 = ROPE == 1 ? 0 : 16;
#pragma unroll
        for (int b = 0; b < NB; ++b) { const float pos = b ? pb : pa;
#pragma unroll
            for (int k = 0; k < HC; ++k) { const int c1 = C0 + 2 * HC * b + k, c2 = c1 + HC; float x1[8], x2[8];
                ld8(c1 < W0 / 8 ? s0 + 8 * c1 : s1 + 8 * (c1 - W0 / 8), x1); ld8(c2 < W0 / 8 ? s0 + 8 * c2 : s1 + 8 * (c2 - W0 / 8), x2);
#pragma unroll
                for (int e = 0; e < 8; ++e) { const int j = 8 * k + e; const float inv = ROPE == 1 ? inv64(2 * j) : inv64(j); float sn, cs; sincos_ang(pos * inv, sn, cs);
                    const float y1 = x1[e] * rs * gain[8 * c1 + e], y2 = x2[e] * rs * gain[8 * c2 + e]; x1[e] = y1 * cs - y2 * sn; x2[e] = y2 * cs + y1 * sn; }
                st8(dst + 8 * c1, x1); st8(dst + 8 * c2, x2); } }
    }
}
template <int W> DI void transpose_task(const bf16_t* src, bf16_t* dstT, int row) {
#pragma unroll 2
    for (int c = 0; c < W / 8; ++c) { const u32x4 r = *(const u32x4*)(src + 8 * c);
#pragma unroll
        for (int i = 0; i < 4; ++i) { dstT[(size_t)(8 * c + 2 * i) * RA + row] = (bf16_t)(r[i] & 0xffffu); dstT[(size_t)(8 * c + 2 * i + 1) * RA + row] = (bf16_t)(r[i] >> 16); } }
}
struct RowPos { float lin, row, col; };
DI RowPos row_pos(const Chunk& ck, int r) {
    const int li = r >= ck.rows_per_seq() ? r - ck.rows_per_seq() : r; RowPos p;
    if (li < ck.n) { p.lin = (float)(li + 16); p.row = (float)(li >> 6); p.col = (float)(li & 63); }
    else if (li < ck.n + 16) { p.lin = (float)(li - ck.n); p.row = -1.f; p.col = (float)(li - ck.n); }
    else { p.lin = 0.f; p.row = 0.f; p.col = 0.f; }
    return p;
}

DI void ew1_phase(const Params& p, const Chunk& ck, int l, int gw, int NGW, int lane) {
    unsigned char* ws = p.ws; asm volatile("" : "+s"(ws));
    const bf16_t* ZM = (const bf16_t*)(ws + WS_ZM); bf16_t* QKV = (bf16_t*)(ws + WS_QKV);
    bf16_t* CQN = (bf16_t*)(ws + WS_SM + SM_CQN); bf16_t* CKVN = (bf16_t*)(ws + WS_SM + SM_CKVN); bf16_t* KPE = (bf16_t*)(ws + WS_SM + SM_KPE);
    const int nrb = ck.rows() / 64; const float QS = 0.125f * LOG2E;
    for (int w = gw; w < nrb * 34; w += NGW) {
        const int rb = w / 34, task = w % 34, row = rb * 64 + lane;
        const bf16_t* z = ZM + (size_t)row * ZM_LD; const RowPos ps = row_pos(ck, row);
        if (task < 8) { const int h = task; norm_task<64, 64, 1>(z + 64 * h, z, p.in[6] + l * 64, QS, QKV + QA_O + ((size_t)h * RA + row) * 64, ps.row, ps.col); }
        else if (task < 10) { const int h = task - 8; norm_task<64, 64, 1>(z + 512 + 64 * h, z, p.in[7] + l * 64, 1.f, QKV + KA_O + ((size_t)h * RA + row) * 64, ps.row, ps.col); }
        else if (task < 12) { const int h = task - 10; transpose_task<64>(z + 640 + 64 * h, QKV + VA_O + (size_t)h * 64 * RA, row); }
        else if (task < 20) { const int hm = task - 12; norm_task<64, 64, 0>(z + 768 + 64 * hm, z, p.in[8] + l * 64, QS, QKV + QB_O + ((size_t)hm * RA + row) * 64, 0.f, 0.f); }
        else if (task < 28) { const int hm = task - 20; norm_task<64, 64, 0>(z + 1280 + 64 * hm, z, p.in[9] + l * 64, 1.f, QKV + KB_O + ((size_t)hm * RA + row) * 64, 0.f, 0.f); }
        else if (task < 32) { const int h = task - 28; transpose_task<128>(z + 1792 + 128 * h, QKV + VB_O + (size_t)h * 128 * RA, row); }
        else if (task == 32) { norm_task<256, 256, 0>(z + 2304, z, p.in[15] + l * 256, 1.f, CQN + (size_t)row * 256, 0.f, 0.f); }
        else { norm_task<128, 128, 0>(z + 2560, z, p.in[17] + l * 128, 1.f, CKVN + (size_t)row * 128, 0.f, 0.f);
#pragma unroll
            for (int c = 0; c < 8; ++c) *(u32x4*)(KPE + (size_t)row * 64 + 8 * c) = *(const u32x4*)(z + 2688 + 8 * c); }
    }
}
DI void ew2_phase(const Params& p, const Chunk& ck, int l, int gw, int NGW, int lane) {
    unsigned char* ws = p.ws; asm volatile("" : "+s"(ws));
    const bf16_t* QCR = (const bf16_t*)(ws + WS_ZM + OFF_QCR); const bf16_t* KVR = (const bf16_t*)(ws + WS_ZM + OFF_KVR); const bf16_t* KPE = (const bf16_t*)(ws + WS_SM + SM_KPE);
    bf16_t* QKV = (bf16_t*)(ws + WS_QKV);
    const int nrb = ck.rows() / 64; const float QS = 0.07216878364870322f * LOG2E;
    for (int w = gw; w < nrb * 12; w += NGW) {
        const int rb = w / 12, task = w % 12, row = rb * 64 + lane; const RowPos ps = row_pos(ck, row);
        if (task < 4) { const int h = task; norm_task<192, 192, 2>(QCR + (size_t)row * 768 + 192 * h, QCR, p.in[19] + l * 192, QS, QKV + QC_O + ((size_t)h * RA + row) * 192, ps.lin, 0.f); }
        else if (task < 8) { const int h = task - 4; norm_task<192, 128, 2>(KVR + (size_t)row * 1024 + 256 * h, KPE + (size_t)row * 64, p.in[20] + l * 192, 1.f, QKV + KC_O + ((size_t)h * RA + row) * 192, ps.lin, 0.f); }
        else { const int h = task - 8; transpose_task<128>(KVR + (size_t)row * 1024 + 256 * h + 128, QKV + VC_O + (size_t)h * 128 * RA, row); }
    }
}
DI void ew3_phase(const Params& p, const Chunk& ck, int l, bool last, int gw, int NGW, int lane) {
    unsigned char* ws = p.ws; asm volatile("" : "+s"(ws));
    bf16_t* O1 = (bf16_t*)(ws + WS_ZM) + 1 * OSLOT; const bf16_t* O2 = (const bf16_t*)(ws + WS_ZM) + 3 * OSLOT;
    const float d1 = wave_sum(p.in[10][l * 64 + lane] * p.in[11][l * 64 + lane], lane), d2 = wave_sum(p.in[12][l * 64 + lane] * p.in[13][l * 64 + lane], lane);
    int lz = l; asm volatile("" : "+s"(lz));
    const float lam_init = __uint_as_float(lz == 0 ? 0x3e4ccccdu : 0x3eb60549u)  , lam = expf(d1) - expf(d2) + lam_init, osc = 1.f - lam_init;
    const float* gs = p.in[14] + l * 128;
    const int nrb = ck.rows() / 64;
    for (int w = gw; w < nrb * 4; w += NGW) {
        const int rb = w >> 2, h = w & 3, row = rb * 64 + lane;
        if (last && (row >= ck.rows_per_seq() ? row - ck.rows_per_seq() : row) >= (ck.tps - 1) * 256) continue;
        bf16_t* a = O1 + (size_t)row * 512 + 128 * h; const bf16_t* b = O2 + (size_t)row * 512 + 128 * h;
        float ss = 0.f;
#pragma unroll 2
        for (int c = 0; c < 16; ++c) { float x[8], y[8]; ld8(a + 8 * c, x); ld8(b + 8 * c, y);
#pragma unroll
            for (int e = 0; e < 8; ++e) { const float d = x[e] - lam * y[e]; ss += d * d; } }
        const float rs = rsqrtf(ss * (1.f / 128.f) + 1e-6f) * osc;
#pragma unroll 2
        for (int c = 0; c < 16; ++c) { float x[8], y[8]; ld8(a + 8 * c, x); ld8(b + 8 * c, y);
#pragma unroll
            for (int e = 0; e < 8; ++e) x[e] = (x[e] - lam * y[e]) * rs * gs[8 * c + e];
            st8(a + 8 * c, x); }
    }
}

template <int DQK, int DV, bool ALIBI, bool PIPE>
DI void attn_unit(LAS unsigned char* lds, const bf16_t* __restrict__ Q, const bf16_t* __restrict__ K, const bf16_t* __restrict__ Vt, bf16_t* __restrict__ O, int r0, int qb, int n, float sl, const int wid, const int dkeys = 0x3fffffff) {
    constexpr bool EARLYV = true;
    constexpr bool NEGM = (DQK == 64);
    constexpr int KROW = DQK * 2 + 16, KT = 64 * KROW, VROW = 144, VT = DV * VROW, KCH = DQK / 8, NKC = 64 * KCH / 512, NVC = DV * 8 / 512, NKS = DQK / 16, NDB = DV / 32, VB0 = 2 * KT;
    typedef const __attribute__((address_space(1))) u32x4* gptr;
    const int lane = lane_fresh(), tid = wid * 64 + lane, r = lane & 31, h = lane >> 5;
    const int nk = n + 16, NT = (nk + 63) >> 6;
    const int li = qb * 256 + wid * 32 + r;
    const int tq = ALIBI ? ((4 * qb + 3 < NT - 1) ? 4 * qb + 3 : NT - 1) : -1;
    int tlo = 0, thi = NT - 2, NIT = NT;
    if (ALIBI && qb * 256 < n) {
        const int x = qb * 256 + 16 - dkeys - 79, y = qb * 256 + 255 + 16 + dkeys - 16;
        tlo = x > 0 ? (x + 63) >> 6 : 0; if (tlo > tq) tlo = tq;
        thi = (y >> 6) < NT - 2 ? (y >> 6) : NT - 2; if (thi < tq) thi = tq;
        NIT = (tq - tlo + 1) + (thi - tq) + 1;
    }
    const int nleft = tq - tlo + 1;
#define TILE(j) (ALIBI ? ((j) < nleft ? tq - (j) : (tq + 1 + (j) - nleft <= thi ? tq + 1 + (j) - nleft : NT - 1)) : (j))
    const bool active = (qb * 256 + wid * 32) < nk;
    const int qrow = r0 + li;
    const float qlin = (li < n) ? (float)(li + 16) : (li < nk ? (float)(li - n) : 0.f);
    bf16x8 qf[NKS];
#pragma unroll
    for (int ks = 0; ks < NKS; ++ks) qf[ks] = *(const bf16x8*)(Q + (size_t)qrow * DQK + ks * 16 + h * 8);
    f32x16 o[NDB];
#pragma unroll
    for (int d = 0; d < NDB; ++d)
#pragma unroll
        for (int i = 0; i < 16; ++i) o[d][i] = 0.f;
    float m = 0.f, l = 0.f; f32x16 negm, zero16;
#pragma unroll
    for (int i = 0; i < 16; ++i) { negm[i] = 0.f; zero16[i] = 0.f; }
    const bf16_t* kg0 = K + (size_t)r0 * DQK + tid * 8; const bf16_t* vg0 = Vt + (size_t)(tid >> 3) * RA + r0 + (tid & 7) * 8; const int vl0 = VB0 + (tid >> 3) * VROW + (tid & 7) * 16;
#define KL(i) ((((tid + 512 * (i)) / KCH) * KROW) + ((tid + 512 * (i)) % KCH) * 16)
#define KG(i, t) ((gptr)(kg0 + (i) * 4096 + (size_t)(t) * 64 * DQK))
#define VG(i, t) ((gptr)(vg0 + (size_t)(i) * 64 * RA + (size_t)(t) * 64))
#define VL(i) (vl0 + (i) * 64 * VROW)
    const int pr = (r & ~12) | ((r & 4) << 1) | ((r & 8) >> 1);
    const int kaddr = pr * KROW + h * 16, vaddr = VB0 + r * VROW + h * 16;
    u32x4 kst[NKC], vst[NVC], kstn[NKC], vstn[NVC];
#define QK_TILE(A0, A1, kb_) do { const int ko_ = (kb_) * KT + kaddr; \
        _Pragma("unroll") for (int kb4 = 0; kb4 < NKS; kb4 += 4) { bf16x8 kq[8]; \
            _Pragma("unroll") for (int j = 0; j < 4; ++j) { kq[2 * j] = *(const LAS bf16x8*)(lds + ko_ + (kb4 + j) * 32); kq[2 * j + 1] = *(const LAS bf16x8*)(lds + ko_ + 32 * KROW + (kb4 + j) * 32); } \
            asm volatile("" : "+v"(kq[0]), "+v"(kq[1]), "+v"(kq[2]), "+v"(kq[3]), "+v"(kq[4]), "+v"(kq[5]), "+v"(kq[6]), "+v"(kq[7]));     \
            _Pragma("unroll") for (int j = 0; j < 4; ++j) { \
                if (kb4 + j == 0) { A0 = __builtin_amdgcn_mfma_f32_32x32x16_bf16(kq[0], qf[0], NEGM ? negm : zero16, 0, 0, 0); A1 = __builtin_amdgcn_mfma_f32_32x32x16_bf16(kq[1], qf[0], NEGM ? negm : zero16, 0, 0, 0); } \
                else { A0 = __builtin_amdgcn_mfma_f32_32x32x16_bf16(kq[2 * j], qf[kb4 + j], A0, 0, 0, 0); A1 = __builtin_amdgcn_mfma_f32_32x32x16_bf16(kq[2 * j + 1], qf[kb4 + j], A1, 0, 0, 0); } } \
            __builtin_amdgcn_sched_barrier(0); } } while (0)
#pragma unroll
    for (int i = 0; i < NKC; ++i) kst[i] = *KG(i, TILE(0));
#pragma unroll
    for (int i = 0; i < NVC; ++i) vst[i] = *VG(i, TILE(0));
#pragma unroll
    for (int i = 0; i < NKC; ++i) *(LAS u32x4*)(lds + KL(i)) = kst[i];
#pragma unroll
    for (int i = 0; i < NVC; ++i) *(LAS u32x4*)(lds + VL(i)) = vst[i];
    if constexpr (PIPE) {
#pragma unroll
        for (int i = 0; i < NKC; ++i) kst[i] = *KG(i, 1);
#pragma unroll
        for (int i = 0; i < NKC; ++i) *(LAS u32x4*)(lds + KT + KL(i)) = kst[i];
#pragma unroll
        for (int i = 0; i < NKC; ++i) kst[i] = *KG(i, 2);
#pragma unroll
        for (int i = 0; i < NVC; ++i) vst[i] = *VG(i, 1);
    }
    __syncthreads();
    f32x16 s0, s1, n0, n1;
    if constexpr (PIPE) { QK_TILE(s0, s1, 0); __syncthreads(); }
    for (int jt = 0; jt < NIT; ++jt) {
        const int t = PIPE ? jt : TILE(jt), tn = TILE(jt + 1);
        const int cb = jt & 1;
        const bool moreV = (jt + 1 < NIT), moreK = PIPE ? (jt + 2 < NIT) : moreV;
        if constexpr (PIPE) {
            if (t + 3 < NT) {
#pragma unroll
                for (int i = 0; i < NKC; ++i) kstn[i] = *KG(i, t + 3);
            }
            if (t + 2 < NT) {
#pragma unroll
                for (int i = 0; i < NVC; ++i) vstn[i] = *VG(i, t + 2);
            }
        } else {
            if (moreK) {
#pragma unroll
                for (int i = 0; i < NKC; ++i) kst[i] = *KG(i, tn);
            }
            if (moreV) {
#pragma unroll
                for (int i = 0; i < NVC; ++i) vst[i] = *VG(i, tn);
            }
#ifdef PROBE_MEM2
            { int zo = 0; asm volatile("" : "+v"(zo));
              if (moreK) {
#pragma unroll
                for (int i = 0; i < NKC; ++i) { u32x4 d = *(KG(i, t + 1) + zo); asm volatile("" :: "v"(d)); } }
              if (moreV) {
#pragma unroll
                for (int i = 0; i < NVC; ++i) { u32x4 d = *(VG(i, t + 1) + zo); asm volatile("" :: "v"(d)); } } }
#endif
        }
        if (active) {
        if constexpr (PIPE) { if (moreV) QK_TILE(n0, n1, cb ^ 1); }
        else QK_TILE(s0, s1, cb);
        bf16x8 vf0[8];
        if constexpr (EARLYV) {
#pragma unroll
            for (int j = 0; j < 8; ++j) vf0[j] = *(const LAS bf16x8*)(lds + cb * VT + vaddr + (j >> 2) * 32 * VROW + (j & 3) * 32);
        }
        if (t < NT - 1) {
            if constexpr (ALIBI) {
                const float qo = qlin - (float)(16 + 8 * h + t * 64);
#pragma unroll
                for (int i = 0; i < 16; ++i) { const float ci = (float)(16 * (i >> 3) + (i & 7)); s0[i] = __builtin_fmaf(-sl, __builtin_fabsf(qo - ci), s0[i]); s1[i] = __builtin_fmaf(-sl, __builtin_fabsf(qo - 32.f - ci), s1[i]); }
            }
        } else {
#pragma unroll
            for (int i = 0; i < 16; ++i) { const int kk = 16 * (i >> 3) + 8 * h + (i & 7);
                if (kk < 16) { if constexpr (ALIBI) s0[i] = __builtin_fmaf(-sl, __builtin_fabsf(qlin - (float)kk), s0[i]); } else s0[i] = -1e30f;
                s1[i] = -1e30f; }
        }
        float mx;
        { float a = MX2(s0[0], s1[0]), b = MX2(s0[1], s1[1]);
#pragma unroll
          for (int i = 2; i < 16; i += 2) { a = MX2(a, MX2(s0[i], s1[i])); b = MX2(b, MX2(s0[i + 1], s1[i + 1])); }
          mx = swap32_max(MX2(a, b)); }
        if constexpr (!NEGM) mx -= m;
        if (__builtin_expect(jt == 0 || __builtin_amdgcn_ballot_w64(mx > 8.f) != 0ull, 0)) {
            const float dl = (jt == 0) ? mx : fmaxf(mx, 0.f);
            m += dl;
            if constexpr (NEGM) {
#pragma unroll
                for (int i = 0; i < 16; ++i) { s0[i] -= dl; s1[i] -= dl; negm[i] = -m; } }
            if constexpr (PIPE) {
#pragma unroll
                for (int i = 0; i < 16; ++i) { n0[i] -= dl; n1[i] -= dl; } }
            if (jt != 0) { const float f = __builtin_amdgcn_exp2f(-dl); l *= f;
#pragma unroll
                for (int d = 0; d < NDB; ++d)
#pragma unroll
                    for (int i = 0; i < 16; ++i) o[d][i] *= f; }
            asm volatile("" ::: "memory");
        }
        float ra = 0.f, rb = 0.f;
#pragma unroll
        for (int i = 0; i < 16; ++i) { s0[i] = __builtin_amdgcn_exp2f(NEGM ? s0[i] : s0[i] - m); s1[i] = __builtin_amdgcn_exp2f(NEGM ? s1[i] : s1[i] - m); ra += s0[i]; rb += s1[i]; }
        l += ra + rb;
        bf16x8 pf[4];
        { u32x4 w;
          w.x = pk2(s0[0], s0[1]); w.y = pk2(s0[2], s0[3]); w.z = pk2(s0[4], s0[5]); w.w = pk2(s0[6], s0[7]); pf[0] = __builtin_bit_cast(bf16x8, w);
          w.x = pk2(s0[8], s0[9]); w.y = pk2(s0[10], s0[11]); w.z = pk2(s0[12], s0[13]); w.w = pk2(s0[14], s0[15]); pf[1] = __builtin_bit_cast(bf16x8, w);
          w.x = pk2(s1[0], s1[1]); w.y = pk2(s1[2], s1[3]); w.z = pk2(s1[4], s1[5]); w.w = pk2(s1[6], s1[7]); pf[2] = __builtin_bit_cast(bf16x8, w);
          w.x = pk2(s1[8], s1[9]); w.y = pk2(s1[10], s1[11]); w.z = pk2(s1[12], s1[13]); w.w = pk2(s1[14], s1[15]); pf[3] = __builtin_bit_cast(bf16x8, w); }
#pragma unroll
        for (int d0 = 0; d0 < NDB; d0 += 2) { bf16x8 vf[8];
#pragma unroll
            for (int j = 0; j < 8; ++j) { if (EARLYV && d0 == 0) vf[j] = vf0[j]; else vf[j] = *(const LAS bf16x8*)(lds + cb * VT + vaddr + (d0 + (j >> 2)) * 32 * VROW + (j & 3) * 32); }
            asm volatile("" : "+v"(vf[0]), "+v"(vf[1]), "+v"(vf[2]), "+v"(vf[3]), "+v"(vf[4]), "+v"(vf[5]), "+v"(vf[6]), "+v"(vf[7]));
#pragma unroll
            for (int j = 0; j < 8; ++j) o[d0 + (j >> 2)] = __builtin_amdgcn_mfma_f32_32x32x16_bf16(vf[j], pf[j & 3], o[d0 + (j >> 2)], 0, 0, 0);
            __builtin_amdgcn_sched_barrier(0); }
        }
        if (moreK) {
#pragma unroll
            for (int i = 0; i < NKC; ++i) *(LAS u32x4*)(lds + (PIPE ? cb : (cb ^ 1)) * KT + KL(i)) = kst[i];
        }
        if (moreV) {
#pragma unroll
            for (int i = 0; i < NVC; ++i) *(LAS u32x4*)(lds + (cb ^ 1) * VT + VL(i)) = vst[i];
        }
        asm volatile("s_waitcnt lgkmcnt(0)" ::: "memory"); __builtin_amdgcn_s_barrier(); asm volatile("" ::: "memory");
        if constexpr (PIPE) { s0 = n0; s1 = n1;
#pragma unroll
            for (int i = 0; i < NKC; ++i) kst[i] = kstn[i];
#pragma unroll
            for (int i = 0; i < NVC; ++i) vst[i] = vstn[i]; }
    }
    l = swap32_add(l);
    const float il = 1.f / l;
    bf16_t* orow = O + (size_t)qrow * 512;
    if (active)
#pragma unroll
    for (int d = 0; d < NDB; ++d)
#pragma unroll
        for (int g = 0; g < 4; ++g) { u32x2 w; w.x = pk2(o[d][4 * g] * il, o[d][4 * g + 1] * il); w.y = pk2(o[d][4 * g + 2] * il, o[d][4 * g + 3] * il);
            *(u32x2*)(orow + 32 * d + 8 * g + 4 * h) = w; }
#undef KG
#undef KL
#undef VG
#undef VL
#undef QK_TILE
#undef TILE
}

template <int DV, bool ALIBI>
DI void attn_unit2(LAS unsigned char* lds, const bf16_t* __restrict__ Q, const bf16_t* __restrict__ K, const bf16_t* __restrict__ Vt, bf16_t* __restrict__ O, int r0, int qb, int n, float sl, const int wid) {
    constexpr int DQK = 64, KROW = DQK * 2 + 16, KT = 64 * KROW, VROW = 144, VT = DV * VROW, NVC = DV * 8 / 512, NKS = 4, NDB = DV / 32, VB0 = 2 * KT;
    typedef const __attribute__((address_space(1))) u32x4* gptr;
    const int lane = lane_fresh(), tid = wid * 64 + lane, r = lane & 31, h = lane >> 5;
    const int nk = n + 16, NT = (nk + 63) >> 6;
    const int li = qb * 256 + wid * 32 + r;
    const int qrow = r0 + li;
    const float qlin = (li < n) ? (float)(li + 16) : (li < nk ? (float)(li - n) : 0.f);
    bf16x8 qf[NKS];
#pragma unroll
    for (int ks = 0; ks < NKS; ++ks) qf[ks] = *(const bf16x8*)(Q + (size_t)qrow * DQK + ks * 16 + h * 8);
    f32x16 o[NDB];
#pragma unroll
    for (int d = 0; d < NDB; ++d)
#pragma unroll
        for (int i = 0; i < 16; ++i) o[d][i] = 0.f;
    float m = 0.f, l = 0.f; f32x16 negm;
#pragma unroll
    for (int i = 0; i < 16; ++i) negm[i] = 0.f;
    const bf16_t* kg0 = K + (size_t)r0 * DQK + tid * 8; const bf16_t* vg0 = Vt + (size_t)(tid >> 3) * RA + r0 + (tid & 7) * 8;
    const int kl0 = (tid >> 3) * KROW + (tid & 7) * 16, vl0 = VB0 + (tid >> 3) * VROW + (tid & 7) * 16;
#define KG2(t) ((gptr)(kg0 + (size_t)(t) * 64 * DQK))
#define VG2(i, t) ((gptr)(vg0 + (size_t)(i) * 64 * RA + (size_t)(t) * 64))
    const int pr = (r & ~12) | ((r & 4) << 1) | ((r & 8) >> 1);
    const int kaddr = pr * KROW + h * 16, vaddr = VB0 + r * VROW + h * 16;
    u32x4 kst, vst[NVC];
    bf16x8 kf[8];
#define LDK(kb_) do { _Pragma("unroll") for (int ks = 0; ks < 4; ++ks) { kf[2 * ks] = *(const LAS bf16x8*)(lds + (kb_) * KT + kaddr + ks * 32); kf[2 * ks + 1] = *(const LAS bf16x8*)(lds + (kb_) * KT + kaddr + 32 * KROW + ks * 32); } \
        asm volatile("" : "+v"(kf[0]), "+v"(kf[1]), "+v"(kf[2]), "+v"(kf[3]), "+v"(kf[4]), "+v"(kf[5]), "+v"(kf[6]), "+v"(kf[7])); } while (0)
#define QKM(A0, A1) do { A0 = __builtin_amdgcn_mfma_f32_32x32x16_bf16(kf[0], qf[0], negm, 0, 0, 0); A1 = __builtin_amdgcn_mfma_f32_32x32x16_bf16(kf[1], qf[0], negm, 0, 0, 0); \
        _Pragma("unroll") for (int ks = 1; ks < 4; ++ks) { A0 = __builtin_amdgcn_mfma_f32_32x32x16_bf16(kf[2 * ks], qf[ks], A0, 0, 0, 0); A1 = __builtin_amdgcn_mfma_f32_32x32x16_bf16(kf[2 * ks + 1], qf[ks], A1, 0, 0, 0); } } while (0)
#define PV2(vb_, d0_) do { bf16x8 vf[8]; \
        _Pragma("unroll") for (int j = 0; j < 8; ++j) vf[j] = *(const LAS bf16x8*)(lds + (vb_) * VT + vaddr + ((d0_) + (j >> 2)) * 32 * VROW + (j & 3) * 32); \
        asm volatile("" : "+v"(vf[0]), "+v"(vf[1]), "+v"(vf[2]), "+v"(vf[3]), "+v"(vf[4]), "+v"(vf[5]), "+v"(vf[6]), "+v"(vf[7])); \
        _Pragma("unroll") for (int j = 0; j < 8; ++j) o[(d0_) + (j >> 2)] = __builtin_amdgcn_mfma_f32_32x32x16_bf16(vf[j], pf[j & 3], o[(d0_) + (j >> 2)], 0, 0, 0); } while (0)
    kst = *KG2(0);
#pragma unroll
    for (int i = 0; i < NVC; ++i) vst[i] = *VG2(i, 0);
    *(LAS u32x4*)(lds + kl0) = kst;
#pragma unroll
    for (int i = 0; i < NVC; ++i) *(LAS u32x4*)(lds + vl0 + i * 64 * VROW) = vst[i];
    kst = *KG2(1);
    *(LAS u32x4*)(lds + KT + kl0) = kst;
    __syncthreads();
    f32x16 s0, s1, n0, n1;
    bf16x8 pf[4];
    LDK(0); QKM(s0, s1);
    __syncthreads();
    int vcur = 0;
    for (int t = 0; t < NT; ++t) {
        const int cb = t & 1;
        const bool moreV = (t + 1 < NT), moreK = (t + 2 < NT);
        const int vprev = (vcur == 0) ? 2 : vcur - 1, vnext = (vcur == 2) ? 0 : vcur + 1;
        if (moreK) kst = *KG2(t + 2);
        if (moreV) {
#pragma unroll
            for (int i = 0; i < NVC; ++i) vst[i] = *VG2(i, t + 1);
        }
#ifdef PROBE_MEM2
        { int zo = 0; asm volatile("" : "+v"(zo));
          if (moreK) { u32x4 d = *(KG2(t + 2) + zo); asm volatile("" :: "v"(d)); }
          if (moreV) {
#pragma unroll
            for (int i = 0; i < NVC; ++i) { u32x4 d = *(VG2(i, t + 1) + zo); asm volatile("" :: "v"(d)); } } }
#endif
        __builtin_amdgcn_s_setprio(1);
        if (moreV) { LDK(cb ^ 1); QKM(n0, n1); }
        if (t > 0) { PV2(vprev, 0); if constexpr (NDB == 4) PV2(vprev, 2); }
        __builtin_amdgcn_s_setprio(0);
        if (t < NT - 1) {
            if constexpr (ALIBI) {
                const float qo = qlin - (float)(16 + 8 * h + t * 64);
#pragma unroll
                for (int i = 0; i < 16; ++i) { const float ci = (float)(16 * (i >> 3) + (i & 7)); s0[i] = __builtin_fmaf(-sl, __builtin_fabsf(qo - ci), s0[i]); s1[i] = __builtin_fmaf(-sl, __builtin_fabsf(qo - 32.f - ci), s1[i]); }
            }
        } else {
#pragma unroll
            for (int i = 0; i < 16; ++i) { const int kk = 16 * (i >> 3) + 8 * h + (i & 7);
                if (kk < 16) { if constexpr (ALIBI) s0[i] = __builtin_fmaf(-sl, __builtin_fabsf(qlin - (float)kk), s0[i]); } else s0[i] = -1e30f;
                s1[i] = -1e30f; }
        }
        float mx;
        { float a = MX2(s0[0], s1[0]), b = MX2(s0[1], s1[1]);
#pragma unroll
          for (int i = 2; i < 16; i += 2) { a = MX2(a, MX2(s0[i], s1[i])); b = MX2(b, MX2(s0[i + 1], s1[i + 1])); }
          mx = swap32_max(MX2(a, b)); }
        if (__builtin_expect(t == 0 || __builtin_amdgcn_ballot_w64(mx > 8.f) != 0ull, 0)) {
            const float dl = (t == 0) ? mx : fmaxf(mx, 0.f);
            m += dl;
#pragma unroll
            for (int i = 0; i < 16; ++i) { s0[i] -= dl; s1[i] -= dl; n0[i] -= dl; n1[i] -= dl; negm[i] = -m; }
            if (t != 0) { const float f = __builtin_amdgcn_exp2f(-dl); l *= f;
#pragma unroll
                for (int d = 0; d < NDB; ++d)
#pragma unroll
                    for (int i = 0; i < 16; ++i) o[d][i] *= f; }
            asm volatile("" ::: "memory");
        }
        float ra = 0.f, rb = 0.f;
#pragma unroll
        for (int i = 0; i < 16; ++i) { s0[i] = __builtin_amdgcn_exp2f(s0[i]); s1[i] = __builtin_amdgcn_exp2f(s1[i]); ra += s0[i]; rb += s1[i]; }
        l += ra + rb;
        { u32x4 w;
          w.x = pk2(s0[0], s0[1]); w.y = pk2(s0[2], s0[3]); w.z = pk2(s0[4], s0[5]); w.w = pk2(s0[6], s0[7]); pf[0] = __builtin_bit_cast(bf16x8, w);
          w.x = pk2(s0[8], s0[9]); w.y = pk2(s0[10], s0[11]); w.z = pk2(s0[12], s0[13]); w.w = pk2(s0[14], s0[15]); pf[1] = __builtin_bit_cast(bf16x8, w);
          w.x = pk2(s1[0], s1[1]); w.y = pk2(s1[2], s1[3]); w.z = pk2(s1[4], s1[5]); w.w = pk2(s1[6], s1[7]); pf[2] = __builtin_bit_cast(bf16x8, w);
          w.x = pk2(s1[8], s1[9]); w.y = pk2(s1[10], s1[11]); w.z = pk2(s1[12], s1[13]); w.w = pk2(s1[14], s1[15]); pf[3] = __builtin_bit_cast(bf16x8, w); }
        if (moreK) *(LAS u32x4*)(lds + cb * KT + kl0) = kst;
        if (moreV) {
#pragma unroll
            for (int i = 0; i < NVC; ++i) *(LAS u32x4*)(lds + vnext * VT + vl0 + i * 64 * VROW) = vst[i];
        }
        asm volatile("s_waitcnt lgkmcnt(0)" ::: "memory"); __builtin_amdgcn_s_barrier(); asm volatile("" ::: "memory");
        s0 = n0; s1 = n1; vcur = vnext;
    }
    { const int vlast = (vcur == 0) ? 2 : vcur - 1; PV2(vlast, 0); if constexpr (NDB == 4) PV2(vlast, 2); }
    asm volatile("s_waitcnt lgkmcnt(0)" ::: "memory"); __builtin_amdgcn_s_barrier(); asm volatile("" ::: "memory");
    l = swap32_add(l);
    const float il = 1.f / l;
    bf16_t* orow = O + (size_t)qrow * 512;
#pragma unroll
    for (int d = 0; d < NDB; ++d)
#pragma unroll
        for (int g = 0; g < 4; ++g) { u32x2 w; w.x = pk2(o[d][4 * g] * il, o[d][4 * g + 1] * il); w.y = pk2(o[d][4 * g + 2] * il, o[d][4 * g + 3] * il);
            *(u32x2*)(orow + 32 * d + 8 * g + 4 * h) = w; }
#undef KG2
#undef VG2
#undef LDK
#undef QKM
#undef PV2
}


template <int DQK, int DV, bool ALIBI>
DI void attn_unit_s(LAS unsigned char* lds, const bf16_t* __restrict__ Q, const bf16_t* __restrict__ K, const bf16_t* __restrict__ Vt, bf16_t* __restrict__ O, int r0, int qb, int n, float sl, const int wid) {
    constexpr bool NEGM = (DQK == 64);
    constexpr int KROW = DQK * 2 + 16, KT = 64 * KROW, VROW = 144, VT = DV * VROW, KCH = DQK / 8, NKC = 64 * KCH / 512, NVC = DV * 8 / 512, NKS = DQK / 16, NDB = DV / 32, VB0 = 2 * KT;
    typedef const __attribute__((address_space(1))) u32x4* gptr;
#define LBAR() do { asm volatile("s_waitcnt lgkmcnt(0)" ::: "memory"); __builtin_amdgcn_s_barrier(); asm volatile("" ::: "memory"); } while (0)
#ifdef GRP_ODD
    const int grp_ = wid & 1;
#else
    const int grp_ = wid >> 2;
#endif
    const int lane = lane_fresh(), tid = wid * 64 + lane, r = lane & 31, h = lane >> 5, grp = grp_;
    const int nk = n + 16, NT = (nk + 63) >> 6;
    const int li = qb * 256 + wid * 32 + r;
    const int qrow = r0 + li;
    const float qlin = (li < n) ? (float)(li + 16) : (li < nk ? (float)(li - n) : 0.f);
    bf16x8 qf[NKS];
#pragma unroll
    for (int ks = 0; ks < NKS; ++ks) qf[ks] = *(const bf16x8*)(Q + (size_t)qrow * DQK + ks * 16 + h * 8);
    f32x16 o[NDB];
#pragma unroll
    for (int d = 0; d < NDB; ++d)
#pragma unroll
        for (int i = 0; i < 16; ++i) o[d][i] = 0.f;
    float m = 0.f, l = 0.f; f32x16 negm, zero16;
#pragma unroll
    for (int i = 0; i < 16; ++i) { negm[i] = 0.f; zero16[i] = 0.f; }
    const bf16_t* kg0 = K + (size_t)r0 * DQK + tid * 8; const bf16_t* vg0 = Vt + (size_t)(tid >> 3) * RA + r0 + (tid & 7) * 8; const int vl0 = VB0 + (tid >> 3) * VROW + (tid & 7) * 16;
#define KL(i) ((((tid + 512 * (i)) / KCH) * KROW) + ((tid + 512 * (i)) % KCH) * 16)
#define KG(i, t) ((gptr)(kg0 + (i) * 4096 + (size_t)(t) * 64 * DQK))
#define VG(i, t) ((gptr)(vg0 + (size_t)(i) * 64 * RA + (size_t)(t) * 64))
#define VL(i) (vl0 + (i) * 64 * VROW)
    const int pr = (r & ~12) | ((r & 4) << 1) | ((r & 8) >> 1);
    const int kaddr = pr * KROW + h * 16, vaddr = VB0 + r * VROW + h * 16;
    u32x4 kst[NKC], vst[NVC];
#pragma unroll
    for (int i = 0; i < NKC; ++i) kst[i] = *KG(i, 0);
#pragma unroll
    for (int i = 0; i < NKC; ++i) *(LAS u32x4*)(lds + KL(i)) = kst[i];
#pragma unroll
    for (int i = 0; i < NKC; ++i) kst[i] = *KG(i, 1);
#pragma unroll
    for (int i = 0; i < NVC; ++i) vst[i] = *VG(i, 0);
    __syncthreads();
    if (grp == 1) LBAR();
    f32x16 s0, s1; bf16x8 pf[4];
    for (int t = 0; t < NT; ++t) {
        const int cb = t & 1;
        { const int ko_ = cb * KT + kaddr;
#pragma unroll
          for (int kb4 = 0; kb4 < NKS; kb4 += 4) { bf16x8 kq[8];
#pragma unroll
            for (int j = 0; j < 4; ++j) { kq[2 * j] = *(const LAS bf16x8*)(lds + ko_ + (kb4 + j) * 32); kq[2 * j + 1] = *(const LAS bf16x8*)(lds + ko_ + 32 * KROW + (kb4 + j) * 32); }
            asm volatile("" : "+v"(kq[0]), "+v"(kq[1]), "+v"(kq[2]), "+v"(kq[3]), "+v"(kq[4]), "+v"(kq[5]), "+v"(kq[6]), "+v"(kq[7]));
#pragma unroll
            for (int j = 0; j < 4; ++j) {
                if (kb4 + j == 0) { s0 = __builtin_amdgcn_mfma_f32_32x32x16_bf16(kq[0], qf[0], NEGM ? negm : zero16, 0, 0, 0); s1 = __builtin_amdgcn_mfma_f32_32x32x16_bf16(kq[1], qf[0], NEGM ? negm : zero16, 0, 0, 0); }
                else { s0 = __builtin_amdgcn_mfma_f32_32x32x16_bf16(kq[2 * j], qf[kb4 + j], s0, 0, 0, 0); s1 = __builtin_amdgcn_mfma_f32_32x32x16_bf16(kq[2 * j + 1], qf[kb4 + j], s1, 0, 0, 0); } }
            __builtin_amdgcn_sched_barrier(0); } }
        if (t > 0) {
#pragma unroll
            for (int d0 = 0; d0 < NDB; d0 += 2) { bf16x8 vf[8];
#pragma unroll
                for (int j = 0; j < 8; ++j) vf[j] = *(const LAS bf16x8*)(lds + (cb ^ 1) * VT + vaddr + (d0 + (j >> 2)) * 32 * VROW + (j & 3) * 32);
                asm volatile("" : "+v"(vf[0]), "+v"(vf[1]), "+v"(vf[2]), "+v"(vf[3]), "+v"(vf[4]), "+v"(vf[5]), "+v"(vf[6]), "+v"(vf[7]));
#pragma unroll
                for (int j = 0; j < 8; ++j) o[d0 + (j >> 2)] = __builtin_amdgcn_mfma_f32_32x32x16_bf16(vf[j], pf[j & 3], o[d0 + (j >> 2)], 0, 0, 0);
                __builtin_amdgcn_sched_barrier(0); }
        }
        if (t + 1 < NT) {
#pragma unroll
            for (int i = 0; i < NKC; ++i) *(LAS u32x4*)(lds + (cb ^ 1) * KT + KL(i)) = kst[i];
        }
#pragma unroll
        for (int i = 0; i < NVC; ++i) *(LAS u32x4*)(lds + cb * VT + VL(i)) = vst[i];
        LBAR();
        if (t + 2 < NT) {
#pragma unroll
            for (int i = 0; i < NKC; ++i) kst[i] = *KG(i, t + 2);
        }
        if (t + 1 < NT) {
#pragma unroll
            for (int i = 0; i < NVC; ++i) vst[i] = *VG(i, t + 1);
        }
        if (t < NT - 1) {
            if constexpr (ALIBI) {
                const float qo = qlin - (float)(16 + 8 * h + t * 64);
#pragma unroll
                for (int i = 0; i < 16; ++i) { const float ci = (float)(16 * (i >> 3) + (i & 7)); s0[i] = __builtin_fmaf(-sl, __builtin_fabsf(qo - ci), s0[i]); s1[i] = __builtin_fmaf(-sl, __builtin_fabsf(qo - 32.f - ci), s1[i]); }
            }
        } else {
#pragma unroll
            for (int i = 0; i < 16; ++i) { const int kk = 16 * (i >> 3) + 8 * h + (i & 7);
                if (kk < 16) { if constexpr (ALIBI) s0[i] = __builtin_fmaf(-sl, __builtin_fabsf(qlin - (float)kk), s0[i]); } else s0[i] = -1e30f;
                s1[i] = -1e30f; }
        }
        float mx;
        { float a = MX2(s0[0], s1[0]), b = MX2(s0[1], s1[1]);
#pragma unroll
          for (int i = 2; i < 16; i += 2) { a = MX2(a, MX2(s0[i], s1[i])); b = MX2(b, MX2(s0[i + 1], s1[i + 1])); }
          mx = swap32_max(MX2(a, b)); }
        if constexpr (!NEGM) mx -= m;
        if (__builtin_expect(t == 0 || __builtin_amdgcn_ballot_w64(mx > 8.f) != 0ull, 0)) {
            const float dl = (t == 0) ? mx : fmaxf(mx, 0.f);
            m += dl;
            if constexpr (NEGM) {
#pragma unroll
                for (int i = 0; i < 16; ++i) { s0[i] -= dl; s1[i] -= dl; negm[i] = -m; } }
            if (t != 0) { const float f = __builtin_amdgcn_exp2f(-dl); l *= f;
#pragma unroll
                for (int d = 0; d < NDB; ++d)
#pragma unroll
                    for (int i = 0; i < 16; ++i) o[d][i] *= f; }
            asm volatile("" ::: "memory");
        }
        float ra = 0.f, rb = 0.f;
#pragma unroll
        for (int i = 0; i < 16; ++i) { s0[i] = __builtin_amdgcn_exp2f(NEGM ? s0[i] : s0[i] - m); s1[i] = __builtin_amdgcn_exp2f(NEGM ? s1[i] : s1[i] - m); ra += s0[i]; rb += s1[i]; }
        l += ra + rb;
        { u32x4 w;
          w.x = pk2(s0[0], s0[1]); w.y = pk2(s0[2], s0[3]); w.z = pk2(s0[4], s0[5]); w.w = pk2(s0[6], s0[7]); pf[0] = __builtin_bit_cast(bf16x8, w);
          w.x = pk2(s0[8], s0[9]); w.y = pk2(s0[10], s0[11]); w.z = pk2(s0[12], s0[13]); w.w = pk2(s0[14], s0[15]); pf[1] = __builtin_bit_cast(bf16x8, w);
          w.x = pk2(s1[0], s1[1]); w.y = pk2(s1[2], s1[3]); w.z = pk2(s1[4], s1[5]); w.w = pk2(s1[6], s1[7]); pf[2] = __builtin_bit_cast(bf16x8, w);
          w.x = pk2(s1[8], s1[9]); w.y = pk2(s1[10], s1[11]); w.z = pk2(s1[12], s1[13]); w.w = pk2(s1[14], s1[15]); pf[3] = __builtin_bit_cast(bf16x8, w); }
        LBAR();
    }
    { const int vb = (NT - 1) & 1;
#pragma unroll
      for (int d0 = 0; d0 < NDB; d0 += 2) { bf16x8 vf[8];
#pragma unroll
        for (int j = 0; j < 8; ++j) vf[j] = *(const LAS bf16x8*)(lds + vb * VT + vaddr + (d0 + (j >> 2)) * 32 * VROW + (j & 3) * 32);
        asm volatile("" : "+v"(vf[0]), "+v"(vf[1]), "+v"(vf[2]), "+v"(vf[3]), "+v"(vf[4]), "+v"(vf[5]), "+v"(vf[6]), "+v"(vf[7]));
#pragma unroll
        for (int j = 0; j < 8; ++j) o[d0 + (j >> 2)] = __builtin_amdgcn_mfma_f32_32x32x16_bf16(vf[j], pf[j & 3], o[d0 + (j >> 2)], 0, 0, 0); } }
    if (grp == 0) LBAR();
    LBAR();
    l = swap32_add(l);
    const float il = 1.f / l;
    bf16_t* orow = O + (size_t)qrow * 512;
#pragma unroll
    for (int d = 0; d < NDB; ++d)
#pragma unroll
        for (int g = 0; g < 4; ++g) { u32x2 w; w.x = pk2(o[d][4 * g] * il, o[d][4 * g + 1] * il); w.y = pk2(o[d][4 * g + 2] * il, o[d][4 * g + 3] * il);
            *(u32x2*)(orow + 32 * d + 8 * g + 4 * h) = w; }
#undef KG
#undef KL
#undef VG
#undef VL
#undef LBAR
}

DI void attn_unit_a64(LAS unsigned char* lds, const bf16_t* __restrict__ Q, const bf16_t* __restrict__ K, const bf16_t* __restrict__ Vt, bf16_t* __restrict__ O, int r0, int qb, int n, int seqrows, const int wid) {
    constexpr int DQK = 64, KROW = 144, KT = 64 * KROW, VROW = 144, VT = 64 * VROW, VB0 = 2 * KT;
    typedef const __attribute__((address_space(1))) u32x4* gptr;
    const int lane = lane_fresh(), tid = wid * 64 + lane, r = lane & 31, h = lane >> 5;
    const int nk = n + 16, NT = (nk + 63) >> 6;
    const int li0 = qb * 512 + wid * 64 + r, li1 = li0 + 32;
    bf16x8 qf0[4], qf1[4];
#pragma unroll
    for (int ks = 0; ks < 4; ++ks) { qf0[ks] = *(const bf16x8*)(Q + (size_t)(r0 + li0) * DQK + ks * 16 + h * 8); qf1[ks] = *(const bf16x8*)(Q + (size_t)(r0 + li1) * DQK + ks * 16 + h * 8); }
    f32x16 oa0, oa1, ob0, ob1, zero16;
#pragma unroll
    for (int i = 0; i < 16; ++i) { oa0[i] = 0.f; oa1[i] = 0.f; ob0[i] = 0.f; ob1[i] = 0.f; zero16[i] = 0.f; }
    float ma = 0.f, mb = 0.f, la = 0.f, lb = 0.f;
    const bf16_t* kg0 = K + (size_t)r0 * DQK + tid * 8; const bf16_t* vg0 = Vt + (size_t)(tid >> 3) * RA + r0 + (tid & 7) * 8;
    const int kl0 = (tid >> 3) * KROW + (tid & 7) * 16, vl0 = VB0 + (tid >> 3) * VROW + (tid & 7) * 16;
    const int pr = (r & ~12) | ((r & 4) << 1) | ((r & 8) >> 1);
    const int kaddr = pr * KROW + h * 16, vaddr = VB0 + r * VROW + h * 16;
    u32x4 kst, vst;
    kst = *(gptr)kg0; vst = *(gptr)vg0;
    *(LAS u32x4*)(lds + kl0) = kst; *(LAS u32x4*)(lds + vl0) = vst;
    __syncthreads();
#define SOFTMAX64(S0, S1, M, L, OX0, OX1) do { \
        if (t == NT - 1) { _Pragma("unroll") for (int i = 0; i < 16; ++i) { if (i >= 8) S0[i] = -1e30f; S1[i] = -1e30f; } } \
        float a_ = MX2(S0[0], S1[0]), b_ = MX2(S0[1], S1[1]); \
        _Pragma("unroll") for (int i = 2; i < 16; i += 2) { a_ = MX2(a_, MX2(S0[i], S1[i])); b_ = MX2(b_, MX2(S0[i + 1], S1[i + 1])); } \
        const float mx_ = swap32_max(MX2(a_, b_)) - M; \
        if (__builtin_expect(t == 0 || __builtin_amdgcn_ballot_w64(mx_ > 8.f) != 0ull, 0)) { \
            const float dl_ = (t == 0) ? mx_ : fmaxf(mx_, 0.f); M += dl_; \
            if (t != 0) { const float f_ = __builtin_amdgcn_exp2f(-dl_); L *= f_; _Pragma("unroll") for (int i = 0; i < 16; ++i) { OX0[i] *= f_; OX1[i] *= f_; } } \
            asm volatile("" ::: "memory"); } \
        float ra_ = 0.f, rb_ = 0.f; \
        _Pragma("unroll") for (int i = 0; i < 16; ++i) { S0[i] = __builtin_amdgcn_exp2f(S0[i] - M); S1[i] = __builtin_amdgcn_exp2f(S1[i] - M); ra_ += S0[i]; rb_ += S1[i]; } \
        L += ra_ + rb_; \
        u32x4 w_; \
        w_.x = pk2(S0[0], S0[1]); w_.y = pk2(S0[2], S0[3]); w_.z = pk2(S0[4], S0[5]); w_.w = pk2(S0[6], S0[7]); pf[0] = __builtin_bit_cast(bf16x8, w_); \
        w_.x = pk2(S0[8], S0[9]); w_.y = pk2(S0[10], S0[11]); w_.z = pk2(S0[12], S0[13]); w_.w = pk2(S0[14], S0[15]); pf[1] = __builtin_bit_cast(bf16x8, w_); \
        w_.x = pk2(S1[0], S1[1]); w_.y = pk2(S1[2], S1[3]); w_.z = pk2(S1[4], S1[5]); w_.w = pk2(S1[6], S1[7]); pf[2] = __builtin_bit_cast(bf16x8, w_); \
        w_.x = pk2(S1[8], S1[9]); w_.y = pk2(S1[10], S1[11]); w_.z = pk2(S1[12], S1[13]); w_.w = pk2(S1[14], S1[15]); pf[3] = __builtin_bit_cast(bf16x8, w_); } while (0)
    for (int t = 0; t < NT; ++t) {
        const int cb = t & 1; const bool more = (t + 1 < NT);
        if (more) { kst = *(gptr)(kg0 + (size_t)(t + 1) * 64 * DQK); vst = *(gptr)(vg0 + (size_t)(t + 1) * 64); }
        bf16x8 kq[8];
#pragma unroll
        for (int j = 0; j < 4; ++j) { kq[2 * j] = *(const LAS bf16x8*)(lds + cb * KT + kaddr + j * 32); kq[2 * j + 1] = *(const LAS bf16x8*)(lds + cb * KT + kaddr + 32 * KROW + j * 32); }
        asm volatile("" : "+v"(kq[0]), "+v"(kq[1]), "+v"(kq[2]), "+v"(kq[3]), "+v"(kq[4]), "+v"(kq[5]), "+v"(kq[6]), "+v"(kq[7]));
        f32x16 sa0, sa1, sb0, sb1;
        sa0 = __builtin_amdgcn_mfma_f32_32x32x16_bf16(kq[0], qf0[0], zero16, 0, 0, 0); sa1 = __builtin_amdgcn_mfma_f32_32x32x16_bf16(kq[1], qf0[0], zero16, 0, 0, 0);
#pragma unroll
        for (int j = 1; j < 4; ++j) { sa0 = __builtin_amdgcn_mfma_f32_32x32x16_bf16(kq[2 * j], qf0[j], sa0, 0, 0, 0); sa1 = __builtin_amdgcn_mfma_f32_32x32x16_bf16(kq[2 * j + 1], qf0[j], sa1, 0, 0, 0); }
        sb0 = __builtin_amdgcn_mfma_f32_32x32x16_bf16(kq[0], qf1[0], zero16, 0, 0, 0); sb1 = __builtin_amdgcn_mfma_f32_32x32x16_bf16(kq[1], qf1[0], zero16, 0, 0, 0);
#pragma unroll
        for (int j = 1; j < 4; ++j) { sb0 = __builtin_amdgcn_mfma_f32_32x32x16_bf16(kq[2 * j], qf1[j], sb0, 0, 0, 0); sb1 = __builtin_amdgcn_mfma_f32_32x32x16_bf16(kq[2 * j + 1], qf1[j], sb1, 0, 0, 0); }
        bf16x8 vf[8];
#pragma unroll
        for (int j = 0; j < 8; ++j) vf[j] = *(const LAS bf16x8*)(lds + cb * VT + vaddr + (j >> 2) * 32 * VROW + (j & 3) * 32);
        bf16x8 pf[4];
        SOFTMAX64(sa0, sa1, ma, la, oa0, oa1);
        asm volatile("" : "+v"(vf[0]), "+v"(vf[1]), "+v"(vf[2]), "+v"(vf[3]), "+v"(vf[4]), "+v"(vf[5]), "+v"(vf[6]), "+v"(vf[7]));
#pragma unroll
        for (int j = 0; j < 4; ++j) { oa0 = __builtin_amdgcn_mfma_f32_32x32x16_bf16(vf[j], pf[j], oa0, 0, 0, 0); oa1 = __builtin_amdgcn_mfma_f32_32x32x16_bf16(vf[4 + j], pf[j], oa1, 0, 0, 0); }
        SOFTMAX64(sb0, sb1, mb, lb, ob0, ob1);
#pragma unroll
        for (int j = 0; j < 4; ++j) { ob0 = __builtin_amdgcn_mfma_f32_32x32x16_bf16(vf[j], pf[j], ob0, 0, 0, 0); ob1 = __builtin_amdgcn_mfma_f32_32x32x16_bf16(vf[4 + j], pf[j], ob1, 0, 0, 0); }
        if (more) { *(LAS u32x4*)(lds + (cb ^ 1) * KT + kl0) = kst; *(LAS u32x4*)(lds + (cb ^ 1) * VT + vl0) = vst; }
        asm volatile("s_waitcnt lgkmcnt(0)" ::: "memory"); __builtin_amdgcn_s_barrier(); asm volatile("" ::: "memory");
    }
#undef SOFTMAX64
    la = swap32_add(la); lb = swap32_add(lb);
    const float ia = 1.f / la, ib = 1.f / lb;
    if (li0 < seqrows) { bf16_t* orow = O + (size_t)(r0 + li0) * 512;
#pragma unroll
        for (int g = 0; g < 4; ++g) { u32x2 w; w.x = pk2(oa0[4 * g] * ia, oa0[4 * g + 1] * ia); w.y = pk2(oa0[4 * g + 2] * ia, oa0[4 * g + 3] * ia); *(u32x2*)(orow + 8 * g + 4 * h) = w;
            w.x = pk2(oa1[4 * g] * ia, oa1[4 * g + 1] * ia); w.y = pk2(oa1[4 * g + 2] * ia, oa1[4 * g + 3] * ia); *(u32x2*)(orow + 32 + 8 * g + 4 * h) = w; } }
    if (li1 < seqrows) { bf16_t* orow = O + (size_t)(r0 + li1) * 512;
#pragma unroll
        for (int g = 0; g < 4; ++g) { u32x2 w; w.x = pk2(ob0[4 * g] * ib, ob0[4 * g + 1] * ib); w.y = pk2(ob0[4 * g + 2] * ib, ob0[4 * g + 3] * ib); *(u32x2*)(orow + 8 * g + 4 * h) = w;
            w.x = pk2(ob1[4 * g] * ib, ob1[4 * g + 1] * ib); w.y = pk2(ob1[4 * g + 2] * ib, ob1[4 * g + 3] * ib); *(u32x2*)(orow + 32 + 8 * g + 4 * h) = w; } }
}

#if defined(STAGGER) && !defined(STAGGER_NOC)
#define ATTN_C attn_unit_s<192, 128, false>
#else
#define ATTN_C attn_unit<192, 128, false, false>
#endif
#if defined(STAGGER)
#define ATTN_B attn_unit_s<64, 128, true>
#define ATTN_A attn_unit_s<64, 64, false>
#elif defined(NOPIPE_AB)
#define ATTN_B attn_unit<64, 128, true, false>
#define ATTN_A attn_unit<64, 64, false, false>
#else
#define ATTN_B attn_unit<64, 128, true, false>
#define ATTN_A attn_unit2<64, false>
#endif
DI void attn_phase(const Params& p, const Chunk& ck, bool last, const int lidx, LAS unsigned char* lds, unsigned* q  , const int wave) {
    unsigned char* ws = p.ws; asm volatile("" : "+s"(ws));
    const bf16_t* QKV = (const bf16_t*)(ws + WS_QKV); bf16_t* OB = (bf16_t*)(ws + WS_ZM);
#if defined(PROBE_DUPC)
    constexpr int NDUP = 8, DUP0 = 0;
#elif defined(PROBE_DUPB)
    constexpr int NDUP = 16, DUP0 = 8;
#elif defined(PROBE_DUPA)
    constexpr int NDUP = 16, DUP0 = 24;
#else
    constexpr int NDUP = 0, DUP0 = 0;
#endif
    const int nmeta = last ? 0 : 20 * ck.nseq, nms = (nmeta + 7) >> 3, nsuper = nms + 40 + NDUP;
    volatile LAS int* su = (volatile LAS int*)(lds + LDS_MISC);
    float qkb;
    { const int ln = lane_fresh(); float gq = fabsf(p.in[8][lidx * 64 + ln]), gk = fabsf(p.in[9][lidx * 64 + ln]);
#pragma unroll
      for (int o = 1; o < 64; o <<= 1) { gq = fmaxf(gq, __int_as_float(__builtin_amdgcn_ds_bpermute((ln ^ o) << 2, __float_as_int(gq)))); gk = fmaxf(gk, __int_as_float(__builtin_amdgcn_ds_bpermute((ln ^ o) << 2, __float_as_int(gk)))); }
      qkb = 1.05f * 64.f * 0.125f * LOG2E * gq * gk; }
    for (;;) {
        if (wave == 0 && lane_fresh() == 0) {
#ifdef FLATQ
            const unsigned x = 0u;
#else
            const unsigned x = (unsigned)__builtin_amdgcn_s_getreg((3 << 11) | 20) & 0xFu;
#endif
            int res = -1, lin = 0;
            for (;;) {
                const unsigned idx = __hip_atomic_fetch_add(q + 64 + 16 * x, 1u, __ATOMIC_RELAXED, __HIP_MEMORY_SCOPE_AGENT);
                const unsigned slot = (idx >> 5) & 63u; lin = (int)(idx & 31u);
                unsigned* te = q + 512 + x * 64 + slot; unsigned g;
                if (lin == 0) { g = __hip_atomic_fetch_add(q, 1u, __ATOMIC_RELAXED, __HIP_MEMORY_SCOPE_AGENT); __hip_atomic_store(te, g + 1u, __ATOMIC_RELAXED, __HIP_MEMORY_SCOPE_AGENT); }
                else { while ((g = __hip_atomic_load(te, __ATOMIC_RELAXED, __HIP_MEMORY_SCOPE_AGENT)) == 0u) __builtin_amdgcn_s_sleep(2); g -= 1u; }
                if ((int)g >= nsuper) { res = -1; break; }
                if ((int)g < nms && (lin >= 8 || (int)g * 8 + lin >= nmeta)) continue;
#ifdef A64
                if ((int)g >= nms + 24) {
                    const int sub_ = ((int)g - nms) & 1;
                    if (ck.nseq == 1 ? (sub_ == 1) : (lin >= 16)) continue; }
#endif
                res = (int)g; break;
            }
            su[0] = res; su[1] = lin;
        }
        __syncthreads();
        const int g = su[0], lin = su[1];
        __syncthreads();
        if (g < 0) break;
        int type, hd, s, qb;
        int sh = ck.nseq - 1; asm volatile("" : "+s"(sh));
        if (g < nms) { const int mu = g * 8 + lin, jh = mu >> sh; s = mu & sh; qb = ck.tps - 1;
            if (jh < 4) { type = 0; hd = jh; } else if (jh < 12) { type = 1; hd = jh - 4; } else { type = 2; hd = jh - 12; } }
        else { const int gr0 = g - nms, gr = gr0 >= 40 ? gr0 - 40 + DUP0 : gr0, sub = gr & 1;
            if (gr < 8) { type = 0; hd = gr >> 1; } else if (gr < 24) { type = 1; hd = 7 - ((gr - 8) >> 1); } else { type = 2; hd = (gr - 24) >> 1; }
            s = sub * sh; qb = lin + (sub * 32) * (1 - sh); }
        const int r0 = s * ck.rows_per_seq();
        if (type == 0) {
            ATTN_C(lds, QKV + QC_O + (size_t)hd * RA * 192, QKV + KC_O + (size_t)hd * RA * 192, QKV + VC_O + (size_t)hd * 128 * RA, OB + 2 * OSLOT + 128 * hd, r0, qb, ck.n, 0.f, wave);
        } else if (type == 1) { const int hh = hd >> 1;
            const float sl = LOG2E * (hh == 0 ? 0.25f : hh == 1 ? 0.0625f : hh == 2 ? 0.015625f : 0.00390625f);
            const float dkf = (2.f * qkb + 168.f) / sl + 2.f; const int dkeys = dkf < 1.0e9f ? (int)dkf : 0x3fffffff;
            ATTN_B(lds, QKV + QB_O + (size_t)hd * RA * 64, QKV + KB_O + (size_t)hd * RA * 64, QKV + VB_O + (size_t)hh * 128 * RA, OB + ((hd & 1) ? 3 : 1) * OSLOT + 128 * hh, r0, qb, ck.n, sl, wave, dkeys);
        } else { const int kv = hd >> 2;
#ifdef A64
            const int qb5 = (g < nms) ? (ck.n >> 9) : lin;
            attn_unit_a64(lds, QKV + QA_O + (size_t)hd * RA * 64, QKV + KA_O + (size_t)kv * RA * 64, QKV + VA_O + (size_t)kv * 64 * RA, OB + 64 * hd, r0, qb5, ck.n, ck.rows_per_seq(), wave);
#else
            ATTN_A(lds, QKV + QA_O + (size_t)hd * RA * 64, QKV + KA_O + (size_t)kv * RA * 64, QKV + VA_O + (size_t)kv * 64 * RA, OB + 64 * hd, r0, qb, ck.n, 0.f, wave);
#endif
        }
    }
}

#define XB_TMO      128
#define XB_XCNT(j)  (256  + 64 * (j))
#define XB_XSUB(j)  (1280 + 64 * (j))
#define XB_XGEN(j)  (2304 + 64 * (j))
#define XB_TOP      3328
#define XB_TOPGEN   3392
#define XCD_BAR_WORDS 3456
#define XB_SPIN_CAP (1u << 22)
DI unsigned xb_ld(unsigned* p)              { return __hip_atomic_load(p, __ATOMIC_RELAXED, __HIP_MEMORY_SCOPE_AGENT); }
DI unsigned xb_add(unsigned* p, unsigned v) { return __hip_atomic_fetch_add(p, v, __ATOMIC_RELAXED, __HIP_MEMORY_SCOPE_AGENT); }
DI unsigned xb_xcc_id() { return (unsigned)__builtin_amdgcn_s_getreg((3 << 11) | 20) & 0xFu; }
#define XB_SPIN(cond, bar) do { unsigned _sp = 0; while (cond) { __builtin_amdgcn_s_sleep(1); \
    if ((++_sp & 255u) == 0u) { if (xb_ld(&(bar)[XB_TMO])) break; if (_sp > XB_SPIN_CAP) { atomicAdd(&(bar)[XB_TMO], 1u); break; } } } } while (0)
DI void xcd_barrier_complete(unsigned* bar, unsigned x, unsigned G, unsigned& nloc, unsigned& nx) {
    unsigned sum, cnt, mine, sp = 0u;
    for (;;) {
        sum = 0u; cnt = 0u; mine = 0u;
#pragma unroll
        for (unsigned j = 0; j < 16; ++j) { const unsigned c = xb_ld(&bar[XB_XCNT(j)]); sum += c; cnt += (c > 0u) ? 1u : 0u; mine = (j == x) ? c : mine; }
        if (sum == G) break;
        __builtin_amdgcn_s_sleep(1);
        if ((++sp & 255u) == 0u) { if (xb_ld(&bar[XB_TMO])) break; if (sp > XB_SPIN_CAP) { atomicAdd(&bar[XB_TMO], 1u); break; } }
    }
    nloc = mine > 0u ? mine : 1u; nx = cnt > 0u ? cnt : 1u;
}
DI void xcd_barrier(unsigned* bar, volatile LAS unsigned* st, const int wave) {
    asm volatile("s_waitcnt vmcnt(0)" ::: "memory");
    __syncthreads();
    if (wave == 0 && lane_fresh() == 0) {
        __builtin_amdgcn_s_waitcnt(0);
        const unsigned x = xb_xcc_id();
        unsigned nloc = st[0], nx = st[1];
        if (nloc == 0u) { xcd_barrier_complete(bar, x, gridDim.x, nloc, nx); st[0] = nloc; st[1] = nx; }
        const unsigned old = xb_add(&bar[XB_XSUB(x)], 1u);
        const unsigned gen = old / nloc;
        if (old + 1u == (gen + 1u) * nloc) {
            __builtin_amdgcn_fence(__ATOMIC_RELEASE, "agent");
            asm volatile("s_waitcnt vmcnt(0)" ::: "memory");
            const unsigned og = xb_add(&bar[XB_TOP], 1u);
            const unsigned tg = og / nx;
            if (og + 1u == (tg + 1u) * nx) xb_add(&bar[XB_TOPGEN], 1u);
            else XB_SPIN(xb_ld(&bar[XB_TOPGEN]) == tg, bar);
            __builtin_amdgcn_fence(__ATOMIC_ACQUIRE, "agent");
            xb_add(&bar[XB_XGEN(x)], 1u);
            asm volatile("s_waitcnt vmcnt(0)" ::: "memory");
        } else {
            XB_SPIN(xb_ld(&bar[XB_XGEN(x)]) == gen, bar);
            __builtin_amdgcn_fence(__ATOMIC_ACQUIRE, "agent");
            asm volatile("s_waitcnt vmcnt(0)" ::: "memory");
        }
    }
    __syncthreads();
}


#define SK_LOOP(ACC, AP, BP, KK) do { _Pragma("unroll") for (int k0_ = 0; k0_ < (KK); k0_ += 32) { \
        const bf16x8 a_ = *(const bf16x8*)((AP) + k0_), b_ = *(const bf16x8*)((BP) + k0_); ACC = __builtin_amdgcn_mfma_f32_16x16x32_bf16(a_, b_, ACC, 0, 0, 0); } } while (0)
DI void skinny_phase(int which  , const Params& p, const Chunk& ck, const XMap& xm, const unsigned char* wbl, int gw, int NGW, int lane) {
    unsigned char* ws = p.ws; asm volatile("" : "+s"(ws));
    const int row = lane & 15, quad = lane >> 4;
    if (which == 0) {
        const bf16_t* OB = (const bf16_t*)(ws + WS_ZM); const bf16_t* G = (const bf16_t*)(ws + WS_G); bf16_t* MGb = (bf16_t*)(ws + WS_XN);
        for (int it = gw; it < ck.nseq * 64; it += NGW) {
            const int s = it >> 6, tile = it & 63, R0 = (s * ck.tps + ck.tps - 1) * 256, col = tile * 16 + row;
            f32x4 sum = {0.f, 0.f, 0.f, 0.f};
#pragma unroll 1
            for (int z = 0; z < 3; ++z) { f32x4 a = {0.f, 0.f, 0.f, 0.f};
                const bf16_t* ap = OB + (size_t)z * OSLOT + (size_t)(R0 + row) * 512 + quad * 8; const bf16_t* bp = (const bf16_t*)(wbl + W_BR) + (size_t)z * 1024 * 512 + (size_t)col * 512 + quad * 8;
                SK_LOOP(a, ap, bp, 512);
#pragma unroll
                for (int j = 0; j < 4; ++j) { const float g = __uint_as_float((unsigned)G[(size_t)(R0 + quad * 4 + j) * G_LD + z * 1024 + col] << 16); sum[j] += g * a[j]; } }
#pragma unroll
            for (int j = 0; j < 4; ++j) MGb[(size_t)(R0 + quad * 4 + j) * DM + col] = (bf16_t)(pk2(sum[j], 0.f) & 0xffffu);
        }
    } else if (which == 2) {
        const bf16_t* XNp = (const bf16_t*)(ws + WS_XN); bf16_t* U_ = (bf16_t*)(ws + WS_G);
        for (int it = gw; it < ck.nseq * 256; it += NGW) {
            const int s = it >> 8, tile = it & 255, R0 = (s * ck.tps + ck.tps - 1) * 256, col = tile * 16 + row;
            f32x4 acc = {0.f, 0.f, 0.f, 0.f};
            const bf16_t* ap = XNp + (size_t)(R0 + row) * 1024 + quad * 8; const bf16_t* bp = (const bf16_t*)(wbl + W_UP) + (size_t)col * 1024 + quad * 8;
#pragma unroll 1
            for (int kh = 0; kh < 2; ++kh) SK_LOOP(acc, ap + kh * 512, bp + kh * 512, 512);
#pragma unroll
            for (int j = 0; j < 4; ++j) { const float v = fmaxf(acc[j], 0.f); U_[(size_t)(R0 + quad * 4 + j) * 4096 + col] = (bf16_t)(pk2(v * v, 0.f) & 0xffffu); }
        }
    } else {
        const int K = (which == 1) ? 1024 : 4096, nkc = K >> 9;
        const bf16_t* A = (which == 1) ? (const bf16_t*)(ws + WS_XN) : (const bf16_t*)(ws + WS_G);
        const bf16_t* W = (const bf16_t*)(wbl + (which == 1 ? W_OUT : W_DOWN));
        for (int it = gw; it < ck.nseq * 64 * nkc; it += NGW) {
            const int kc = it % nkc, rem = it / nkc, s = rem >> 6, tile = rem & 63, pt = s * ck.tps + ck.tps - 1, R0 = pt * 256, col = tile * 16 + row;
            f32x4 acc = {0.f, 0.f, 0.f, 0.f};
            const bf16_t* ap = A + (size_t)(R0 + row) * K + kc * 512 + quad * 8; const bf16_t* bp = W + (size_t)col * K + kc * 512 + quad * 8;
            SK_LOOP(acc, ap, bp, 512);
            float* wp = xm.xw(pt);
#pragma unroll
            for (int j = 0; j < 4; ++j) atomicAdd(wp + (size_t)(quad * 4 + j) * DM + col, acc[j]);
        }
    }
}

#define GSYNC() xcd_barrier(xbar, xst, wave)
__global__ void __launch_bounds__(512) fwd_kernel(Params p) {
    extern __shared__ __attribute__((aligned(16))) unsigned char lds_raw[];
    LAS unsigned char* lds = (LAS unsigned char*)lds_raw;
    cg::grid_group grid = cg::this_grid();
    const int wave = __builtin_amdgcn_readfirstlane((int)threadIdx.x >> 6); int lane = lane_fresh();
    const int G = gridDim.x, bx = blockIdx.x, NGW = G * 8, gw = bx * 8 + wave;
#define WSP(off) ({ unsigned char* w_ = p.ws; asm volatile("" : "+s"(w_)); w_ + (off); })
#define ctl ((unsigned*)WSP(WS_CTL))
#define xbar (ctl + 1024)
    volatile LAS unsigned* xst = (volatile LAS unsigned*)(lds + LDS_MISC + 16);
    if (wave == 0 && lane == 0) { xst[0] = 0u; xst[1] = 0u; (void)xb_add(&xbar[XB_XCNT(xb_xcc_id())], 1u); }
    __syncthreads();
#define XN ((bf16_t*)WSP(WS_XN))
#define ZM ((bf16_t*)WSP(WS_ZM))
#define GB ((bf16_t*)WSP(WS_G))
#define CQN ((bf16_t*)WSP(WS_SM + SM_CQN))
#define CKVN ((bf16_t*)WSP(WS_SM + SM_CKVN))
#define QCR ((bf16_t*)WSP(WS_ZM + OFF_QCR))
#define KVR ((bf16_t*)WSP(WS_ZM + OFF_KVR))
#define MG ((float*)WSP(WS_QKV))
#define U ((bf16_t*)WSP(WS_G))

#if !defined(PH) || (PH & 1)
    prologue(p, lds, gw, NGW, wave, lane);
#ifdef PROBE_PRO2
    prologue(p, lds, gw, NGW, wave, lane);
#endif
#endif
    grid.sync();
    for (int l = 0; l < 2; ++l) {
        const bool last = (l == 1);
#define wb (WSP(WS_W) + (size_t)l * LW_STRIDE)
        for (int c = 0; c < 3; ++c) {
            const Chunk ck = make_chunk(c);
            const int ta = ck.tps - 1;
            XMap xm; xm.out = p.out; xm.metax = (float*)WSP(WS_METAX); xm.xp = p.in[0]; xm.xs = p.in[1]; xm.meta0 = (const float*)WSP(WS_META0); xm.seq0 = ck.seq0; xm.tps = ck.tps; xm.first = (l == 0);
#define RELAUNDER() do { lane = lane_fresh(); } while (0)
            RELAUNDER();
#if !defined(PH) || (PH & 2)
            norm_phase(xm, ck.rows(), p.in[3] + l * DM, XN, gw, NGW, lane);
#ifdef PROBE_EW2
            RELAUNDER(); norm_phase(xm, ck.rows(), p.in[3] + l * DM, XN, gw, NGW, lane);
#endif
#endif
            GSYNC();
            { pg8::Gemm g{XN, (const bf16_t*)(wb + W_IN), 1024, 0, 0}; Sched S; S.init(ck.nseq, ck.tps, ck.tps, IN_N / 256, 1, G, bx);
              EpiIn E{ZM, GB, p.in[5] + l * 3072};
#if !defined(PH) || (PH & 4)
              pg8::gemm_phase<EpiIn, Sched, true, true>(lds, g, S, E, wave);
#ifdef PROBE_IN2
              pg8::gemm_phase<EpiIn, Sched, true, true>(lds, g, S, E, wave);
#endif
#endif
 }
            GSYNC();
            RELAUNDER();
#if !defined(PH) || (PH & 128)
            ew1_phase(p, ck, l, gw, NGW, lane);
#ifdef PROBE_EW2
            RELAUNDER(); ew1_phase(p, ck, l, gw, NGW, lane);
#endif
#endif
            GSYNC();
            { pg8::Gemm g{CQN, (const bf16_t*)(wb + W_QB), 256, 0, 0}; Sched S; S.init(ck.nseq, ck.tps, ck.tps, 3, 1, G, bx); EpiBf16<0> E{QCR, 768};
#if !defined(PH) || (PH & 8)
              pg8::gemm_phase<EpiBf16<0>, Sched, true, true>(lds, g, S, E, wave);
#endif
 }
            { pg8::Gemm g{CKVN, (const bf16_t*)(wb + W_KVB), 128, 0, 0}; Sched S; S.init(ck.nseq, ck.tps, ck.tps, 4, 1, G, bx); EpiBf16<0> E{KVR, 1024};
#if !defined(PH) || (PH & 8)
              pg8::gemm_phase<EpiBf16<0>, Sched, true, true>(lds, g, S, E, wave);
#endif
 }
            GSYNC();
            RELAUNDER();
#if !defined(PH) || (PH & 256)
            ew2_phase(p, ck, l, gw, NGW, lane);
#ifdef PROBE_EW2
            RELAUNDER(); ew2_phase(p, ck, l, gw, NGW, lane);
#endif
#endif
            GSYNC();
#if !defined(PH) || (PH & 1024)
            attn_phase(p, ck, last, l, lds, ctl + 8192 + 2048 * (l * 3 + c), wave);
#ifdef PROBE_ATTN2
            GSYNC();
            attn_phase(p, ck, last, l, lds, ctl + 8192 + 2048 * (6 + l * 3 + c), wave);
#endif
#endif
            GSYNC();
            RELAUNDER();
#if !defined(PH) || (PH & 512)
            ew3_phase(p, ck, l, last, gw, NGW, lane);
#endif
            GSYNC();
            { pg8::Gemm g{ZM, (const bf16_t*)(wb + W_BR), 512, OSLOT, (size_t)1024 * 512}; Sched S; S.init(ck.nseq, ta, ck.tps, 4, 3, G, bx); EpiBranch E{GB, MG, XN};
#if !defined(PH) || (PH & 16)
              pg8::gemm_phase<EpiBranch, Sched, true, true>(lds, g, S, E, wave);
#ifdef PROBE_BR2
              pg8::gemm_phase<EpiBranch, Sched, true, true>(lds, g, S, E, wave);
#endif
#endif
 }
            if (!last) { RELAUNDER(); skinny_phase(0, p, ck, xm, wb, gw, NGW, lane); }
            GSYNC();
            { pg8::Gemm g{XN, (const bf16_t*)(wb + W_OUT), 1024, 0, 0}; Sched S; S.init(ck.nseq, ta, ck.tps, 4, 1, G, bx); EpiResid E{xm};
#if !defined(PH) || (PH & 32)
              pg8::gemm_phase<EpiResid, Sched, true, true>(lds, g, S, E, wave);
#endif
 }
            if (!last) { RELAUNDER(); skinny_phase(1, p, ck, xm, wb, gw, NGW, lane); }
            GSYNC();
            xm.first = 0;
            RELAUNDER();
#if !defined(PH) || (PH & 2)
            norm_phase(xm, ck.rows(), p.in[25] + l * DM, XN, gw, NGW, lane);
#ifdef PROBE_EW2
            RELAUNDER(); norm_phase(xm, ck.rows(), p.in[25] + l * DM, XN, gw, NGW, lane);
#endif
#endif
            GSYNC();
            { pg8::Gemm g{XN, (const bf16_t*)(wb + W_UP), 1024, 0, 0}; Sched S; S.init(ck.nseq, ta, ck.tps, 16, 1, G, bx); EpiBf16<2> E{U, 4096};
#if !defined(PH) || (PH & 64)
              pg8::gemm_phase<EpiBf16<2>, Sched, true, true>(lds, g, S, E, wave);
#ifdef PROBE_UP2
              pg8::gemm_phase<EpiBf16<2>, Sched, true, true>(lds, g, S, E, wave);
#endif
#endif
 }
            if (!last) { RELAUNDER(); skinny_phase(2, p, ck, xm, wb, gw, NGW, lane); }
            GSYNC();
            { pg8::Gemm g{U, (const bf16_t*)(wb + W_DOWN), 4096, 0, 0}; Sched S; S.init(ck.nseq, ta, ck.tps, 4, 1, G, bx); EpiResid E{xm};
#if !defined(PH) || (PH & 32)
              pg8::gemm_phase<EpiResid, Sched, true, true>(lds, g, S, E, wave);
#endif
 }
            if (!last) { RELAUNDER(); skinny_phase(3, p, ck, xm, wb, gw, NGW, lane); }
        }
    }
}

extern "C" void kernel_launch(void* const* d_in, const int* in_sizes, int n_in, void* d_out, int out_size, void* d_ws, size_t ws_size, hipStream_t stream) {
    static int grid_blocks = 0;
    if (grid_blocks == 0) {
        if (n_in != 28 || ws_size < WS_END) { fprintf(stderr, "kernel_launch: unexpected n_in %d / ws_size %zu (need %zu)\n", n_in, ws_size, (size_t)WS_END); grid_blocks = -1; return; }
        int dev = 0, cus = 0, per_cu = 0;
        hipGetDevice(&dev); hipDeviceGetAttribute(&cus, hipDeviceAttributeMultiprocessorCount, dev);
        hipFuncSetAttribute((const void*)fwd_kernel, hipFuncAttributeMaxDynamicSharedMemorySize, LDS_BYTES);
        hipOccupancyMaxActiveBlocksPerMultiprocessor(&per_cu, (const void*)fwd_kernel, 512, LDS_BYTES);
        if (per_cu < 1) { fprintf(stderr, "kernel_launch: occupancy query says %d blocks/CU\n", per_cu); per_cu = 1; }
        grid_blocks = cus * 1;
        (void)hipGetLastError();
    }
    if (grid_blocks < 0) return;
    hipMemsetAsync((char*)d_ws + WS_CTL, 0, CTL_BYTES, stream);
    Params p{};
    for (int i = 0; i < 28; ++i) p.in[i] = (const float*)d_in[i];
    p.out = (float*)d_out; p.ws = (unsigned char*)d_ws;
    void* args[] = {&p};
    hipError_t e = hipLaunchCooperativeKernel((const void*)fwd_kernel, dim3(grid_blocks), dim3(512), args, LDS_BYTES, stream);
    if (e != hipSuccess) fprintf(stderr, "cooperative launch failed: %s (grid %d)\n", hipGetErrorString(e), grid_blocks);
}
```

```cpp
#include <hip/hip_runtime.h>
#include <hip/hip_cooperative_groups.h>
#include <cstdint>
#include <cstdio>
namespace cg = cooperative_groups;
#define NOPIPE_AB 1
#define FLATQ 1
namespace pg8 {
#define PG8_LAS __attribute__((address_space(3)))
typedef unsigned short bf16_t;
typedef short bf16x8 __attribute__((ext_vector_type(8)));
typedef float f32x4 __attribute__((ext_vector_type(4)));
typedef unsigned u32x4 __attribute__((ext_vector_type(4)));
constexpr int BM = 256, BK = 64, HALF = 128, HTB = HALF * BK * 2  , STAGE_BYTES = 8 * HTB, NXCD = 8, WGM = 8;

__host__ __device__ __forceinline__ int lds_byte(int r, int c) { const int st = (r >> 4) * 2 + (c >> 5), rr = r & 15, cc = c & 31, ob = rr * 64 + cc * 2; return st * 1024 + (ob ^ (((ob >> 9) & 1) << 5)); }
__host__ __device__ __forceinline__ void stage_rc(int b, int& R, int& C) { const int st = b / 1024, sb = b % 1024, swz = sb ^ (((sb >> 9) & 1) << 5); R = (st >> 1) * 16 + swz / 64; C = (st & 1) * 32 + (swz % 64) / 2; }
__host__ __device__ __forceinline__ int perm32(int rho) { const int n = rho >> 4, i = rho & 15; return 8 * (i >> 2) + 4 * n + (i & 3); }

struct Unit { int pm, pn, z; };
struct Gemm { const bf16_t* A; const bf16_t* Bt; int K; size_t zsA, zsB; };

template <class Epi, class Sched, bool ALIGN_EPI = false, bool SP2 = false>
__device__ __forceinline__ void gemm_phase(PG8_LAS unsigned char* lds, const Gemm g, const Sched& S, const Epi& E, const int wv  ) {
    int tid_; asm volatile("v_mbcnt_lo_u32_b32 %0, -1, 0\n\tv_mbcnt_hi_u32_b32 %0, -1, %0" : "=v"(tid_)); tid_ += wv * 64;
    const int tid = tid_, wid = __builtin_amdgcn_readfirstlane(tid >> 6), lane = tid & 63, wr = wid >> 2, wc = wid & 3, fr = lane & 15, fq = lane >> 4;
    const int K = g.K, nt = K / BK;
    unsigned voffA[2], voffB[2];
#pragma unroll
    for (int i = 0; i < 2; ++i) { int R, C; stage_rc(tid * 16 + i * 8192, R, C); const int Rb = Epi::PERM ? ((R & ~31) + perm32(R & 31)) : R;
        voffA[i] = (unsigned)(R * K + C) * 2u; voffB[i] = (unsigned)(Rb * K + C) * 2u; }
    const size_t kstep = (size_t)(BK * 2);
    const size_t hstep = (size_t)HALF * K * 2;
    const size_t tstep = 2 * hstep;
    const unsigned ldsw = (unsigned)wid * 1024u;
    const int aoff = lds_byte(wr * 64 + fr, fq * 8), boff = lds_byte(wc * 32 + fr, fq * 8);
#define PG8_SA(b, h) (((b) * 2 + (h)) * HTB)
#define PG8_SB(b, h) ((4 + (b) * 2 + (h)) * HTB)
#define PG8_STAGE(bufoff, gbase, voff) do { _Pragma("unroll") for (int _i = 0; _i < 2; ++_i) \
        __builtin_amdgcn_global_load_lds((const unsigned*)((const char*)(gbase) + (voff)[_i]), (PG8_LAS unsigned*)(lds + (bufoff) + ldsw + _i * 8192), 16, 0, 0); } while (0)
#define PG8_LDA(dst, b, h) do { _Pragma("unroll") for (int m = 0; m < 4; ++m) _Pragma("unroll") for (int k = 0; k < 2; ++k) dst[m][k] = *(const PG8_LAS bf16x8*)(lds + PG8_SA(b, h) + aoff + m * 2048 + k * 1024); } while (0)
#define PG8_LDB(dst, b, h) do { _Pragma("unroll") for (int n = 0; n < 2; ++n) _Pragma("unroll") for (int k = 0; k < 2; ++k) dst[n][k] = *(const PG8_LAS bf16x8*)(lds + PG8_SB(b, h) + boff + n * 2048 + k * 1024); } while (0)
#define PG8_MMA(ai, bj, At, Bt) do { __builtin_amdgcn_s_setprio(1); _Pragma("unroll") for (int m = 0; m < 4; ++m) _Pragma("unroll") for (int n = 0; n < 2; ++n) _Pragma("unroll") for (int k = 0; k < 2; ++k) \
        acc[ai][bj][m][n] = __builtin_amdgcn_mfma_f32_16x16x32_bf16(Bt[n][k], At[m][k], acc[ai][bj][m][n], 0, 0, 0); __builtin_amdgcn_s_setprio(0); } while (0)
#define PG8_WAIT_V(n) asm volatile("s_waitcnt vmcnt(" #n ")" ::: "memory")
#define PG8_WAIT_L(n) asm volatile("s_waitcnt lgkmcnt(" #n ")" ::: "memory")
#define PG8_BAR __builtin_amdgcn_s_barrier()
#define PG8_SCHED __builtin_amdgcn_sched_barrier(0)
    Unit cur, nxt; int ui = 0;
    if (!S.next(0, cur)) return;
    f32x4 acc[2][2][4][2];
#pragma unroll
    for (int a = 0; a < 2; ++a)
#pragma unroll
        for (int b = 0; b < 2; ++b)
#pragma unroll
            for (int m = 0; m < 4; ++m)
#pragma unroll
                for (int n = 0; n < 2; ++n) acc[a][b][m][n] = (f32x4){0.f, 0.f, 0.f, 0.f};
    bf16x8 At[4][2], B0[2][2], B1[2][2];
    const char* cA = (const char*)(g.A + (size_t)cur.z * g.zsA) + (size_t)cur.pm * tstep; const char* cB = (const char*)(g.Bt + (size_t)cur.z * g.zsB) + (size_t)cur.pn * tstep;
    S.a_ready(cur);
    if constexpr (SP2) {
        PG8_STAGE(PG8_SB(0, 0), cB, voffB); PG8_STAGE(PG8_SB(0, 1), cB + hstep, voffB); PG8_STAGE(PG8_SA(0, 0), cA, voffA); PG8_STAGE(PG8_SA(0, 1), cA + hstep, voffA);
        if (wr == 1) PG8_BAR;
        PG8_WAIT_V(2); PG8_BAR;
        PG8_STAGE(PG8_SB(1, 0), cB + kstep, voffB); PG8_STAGE(PG8_SA(1, 0), cA + kstep, voffA); PG8_STAGE(PG8_SB(1, 1), cB + hstep + kstep, voffB);
        PG8_WAIT_V(6); PG8_BAR;
    } else {
        PG8_STAGE(PG8_SB(0, 0), cB, voffB); PG8_STAGE(PG8_SA(0, 0), cA, voffA); PG8_STAGE(PG8_SB(0, 1), cB + hstep, voffB); PG8_STAGE(PG8_SA(0, 1), cA + hstep, voffA);
        if (wr == 1) PG8_BAR;
        PG8_WAIT_V(4); PG8_BAR;
        PG8_STAGE(PG8_SB(1, 0), cB + kstep, voffB); PG8_STAGE(PG8_SA(1, 0), cA + kstep, voffA); PG8_STAGE(PG8_SB(1, 1), cB + hstep + kstep, voffB);
        PG8_WAIT_V(6); PG8_BAR;
    }
    for (;;) {
        const bool has_next = S.next(ui + 1, nxt);
        const char* nA = has_next ? (const char*)(g.A + (size_t)nxt.z * g.zsA) + (size_t)nxt.pm * tstep : cA; const char* nB = has_next ? (const char*)(g.Bt + (size_t)nxt.z * g.zsB) + (size_t)nxt.pn * tstep : cB;
        for (int t = 0; t < nt; t += 2) {
            const bool last = (t == nt - 2);
            const char* a1 = cA + (size_t)(t + 1) * kstep;
            const char* a2 = last ? nA : cA + (size_t)(t + 2) * kstep; const char* b2 = last ? nB : cB + (size_t)(t + 2) * kstep;
            const char* a3 = a2 + kstep; const char* b3 = b2 + kstep;
            if (last && has_next) S.a_ready(nxt);
            if constexpr (SP2) {
            PG8_LDB(B0, 0, 0); PG8_LDB(B1, 0, 1); PG8_SCHED; PG8_LDA(At, 0, 0); PG8_STAGE(PG8_SA(1, 1), a1 + hstep, voffA);
            PG8_WAIT_V(8); PG8_WAIT_L(0); PG8_BAR; PG8_MMA(0, 0, At, B0); PG8_MMA(0, 1, At, B1); PG8_BAR; PG8_SCHED;
            PG8_LDA(At, 0, 1); PG8_STAGE(PG8_SB(0, 0), b2, voffB); PG8_STAGE(PG8_SB(0, 1), b2 + hstep, voffB); PG8_STAGE(PG8_SA(0, 0), a2, voffA);
            PG8_WAIT_V(8); PG8_WAIT_L(0); PG8_BAR; PG8_MMA(1, 0, At, B0); PG8_MMA(1, 1, At, B1); PG8_BAR; PG8_SCHED;
            PG8_LDB(B0, 1, 0); PG8_LDB(B1, 1, 1); PG8_SCHED; PG8_LDA(At, 1, 0); PG8_STAGE(PG8_SA(0, 1), a2 + hstep, voffA);
            PG8_WAIT_V(8); PG8_WAIT_L(0); PG8_BAR; PG8_MMA(0, 0, At, B0); PG8_MMA(0, 1, At, B1); PG8_BAR; PG8_SCHED;
            PG8_LDA(At, 1, 1); PG8_STAGE(PG8_SB(1, 0), b3, voffB); PG8_STAGE(PG8_SB(1, 1), b3 + hstep, voffB); PG8_STAGE(PG8_SA(1, 0), a3, voffA);
            PG8_WAIT_V(8); PG8_WAIT_L(0); PG8_BAR; PG8_MMA(1, 0, At, B0); PG8_MMA(1, 1, At, B1); PG8_BAR; PG8_SCHED;
            } else {
            PG8_LDB(B0, 0, 0); PG8_SCHED; PG8_LDA(At, 0, 0); PG8_STAGE(PG8_SA(1, 1), a1 + hstep, voffA);
            PG8_WAIT_L(8); PG8_BAR; PG8_WAIT_L(0); PG8_MMA(0, 0, At, B0); PG8_BAR; PG8_SCHED;
            PG8_LDB(B1, 0, 1); PG8_STAGE(PG8_SB(0, 0), b2, voffB);
            PG8_BAR; PG8_WAIT_L(0); PG8_MMA(0, 1, At, B1); PG8_BAR;
            PG8_LDA(At, 0, 1); PG8_STAGE(PG8_SA(0, 0), a2, voffA);
            PG8_BAR; PG8_WAIT_L(0); PG8_MMA(1, 0, At, B0); PG8_BAR; PG8_SCHED;
            PG8_STAGE(PG8_SB(0, 1), b2 + hstep, voffB);
            PG8_WAIT_V(6); PG8_BAR; PG8_MMA(1, 1, At, B1); PG8_BAR;
            PG8_LDB(B0, 1, 0); PG8_SCHED; PG8_LDA(At, 1, 0); PG8_STAGE(PG8_SA(0, 1), a2 + hstep, voffA);
            PG8_WAIT_L(8); PG8_BAR; PG8_WAIT_L(0); PG8_MMA(0, 0, At, B0); PG8_BAR; PG8_SCHED;
            PG8_LDB(B1, 1, 1); PG8_STAGE(PG8_SB(1, 0), b3, voffB);
            PG8_BAR; PG8_WAIT_L(0); PG8_MMA(0, 1, At, B1); PG8_BAR;
            PG8_LDA(At, 1, 1); PG8_STAGE(PG8_SA(1, 0), a3, voffA);
            PG8_BAR; PG8_WAIT_L(0); PG8_MMA(1, 0, At, B0); PG8_BAR; PG8_SCHED;
            PG8_STAGE(PG8_SB(1, 1), b3 + hstep, voffB);
            PG8_WAIT_V(6); PG8_BAR; PG8_MMA(1, 1, At, B1); PG8_BAR;
            }
        }
        if constexpr (ALIGN_EPI) { if (wr == 0) PG8_BAR; }
        if constexpr (!Epi::AFTER_DRAIN) { E(acc, cur, wr, wc, fr, fq); S.done(cur); }
        if (!has_next) break;
#pragma unroll
        for (int a = 0; a < 2; ++a)
#pragma unroll
            for (int b = 0; b < 2; ++b)
#pragma unroll
                for (int m = 0; m < 4; ++m)
#pragma unroll
                    for (int n = 0; n < 2; ++n) acc[a][b][m][n] = (f32x4){0.f, 0.f, 0.f, 0.f};
        cur = nxt; cA = nA; cB = nB; ++ui;
        if constexpr (ALIGN_EPI) { if (wr == 1) PG8_BAR; }
    }
    PG8_WAIT_V(0);
    if constexpr (!ALIGN_EPI) { if (wr == 0) PG8_BAR; }
    PG8_BAR;
    if constexpr (Epi::AFTER_DRAIN) { E.fused(acc, cur, wr, wc, fr, fq, lds, wid, lane); S.done(cur); }
#undef PG8_SA
#undef PG8_SB
#undef PG8_STAGE
#undef PG8_LDA
#undef PG8_LDB
#undef PG8_MMA
#undef PG8_WAIT_V
#undef PG8_WAIT_L
#undef PG8_BAR
#undef PG8_SCHED
}
}


using pg8::bf16_t; using pg8::bf16x8; using pg8::f32x4; using pg8::u32x4;
typedef float f32x16 __attribute__((ext_vector_type(16)));
typedef unsigned u32x2 __attribute__((ext_vector_type(2)));
typedef float f32x2_t __attribute__((ext_vector_type(2)));
typedef __bf16 bf16x2_t __attribute__((ext_vector_type(2)));
#define LAS __attribute__((address_space(3)))
#define DI __device__ __forceinline__

constexpr int DM = 1024, RA = 16896;
constexpr int ZM_LD = 2816, G_LD = 3072, IN_N = 5888;
constexpr float LOG2E = 1.4426950408889634f;
constexpr size_t MiB = 1u << 20;
constexpr size_t WS_CTL = 0, CTL_BYTES = 131072;
constexpr size_t WS_W = 1 * MiB, LW_STRIDE = 34 * MiB;
constexpr size_t W_IN = 0, W_QB = W_IN + (size_t)IN_N * 1024 * 2, W_KVB = W_QB + 768 * 256 * 2, W_BR = W_KVB + 1024 * 128 * 2,
                 W_OUT = W_BR + 3 * 1024 * 512 * 2, W_UP = W_OUT + 1024 * 1024 * 2, W_DOWN = W_UP + 4096 * 1024 * 2, W_END = W_DOWN + 4096 * 1024 * 2;
static_assert(W_END <= LW_STRIDE, "weights");
constexpr size_t WS_META0 = 69 * MiB, WS_METAX = 70 * MiB, WS_XN = 74 * MiB, WS_ZM = 107 * MiB, WS_G = 198 * MiB, WS_QKV = 297 * MiB, WS_SM = 438 * MiB, WS_END = 454 * MiB;
constexpr size_t OFF_QCR = 0, OFF_KVR = 25 * MiB;
constexpr size_t OSLOT = (size_t)RA * 512;
constexpr size_t QA_O = 0, KA_O = 512ull * RA, VA_O = 640ull * RA, QB_O = 768ull * RA, KB_O = 1280ull * RA, VB_O = 1792ull * RA, QC_O = 2304ull * RA, KC_O = 3072ull * RA, VC_O = 3840ull * RA;
constexpr size_t SM_CQN = 0, SM_CKVN = 9 * MiB, SM_KPE = 14 * MiB;
constexpr int LDS_MISC = 131072, LDS_BYTES = 131072 + 256;

struct Params { const float* in[28]; float* out; unsigned char* ws; };

DI unsigned pk2(float lo, float hi) { f32x2_t v = {lo, hi}; bf16x2_t b = __builtin_convertvector(v, bf16x2_t); return __builtin_bit_cast(unsigned, b); }
DI void ld8(const bf16_t* p, float (&f)[8]) {
    const u32x4 r = *(const u32x4*)p;
#pragma unroll
    for (int i = 0; i < 4; ++i) { f[2 * i] = __uint_as_float(r[i] << 16); f[2 * i + 1] = __uint_as_float(r[i] & 0xffff0000u); }
}
DI void st8(bf16_t* p, const float (&f)[8]) { u32x4 w; w.x = pk2(f[0], f[1]); w.y = pk2(f[2], f[3]); w.z = pk2(f[4], f[5]); w.w = pk2(f[6], f[7]); *(u32x4*)p = w; }
DI int lane_fresh() { int l; asm volatile("v_mbcnt_lo_u32_b32 %0, -1, 0\n\tv_mbcnt_hi_u32_b32 %0, -1, %0" : "=v"(l)); return l; }
DI float wave_sum(float v, int lane) {
#pragma unroll
    for (int o = 1; o < 64; o <<= 1) v += __int_as_float(__builtin_amdgcn_ds_bpermute((lane ^ o) << 2, __float_as_int(v)));
    return v;
}
DI float max3f(float a, float b, float c) { float r; asm("v_max3_f32 %0, %1, %2, %3" : "=v"(r) : "v"(a), "v"(b), "v"(c)); return r; }
DI float max2f(float a, float b) { float r; asm("v_max_f32_e32 %0, %1, %2" : "=v"(r) : "v"(a), "v"(b)); return r; }
DI float fadd_s(float a, float b) { float r; asm("v_add_f32_e32 %0, %1, %2" : "=v"(r) : "v"(a), "v"(b)); return r; }
#define MX2(a, b) __builtin_amdgcn_fmed3f((a), (b), __builtin_inff())
DI float swap32_max(float v) { auto rr = __builtin_amdgcn_permlane32_swap(__float_as_uint(v), __float_as_uint(v), false, false); return __builtin_amdgcn_fmed3f(__uint_as_float(rr[0]), __uint_as_float(rr[1]), __builtin_inff()); }
DI float swap32_add(float v) { auto rr = __builtin_amdgcn_permlane32_swap(__float_as_uint(v), __float_as_uint(v), false, false); return __uint_as_float(rr[0]) + __uint_as_float(rr[1]); }
DI constexpr float inv64(int j) {
    constexpr float T[32] = {1.0f, 0.749894209f, 0.562341325f, 0.421696503f, 0.316227766f, 0.237137371f, 0.177827941f, 0.133352143f, 0.1f, 0.0749894209f, 0.0562341325f, 0.0421696503f,
                             0.0316227766f, 0.0237137371f, 0.0177827941f, 0.0133352143f, 0.01f, 0.00749894209f, 0.00562341325f, 0.00421696503f, 0.00316227766f, 0.00237137371f,
                             0.00177827941f, 0.00133352143f, 0.001f, 0.000749894209f, 0.000562341325f, 0.000421696503f, 0.000316227766f, 0.000237137371f, 0.000177827941f, 0.000133352143f};
    return T[j];
}
DI void sincos_ang(float ang, float& s, float& c) {
    double t = (double)ang * 0.15915494309189535; t -= __builtin_rint(t); const float f = (float)t;
    s = __builtin_amdgcn_sinf(f); c = __builtin_amdgcn_cosf(f);
}

struct Chunk {
    int id, nseq, seq0, tps, n;
    DI int rows_per_seq() const { return tps * 256; }
    DI int rows() const { return nseq * tps * 256; }
};
DI Chunk make_chunk(int c) { Chunk k; k.id = c; if (c < 2) { k.nseq = 1; k.seq0 = c; k.tps = 65; k.n = 16384; } else { k.nseq = 2; k.seq0 = 2; k.tps = 33; k.n = 8192; } return k; }
struct XMap {
    float* out; float* metax; const float* xp; const float* xs; const float* meta0; int seq0, tps, first;
    DI float* xw(int pt) const {
        const int hi = pt >= tps ? 1 : 0, s = seq0 + hi, lt = pt - hi * tps;
        if (lt == tps - 1) return metax + (size_t)s * 256 * DM;
        const int ob = (s < 2) ? s * 16384 : 32768 + (s - 2) * 8192;
        return out + ((size_t)ob + (size_t)lt * 256) * DM;
    }
    DI const float* xr(int pt) const {
        if (!first) return xw(pt);
        const int hi = pt >= tps ? 1 : 0, s = seq0 + hi, lt = pt - hi * tps;
        if (lt == tps - 1) return metax + (size_t)s * 256 * DM;
        return (s < 2) ? xp + ((size_t)s * 16384 + (size_t)lt * 256) * DM : xs + ((size_t)(s - 2) * 8192 + (size_t)lt * 256) * DM;
    }
};

struct Sched {
    int nM, nN, nZ, nwg, G, c, ta, tps;
    DI void init(int nseq, int ta_, int tps_, int nN_, int nZ_, int G_, int c_) { ta = ta_; tps = tps_; nM = nseq * ta_; nN = nN_; nZ = nZ_; nwg = nM * nN; G = G_; c = c_; }
    DI bool next(int i, pg8::Unit& u) const {
        const int tl = (i / nZ) * G + c; if (tl >= nwg) return false;
        u.z = i % nZ;
        int wgid = tl; { const int q = nwg / pg8::NXCD, r = nwg % pg8::NXCD, xcd = wgid % pg8::NXCD, off = wgid / pg8::NXCD; wgid = (xcd < r ? xcd * (q + 1) : r * (q + 1) + (xcd - r) * q) + off; }
        const int nig = pg8::WGM * nN, gid = wgid / nig, fm = gid * pg8::WGM, gsz = (nM - fm) < pg8::WGM ? (nM - fm) : pg8::WGM;
        const int pa = fm + ((wgid % nig) % gsz); u.pn = (wgid % nig) / gsz;
        u.pm = pa >= ta ? pa - ta + tps : pa;
        return true;
    }
    DI void a_ready(const pg8::Unit&) const {}
    DI void done(const pg8::Unit&) const {}
};

template <int ACT  > struct EpiBf16 {
    static constexpr bool PERM = true, AFTER_DRAIN = false;
    bf16_t* O; int ldc;
    DI void operator()(const f32x4 (&acc)[2][2][4][2], const pg8::Unit& u, int wr, int wc, int fr_, int fq_) const {
        const int ln_ = lane_fresh(), fr = ln_ & 15, fq = ln_ >> 4;
        const int row0 = u.pm * 256 + wr * 64 + fr, col0 = u.pn * 256 + wc * 32 + 8 * fq;
#pragma unroll
        for (int ai = 0; ai < 2; ++ai)
#pragma unroll
            for (int m = 0; m < 4; ++m) { bf16_t* rowp = O + (size_t)(row0 + ai * 128 + m * 16) * ldc + col0;
#pragma unroll
                for (int bj = 0; bj < 2; ++bj) { f32x4 v0 = acc[ai][bj][m][0], v1 = acc[ai][bj][m][1];
                    if (ACT == 2) {
#pragma unroll
                        for (int k = 0; k < 4; ++k) { const float a = fmaxf(v0[k], 0.f), b = fmaxf(v1[k], 0.f); v0[k] = a * a; v1[k] = b * b; } }
                    u32x4 w; w.x = pk2(v0[0], v0[1]); w.y = pk2(v0[2], v0[3]); w.z = pk2(v1[0], v1[1]); w.w = pk2(v1[2], v1[3]);
                    *(u32x4*)(rowp + bj * 128) = w; } }
    }
};
struct EpiIn {
    static constexpr bool PERM = true, AFTER_DRAIN = false;
    bf16_t* ZM; bf16_t* G; const float* bgate;
    DI void operator()(const f32x4 (&acc)[2][2][4][2], const pg8::Unit& u, int wr, int wc, int fr_, int fq_) const {
        const int ln_ = lane_fresh(), fr = ln_ & 15, fq = ln_ >> 4;
        const bool gate = u.pn >= 11;
        const int row0 = u.pm * 256 + wr * 64 + fr, colt = gate ? (u.pn - 11) * 256 : u.pn * 256, col0 = colt + wc * 32 + 8 * fq, ld = gate ? G_LD : ZM_LD;
        bf16_t* base = gate ? G : ZM;
        f32x4 bv[2][2];
#pragma unroll
        for (int bj = 0; bj < 2; ++bj)
#pragma unroll
            for (int n = 0; n < 2; ++n) bv[bj][n] = gate ? *(const f32x4*)(bgate + col0 + bj * 128 + 4 * n) : (f32x4){0.f, 0.f, 0.f, 0.f};
#pragma unroll
        for (int ai = 0; ai < 2; ++ai)
#pragma unroll
            for (int m = 0; m < 4; ++m) { bf16_t* rowp = base + (size_t)(row0 + ai * 128 + m * 16) * ld + col0;
#pragma unroll
                for (int bj = 0; bj < 2; ++bj) { f32x4 v0 = acc[ai][bj][m][0] + bv[bj][0], v1 = acc[ai][bj][m][1] + bv[bj][1];
                    if (gate) {
#pragma unroll
                        for (int k = 0; k < 4; ++k) { v0[k] = __builtin_amdgcn_rcpf(1.f + __builtin_amdgcn_exp2f(-LOG2E * v0[k])); v1[k] = __builtin_amdgcn_rcpf(1.f + __builtin_amdgcn_exp2f(-LOG2E * v1[k])); } }
                    u32x4 w; w.x = pk2(v0[0], v0[1]); w.y = pk2(v0[2], v0[3]); w.z = pk2(v1[0], v1[1]); w.w = pk2(v1[2], v1[3]);
                    *(u32x4*)(rowp + bj * 128) = w; } }
    }
};
struct EpiBranch {
    static constexpr bool PERM = false, AFTER_DRAIN = false;
    const bf16_t* G; float* MG; bf16_t* MGb;
    DI void operator()(const f32x4 (&acc)[2][2][4][2], const pg8::Unit& u, int wr, int wc, int fr_, int fq_) const {
        const int ln_ = lane_fresh(), fr = ln_ & 15, fq = ln_ >> 4;
        const int row0 = u.pm * 256 + wr * 64 + fr, col0 = u.pn * 256 + wc * 32 + 4 * fq;
#pragma unroll
        for (int ai = 0; ai < 2; ++ai)
#pragma unroll
            for (int m = 0; m < 4; ++m) { const size_t row = (size_t)(row0 + ai * 128 + m * 16);
#pragma unroll
                for (int bj = 0; bj < 2; ++bj)
#pragma unroll
                    for (int n = 0; n < 2; ++n) { const int col = col0 + bj * 128 + n * 16;
                        const u32x2 gr = *(const u32x2*)(G + row * G_LD + u.z * 1024 + col);
                        f32x4 g; g[0] = __uint_as_float(gr.x << 16); g[1] = __uint_as_float(gr.x & 0xffff0000u); g[2] = __uint_as_float(gr.y << 16); g[3] = __uint_as_float(gr.y & 0xffff0000u);
                        f32x4 v = g * acc[ai][bj][m][n];
                        float* mp = MG + row * DM + col;
                        if (u.z > 0) v += *(const f32x4*)mp;
                        if (u.z < 2) *(f32x4*)mp = v;
                        else { u32x2 w; w.x = pk2(v[0], v[1]); w.y = pk2(v[2], v[3]); *(u32x2*)(MGb + row * DM + col) = w; } }
                asm volatile("" ::: "memory"); }
    }
};
struct EpiResid {
    static constexpr bool PERM = false, AFTER_DRAIN = false;
    XMap xm;
    DI void operator()(const f32x4 (&acc)[2][2][4][2], const pg8::Unit& u, int wr, int wc, int fr_, int fq_) const {
        const int ln_ = lane_fresh(), fr = ln_ & 15, fq = ln_ >> 4;
        const float* rd = xm.xr(u.pm); float* wp = xm.xw(u.pm);
        const int row0 = wr * 64 + fr, col0 = u.pn * 256 + wc * 32 + 4 * fq;
#pragma unroll
        for (int ai = 0; ai < 2; ++ai)
#pragma unroll
            for (int m = 0; m < 4; ++m) { const size_t off = (size_t)(row0 + ai * 128 + m * 16) * DM + col0;
#pragma unroll
                for (int bj = 0; bj < 2; ++bj)
#pragma unroll
                    for (int n = 0; n < 2; ++n) { const size_t o = off + bj * 128 + n * 16; *(f32x4*)(wp + o) = *(const f32x4*)(rd + o) + acc[ai][bj][m][n]; }
                asm volatile("" ::: "memory"); }
    }
};

DI void transpose_item(const float* W, int K, int N, bf16_t* WT, int split, int extra, LAS float* scr, int item, int lane) {
    const int nblk = N / 32, kb = item / nblk, nb = item % nblk, k0 = 64 * kb, n0 = 32 * nb;
    const int row_off = (n0 >= split) ? extra : 0;
#pragma unroll 8
    for (int i = 0; i < 32; ++i) { const int kk = 2 * i + (lane >> 5); scr[kk * 33 + (lane & 31)] = W[(size_t)(k0 + kk) * N + n0 + (lane & 31)]; }
    asm volatile("s_waitcnt lgkmcnt(0)" ::: "memory");
    const int c = lane & 7;
#pragma unroll
    for (int j = 0; j < 4; ++j) { const int n = (lane >> 3) + 8 * j; const LAS float* s = scr + (8 * c) * 33 + n;
        u32x4 o; o.x = pk2(s[0 * 33], s[1 * 33]); o.y = pk2(s[2 * 33], s[3 * 33]); o.z = pk2(s[4 * 33], s[5 * 33]); o.w = pk2(s[6 * 33], s[7 * 33]);
        *(u32x4*)(WT + (size_t)(row_off + n0 + n) * K + k0 + 8 * c) = o; }
    asm volatile("s_waitcnt lgkmcnt(0)" ::: "memory");
}
DI void prologue(const Params& p, LAS unsigned char* lds, int gw, int NGW, int wave, int lane) {
    LAS float* scr = (LAS float*)(lds + wave * 16384);
    constexpr int I_IN = 16 * 182, I_QB = 4 * 24, I_KVB = 2 * 32, I_BR = 8 * 32, I_OUT = 16 * 32, I_UP = 16 * 128, I_DN = 64 * 32;
    constexpr int PER_L = I_IN + I_QB + I_KVB + 3 * I_BR + I_OUT + I_UP + I_DN;
    for (int it = gw; it < 2 * PER_L; it += NGW) {
        const int l = it / PER_L; int r = it % PER_L;
        unsigned char* wb = p.ws + WS_W + (size_t)l * LW_STRIDE;
        if (r < I_IN) { transpose_item(p.in[4] + (size_t)l * 1024 * 5824, 1024, 5824, (bf16_t*)(wb + W_IN), 2752, 64, scr, r, lane); continue; } r -= I_IN;
        if (r < I_QB) { transpose_item(p.in[16] + (size_t)l * 256 * 768, 256, 768, (bf16_t*)(wb + W_QB), 1 << 30, 0, scr, r, lane); continue; } r -= I_QB;
        if (r < I_KVB) { transpose_item(p.in[18] + (size_t)l * 128 * 1024, 128, 1024, (bf16_t*)(wb + W_KVB), 1 << 30, 0, scr, r, lane); continue; } r -= I_KVB;
        if (r < 3 * I_BR) { const int b = r / I_BR; transpose_item(p.in[21 + b] + (size_t)l * 512 * 1024, 512, 1024, (bf16_t*)(wb + W_BR) + (size_t)b * 1024 * 512, 1 << 30, 0, scr, r % I_BR, lane); continue; } r -= 3 * I_BR;
        if (r < I_OUT) { transpose_item(p.in[24] + (size_t)l * 1024 * 1024, 1024, 1024, (bf16_t*)(wb + W_OUT), 1 << 30, 0, scr, r, lane); continue; } r -= I_OUT;
        if (r < I_UP) { transpose_item(p.in[26] + (size_t)l * 1024 * 4096, 1024, 4096, (bf16_t*)(wb + W_UP), 1 << 30, 0, scr, r, lane); continue; } r -= I_UP;
        transpose_item(p.in[27] + (size_t)l * 4096 * 1024, 4096, 1024, (bf16_t*)(wb + W_DOWN), 1 << 30, 0, scr, r, lane);
    }
    { float* mx0 = (float*)(p.ws + WS_METAX);
      for (int r = gw; r < 4 * 256; r += NGW) { const int rr = r & 255; f32x4* o = (f32x4*)(mx0 + (size_t)r * DM) + lane;
#pragma unroll
        for (int j = 0; j < 4; ++j) o[64 * j] = (rr < 16) ? ((const f32x4*)(p.in[2] + (size_t)rr * DM))[lane + 64 * j] : (f32x4){0.f, 0.f, 0.f, 0.f}; } }
    float* m0 = (float*)(p.ws + WS_META0);
    for (int r = gw; r < 256; r += NGW) { f32x4* o = (f32x4*)(m0 + (size_t)r * DM) + lane;
#pragma unroll
        for (int j = 0; j < 4; ++j) o[64 * j] = (r < 16) ? ((const f32x4*)(p.in[2] + (size_t)r * DM))[lane + 64 * j] : (f32x4){0.f, 0.f, 0.f, 0.f}; }
}

DI void norm_phase(const XMap& xm, int rows, const float* g, bf16_t* XN, int gw, int NGW, int lane) {
    for (int r = gw; r < rows; r += NGW) {
        const float* xrow = xm.xr(r >> 8) + (size_t)(r & 255) * DM;
        const f32x4* xr = (const f32x4*)xrow + lane;
        f32x4 v[4]; float s = 0.f;
#pragma unroll
        for (int j = 0; j < 4; ++j) { v[j] = xr[64 * j]; s += (v[j].x * v[j].x + v[j].y * v[j].y) + (v[j].z * v[j].z + v[j].w * v[j].w); }
        const float rs = rsqrtf(wave_sum(s, lane) * (1.f / DM) + 1e-6f);
        u32x2* o8 = (u32x2*)(XN + (size_t)r * DM) + lane;
#pragma unroll
        for (int j = 0; j < 4; ++j) { const f32x4 gg = ((const f32x4*)g)[lane + 64 * j]; u32x2 w; w.x = pk2(v[j].x * rs * gg.x, v[j].y * rs * gg.y); w.y = pk2(v[j].z * rs * gg.z, v[j].w * rs * gg.w); o8[64 * j] = w; }
    }
}

template <int W, int W0, int ROPE> DI void norm_task(const bf16_t* s0, const bf16_t* s1, const float* gain, float oscale, bf16_t* dst, float pa, float pb) {
    float ss = 0.f;
#pragma unroll 2
    for (int c = 0; c < W / 8; ++c) { float x[8]; ld8(c < W0 / 8 ? s0 + 8 * c : s1 + 8 * (c - W0 / 8), x);
#pragma unroll
        for (int e = 0; e < 8; ++e) ss += x[e] * x[e]; }
    const float rs = rsqrtf(ss * (1.f / W) + 1e-6f) * oscale;
    constexpr int NPLAIN = ROPE == 1 ? 0 : (ROPE == 2 ? 16 : W / 8);
#pragma unroll 2
    for (int c = 0; c < NPLAIN; ++c) { float x[8]; ld8(c < W0 / 8 ? s0 + 8 * c : s1 + 8 * (c - W0 / 8), x);
#pragma unroll
        for (int e = 0; e < 8; ++e) x[e] *= rs * gain[8 * c + e];
        st8(dst + 8 * c, x); }
    if constexpr (ROPE != 0) {
        constexpr int NB = ROPE == 1 ? 2 : 1, HC = ROPE == 1 ? 2 : 4, C0 = ROPE == 1 ? 0 : 16;
#pragma unroll
        for (int b = 0; b < NB; ++b) { const float pos = b ? pb : pa;
#pragma unroll
            for (int k = 0; k < HC; ++k) { const int c1 = C0 + 2 * HC * b + k, c2 = c1 + HC; float x1[8], x2[8];
                ld8(c1 < W0 / 8 ? s0 + 8 * c1 : s1 + 8 * (c1 - W0 / 8), x1); ld8(c2 < W0 / 8 ? s0 + 8 * c2 : s1 + 8 * (c2 - W0 / 8), x2);
#pragma unroll
                for (int e = 0; e < 8; ++e) { const int j = 8 * k + e; const float inv = ROPE == 1 ? inv64(2 * j) : inv64(j); float sn, cs; sincos_ang(pos * inv, sn, cs);
                    const float y1 = x1[e] * rs * gain[8 * c1 + e], y2 = x2[e] * rs * gain[8 * c2 + e]; x1[e] = y1 * cs - y2 * sn; x2[e] = y2 * cs + y1 * sn; }
                st8(dst + 8 * c1, x1); st8(dst + 8 * c2, x2); } }
    }
}
template <int W> DI void transpose_task(const bf16_t* src, bf16_t* dstT, int row) {
#pragma unroll 2
    for (int c = 0; c < W / 8; ++c) { const u32x4 r = *(const u32x4*)(src + 8 * c);
#pragma unroll
        for (int i = 0; i < 4; ++i) { dstT[(size_t)(8 * c + 2 * i) * RA + row] = (bf16_t)(r[i] & 0xffffu); dstT[(size_t)(8 * c + 2 * i + 1) * RA + row] = (bf16_t)(r[i] >> 16); } }
}
struct RowPos { float lin, row, col; };
DI RowPos row_pos(const Chunk& ck, int r) {
    const int li = r >= ck.rows_per_seq() ? r - ck.rows_per_seq() : r; RowPos p;
    if (li < ck.n) { p.lin = (float)(li + 16); p.row = (float)(li >> 6); p.col = (float)(li & 63); }
    else if (li < ck.n + 16) { p.lin = (float)(li - ck.n); p.row = -1.f; p.col = (float)(li - ck.n); }
    else { p.lin = 0.f; p.row = 0.f; p.col = 0.f; }
    return p;
}

DI void ew1_phase(const Params& p, const Chunk& ck, int l, int gw, int NGW, int lane) {
    unsigned char* ws = p.ws; asm volatile("" : "+s"(ws));
    const bf16_t* ZM = (const bf16_t*)(ws + WS_ZM); bf16_t* QKV = (bf16_t*)(ws + WS_QKV);
    bf16_t* CQN = (bf16_t*)(ws + WS_SM + SM_CQN); bf16_t* CKVN = (bf16_t*)(ws + WS_SM + SM_CKVN); bf16_t* KPE = (bf16_t*)(ws + WS_SM + SM_KPE);
    const int nrb = ck.rows() / 64; const float QS = 0.125f * LOG2E;
    for (int w = gw; w < nrb * 34; w += NGW) {
        const int rb = w / 34, task = w % 34, row = rb * 64 + lane;
        const bf16_t* z = ZM + (size_t)row * ZM_LD; const RowPos ps = row_pos(ck, row);
        if (task < 8) { const int h = task; norm_task<64, 64, 1>(z + 64 * h, z, p.in[6] + l * 64, QS, QKV + QA_O + ((size_t)h * RA + row) * 64, ps.row, ps.col); }
        else if (task < 10) { const int h = task - 8; norm_task<64, 64, 1>(z + 512 + 64 * h, z, p.in[7] + l * 64, 1.f, QKV + KA_O + ((size_t)h * RA + row) * 64, ps.row, ps.col); }
        else if (task < 12) { const int h = task - 10; transpose_task<64>(z + 640 + 64 * h, QKV + VA_O + (size_t)h * 64 * RA, row); }
        else if (task < 20) { const int hm = task - 12; norm_task<64, 64, 0>(z + 768 + 64 * hm, z, p.in[8] + l * 64, QS, QKV + QB_O + ((size_t)hm * RA + row) * 64, 0.f, 0.f); }
        else if (task < 28) { const int hm = task - 20; norm_task<64, 64, 0>(z + 1280 + 64 * hm, z, p.in[9] + l * 64, 1.f, QKV + KB_O + ((size_t)hm * RA + row) * 64, 0.f, 0.f); }
        else if (task < 32) { const int h = task - 28; transpose_task<128>(z + 1792 + 128 * h, QKV + VB_O + (size_t)h * 128 * RA, row); }
        else if (task == 32) { norm_task<256, 256, 0>(z + 2304, z, p.in[15] + l * 256, 1.f, CQN + (size_t)row * 256, 0.f, 0.f); }
        else { norm_task<128, 128, 0>(z + 2560, z, p.in[17] + l * 128, 1.f, CKVN + (size_t)row * 128, 0.f, 0.f);
#pragma unroll
            for (int c = 0; c < 8; ++c) *(u32x4*)(KPE + (size_t)row * 64 + 8 * c) = *(const u32x4*)(z + 2688 + 8 * c); }
    }
}
DI void ew2_phase(const Params& p, const Chunk& ck, int l, int gw, int NGW, int lane) {
    unsigned char* ws = p.ws; asm volatile("" : "+s"(ws));
    const bf16_t* QCR = (const bf16_t*)(ws + WS_ZM + OFF_QCR); const bf16_t* KVR = (const bf16_t*)(ws + WS_ZM + OFF_KVR); const bf16_t* KPE = (const bf16_t*)(ws + WS_SM + SM_KPE);
    bf16_t* QKV = (bf16_t*)(ws + WS_QKV);
    const int nrb = ck.rows() / 64; const float QS = 0.07216878364870322f * LOG2E;
    for (int w = gw; w < nrb * 12; w += NGW) {
        const int rb = w / 12, task = w % 12, row = rb * 64 + lane; const RowPos ps = row_pos(ck, row);
        if (task < 4) { const int h = task; norm_task<192, 192, 2>(QCR + (size_t)row * 768 + 192 * h, QCR, p.in[19] + l * 192, QS, QKV + QC_O + ((size_t)h * RA + row) * 192, ps.lin, 0.f); }
        else if (task < 8) { const int h = task - 4; norm_task<192, 128, 2>(KVR + (size_t)row * 1024 + 256 * h, KPE + (size_t)row * 64, p.in[20] + l * 192, 1.f, QKV + KC_O + ((size_t)h * RA + row) * 192, ps.lin, 0.f); }
        else { const int h = task - 8; transpose_task<128>(KVR + (size_t)row * 1024 + 256 * h + 128, QKV + VC_O + (size_t)h * 128 * RA, row); }
    }
}
DI void ew3_phase(const Params& p, const Chunk& ck, int l, bool last, int gw, int NGW, int lane) {
    unsigned char* ws = p.ws; asm volatile("" : "+s"(ws));
    bf16_t* O1 = (bf16_t*)(ws + WS_ZM) + 1 * OSLOT; const bf16_t* O2 = (const bf16_t*)(ws + WS_ZM) + 3 * OSLOT;
    const float d1 = wave_sum(p.in[10][l * 64 + lane] * p.in[11][l * 64 + lane], lane), d2 = wave_sum(p.in[12][l * 64 + lane] * p.in[13][l * 64 + lane], lane);
    int lz = l; asm volatile("" : "+s"(lz));
    const float lam_init = __uint_as_float(lz == 0 ? 0x3e4ccccdu : 0x3eb60549u)  , lam = expf(d1) - expf(d2) + lam_init, osc = 1.f - lam_init;
    const float* gs = p.in[14] + l * 128;
    const int nrb = ck.rows() / 64;
    for (int w = gw; w < nrb * 4; w += NGW) {
        const int rb = w >> 2, h = w & 3, row = rb * 64 + lane;
        if (last && (row >= ck.rows_per_seq() ? row - ck.rows_per_seq() : row) >= (ck.tps - 1) * 256) continue;
        bf16_t* a = O1 + (size_t)row * 512 + 128 * h; const bf16_t* b = O2 + (size_t)row * 512 + 128 * h;
        float ss = 0.f;
#pragma unroll 2
        for (int c = 0; c < 16; ++c) { float x[8], y[8]; ld8(a + 8 * c, x); ld8(b + 8 * c, y);
#pragma unroll
            for (int e = 0; e < 8; ++e) { const float d = x[e] - lam * y[e]; ss += d * d; } }
        const float rs = rsqrtf(ss * (1.f / 128.f) + 1e-6f) * osc;
#pragma unroll 2
        for (int c = 0; c < 16; ++c) { float x[8], y[8]; ld8(a + 8 * c, x); ld8(b + 8 * c, y);
#pragma unroll
            for (int e = 0; e < 8; ++e) x[e] = (x[e] - lam * y[e]) * rs * gs[8 * c + e];
            st8(a + 8 * c, x); }
    }
}

template <int DQK, int DV, bool ALIBI, bool PIPE>
DI void attn_unit(LAS unsigned char* lds, const bf16_t* __restrict__ Q, const bf16_t* __restrict__ K, const bf16_t* __restrict__ Vt, bf16_t* __restrict__ O, int r0, int qb, int n, float sl, const int wid, const int dkeys = 0x3fffffff) {
    constexpr bool EARLYV = true;
    constexpr bool NEGM = (DQK == 64);
    constexpr int KROW = DQK * 2 + 16, KT = 64 * KROW, VROW = 144, VT = DV * VROW, KCH = DQK / 8, NKC = 64 * KCH / 512, NVC = DV * 8 / 512, NKS = DQK / 16, NDB = DV / 32, VB0 = 2 * KT;
    typedef const __attribute__((address_space(1))) u32x4* gptr;
    const int lane = lane_fresh(), tid = wid * 64 + lane, r = lane & 31, h = lane >> 5;
    const int nk = n + 16, NT = (nk + 63) >> 6;
    const int li = qb * 256 + wid * 32 + r;
    const int tq = ALIBI ? ((4 * qb + 3 < NT - 1) ? 4 * qb + 3 : NT - 1) : -1;
    int tlo = 0, thi = NT - 2, NIT = NT;
    if (ALIBI && qb * 256 < n) {
        const int x = qb * 256 + 16 - dkeys - 79, y = qb * 256 + 255 + 16 + dkeys - 16;
        tlo = x > 0 ? (x + 63) >> 6 : 0; if (tlo > tq) tlo = tq;
        thi = (y >> 6) < NT - 2 ? (y >> 6) : NT - 2; if (thi < tq) thi = tq;
        NIT = (tq - tlo + 1) + (thi - tq) + 1;
    }
    const int nleft = tq - tlo + 1;
#define TILE(j) (ALIBI ? ((j) < nleft ? tq - (j) : (tq + 1 + (j) - nleft <= thi ? tq + 1 + (j) - nleft : NT - 1)) : (j))
    const bool active = (qb * 256 + wid * 32) < nk;
    const int qrow = r0 + li;
    const float qlin = (li < n) ? (float)(li + 16) : (li < nk ? (float)(li - n) : 0.f);
    bf16x8 qf[NKS];
#pragma unroll
    for (int ks = 0; ks < NKS; ++ks) qf[ks] = *(const bf16x8*)(Q + (size_t)qrow * DQK + ks * 16 + h * 8);
    f32x16 o[NDB];
#pragma unroll
    for (int d = 0; d < NDB; ++d)
#pragma unroll
        for (int i = 0; i < 16; ++i) o[d][i] = 0.f;
    float m = 0.f, l = 0.f; f32x16 negm, zero16;
#pragma unroll
    for (int i = 0; i < 16; ++i) { negm[i] = 0.f; zero16[i] = 0.f; }
    const bf16_t* kg0 = K + (size_t)r0 * DQK + tid * 8; const bf16_t* vg0 = Vt + (size_t)(tid >> 3) * RA + r0 + (tid & 7) * 8; const int vl0 = VB0 + (tid >> 3) * VROW + (tid & 7) * 16;
#define KL(i) ((((tid + 512 * (i)) / KCH) * KROW) + ((tid + 512 * (i)) % KCH) * 16)
#define KG(i, t) ((gptr)(kg0 + (i) * 4096 + (size_t)(t) * 64 * DQK))
#define VG(i, t) ((gptr)(vg0 + (size_t)(i) * 64 * RA + (size_t)(t) * 64))
#define VL(i) (vl0 + (i) * 64 * VROW)
    const int pr = (r & ~12) | ((r & 4) << 1) | ((r & 8) >> 1);
    const int kaddr = pr * KROW + h * 16, vaddr = VB0 + r * VROW + h * 16;
    u32x4 kst[NKC], vst[NVC], kstn[NKC], vstn[NVC];
#define QK_TILE(A0, A1, kb_) do { const int ko_ = (kb_) * KT + kaddr; \
        _Pragma("unroll") for (int kb4 = 0; kb4 < NKS; kb4 += 4) { bf16x8 kq[8]; \
            _Pragma("unroll") for (int j = 0; j < 4; ++j) { kq[2 * j] = *(const LAS bf16x8*)(lds + ko_ + (kb4 + j) * 32); kq[2 * j + 1] = *(const LAS bf16x8*)(lds + ko_ + 32 * KROW + (kb4 + j) * 32); } \
            asm volatile("" : "+v"(kq[0]), "+v"(kq[1]), "+v"(kq[2]), "+v"(kq[3]), "+v"(kq[4]), "+v"(kq[5]), "+v"(kq[6]), "+v"(kq[7]));     \
            _Pragma("unroll") for (int j = 0; j < 4; ++j) { \
                if (kb4 + j == 0) { A0 = __builtin_amdgcn_mfma_f32_32x32x16_bf16(kq[0], qf[0], NEGM ? negm : zero16, 0, 0, 0); A1 = __builtin_amdgcn_mfma_f32_32x32x16_bf16(kq[1], qf[0], NEGM ? negm : zero16, 0, 0, 0); } \
                else { A0 = __builtin_amdgcn_mfma_f32_32x32x16_bf16(kq[2 * j], qf[kb4 + j], A0, 0, 0, 0); A1 = __builtin_amdgcn_mfma_f32_32x32x16_bf16(kq[2 * j + 1], qf[kb4 + j], A1, 0, 0, 0); } } \
            __builtin_amdgcn_sched_barrier(0); } } while (0)
#pragma unroll
    for (int i = 0; i < NKC; ++i) kst[i] = *KG(i, TILE(0));
#pragma unroll
    for (int i = 0; i < NVC; ++i) vst[i] = *VG(i, TILE(0));
#pragma unroll
    for (int i = 0; i < NKC; ++i) *(LAS u32x4*)(lds + KL(i)) = kst[i];
#pragma unroll
    for (int i = 0; i < NVC; ++i) *(LAS u32x4*)(lds + VL(i)) = vst[i];
    if constexpr (PIPE) {
#pragma unroll
        for (int i = 0; i < NKC; ++i) kst[i] = *KG(i, 1);
#pragma unroll
        for (int i = 0; i < NKC; ++i) *(LAS u32x4*)(lds + KT + KL(i)) = kst[i];
#pragma unroll
        for (int i = 0; i < NKC; ++i) kst[i] = *KG(i, 2);
#pragma unroll
        for (int i = 0; i < NVC; ++i) vst[i] = *VG(i, 1);
    }
    __syncthreads();
    f32x16 s0, s1, n0, n1;
    if constexpr (PIPE) { QK_TILE(s0, s1, 0); __syncthreads(); }
    for (int jt = 0; jt < NIT; ++jt) {
        const int t = PIPE ? jt : TILE(jt), tn = TILE(jt + 1);
        const int cb = jt & 1;
        const bool moreV = (jt + 1 < NIT), moreK = PIPE ? (jt + 2 < NIT) : moreV;
        if constexpr (PIPE) {
            if (t + 3 < NT) {
#pragma unroll
                for (int i = 0; i < NKC; ++i) kstn[i] = *KG(i, t + 3);
            }
            if (t + 2 < NT) {
#pragma unroll
                for (int i = 0; i < NVC; ++i) vstn[i] = *VG(i, t + 2);
            }
        } else {
            if (moreK) {
#pragma unroll
                for (int i = 0; i < NKC; ++i) kst[i] = *KG(i, tn);
            }
            if (moreV) {
#pragma unroll
                for (int i = 0; i < NVC; ++i) vst[i] = *VG(i, tn);
            }
#ifdef PROBE_MEM2
            { int zo = 0; asm volatile("" : "+v"(zo));
              if (moreK) {
#pragma unroll
                for (int i = 0; i < NKC; ++i) { u32x4 d = *(KG(i, t + 1) + zo); asm volatile("" :: "v"(d)); } }
              if (moreV) {
#pragma unroll
                for (int i = 0; i < NVC; ++i) { u32x4 d = *(VG(i, t + 1) + zo); asm volatile("" :: "v"(d)); } } }
#endif
        }
        if (active) {
        if constexpr (PIPE) { if (moreV) QK_TILE(n0, n1, cb ^ 1); }
        else QK_TILE(s0, s1, cb);
        bf16x8 vf0[8];
        if constexpr (EARLYV) {
#pragma unroll
            for (int j = 0; j < 8; ++j) vf0[j] = *(const LAS bf16x8*)(lds + cb * VT + vaddr + (j >> 2) * 32 * VROW + (j & 3) * 32);
        }
        if (t < NT - 1) {
            if constexpr (ALIBI) {
                const float qo = qlin - (float)(16 + 8 * h + t * 64);
#pragma unroll
                for (int i = 0; i < 16; ++i) { const float ci = (float)(16 * (i >> 3) + (i & 7)); s0[i] = __builtin_fmaf(-sl, __builtin_fabsf(qo - ci), s0[i]); s1[i] = __builtin_fmaf(-sl, __builtin_fabsf(qo - 32.f - ci), s1[i]); }
            }
        } else {
#pragma unroll
            for (int i = 0; i < 16; ++i) { const int kk = 16 * (i >> 3) + 8 * h + (i & 7);
                if (kk < 16) { if constexpr (ALIBI) s0[i] = __builtin_fmaf(-sl, __builtin_fabsf(qlin - (float)kk), s0[i]); } else s0[i] = -1e30f;
                s1[i] = -1e30f; }
        }
        float mx;
        { float a = MX2(s0[0], s1[0]), b = MX2(s0[1], s1[1]);
#pragma unroll
          for (int i = 2; i < 16; i += 2) { a = MX2(a, MX2(s0[i], s1[i])); b = MX2(b, MX2(s0[i + 1], s1[i + 1])); }
          mx = swap32_max(MX2(a, b)); }
        if constexpr (!NEGM) mx -= m;
        if (__builtin_expect(jt == 0 || __builtin_amdgcn_ballot_w64(mx > 8.f) != 0ull, 0)) {
            const float dl = (jt == 0) ? mx : fmaxf(mx, 0.f);
            m += dl;
            if constexpr (NEGM) {
#pragma unroll
                for (int i = 0; i < 16; ++i) { s0[i] -= dl; s1[i] -= dl; negm[i] = -m; } }
            if constexpr (PIPE) {
#pragma unroll
                for (int i = 0; i < 16; ++i) { n0[i] -= dl; n1[i] -= dl; } }
            if (jt != 0) { const float f = __builtin_amdgcn_exp2f(-dl); l *= f;
#pragma unroll
                for (int d = 0; d < NDB; ++d)
#pragma unroll
                    for (int i = 0; i < 16; ++i) o[d][i] *= f; }
            asm volatile("" ::: "memory");
        }
        float ra = 0.f, rb = 0.f;
#pragma unroll
        for (int i = 0; i < 16; ++i) { s0[i] = __builtin_amdgcn_exp2f(NEGM ? s0[i] : s0[i] - m); s1[i] = __builtin_amdgcn_exp2f(NEGM ? s1[i] : s1[i] - m); ra += s0[i]; rb += s1[i]; }
        l += ra + rb;
        bf16x8 pf[4];
        { u32x4 w;
          w.x = pk2(s0[0], s0[1]); w.y = pk2(s0[2], s0[3]); w.z = pk2(s0[4], s0[5]); w.w = pk2(s0[6], s0[7]); pf[0] = __builtin_bit_cast(bf16x8, w);
          w.x = pk2(s0[8], s0[9]); w.y = pk2(s0[10], s0[11]); w.z = pk2(s0[12], s0[13]); w.w = pk2(s0[14], s0[15]); pf[1] = __builtin_bit_cast(bf16x8, w);
          w.x = pk2(s1[0], s1[1]); w.y = pk2(s1[2], s1[3]); w.z = pk2(s1[4], s1[5]); w.w = pk2(s1[6], s1[7]); pf[2] = __builtin_bit_cast(bf16x8, w);
          w.x = pk2(s1[8], s1[9]); w.y = pk2(s1[10], s1[11]); w.z = pk2(s1[12], s1[13]); w.w = pk2(s1[14], s1[15]); pf[3] = __builtin_bit_cast(bf16x8, w); }
#pragma unroll
        for (int d0 = 0; d0 < NDB; d0 += 2) { bf16x8 vf[8];
#pragma unroll
            for (int j = 0; j < 8; ++j) { if (EARLYV && d0 == 0) vf[j] = vf0[j]; else vf[j] = *(const LAS bf16x8*)(lds + cb * VT + vaddr + (d0 + (j >> 2)) * 32 * VROW + (j & 3) * 32); }
            asm volatile("" : "+v"(vf[0]), "+v"(vf[1]), "+v"(vf[2]), "+v"(vf[3]), "+v"(vf[4]), "+v"(vf[5]), "+v"(vf[6]), "+v"(vf[7]));
#pragma unroll
            for (int j = 0; j < 8; ++j) o[d0 + (j >> 2)] = __builtin_amdgcn_mfma_f32_32x32x16_bf16(vf[j], pf[j & 3], o[d0 + (j >> 2)], 0, 0, 0);
            __builtin_amdgcn_sched_barrier(0); }
        }
        if (moreK) {
#pragma unroll
            for (int i = 0; i < NKC; ++i) *(LAS u32x4*)(lds + (PIPE ? cb : (cb ^ 1)) * KT + KL(i)) = kst[i];
        }
        if (moreV) {
#pragma unroll
            for (int i = 0; i < NVC; ++i) *(LAS u32x4*)(lds + (cb ^ 1) * VT + VL(i)) = vst[i];
        }
        asm volatile("s_waitcnt lgkmcnt(0)" ::: "memory"); __builtin_amdgcn_s_barrier(); asm volatile("" ::: "memory");
        if constexpr (PIPE) { s0 = n0; s1 = n1;
#pragma unroll
            for (int i = 0; i < NKC; ++i) kst[i] = kstn[i];
#pragma unroll
            for (int i = 0; i < NVC; ++i) vst[i] = vstn[i]; }
    }
    l = swap32_add(l);
    const float il = 1.f / l;
    bf16_t* orow = O + (size_t)qrow * 512;
    if (active)
#pragma unroll
    for (int d = 0; d < NDB; ++d)
#pragma unroll
        for (int g = 0; g < 4; ++g) { u32x2 w; w.x = pk2(o[d][4 * g] * il, o[d][4 * g + 1] * il); w.y = pk2(o[d][4 * g + 2] * il, o[d][4 * g + 3] * il);
            *(u32x2*)(orow + 32 * d + 8 * g + 4 * h) = w; }
#undef KG
#undef KL
#undef VG
#undef VL
#undef QK_TILE
#undef TILE
}

template <int DV, bool ALIBI>
DI void attn_unit2(LAS unsigned char* lds, const bf16_t* __restrict__ Q, const bf16_t* __restrict__ K, const bf16_t* __restrict__ Vt, bf16_t* __restrict__ O, int r0, int qb, int n, float sl, const int wid) {
    constexpr int DQK = 64, KROW = DQK * 2 + 16, KT = 64 * KROW, VROW = 144, VT = DV * VROW, NVC = DV * 8 / 512, NKS = 4, NDB = DV / 32, VB0 = 2 * KT;
    typedef const __attribute__((address_space(1))) u32x4* gptr;
    const int lane = lane_fresh(), tid = wid * 64 + lane, r = lane & 31, h = lane >> 5;
    const int nk = n + 16, NT = (nk + 63) >> 6;
    const int li = qb * 256 + wid * 32 + r;
    const int qrow = r0 + li;
    const float qlin = (li < n) ? (float)(li + 16) : (li < nk ? (float)(li - n) : 0.f);
    bf16x8 qf[NKS];
#pragma unroll
    for (int ks = 0; ks < NKS; ++ks) qf[ks] = *(const bf16x8*)(Q + (size_t)qrow * DQK + ks * 16 + h * 8);
    f32x16 o[NDB];
#pragma unroll
    for (int d = 0; d < NDB; ++d)
#pragma unroll
        for (int i = 0; i < 16; ++i) o[d][i] = 0.f;
    float m = 0.f, l = 0.f; f32x16 negm;
#pragma unroll
    for (int i = 0; i < 16; ++i) negm[i] = 0.f;
    const bf16_t* kg0 = K + (size_t)r0 * DQK + tid * 8; const bf16_t* vg0 = Vt + (size_t)(tid >> 3) * RA + r0 + (tid & 7) * 8;
    const int kl0 = (tid >> 3) * KROW + (tid & 7) * 16, vl0 = VB0 + (tid >> 3) * VROW + (tid & 7) * 16;
#define KG2(t) ((gptr)(kg0 + (size_t)(t) * 64 * DQK))
#define VG2(i, t) ((gptr)(vg0 + (size_t)(i) * 64 * RA + (size_t)(t) * 64))
    const int pr = (r & ~12) | ((r & 4) << 1) | ((r & 8) >> 1);
    const int kaddr = pr * KROW + h * 16, vaddr = VB0 + r * VROW + h * 16;
    u32x4 kst, vst[NVC];
    bf16x8 kf[8];
#define LDK(kb_) do { _Pragma("unroll") for (int ks = 0; ks < 4; ++ks) { kf[2 * ks] = *(const LAS bf16x8*)(lds + (kb_) * KT + kaddr + ks * 32); kf[2 * ks + 1] = *(const LAS bf16x8*)(lds + (kb_) * KT + kaddr + 32 * KROW + ks * 32); } \
        asm volatile("" : "+v"(kf[0]), "+v"(kf[1]), "+v"(kf[2]), "+v"(kf[3]), "+v"(kf[4]), "+v"(kf[5]), "+v"(kf[6]), "+v"(kf[7])); } while (0)
#define QKM(A0, A1) do { A0 = __builtin_amdgcn_mfma_f32_32x32x16_bf16(kf[0], qf[0], negm, 0, 0, 0); A1 = __builtin_amdgcn_mfma_f32_32x32x16_bf16(kf[1], qf[0], negm, 0, 0, 0); \
        _Pragma("unroll") for (int ks = 1; ks < 4; ++ks) { A0 = __builtin_amdgcn_mfma_f32_32x32x16_bf16(kf[2 * ks], qf[ks], A0, 0, 0, 0); A1 = __builtin_amdgcn_mfma_f32_32x32x16_bf16(kf[2 * ks + 1], qf[ks], A1, 0, 0, 0); } } while (0)
#define PV2(vb_, d0_) do { bf16x8 vf[8]; \
        _Pragma("unroll") for (int j = 0; j < 8; ++j) vf[j] = *(const LAS bf16x8*)(lds + (vb_) * VT + vaddr + ((d0_) + (j >> 2)) * 32 * VROW + (j & 3) * 32); \
        asm volatile("" : "+v"(vf[0]), "+v"(vf[1]), "+v"(vf[2]), "+v"(vf[3]), "+v"(vf[4]), "+v"(vf[5]), "+v"(vf[6]), "+v"(vf[7])); \
        _Pragma("unroll") for (int j = 0; j < 8; ++j) o[(d0_) + (j >> 2)] = __builtin_amdgcn_mfma_f32_32x32x16_bf16(vf[j], pf[j & 3], o[(d0_) + (j >> 2)], 0, 0, 0); } while (0)
    kst = *KG2(0);
#pragma unroll
    for (int i = 0; i < NVC; ++i) vst[i] = *VG2(i, 0);
    *(LAS u32x4*)(lds + kl0) = kst;
#pragma unroll
    for (int i = 0; i < NVC; ++i) *(LAS u32x4*)(lds + vl0 + i * 64 * VROW) = vst[i];
    kst = *KG2(1);
    *(LAS u32x4*)(lds + KT + kl0) = kst;
    __syncthreads();
    f32x16 s0, s1, n0, n1;
    bf16x8 pf[4];
    LDK(0); QKM(s0, s1);
    __syncthreads();
    int vcur = 0;
    for (int t = 0; t < NT; ++t) {
        const int cb = t & 1;
        const bool moreV = (t + 1 < NT), moreK = (t + 2 < NT);
        const int vprev = (vcur == 0) ? 2 : vcur - 1, vnext = (vcur == 2) ? 0 : vcur + 1;
        if (moreK) kst = *KG2(t + 2);
        if (moreV) {
#pragma unroll
            for (int i = 0; i < NVC; ++i) vst[i] = *VG2(i, t + 1);
        }
#ifdef PROBE_MEM2
        { int zo = 0; asm volatile("" : "+v"(zo));
          if (moreK) { u32x4 d = *(KG2(t + 2) + zo); asm volatile("" :: "v"(d)); }
          if (moreV) {
#pragma unroll
            for (int i = 0; i < NVC; ++i) { u32x4 d = *(VG2(i, t + 1) + zo); asm volatile("" :: "v"(d)); } } }
#endif
        __builtin_amdgcn_s_setprio(1);
        if (moreV) { LDK(cb ^ 1); QKM(n0, n1); }
        if (t > 0) { PV2(vprev, 0); if constexpr (NDB == 4) PV2(vprev, 2); }
        __builtin_amdgcn_s_setprio(0);
        if (t < NT - 1) {
            if constexpr (ALIBI) {
                const float qo = qlin - (float)(16 + 8 * h + t * 64);
#pragma unroll
                for (int i = 0; i < 16; ++i) { const float ci = (float)(16 * (i >> 3) + (i & 7)); s0[i] = __builtin_fmaf(-sl, __builtin_fabsf(qo - ci), s0[i]); s1[i] = __builtin_fmaf(-sl, __builtin_fabsf(qo - 32.f - ci), s1[i]); }
            }
        } else {
#pragma unroll
            for (int i = 0; i < 16; ++i) { const int kk = 16 * (i >> 3) + 8 * h + (i & 7);
                if (kk < 16) { if constexpr (ALIBI) s0[i] = __builtin_fmaf(-sl, __builtin_fabsf(qlin - (float)kk), s0[i]); } else s0[i] = -1e30f;
                s1[i] = -1e30f; }
        }
        float mx;
        { float a = MX2(s0[0], s1[0]), b = MX2(s0[1], s1[1]);
#pragma unroll
          for (int i = 2; i < 16; i += 2) { a = MX2(a, MX2(s0[i], s1[i])); b = MX2(b, MX2(s0[i + 1], s1[i + 1])); }
          mx = swap32_max(MX2(a, b)); }
        if (__builtin_expect(t == 0 || __builtin_amdgcn_ballot_w64(mx > 8.f) != 0ull, 0)) {
            const float dl = (t == 0) ? mx : fmaxf(mx, 0.f);
            m += dl;
#pragma unroll
            for (int i = 0; i < 16; ++i) { s0[i] -= dl; s1[i] -= dl; n0[i] -= dl; n1[i] -= dl; negm[i] = -m; }
            if (t != 0) { const float f = __builtin_amdgcn_exp2f(-dl); l *= f;
#pragma unroll
                for (int d = 0; d < NDB; ++d)
#pragma unroll
                    for (int i = 0; i < 16; ++i) o[d][i] *= f; }
            asm volatile("" ::: "memory");
        }
        float ra = 0.f, rb = 0.f;
#pragma unroll
        for (int i = 0; i < 16; ++i) { s0[i] = __builtin_amdgcn_exp2f(s0[i]); s1[i] = __builtin_amdgcn_exp2f(s1[i]); ra += s0[i]; rb += s1[i]; }
        l += ra + rb;
        { u32x4 w;
          w.x = pk2(s0[0], s0[1]); w.y = pk2(s0[2], s0[3]); w.z = pk2(s0[4], s0[5]); w.w = pk2(s0[6], s0[7]); pf[0] = __builtin_bit_cast(bf16x8, w);
          w.x = pk2(s0[8], s0[9]); w.y = pk2(s0[10], s0[11]); w.z = pk2(s0[12], s0[13]); w.w = pk2(s0[14], s0[15]); pf[1] = __builtin_bit_cast(bf16x8, w);
          w.x = pk2(s1[0], s1[1]); w.y = pk2(s1[2], s1[3]); w.z = pk2(s1[4], s1[5]); w.w = pk2(s1[6], s1[7]); pf[2] = __builtin_bit_cast(bf16x8, w);
          w.x = pk2(s1[8], s1[9]); w.y = pk2(s1[10], s1[11]); w.z = pk2(s1[12], s1[13]); w.w = pk2(s1[14], s1[15]); pf[3] = __builtin_bit_cast(bf16x8, w); }
        if (moreK) *(LAS u32x4*)(lds + cb * KT + kl0) = kst;
        if (moreV) {
#pragma unroll
            for (int i = 0; i < NVC; ++i) *(LAS u32x4*)(lds + vnext * VT + vl0 + i * 64 * VROW) = vst[i];
        }
        asm volatile("s_waitcnt lgkmcnt(0)" ::: "memory"); __builtin_amdgcn_s_barrier(); asm volatile("" ::: "memory");
        s0 = n0; s1 = n1; vcur = vnext;
    }
    { const int vlast = (vcur == 0) ? 2 : vcur - 1; PV2(vlast, 0); if constexpr (NDB == 4) PV2(vlast, 2); }
    asm volatile("s_waitcnt lgkmcnt(0)" ::: "memory"); __builtin_amdgcn_s_barrier(); asm volatile("" ::: "memory");
    l = swap32_add(l);
    const float il = 1.f / l;
    bf16_t* orow = O + (size_t)qrow * 512;
#pragma unroll
    for (int d = 0; d < NDB; ++d)
#pragma unroll
        for (int g = 0; g < 4; ++g) { u32x2 w; w.x = pk2(o[d][4 * g] * il, o[d][4 * g + 1] * il); w.y = pk2(o[d][4 * g + 2] * il, o[d][4 * g + 3] * il);
            *(u32x2*)(orow + 32 * d + 8 * g + 4 * h) = w; }
#undef KG2
#undef VG2
#undef LDK
#undef QKM
#undef PV2
}


template <int DQK, int DV, bool ALIBI>
DI void attn_unit_s(LAS unsigned char* lds, const bf16_t* __restrict__ Q, const bf16_t* __restrict__ K, const bf16_t* __restrict__ Vt, bf16_t* __restrict__ O, int r0, int qb, int n, float sl, const int wid) {
    constexpr bool NEGM = (DQK == 64);
    constexpr int KROW = DQK * 2 + 16, KT = 64 * KROW, VROW = 144, VT = DV * VROW, KCH = DQK / 8, NKC = 64 * KCH / 512, NVC = DV * 8 / 512, NKS = DQK / 16, NDB = DV / 32, VB0 = 2 * KT;
    typedef const __attribute__((address_space(1))) u32x4* gptr;
#define LBAR() do { asm volatile("s_waitcnt lgkmcnt(0)" ::: "memory"); __builtin_amdgcn_s_barrier(); asm volatile("" ::: "memory"); } while (0)
#ifdef GRP_ODD
    const int grp_ = wid & 1;
#else
    const int grp_ = wid >> 2;
#endif
    const int lane = lane_fresh(), tid = wid * 64 + lane, r = lane & 31, h = lane >> 5, grp = grp_;
    const int nk = n + 16, NT = (nk + 63) >> 6;
    const int li = qb * 256 + wid * 32 + r;
    const int qrow = r0 + li;
    const float qlin = (li < n) ? (float)(li + 16) : (li < nk ? (float)(li - n) : 0.f);
    bf16x8 qf[NKS];
#pragma unroll
    for (int ks = 0; ks < NKS; ++ks) qf[ks] = *(const bf16x8*)(Q + (size_t)qrow * DQK + ks * 16 + h * 8);
    f32x16 o[NDB];
#pragma unroll
    for (int d = 0; d < NDB; ++d)
#pragma unroll
        for (int i = 0; i < 16; ++i) o[d][i] = 0.f;
    float m = 0.f, l = 0.f; f32x16 negm, zero16;
#pragma unroll
    for (int i = 0; i < 16; ++i) { negm[i] = 0.f; zero16[i] = 0.f; }
    const bf16_t* kg0 = K + (size_t)r0 * DQK + tid * 8; const bf16_t* vg0 = Vt + (size_t)(tid >> 3) * RA + r0 + (tid & 7) * 8; const int vl0 = VB0 + (tid >> 3) * VROW + (tid & 7) * 16;
#define KL(i) ((((tid + 512 * (i)) / KCH) * KROW) + ((tid + 512 * (i)) % KCH) * 16)
#define KG(i, t) ((gptr)(kg0 + (i) * 4096 + (size_t)(t) * 64 * DQK))
#define VG(i, t) ((gptr)(vg0 + (size_t)(i) * 64 * RA + (size_t)(t) * 64))
#define VL(i) (vl0 + (i) * 64 * VROW)
    const int pr = (r & ~12) | ((r & 4) << 1) | ((r & 8) >> 1);
    const int kaddr = pr * KROW + h * 16, vaddr = VB0 + r * VROW + h * 16;
    u32x4 kst[NKC], vst[NVC];
#pragma unroll
    for (int i = 0; i < NKC; ++i) kst[i] = *KG(i, 0);
#pragma unroll
    for (int i = 0; i < NKC; ++i) *(LAS u32x4*)(lds + KL(i)) = kst[i];
#pragma unroll
    for (int i = 0; i < NKC; ++i) kst[i] = *KG(i, 1);
#pragma unroll
    for (int i = 0; i < NVC; ++i) vst[i] = *VG(i, 0);
    __syncthreads();
    if (grp == 1) LBAR();
    f32x16 s0, s1; bf16x8 pf[4];
    for (int t = 0; t < NT; ++t) {
        const int cb = t & 1;
        { const int ko_ = cb * KT + kaddr;
#pragma unroll
          for (int kb4 = 0; kb4 < NKS; kb4 += 4) { bf16x8 kq[8];
#pragma unroll
            for (int j = 0; j < 4; ++j) { kq[2 * j] = *(const LAS bf16x8*)(lds + ko_ + (kb4 + j) * 32); kq[2 * j + 1] = *(const LAS bf16x8*)(lds + ko_ + 32 * KROW + (kb4 + j) * 32); }
            asm volatile("" : "+v"(kq[0]), "+v"(kq[1]), "+v"(kq[2]), "+v"(kq[3]), "+v"(kq[4]), "+v"(kq[5]), "+v"(kq[6]), "+v"(kq[7]));
#pragma unroll
            for (int j = 0; j < 4; ++j) {
                if (kb4 + j == 0) { s0 = __builtin_amdgcn_mfma_f32_32x32x16_bf16(kq[0], qf[0], NEGM ? negm : zero16, 0, 0, 0); s1 = __builtin_amdgcn_mfma_f32_32x32x16_bf16(kq[1], qf[0], NEGM ? negm : zero16, 0, 0, 0); }
                else { s0 = __builtin_amdgcn_mfma_f32_32x32x16_bf16(kq[2 * j], qf[kb4 + j], s0, 0, 0, 0); s1 = __builtin_amdgcn_mfma_f32_32x32x16_bf16(kq[2 * j + 1], qf[kb4 + j], s1, 0, 0, 0); } }
            __builtin_amdgcn_sched_barrier(0); } }
        if (t > 0) {
#pragma unroll
            for (int d0 = 0; d0 < NDB; d0 += 2) { bf16x8 vf[8];
#pragma unroll
                for (int j = 0; j < 8; ++j) vf[j] = *(const LAS bf16x8*)(lds + (cb ^ 1) * VT + vaddr + (d0 + (j >> 2)) * 32 * VROW + (j & 3) * 32);
                asm volatile("" : "+v"(vf[0]), "+v"(vf[1]), "+v"(vf[2]), "+v"(vf[3]), "+v"(vf[4]), "+v"(vf[5]), "+v"(vf[6]), "+v"(vf[7]));
#pragma unroll
                for (int j = 0; j < 8; ++j) o[d0 + (j >> 2)] = __builtin_amdgcn_mfma_f32_32x32x16_bf16(vf[j], pf[j & 3], o[d0 + (j >> 2)], 0, 0, 0);
                __builtin_amdgcn_sched_barrier(0); }
        }
        if (t + 1 < NT) {
#pragma unroll
            for (int i = 0; i < NKC; ++i) *(LAS u32x4*)(lds + (cb ^ 1) * KT + KL(i)) = kst[i];
        }
#pragma unroll
        for (int i = 0; i < NVC; ++i) *(LAS u32x4*)(lds + cb * VT + VL(i)) = vst[i];
        LBAR();
        if (t + 2 < NT) {
#pragma unroll
            for (int i = 0; i < NKC; ++i) kst[i] = *KG(i, t + 2);
        }
        if (t + 1 < NT) {
#pragma unroll
            for (int i = 0; i < NVC; ++i) vst[i] = *VG(i, t + 1);
        }
        if (t < NT - 1) {
            if constexpr (ALIBI) {
                const float qo = qlin - (float)(16 + 8 * h + t * 64);
#pragma unroll
                for (int i = 0; i < 16; ++i) { const float ci = (float)(16 * (i >> 3) + (i & 7)); s0[i] = __builtin_fmaf(-sl, __builtin_fabsf(qo - ci), s0[i]); s1[i] = __builtin_fmaf(-sl, __builtin_fabsf(qo - 32.f - ci), s1[i]); }
            }
        } else {
#pragma unroll
            for (int i = 0; i < 16; ++i) { const int kk = 16 * (i >> 3) + 8 * h + (i & 7);
                if (kk < 16) { if constexpr (ALIBI) s0[i] = __builtin_fmaf(-sl, __builtin_fabsf(qlin - (float)kk), s0[i]); } else s0[i] = -1e30f;
                s1[i] = -1e30f; }
        }
        float mx;
        { float a = MX2(s0[0], s1[0]), b = MX2(s0[1], s1[1]);
#pragma unroll
          for (int i = 2; i < 16; i += 2) { a = MX2(a, MX2(s0[i], s1[i])); b = MX2(b, MX2(s0[i + 1], s1[i + 1])); }
          mx = swap32_max(MX2(a, b)); }
        if constexpr (!NEGM) mx -= m;
        if (__builtin_expect(t == 0 || __builtin_amdgcn_ballot_w64(mx > 8.f) != 0ull, 0)) {
            const float dl = (t == 0) ? mx : fmaxf(mx, 0.f);
            m += dl;
            if constexpr (NEGM) {
#pragma unroll
                for (int i = 0; i < 16; ++i) { s0[i] -= dl; s1[i] -= dl; negm[i] = -m; } }
            if (t != 0) { const float f = __builtin_amdgcn_exp2f(-dl); l *= f;
#pragma unroll
                for (int d = 0; d < NDB; ++d)
#pragma unroll
                    for (int i = 0; i < 16; ++i) o[d][i] *= f; }
            asm volatile("" ::: "memory");
        }
        float ra = 0.f, rb = 0.f;
#pragma unroll
        for (int i = 0; i < 16; ++i) { s0[i] = __builtin_amdgcn_exp2f(NEGM ? s0[i] : s0[i] - m); s1[i] = __builtin_amdgcn_exp2f(NEGM ? s1[i] : s1[i] - m); ra += s0[i]; rb += s1[i]; }
        l += ra + rb;
        { u32x4 w;
          w.x = pk2(s0[0], s0[1]); w.y = pk2(s0[2], s0[3]); w.z = pk2(s0[4], s0[5]); w.w = pk2(s0[6], s0[7]); pf[0] = __builtin_bit_cast(bf16x8, w);
          w.x = pk2(s0[8], s0[9]); w.y = pk2(s0[10], s0[11]); w.z = pk2(s0[12], s0[13]); w.w = pk2(s0[14], s0[15]); pf[1] = __builtin_bit_cast(bf16x8, w);
          w.x = pk2(s1[0], s1[1]); w.y = pk2(s1[2], s1[3]); w.z = pk2(s1[4], s1[5]); w.w = pk2(s1[6], s1[7]); pf[2] = __builtin_bit_cast(bf16x8, w);
          w.x = pk2(s1[8], s1[9]); w.y = pk2(s1[10], s1[11]); w.z = pk2(s1[12], s1[13]); w.w = pk2(s1[14], s1[15]); pf[3] = __builtin_bit_cast(bf16x8, w); }
        LBAR();
    }
    { const int vb = (NT - 1) & 1;
#pragma unroll
      for (int d0 = 0; d0 < NDB; d0 += 2) { bf16x8 vf[8];
#pragma unroll
        for (int j = 0; j < 8; ++j) vf[j] = *(const LAS bf16x8*)(lds + vb * VT + vaddr + (d0 + (j >> 2)) * 32 * VROW + (j & 3) * 32);
        asm volatile("" : "+v"(vf[0]), "+v"(vf[1]), "+v"(vf[2]), "+v"(vf[3]), "+v"(vf[4]), "+v"(vf[5]), "+v"(vf[6]), "+v"(vf[7]));
#pragma unroll
        for (int j = 0; j < 8; ++j) o[d0 + (j >> 2)] = __builtin_amdgcn_mfma_f32_32x32x16_bf16(vf[j], pf[j & 3], o[d0 + (j >> 2)], 0, 0, 0); } }
    if (grp == 0) LBAR();
    LBAR();
    l = swap32_add(l);
    const float il = 1.f / l;
    bf16_t* orow = O + (size_t)qrow * 512;
#pragma unroll
    for (int d = 0; d < NDB; ++d)
#pragma unroll
        for (int g = 0; g < 4; ++g) { u32x2 w; w.x = pk2(o[d][4 * g] * il, o[d][4 * g + 1] * il); w.y = pk2(o[d][4 * g + 2] * il, o[d][4 * g + 3] * il);
            *(u32x2*)(orow + 32 * d + 8 * g + 4 * h) = w; }
#undef KG
#undef KL
#undef VG
#undef VL
#undef LBAR
}

DI void attn_unit_a64(LAS unsigned char* lds, const bf16_t* __restrict__ Q, const bf16_t* __restrict__ K, const bf16_t* __restrict__ Vt, bf16_t* __restrict__ O, int r0, int qb, int n, int seqrows, const int wid) {
    constexpr int DQK = 64, KROW = 144, KT = 64 * KROW, VROW = 144, VT = 64 * VROW, VB0 = 2 * KT;
    typedef const __attribute__((address_space(1))) u32x4* gptr;
    const int lane = lane_fresh(), tid = wid * 64 + lane, r = lane & 31, h = lane >> 5;
    const int nk = n + 16, NT = (nk + 63) >> 6;
    const int li0 = qb * 512 + wid * 64 + r, li1 = li0 + 32;
    bf16x8 qf0[4], qf1[4];
#pragma unroll
    for (int ks = 0; ks < 4; ++ks) { qf0[ks] = *(const bf16x8*)(Q + (size_t)(r0 + li0) * DQK + ks * 16 + h * 8); qf1[ks] = *(const bf16x8*)(Q + (size_t)(r0 + li1) * DQK + ks * 16 + h * 8); }
    f32x16 oa0, oa1, ob0, ob1, zero16;
#pragma unroll
    for (int i = 0; i < 16; ++i) { oa0[i] = 0.f; oa1[i] = 0.f; ob0[i] = 0.f; ob1[i] = 0.f; zero16[i] = 0.f; }
    float ma = 0.f, mb = 0.f, la = 0.f, lb = 0.f;
    const bf16_t* kg0 = K + (size_t)r0 * DQK + tid * 8; const bf16_t* vg0 = Vt + (size_t)(tid >> 3) * RA + r0 + (tid & 7) * 8;
    const int kl0 = (tid >> 3) * KROW + (tid & 7) * 16, vl0 = VB0 + (tid >> 3) * VROW + (tid & 7) * 16;
    const int pr = (r & ~12) | ((r & 4) << 1) | ((r & 8) >> 1);
    const int kaddr = pr * KROW + h * 16, vaddr = VB0 + r * VROW + h * 16;
    u32x4 kst, vst;
    kst = *(gptr)kg0; vst = *(gptr)vg0;
    *(LAS u32x4*)(lds + kl0) = kst; *(LAS u32x4*)(lds + vl0) = vst;
    __syncthreads();
#define SOFTMAX64(S0, S1, M, L, OX0, OX1) do { \
        if (t == NT - 1) { _Pragma("unroll") for (int i = 0; i < 16; ++i) { if (i >= 8) S0[i] = -1e30f; S1[i] = -1e30f; } } \
        float a_ = MX2(S0[0], S1[0]), b_ = MX2(S0[1], S1[1]); \
        _Pragma("unroll") for (int i = 2; i < 16; i += 2) { a_ = MX2(a_, MX2(S0[i], S1[i])); b_ = MX2(b_, MX2(S0[i + 1], S1[i + 1])); } \
        const float mx_ = swap32_max(MX2(a_, b_)) - M; \
        if (__builtin_expect(t == 0 || __builtin_amdgcn_ballot_w64(mx_ > 8.f) != 0ull, 0)) { \
            const float dl_ = (t == 0) ? mx_ : fmaxf(mx_, 0.f); M += dl_; \
            if (t != 0) { const float f_ = __builtin_amdgcn_exp2f(-dl_); L *= f_; _Pragma("unroll") for (int i = 0; i < 16; ++i) { OX0[i] *= f_; OX1[i] *= f_; } } \
            asm volatile("" ::: "memory"); } \
        float ra_ = 0.f, rb_ = 0.f; \
        _Pragma("unroll") for (int i = 0; i < 16; ++i) { S0[i] = __builtin_amdgcn_exp2f(S0[i] - M); S1[i] = __builtin_amdgcn_exp2f(S1[i] - M); ra_ += S0[i]; rb_ += S1[i]; } \
        L += ra_ + rb_; \
        u32x4 w_; \
        w_.x = pk2(S0[0], S0[1]); w_.y = pk2(S0[2], S0[3]); w_.z = pk2(S0[4], S0[5]); w_.w = pk2(S0[6], S0[7]); pf[0] = __builtin_bit_cast(bf16x8, w_); \
        w_.x = pk2(S0[8], S0[9]); w_.y = pk2(S0[10], S0[11]); w_.z = pk2(S0[12], S0[13]); w_.w = pk2(S0[14], S0[15]); pf[1] = __builtin_bit_cast(bf16x8, w_); \
        w_.x = pk2(S1[0], S1[1]); w_.y = pk2(S1[2], S1[3]); w_.z = pk2(S1[4], S1[5]); w_.w = pk2(S1[6], S1[7]); pf[2] = __builtin_bit_cast(bf16x8, w_); \
        w_.x = pk2(S1[8], S1[9]); w_.y = pk2(S1[10], S1[11]); w_.z = pk2(S1[12], S1[13]); w_.w = pk2(S1[14], S1[15]); pf[3] = __builtin_bit_cast(bf16x8, w_); } while (0)
    for (int t = 0; t < NT; ++t) {
        const int cb = t & 1; const bool more = (t + 1 < NT);
        if (more) { kst = *(gptr)(kg0 + (size_t)(t + 1) * 64 * DQK); vst = *(gptr)(vg0 + (size_t)(t + 1) * 64); }
        bf16x8 kq[8];
#pragma unroll
        for (int j = 0; j < 4; ++j) { kq[2 * j] = *(const LAS bf16x8*)(lds + cb * KT + kaddr + j * 32); kq[2 * j + 1] = *(const LAS bf16x8*)(lds + cb * KT + kaddr + 32 * KROW + j * 32); }
        asm volatile("" : "+v"(kq[0]), "+v"(kq[1]), "+v"(kq[2]), "+v"(kq[3]), "+v"(kq[4]), "+v"(kq[5]), "+v"(kq[6]), "+v"(kq[7]));
        f32x16 sa0, sa1, sb0, sb1;
        sa0 = __builtin_amdgcn_mfma_f32_32x32x16_bf16(kq[0], qf0[0], zero16, 0, 0, 0); sa1 = __builtin_amdgcn_mfma_f32_32x32x16_bf16(kq[1], qf0[0], zero16, 0, 0, 0);
#pragma unroll
        for (int j = 1; j < 4; ++j) { sa0 = __builtin_amdgcn_mfma_f32_32x32x16_bf16(kq[2 * j], qf0[j], sa0, 0, 0, 0); sa1 = __builtin_amdgcn_mfma_f32_32x32x16_bf16(kq[2 * j + 1], qf0[j], sa1, 0, 0, 0); }
        sb0 = __builtin_amdgcn_mfma_f32_32x32x16_bf16(kq[0], qf1[0], zero16, 0, 0, 0); sb1 = __builtin_amdgcn_mfma_f32_32x32x16_bf16(kq[1], qf1[0], zero16, 0, 0, 0);
#pragma unroll
        for (int j = 1; j < 4; ++j) { sb0 = __builtin_amdgcn_mfma_f32_32x32x16_bf16(kq[2 * j], qf1[j], sb0, 0, 0, 0); sb1 = __builtin_amdgcn_mfma_f32_32x32x16_bf16(kq[2 * j + 1], qf1[j], sb1, 0, 0, 0); }
        bf16x8 vf[8];
#pragma unroll
        for (int j = 0; j < 8; ++j) vf[j] = *(const LAS bf16x8*)(lds + cb * VT + vaddr + (j >> 2) * 32 * VROW + (j & 3) * 32);
        bf16x8 pf[4];
        SOFTMAX64(sa0, sa1, ma, la, oa0, oa1);
        asm volatile("" : "+v"(vf[0]), "+v"(vf[1]), "+v"(vf[2]), "+v"(vf[3]), "+v"(vf[4]), "+v"(vf[5]), "+v"(vf[6]), "+v"(vf[7]));
#pragma unroll
        for (int j = 0; j < 4; ++j) { oa0 = __builtin_amdgcn_mfma_f32_32x32x16_bf16(vf[j], pf[j], oa0, 0, 0, 0); oa1 = __builtin_amdgcn_mfma_f32_32x32x16_bf16(vf[4 + j], pf[j], oa1, 0, 0, 0); }
        SOFTMAX64(sb0, sb1, mb, lb, ob0, ob1);
#pragma unroll
        for (int j = 0; j < 4; ++j) { ob0 = __builtin_amdgcn_mfma_f32_32x32x16_bf16(vf[j], pf[j], ob0, 0, 0, 0); ob1 = __builtin_amdgcn_mfma_f32_32x32x16_bf16(vf[4 + j], pf[j], ob1, 0, 0, 0); }
        if (more) { *(LAS u32x4*)(lds + (cb ^ 1) * KT + kl0) = kst; *(LAS u32x4*)(lds + (cb ^ 1) * VT + vl0) = vst; }
        asm volatile("s_waitcnt lgkmcnt(0)" ::: "memory"); __builtin_amdgcn_s_barrier(); asm volatile("" ::: "memory");
    }
#undef SOFTMAX64
    la = swap32_add(la); lb = swap32_add(lb);
    const float ia = 1.f / la, ib = 1.f / lb;
    if (li0 < seqrows) { bf16_t* orow = O + (size_t)(r0 + li0) * 512;
#pragma unroll
        for (int g = 0; g < 4; ++g) { u32x2 w; w.x = pk2(oa0[4 * g] * ia, oa0[4 * g + 1] * ia); w.y = pk2(oa0[4 * g + 2] * ia, oa0[4 * g + 3] * ia); *(u32x2*)(orow + 8 * g + 4 * h) = w;
            w.x = pk2(oa1[4 * g] * ia, oa1[4 * g + 1] * ia); w.y = pk2(oa1[4 * g + 2] * ia, oa1[4 * g + 3] * ia); *(u32x2*)(orow + 32 + 8 * g + 4 * h) = w; } }
    if (li1 < seqrows) { bf16_t* orow = O + (size_t)(r0 + li1) * 512;
#pragma unroll
        for (int g = 0; g < 4; ++g) { u32x2 w; w.x = pk2(ob0[4 * g] * ib, ob0[4 * g + 1] * ib); w.y = pk2(ob0[4 * g + 2] * ib, ob0[4 * g + 3] * ib); *(u32x2*)(orow + 8 * g + 4 * h) = w;
            w.x = pk2(ob1[4 * g] * ib, ob1[4 * g + 1] * ib); w.y = pk2(ob1[4 * g + 2] * ib, ob1[4 * g + 3] * ib); *(u32x2*)(orow + 32 + 8 * g + 4 * h) = w; } }
}

#if defined(STAGGER) && !defined(STAGGER_NOC)
#define ATTN_C attn_unit_s<192, 128, false>
#else
#define ATTN_C attn_unit<192, 128, false, false>
#endif
#if defined(STAGGER)
#define ATTN_B attn_unit_s<64, 128, true>
#define ATTN_A attn_unit_s<64, 64, false>
#elif defined(NOPIPE_AB)
#define ATTN_B attn_unit<64, 128, true, false>
#define ATTN_A attn_unit<64, 64, false, false>
#else
#define ATTN_B attn_unit<64, 128, true, false>
#define ATTN_A attn_unit2<64, false>
#endif
DI void attn_phase(const Params& p, const Chunk& ck, bool last, const int lidx, LAS unsigned char* lds, unsigned* q  , const int wave) {
    unsigned char* ws = p.ws; asm volatile("" : "+s"(ws));
    const bf16_t* QKV = (const bf16_t*)(ws + WS_QKV); bf16_t* OB = (bf16_t*)(ws + WS_ZM);
#if defined(PROBE_DUPC)
    constexpr int NDUP = 8, DUP0 = 0;
#elif defined(PROBE_DUPB)
    constexpr int NDUP = 16, DUP0 = 8;
#elif defined(PROBE_DUPA)
    constexpr int NDUP = 16, DUP0 = 24;
#else
    constexpr int NDUP = 0, DUP0 = 0;
#endif
    const int nmeta = last ? 0 : 20 * ck.nseq, nms = (nmeta + 7) >> 3, nsuper = nms + 40 + NDUP;
    volatile LAS int* su = (volatile LAS int*)(lds + LDS_MISC);
    float qkb;
    { const int ln = lane_fresh(); float gq = fabsf(p.in[8][lidx * 64 + ln]), gk = fabsf(p.in[9][lidx * 64 + ln]);
#pragma unroll
      for (int o = 1; o < 64; o <<= 1) { gq = fmaxf(gq, __int_as_float(__builtin_amdgcn_ds_bpermute((ln ^ o) << 2, __float_as_int(gq)))); gk = fmaxf(gk, __int_as_float(__builtin_amdgcn_ds_bpermute((ln ^ o) << 2, __float_as_int(gk)))); }
      qkb = 1.05f * 64.f * 0.125f * LOG2E * gq * gk; }
    for (;;) {
        if (wave == 0 && lane_fresh() == 0) {
#ifdef FLATQ
            const unsigned x = 0u;
#else
            const unsigned x = (unsigned)__builtin_amdgcn_s_getreg((3 << 11) | 20) & 0xFu;
#endif
            int res = -1, lin = 0;
            for (;;) {
                const unsigned idx = __hip_atomic_fetch_add(q + 64 + 16 * x, 1u, __ATOMIC_RELAXED, __HIP_MEMORY_SCOPE_AGENT);
                const unsigned slot = (idx >> 5) & 63u; lin = (int)(idx & 31u);
                unsigned* te = q + 512 + x * 64 + slot; unsigned g;
                if (lin == 0) { g = __hip_atomic_fetch_add(q, 1u, __ATOMIC_RELAXED, __HIP_MEMORY_SCOPE_AGENT); __hip_atomic_store(te, g + 1u, __ATOMIC_RELAXED, __HIP_MEMORY_SCOPE_AGENT); }
                else { while ((g = __hip_atomic_load(te, __ATOMIC_RELAXED, __HIP_MEMORY_SCOPE_AGENT)) == 0u) __builtin_amdgcn_s_sleep(2); g -= 1u; }
                if ((int)g >= nsuper) { res = -1; break; }
                if ((int)g < nms && (lin >= 8 || (int)g * 8 + lin >= nmeta)) continue;
#ifdef A64
                if ((int)g >= nms + 24) {
                    const int sub_ = ((int)g - nms) & 1;
                    if (ck.nseq == 1 ? (sub_ == 1) : (lin >= 16)) continue; }
#endif
                res = (int)g; break;
            }
            su[0] = res; su[1] = lin;
        }
        __syncthreads();
        const int g = su[0], lin = su[1];
        __syncthreads();
        if (g < 0) break;
        int type, hd, s, qb;
        int sh = ck.nseq - 1; asm volatile("" : "+s"(sh));
        if (g < nms) { const int mu = g * 8 + lin, jh = mu >> sh; s = mu & sh; qb = ck.tps - 1;
            if (jh < 4) { type = 0; hd = jh; } else if (jh < 12) { type = 1; hd = jh - 4; } else { type = 2; hd = jh - 12; } }
        else { const int gr0 = g - nms, gr = gr0 >= 40 ? gr0 - 40 + DUP0 : gr0, sub = gr & 1;
            if (gr < 8) { type = 0; hd = gr >> 1; } else if (gr < 16) { type = 1; hd = 7 - ((gr - 8) >> 1); } else if (gr < 32) { type = 2; hd = (gr - 16) >> 1; } else { type = 1; hd = 3 - ((gr - 32) >> 1); }
            s = sub * sh; qb = lin + (sub * 32) * (1 - sh); }
        const int r0 = s * ck.rows_per_seq();
        if (type == 0) {
            ATTN_C(lds, QKV + QC_O + (size_t)hd * RA * 192, QKV + KC_O + (size_t)hd * RA * 192, QKV + VC_O + (size_t)hd * 128 * RA, OB + 2 * OSLOT + 128 * hd, r0, qb, ck.n, 0.f, wave);
        } else if (type == 1) { const int hh = hd >> 1;
            const float sl = LOG2E * (hh == 0 ? 0.25f : hh == 1 ? 0.0625f : hh == 2 ? 0.015625f : 0.00390625f);
            const float dkf = (2.f * qkb + 168.f) / sl + 2.f; const int dkeys = dkf < 1.0e9f ? (int)dkf : 0x3fffffff;
            ATTN_B(lds, QKV + QB_O + (size_t)hd * RA * 64, QKV + KB_O + (size_t)hd * RA * 64, QKV + VB_O + (size_t)hh * 128 * RA, OB + ((hd & 1) ? 3 : 1) * OSLOT + 128 * hh, r0, qb, ck.n, sl, wave, dkeys);
        } else { const int kv = hd >> 2;
#ifdef A64
            const int qb5 = (g < nms) ? (ck.n >> 9) : lin;
            attn_unit_a64(lds, QKV + QA_O + (size_t)hd * RA * 64, QKV + KA_O + (size_t)kv * RA * 64, QKV + VA_O + (size_t)kv * 64 * RA, OB + 64 * hd, r0, qb5, ck.n, ck.rows_per_seq(), wave);
#else
            ATTN_A(lds, QKV + QA_O + (size_t)hd * RA * 64, QKV + KA_O + (size_t)kv * RA * 64, QKV + VA_O + (size_t)kv * 64 * RA, OB + 64 * hd, r0, qb, ck.n, 0.f, wave);
#endif
        }
    }
}

#define XB_TMO      128
#define XB_XCNT(j)  (256  + 64 * (j))
#define XB_XSUB(j)  (1280 + 64 * (j))
#define XB_XGEN(j)  (2304 + 64 * (j))
#define XB_TOP      3328
#define XB_TOPGEN   3392
#define XCD_BAR_WORDS 3456
#define XB_SPIN_CAP (1u << 22)
DI unsigned xb_ld(unsigned* p)              { return __hip_atomic_load(p, __ATOMIC_RELAXED, __HIP_MEMORY_SCOPE_AGENT); }
DI unsigned xb_add(unsigned* p, unsigned v) { return __hip_atomic_fetch_add(p, v, __ATOMIC_RELAXED, __HIP_MEMORY_SCOPE_AGENT); }
DI unsigned xb_xcc_id() { return (unsigned)__builtin_amdgcn_s_getreg((3 << 11) | 20) & 0xFu; }
#define XB_SPIN(cond, bar) do { unsigned _sp = 0; while (cond) { __builtin_amdgcn_s_sleep(1); \
    if ((++_sp & 255u) == 0u) { if (xb_ld(&(bar)[XB_TMO])) break; if (_sp > XB_SPIN_CAP) { atomicAdd(&(bar)[XB_TMO], 1u); break; } } } } while (0)
DI void xcd_barrier_complete(unsigned* bar, unsigned x, unsigned G, unsigned& nloc, unsigned& nx) {
    unsigned sum, cnt, mine, sp = 0u;
    for (;;) {
        sum = 0u; cnt = 0u; mine = 0u;
#pragma unroll
        for (unsigned j = 0; j < 16; ++j) { const unsigned c = xb_ld(&bar[XB_XCNT(j)]); sum += c; cnt += (c > 0u) ? 1u : 0u; mine = (j == x) ? c : mine; }
        if (sum == G) break;
        __builtin_amdgcn_s_sleep(1);
        if ((++sp & 255u) == 0u) { if (xb_ld(&bar[XB_TMO])) break; if (sp > XB_SPIN_CAP) { atomicAdd(&bar[XB_TMO], 1u); break; } }
    }
    nloc = mine > 0u ? mine : 1u; nx = cnt > 0u ? cnt : 1u;
}
DI void xcd_barrier(unsigned* bar, volatile LAS unsigned* st, const int wave) {
    asm volatile("s_waitcnt vmcnt(0)" ::: "memory");
    __syncthreads();
    if (wave == 0 && lane_fresh() == 0) {
        __builtin_amdgcn_s_waitcnt(0);
        const unsigned x = xb_xcc_id();
        unsigned nloc = st[0], nx = st[1];
        if (nloc == 0u) { xcd_barrier_complete(bar, x, gridDim.x, nloc, nx); st[0] = nloc; st[1] = nx; }
        const unsigned old = xb_add(&bar[XB_XSUB(x)], 1u);
        const unsigned gen = old / nloc;
        if (old + 1u == (gen + 1u) * nloc) {
            __builtin_amdgcn_fence(__ATOMIC_RELEASE, "agent");
            asm volatile("s_waitcnt vmcnt(0)" ::: "memory");
            const unsigned og = xb_add(&bar[XB_TOP], 1u);
            const unsigned tg = og / nx;
            if (og + 1u == (tg + 1u) * nx) xb_add(&bar[XB_TOPGEN], 1u);
            else XB_SPIN(xb_ld(&bar[XB_TOPGEN]) == tg, bar);
            __builtin_amdgcn_fence(__ATOMIC_ACQUIRE, "agent");
            xb_add(&bar[XB_XGEN(x)], 1u);
            asm volatile("s_waitcnt vmcnt(0)" ::: "memory");
        } else {
            XB_SPIN(xb_ld(&bar[XB_XGEN(x)]) == gen, bar);
            __builtin_amdgcn_fence(__ATOMIC_ACQUIRE, "agent");
            asm volatile("s_waitcnt vmcnt(0)" ::: "memory");
        }
    }
    __syncthreads();
}


#define SK_LOOP(ACC, AP, BP, KK) do { _Pragma("unroll") for (int k0_ = 0; k0_ < (KK); k0_ += 32) { \
        const bf16x8 a_ = *(const bf16x8*)((AP) + k0_), b_ = *(const bf16x8*)((BP) + k0_); ACC = __builtin_amdgcn_mfma_f32_16x16x32_bf16(a_, b_, ACC, 0, 0, 0); } } while (0)
DI void skinny_phase(int which  , const Params& p, const Chunk& ck, const XMap& xm, const unsigned char* wbl, int gw, int NGW, int lane) {
    unsigned char* ws = p.ws; asm volatile("" : "+s"(ws));
    const int row = lane & 15, quad = lane >> 4;
    if (which == 0) {
        const bf16_t* OB = (const bf16_t*)(ws + WS_ZM); const bf16_t* G = (const bf16_t*)(ws + WS_G); bf16_t* MGb = (bf16_t*)(ws + WS_XN);
        for (int it = gw; it < ck.nseq * 64; it += NGW) {
            const int s = it >> 6, tile = it & 63, R0 = (s * ck.tps + ck.tps - 1) * 256, col = tile * 16 + row;
            f32x4 sum = {0.f, 0.f, 0.f, 0.f};
#pragma unroll 1
            for (int z = 0; z < 3; ++z) { f32x4 a = {0.f, 0.f, 0.f, 0.f};
                const bf16_t* ap = OB + (size_t)z * OSLOT + (size_t)(R0 + row) * 512 + quad * 8; const bf16_t* bp = (const bf16_t*)(wbl + W_BR) + (size_t)z * 1024 * 512 + (size_t)col * 512 + quad * 8;
                SK_LOOP(a, ap, bp, 512);
#pragma unroll
                for (int j = 0; j < 4; ++j) { const float g = __uint_as_float((unsigned)G[(size_t)(R0 + quad * 4 + j) * G_LD + z * 1024 + col] << 16); sum[j] += g * a[j]; } }
#pragma unroll
            for (int j = 0; j < 4; ++j) MGb[(size_t)(R0 + quad * 4 + j) * DM + col] = (bf16_t)(pk2(sum[j], 0.f) & 0xffffu);
        }
    } else if (which == 2) {
        const bf16_t* XNp = (const bf16_t*)(ws + WS_XN); bf16_t* U_ = (bf16_t*)(ws + WS_G);
        for (int it = gw; it < ck.nseq * 256; it += NGW) {
            const int s = it >> 8, tile = it & 255, R0 = (s * ck.tps + ck.tps - 1) * 256, col = tile * 16 + row;
            f32x4 acc = {0.f, 0.f, 0.f, 0.f};
            const bf16_t* ap = XNp + (size_t)(R0 + row) * 1024 + quad * 8; const bf16_t* bp = (const bf16_t*)(wbl + W_UP) + (size_t)col * 1024 + quad * 8;
#pragma unroll 1
            for (int kh = 0; kh < 2; ++kh) SK_LOOP(acc, ap + kh * 512, bp + kh * 512, 512);
#pragma unroll
            for (int j = 0; j < 4; ++j) { const float v = fmaxf(acc[j], 0.f); U_[(size_t)(R0 + quad * 4 + j) * 4096 + col] = (bf16_t)(pk2(v * v, 0.f) & 0xffffu); }
        }
    } else {
        const int K = (which == 1) ? 1024 : 4096, nkc = K >> 9;
        const bf16_t* A = (which == 1) ? (const bf16_t*)(ws + WS_XN) : (const bf16_t*)(ws + WS_G);
        const bf16_t* W = (const bf16_t*)(wbl + (which == 1 ? W_OUT : W_DOWN));
        for (int it = gw; it < ck.nseq * 64 * nkc; it += NGW) {
            const int kc = it % nkc, rem = it / nkc, s = rem >> 6, tile = rem & 63, pt = s * ck.tps + ck.tps - 1, R0 = pt * 256, col = tile * 16 + row;
            f32x4 acc = {0.f, 0.f, 0.f, 0.f};
            const bf16_t* ap = A + (size_t)(R0 + row) * K + kc * 512 + quad * 8; const bf16_t* bp = W + (size_t)col * K + kc * 512 + quad * 8;
            SK_LOOP(acc, ap, bp, 512);
            float* wp = xm.xw(pt);
#pragma unroll
            for (int j = 0; j < 4; ++j) atomicAdd(wp + (size_t)(quad * 4 + j) * DM + col, acc[j]);
        }
    }
}

#define GSYNC() xcd_barrier(xbar, xst, wave)
__global__ void __launch_bounds__(512) fwd_kernel(Params p) {
    extern __shared__ __attribute__((aligned(16))) unsigned char lds_raw[];
    LAS unsigned char* lds = (LAS unsigned char*)lds_raw;
    cg::grid_group grid = cg::this_grid();
    const int wave = __builtin_amdgcn_readfirstlane((int)threadIdx.x >> 6); int lane = lane_fresh();
    const int G = gridDim.x, bx = blockIdx.x, NGW = G * 8, gw = bx * 8 + wave;
#define WSP(off) ({ unsigned char* w_ = p.ws; asm volatile("" : "+s"(w_)); w_ + (off); })
#define ctl ((unsigned*)WSP(WS_CTL))
#define xbar (ctl + 1024)
    volatile LAS unsigned* xst = (volatile LAS unsigned*)(lds + LDS_MISC + 16);
    if (wave == 0 && lane == 0) { xst[0] = 0u; xst[1] = 0u; (void)xb_add(&xbar[XB_XCNT(xb_xcc_id())], 1u); }
    __syncthreads();
#define XN ((bf16_t*)WSP(WS_XN))
#define ZM ((bf16_t*)WSP(WS_ZM))
#define GB ((bf16_t*)WSP(WS_G))
#define CQN ((bf16_t*)WSP(WS_SM + SM_CQN))
#define CKVN ((bf16_t*)WSP(WS_SM + SM_CKVN))
#define QCR ((bf16_t*)WSP(WS_ZM + OFF_QCR))
#define KVR ((bf16_t*)WSP(WS_ZM + OFF_KVR))
#define MG ((float*)WSP(WS_QKV))
#define U ((bf16_t*)WSP(WS_G))

#if !defined(PH) || (PH & 1)
    prologue(p, lds, gw, NGW, wave, lane);
#ifdef PROBE_PRO2
    prologue(p, lds, gw, NGW, wave, lane);
#endif
#endif
    grid.sync();
    for (int l = 0; l < 2; ++l) {
        const bool last = (l == 1);
#define wb (WSP(WS_W) + (size_t)l * LW_STRIDE)
        for (int c = 0; c < 3; ++c) {
            const Chunk ck = make_chunk(c);
            const int ta = ck.tps - 1;
            XMap xm; xm.out = p.out; xm.metax = (float*)WSP(WS_METAX); xm.xp = p.in[0]; xm.xs = p.in[1]; xm.meta0 = (const float*)WSP(WS_META0); xm.seq0 = ck.seq0; xm.tps = ck.tps; xm.first = (l == 0);
#define RELAUNDER() do { lane = lane_fresh(); } while (0)
            RELAUNDER();
#if !defined(PH) || (PH & 2)
            norm_phase(xm, ck.rows(), p.in[3] + l * DM, XN, gw, NGW, lane);
#ifdef PROBE_EW2
            RELAUNDER(); norm_phase(xm, ck.rows(), p.in[3] + l * DM, XN, gw, NGW, lane);
#endif
#endif
            GSYNC();
            { pg8::Gemm g{XN, (const bf16_t*)(wb + W_IN), 1024, 0, 0}; Sched S; S.init(ck.nseq, ck.tps, ck.tps, IN_N / 256, 1, G, bx);
              EpiIn E{ZM, GB, p.in[5] + l * 3072};
#if !defined(PH) || (PH & 4)
              pg8::gemm_phase<EpiIn, Sched, true, true>(lds, g, S, E, wave);
#ifdef PROBE_IN2
              pg8::gemm_phase<EpiIn, Sched, true, true>(lds, g, S, E, wave);
#endif
#endif
 }
            GSYNC();
            RELAUNDER();
#if !defined(PH) || (PH & 128)
            ew1_phase(p, ck, l, gw, NGW, lane);
#ifdef PROBE_EW2
            RELAUNDER(); ew1_phase(p, ck, l, gw, NGW, lane);
#endif
#endif
            GSYNC();
            { pg8::Gemm g{CQN, (const bf16_t*)(wb + W_QB), 256, 0, 0}; Sched S; S.init(ck.nseq, ck.tps, ck.tps, 3, 1, G, bx); EpiBf16<0> E{QCR, 768};
#if !defined(PH) || (PH & 8)
              pg8::gemm_phase<EpiBf16<0>, Sched, true, true>(lds, g, S, E, wave);
#endif
 }
            { pg8::Gemm g{CKVN, (const bf16_t*)(wb + W_KVB), 128, 0, 0}; Sched S; S.init(ck.nseq, ck.tps, ck.tps, 4, 1, G, bx); EpiBf16<0> E{KVR, 1024};
#if !defined(PH) || (PH & 8)
              pg8::gemm_phase<EpiBf16<0>, Sched, true, true>(lds, g, S, E, wave);
#endif
 }
            GSYNC();
            RELAUNDER();
#if !defined(PH) || (PH & 256)
            ew2_phase(p, ck, l, gw, NGW, lane);
#ifdef PROBE_EW2
            RELAUNDER(); ew2_phase(p, ck, l, gw, NGW, lane);
#endif
#endif
            GSYNC();
#if !defined(PH) || (PH & 1024)
            attn_phase(p, ck, last, l, lds, ctl + 8192 + 2048 * (l * 3 + c), wave);
#ifdef PROBE_ATTN2
            GSYNC();
            attn_phase(p, ck, last, l, lds, ctl + 8192 + 2048 * (6 + l * 3 + c), wave);
#endif
#endif
            GSYNC();
            RELAUNDER();
#if !defined(PH) || (PH & 512)
            ew3_phase(p, ck, l, last, gw, NGW, lane);
#endif
            GSYNC();
            { pg8::Gemm g{ZM, (const bf16_t*)(wb + W_BR), 512, OSLOT, (size_t)1024 * 512}; Sched S; S.init(ck.nseq, ta, ck.tps, 4, 3, G, bx); EpiBranch E{GB, MG, XN};
#if !defined(PH) || (PH & 16)
              pg8::gemm_phase<EpiBranch, Sched, true, true>(lds, g, S, E, wave);
#ifdef PROBE_BR2
              pg8::gemm_phase<EpiBranch, Sched, true, true>(lds, g, S, E, wave);
#endif
#endif
 }
            if (!last) { RELAUNDER(); skinny_phase(0, p, ck, xm, wb, gw, NGW, lane); }
            GSYNC();
            { pg8::Gemm g{XN, (const bf16_t*)(wb + W_OUT), 1024, 0, 0}; Sched S; S.init(ck.nseq, ta, ck.tps, 4, 1, G, bx); EpiResid E{xm};
#if !defined(PH) || (PH & 32)
              pg8::gemm_phase<EpiResid, Sched, true, true>(lds, g, S, E, wave);
#endif
 }
            if (!last) { RELAUNDER(); skinny_phase(1, p, ck, xm, wb, gw, NGW, lane); }
            GSYNC();
            xm.first = 0;
            RELAUNDER();
#if !defined(PH) || (PH & 2)
            norm_phase(xm, ck.rows(), p.in[25] + l * DM, XN, gw, NGW, lane);
#ifdef PROBE_EW2
            RELAUNDER(); norm_phase(xm, ck.rows(), p.in[25] + l * DM, XN, gw, NGW, lane);
#endif
#endif
            GSYNC();
            { pg8::Gemm g{XN, (const bf16_t*)(wb + W_UP), 1024, 0, 0}; Sched S; S.init(ck.nseq, ta, ck.tps, 16, 1, G, bx); EpiBf16<2> E{U, 4096};
#if !defined(PH) || (PH & 64)
              pg8::gemm_phase<EpiBf16<2>, Sched, true, true>(lds, g, S, E, wave);
#ifdef PROBE_UP2
              pg8::gemm_phase<EpiBf16<2>, Sched, true, true>(lds, g, S, E, wave);
#endif
#endif
 }
            if (!last) { RELAUNDER(); skinny_phase(2, p, ck, xm, wb, gw, NGW, lane); }
            GSYNC();
            { pg8::Gemm g{U, (const bf16_t*)(wb + W_DOWN), 4096, 0, 0}; Sched S; S.init(ck.nseq, ta, ck.tps, 4, 1, G, bx); EpiResid E{xm};
#if !defined(PH) || (PH & 32)
              pg8::gemm_phase<EpiResid, Sched, true, true>(lds, g, S, E, wave);
#endif
 }
            if (!last) { RELAUNDER(); skinny_phase(3, p, ck, xm, wb, gw, NGW, lane); }
        }
    }
}

extern "C" void kernel_launch(void* const* d_in, const int* in_sizes, int n_in, void* d_out, int out_size, void* d_ws, size_t ws_size, hipStream_t stream) {
    static int grid_blocks = 0;
    if (grid_blocks == 0) {
        if (n_in != 28 || ws_size < WS_END) { fprintf(stderr, "kernel_launch: unexpected n_in %d / ws_size %zu (need %zu)\n", n_in, ws_size, (size_t)WS_END); grid_blocks = -1; return; }
        int dev = 0, cus = 0, per_cu = 0;
        hipGetDevice(&dev); hipDeviceGetAttribute(&cus, hipDeviceAttributeMultiprocessorCount, dev);
        hipFuncSetAttribute((const void*)fwd_kernel, hipFuncAttributeMaxDynamicSharedMemorySize, LDS_BYTES);
        hipOccupancyMaxActiveBlocksPerMultiprocessor(&per_cu, (const void*)fwd_kernel, 512, LDS_BYTES);
        if (per_cu < 1) { fprintf(stderr, "kernel_launch: occupancy query says %d blocks/CU\n", per_cu); per_cu = 1; }
        grid_blocks = cus * 1;
        (void)hipGetLastError();
    }
    if (grid_blocks < 0) return;
    hipMemsetAsync((char*)d_ws + WS_CTL, 0, CTL_BYTES, stream);
    Params p{};
    for (int i = 0; i < 28; ++i) p.in[i] = (const float*)d_in[i];
    p.out = (float*)d_out; p.ws = (unsigned char*)d_ws;
    void* args[] = {&p};
    hipError_t e = hipLaunchCooperativeKernel((const void*)fwd_kernel, dim3(grid_blocks), dim3(512), args, LDS_BYTES, stream);
    if (e != hipSuccess) fprintf(stderr, "cooperative launch failed: %s (grid %d)\n", hipGetErrorString(e), grid_blocks);
}
```

```cpp
#include <hip/hip_runtime.h>
#include <hip/hip_cooperative_groups.h>
#include <cstdint>
#include <cstdio>
namespace cg = cooperative_groups;
#define NOPIPE_AB 1
#define FLATQ 1
namespace pg8 {
#define PG8_LAS __attribute__((address_space(3)))
typedef unsigned short bf16_t;
typedef short bf16x8 __attribute__((ext_vector_type(8)));
typedef float f32x4 __attribute__((ext_vector_type(4)));
typedef unsigned u32x4 __attribute__((ext_vector_type(4)));
constexpr int BM = 256, BK = 64, HALF = 128, HTB = HALF * BK * 2  , STAGE_BYTES = 8 * HTB, NXCD = 8, WGM = 8;

__host__ __device__ __forceinline__ int lds_byte(int r, int c) { const int st = (r >> 4) * 2 + (c >> 5), rr = r & 15, cc = c & 31, ob = rr * 64 + cc * 2; return st * 1024 + (ob ^ (((ob >> 9) & 1) << 5)); }
__host__ __device__ __forceinline__ void stage_rc(int b, int& R, int& C) { const int st = b / 1024, sb = b % 1024, swz = sb ^ (((sb >> 9) & 1) << 5); R = (st >> 1) * 16 + swz / 64; C = (st & 1) * 32 + (swz % 64) / 2; }
__host__ __device__ __forceinline__ int perm32(int rho) { const int n = rho >> 4, i = rho & 15; return 8 * (i >> 2) + 4 * n + (i & 3); }

struct Unit { int pm, pn, z; };
struct Gemm { const bf16_t* A; const bf16_t* Bt; int K; size_t zsA, zsB; };

template <class Epi, class Sched, bool ALIGN_EPI = false, bool SP2 = false>
__device__ __forceinline__ void gemm_phase(PG8_LAS unsigned char* lds, const Gemm g, const Sched& S, const Epi& E, const int wv  ) {
    int tid_; asm volatile("v_mbcnt_lo_u32_b32 %0, -1, 0\n\tv_mbcnt_hi_u32_b32 %0, -1, %0" : "=v"(tid_)); tid_ += wv * 64;
    const int tid = tid_, wid = __builtin_amdgcn_readfirstlane(tid >> 6), lane = tid & 63, wr = wid >> 2, wc = wid & 3, fr = lane & 15, fq = lane >> 4;
    const int K = g.K, nt = K / BK;
    unsigned voffA[2], voffB[2];
#pragma unroll
    for (int i = 0; i < 2; ++i) { int R, C; stage_rc(tid * 16 + i * 8192, R, C); const int Rb = Epi::PERM ? ((R & ~31) + perm32(R & 31)) : R;
        voffA[i] = (unsigned)(R * K + C) * 2u; voffB[i] = (unsigned)(Rb * K + C) * 2u; }
    const size_t kstep = (size_t)(BK * 2);
    const size_t hstep = (size_t)HALF * K * 2;
    const size_t tstep = 2 * hstep;
    const unsigned ldsw = (unsigned)wid * 1024u;
    const int aoff = lds_byte(wr * 64 + fr, fq * 8), boff = lds_byte(wc * 32 + fr, fq * 8);
#define PG8_SA(b, h) (((b) * 2 + (h)) * HTB)
#define PG8_SB(b, h) ((4 + (b) * 2 + (h)) * HTB)
#define PG8_STAGE(bufoff, gbase, voff) do { _Pragma("unroll") for (int _i = 0; _i < 2; ++_i) \
        __builtin_amdgcn_global_load_lds((const unsigned*)((const char*)(gbase) + (voff)[_i]), (PG8_LAS unsigned*)(lds + (bufoff) + ldsw + _i * 8192), 16, 0, 0); } while (0)
#define PG8_LDA(dst, b, h) do { _Pragma("unroll") for (int m = 0; m < 4; ++m) _Pragma("unroll") for (int k = 0; k < 2; ++k) dst[m][k] = *(const PG8_LAS bf16x8*)(lds + PG8_SA(b, h) + aoff + m * 2048 + k * 1024); } while (0)
#define PG8_LDB(dst, b, h) do { _Pragma("unroll") for (int n = 0; n < 2; ++n) _Pragma("unroll") for (int k = 0; k < 2; ++k) dst[n][k] = *(const PG8_LAS bf16x8*)(lds + PG8_SB(b, h) + boff + n * 2048 + k * 1024); } while (0)
#define PG8_MMA(ai, bj, At, Bt) do { __builtin_amdgcn_s_setprio(1); _Pragma("unroll") for (int m = 0; m < 4; ++m) _Pragma("unroll") for (int n = 0; n < 2; ++n) _Pragma("unroll") for (int k = 0; k < 2; ++k) \
        acc[ai][bj][m][n] = __builtin_amdgcn_mfma_f32_16x16x32_bf16(Bt[n][k], At[m][k], acc[ai][bj][m][n], 0, 0, 0); __builtin_amdgcn_s_setprio(0); } while (0)
#define PG8_WAIT_V(n) asm volatile("s_waitcnt vmcnt(" #n ")" ::: "memory")
#define PG8_WAIT_L(n) asm volatile("s_waitcnt lgkmcnt(" #n ")" ::: "memory")
#define PG8_BAR __builtin_amdgcn_s_barrier()
#define PG8_SCHED __builtin_amdgcn_sched_barrier(0)
    Unit cur, nxt; int ui = 0;
    if (!S.next(0, cur)) return;
    f32x4 acc[2][2][4][2];
#pragma unroll
    for (int a = 0; a < 2; ++a)
#pragma unroll
        for (int b = 0; b < 2; ++b)
#pragma unroll
            for (int m = 0; m < 4; ++m)
#pragma unroll
                for (int n = 0; n < 2; ++n) acc[a][b][m][n] = (f32x4){0.f, 0.f, 0.f, 0.f};
    bf16x8 At[4][2], B0[2][2], B1[2][2];
    const char* cA = (const char*)(g.A + (size_t)cur.z * g.zsA) + (size_t)cur.pm * tstep; const char* cB = (const char*)(g.Bt + (size_t)cur.z * g.zsB) + (size_t)cur.pn * tstep;
    S.a_ready(cur);
    if constexpr (SP2) {
        PG8_STAGE(PG8_SB(0, 0), cB, voffB); PG8_STAGE(PG8_SB(0, 1), cB + hstep, voffB); PG8_STAGE(PG8_SA(0, 0), cA, voffA); PG8_STAGE(PG8_SA(0, 1), cA + hstep, voffA);
        if (wr == 1) PG8_BAR;
        PG8_WAIT_V(2); PG8_BAR;
        PG8_STAGE(PG8_SB(1, 0), cB + kstep, voffB); PG8_STAGE(PG8_SA(1, 0), cA + kstep, voffA); PG8_STAGE(PG8_SB(1, 1), cB + hstep + kstep, voffB);
        PG8_WAIT_V(6); PG8_BAR;
    } else {
        PG8_STAGE(PG8_SB(0, 0), cB, voffB); PG8_STAGE(PG8_SA(0, 0), cA, voffA); PG8_STAGE(PG8_SB(0, 1), cB + hstep, voffB); PG8_STAGE(PG8_SA(0, 1), cA + hstep, voffA);
        if (wr == 1) PG8_BAR;
        PG8_WAIT_V(4); PG8_BAR;
        PG8_STAGE(PG8_SB(1, 0), cB + kstep, voffB); PG8_STAGE(PG8_SA(1, 0), cA + kstep, voffA); PG8_STAGE(PG8_SB(1, 1), cB + hstep + kstep, voffB);
        PG8_WAIT_V(6); PG8_BAR;
    }
    for (;;) {
        const bool has_next = S.next(ui + 1, nxt);
        const char* nA = has_next ? (const char*)(g.A + (size_t)nxt.z * g.zsA) + (size_t)nxt.pm * tstep : cA; const char* nB = has_next ? (const char*)(g.Bt + (size_t)nxt.z * g.zsB) + (size_t)nxt.pn * tstep : cB;
        for (int t = 0; t < nt; t += 2) {
            const bool last = (t == nt - 2);
            const char* a1 = cA + (size_t)(t + 1) * kstep;
            const char* a2 = last ? nA : cA + (size_t)(t + 2) * kstep; const char* b2 = last ? nB : cB + (size_t)(t + 2) * kstep;
            const char* a3 = a2 + kstep; const char* b3 = b2 + kstep;
            if (last && has_next) S.a_ready(nxt);
            if constexpr (SP2) {
            PG8_LDB(B0, 0, 0); PG8_LDB(B1, 0, 1); PG8_SCHED; PG8_LDA(At, 0, 0); PG8_STAGE(PG8_SA(1, 1), a1 + hstep, voffA);
            PG8_WAIT_V(8); PG8_WAIT_L(0); PG8_BAR; PG8_MMA(0, 0, At, B0); PG8_MMA(0, 1, At, B1); PG8_BAR; PG8_SCHED;
            PG8_LDA(At, 0, 1); PG8_STAGE(PG8_SB(0, 0), b2, voffB); PG8_STAGE(PG8_SB(0, 1), b2 + hstep, voffB); PG8_STAGE(PG8_SA(0, 0), a2, voffA);
            PG8_WAIT_V(8); PG8_WAIT_L(0); PG8_BAR; PG8_MMA(1, 0, At, B0); PG8_MMA(1, 1, At, B1); PG8_BAR; PG8_SCHED;
            PG8_LDB(B0, 1, 0); PG8_LDB(B1, 1, 1); PG8_SCHED; PG8_LDA(At, 1, 0); PG8_STAGE(PG8_SA(0, 1), a2 + hstep, voffA);
            PG8_WAIT_V(8); PG8_WAIT_L(0); PG8_BAR; PG8_MMA(0, 0, At, B0); PG8_MMA(0, 1, At, B1); PG8_BAR; PG8_SCHED;
            PG8_LDA(At, 1, 1); PG8_STAGE(PG8_SB(1, 0), b3, voffB); PG8_STAGE(PG8_SB(1, 1), b3 + hstep, voffB); PG8_STAGE(PG8_SA(1, 0), a3, voffA);
            PG8_WAIT_V(8); PG8_WAIT_L(0); PG8_BAR; PG8_MMA(1, 0, At, B0); PG8_MMA(1, 1, At, B1); PG8_BAR; PG8_SCHED;
            } else {
            PG8_LDB(B0, 0, 0); PG8_SCHED; PG8_LDA(At, 0, 0); PG8_STAGE(PG8_SA(1, 1), a1 + hstep, voffA);
            PG8_WAIT_L(8); PG8_BAR; PG8_WAIT_L(0); PG8_MMA(0, 0, At, B0); PG8_BAR; PG8_SCHED;
            PG8_LDB(B1, 0, 1); PG8_STAGE(PG8_SB(0, 0), b2, voffB);
            PG8_BAR; PG8_WAIT_L(0); PG8_MMA(0, 1, At, B1); PG8_BAR;
            PG8_LDA(At, 0, 1); PG8_STAGE(PG8_SA(0, 0), a2, voffA);
            PG8_BAR; PG8_WAIT_L(0); PG8_MMA(1, 0, At, B0); PG8_BAR; PG8_SCHED;
            PG8_STAGE(PG8_SB(0, 1), b2 + hstep, voffB);
            PG8_WAIT_V(6); PG8_BAR; PG8_MMA(1, 1, At, B1); PG8_BAR;
            PG8_LDB(B0, 1, 0); PG8_SCHED; PG8_LDA(At, 1, 0); PG8_STAGE(PG8_SA(0, 1), a2 + hstep, voffA);
            PG8_WAIT_L(8); PG8_BAR; PG8_WAIT_L(0); PG8_MMA(0, 0, At, B0); PG8_BAR; PG8_SCHED;
            PG8_LDB(B1, 1, 1); PG8_STAGE(PG8_SB(1, 0), b3, voffB);
            PG8_BAR; PG8_WAIT_L(0); PG8_MMA(0, 1, At, B1); PG8_BAR;
            PG8_LDA(At, 1, 1); PG8_STAGE(PG8_SA(1, 0), a3, voffA);
            PG8_BAR; PG8_WAIT_L(0); PG8_MMA(1, 0, At, B0); PG8_BAR; PG8_SCHED;
            PG8_STAGE(PG8_SB(1, 1), b3 + hstep, voffB);
            PG8_WAIT_V(6); PG8_BAR; PG8_MMA(1, 1, At, B1); PG8_BAR;
            }
        }
        if constexpr (ALIGN_EPI) { if (wr == 0) PG8_BAR; }
        if constexpr (!Epi::AFTER_DRAIN) { E(acc, cur, wr, wc, fr, fq); S.done(cur); }
        if (!has_next) break;
#pragma unroll
        for (int a = 0; a < 2; ++a)
#pragma unroll
            for (int b = 0; b < 2; ++b)
#pragma unroll
                for (int m = 0; m < 4; ++m)
#pragma unroll
                    for (int n = 0; n < 2; ++n) acc[a][b][m][n] = (f32x4){0.f, 0.f, 0.f, 0.f};
        cur = nxt; cA = nA; cB = nB; ++ui;
        if constexpr (ALIGN_EPI) { if (wr == 1) PG8_BAR; }
    }
    PG8_WAIT_V(0);
    if constexpr (!ALIGN_EPI) { if (wr == 0) PG8_BAR; }
    PG8_BAR;
    if constexpr (Epi::AFTER_DRAIN) { E.fused(acc, cur, wr, wc, fr, fq, lds, wid, lane); S.done(cur); }
#undef PG8_SA
#undef PG8_SB
#undef PG8_STAGE
#undef PG8_LDA
#undef PG8_LDB
#undef PG8_MMA
#undef PG8_WAIT_V
#undef PG8_WAIT_L
#undef PG8_BAR
#undef PG8_SCHED
}
}


using pg8::bf16_t; using pg8::bf16x8; using pg8::f32x4; using pg8::u32x4;
typedef float f32x16 __attribute__((ext_vector_type(16)));
typedef unsigned u32x2 __attribute__((ext_vector_type(2)));
typedef float f32x2_t __attribute__((ext_vector_type(2)));
typedef __bf16 bf16x2_t __attribute__((ext_vector_type(2)));
#define LAS __attribute__((address_space(3)))
#define DI __device__ __forceinline__

constexpr int DM = 1024, RA = 16896;
constexpr int ZM_LD = 2816, G_LD = 3072, IN_N = 5888;
constexpr float LOG2E = 1.4426950408889634f;
constexpr size_t MiB = 1u << 20;
constexpr size_t WS_CTL = 0, CTL_BYTES = 131072;
constexpr size_t WS_W = 1 * MiB, LW_STRIDE = 34 * MiB;
constexpr size_t W_IN = 0, W_QB = W_IN + (size_t)IN_N * 1024 * 2, W_KVB = W_QB + 768 * 256 * 2, W_BR = W_KVB + 1024 * 128 * 2,
                 W_OUT = W_BR + 3 * 1024 * 512 * 2, W_UP = W_OUT + 1024 * 1024 * 2, W_DOWN = W_UP + 4096 * 1024 * 2, W_END = W_DOWN + 4096 * 1024 * 2;
static_assert(W_END <= LW_STRIDE, "weights");
constexpr size_t WS_META0 = 69 * MiB, WS_METAX = 70 * MiB, WS_XN = 74 * MiB, WS_ZM = 107 * MiB, WS_G = 198 * MiB, WS_QKV = 297 * MiB, WS_SM = 438 * MiB, WS_END = 454 * MiB;
constexpr size_t OFF_QCR = 0, OFF_KVR = 25 * MiB;
constexpr size_t OSLOT = (size_t)RA * 512;
constexpr size_t QA_O = 0, KA_O = 512ull * RA, VA_O = 640ull * RA, QB_O = 768ull * RA, KB_O = 1280ull * RA, VB_O = 1792ull * RA, QC_O = 2304ull * RA, KC_O = 3072ull * RA, VC_O = 3840ull * RA;
constexpr size_t SM_CQN = 0, SM_CKVN = 9 * MiB, SM_KPE = 14 * MiB;
constexpr int LDS_MISC = 131072, LDS_BYTES = 131072 + 256;

struct Params { const float* in[28]; float* out; unsigned char* ws; };

DI unsigned pk2(float lo, float hi) { f32x2_t v = {lo, hi}; bf16x2_t b = __builtin_convertvector(v, bf16x2_t); return __builtin_bit_cast(unsigned, b); }
DI void ld8(const bf16_t* p, float (&f)[8]) {
    const u32x4 r = *(const u32x4*)p;
#pragma unroll
    for (int i = 0; i < 4; ++i) { f[2 * i] = __uint_as_float(r[i] << 16); f[2 * i + 1] = __uint_as_float(r[i] & 0xffff0000u); }
}
DI void st8(bf16_t* p, const float (&f)[8]) { u32x4 w; w.x = pk2(f[0], f[1]); w.y = pk2(f[2], f[3]); w.z = pk2(f[4], f[5]); w.w = pk2(f[6], f[7]); *(u32x4*)p = w; }
DI int lane_fresh() { int l; asm volatile("v_mbcnt_lo_u32_b32 %0, -1, 0\n\tv_mbcnt_hi_u32_b32 %0, -1, %0" : "=v"(l)); return l; }
DI float wave_sum(float v, int lane) {
#pragma unroll
    for (int o = 1; o < 64; o <<= 1) v += __int_as_float(__builtin_amdgcn_ds_bpermute((lane ^ o) << 2, __float_as_int(v)));
    return v;
}
DI float max3f(float a, float b, float c) { float r; asm("v_max3_f32 %0, %1, %2, %3" : "=v"(r) : "v"(a), "v"(b), "v"(c)); return r; }
DI float max2f(float a, float b) { float r; asm("v_max_f32_e32 %0, %1, %2" : "=v"(r) : "v"(a), "v"(b)); return r; }
DI float fadd_s(float a, float b) { float r; asm("v_add_f32_e32 %0, %1, %2" : "=v"(r) : "v"(a), "v"(b)); return r; }
#define MX2(a, b) __builtin_amdgcn_fmed3f((a), (b), __builtin_inff())
DI float swap32_max(float v) { auto rr = __builtin_amdgcn_permlane32_swap(__float_as_uint(v), __float_as_uint(v), false, false); return __builtin_amdgcn_fmed3f(__uint_as_float(rr[0]), __uint_as_float(rr[1]), __builtin_inff()); }
DI float swap32_add(float v) { auto rr = __builtin_amdgcn_permlane32_swap(__float_as_uint(v), __float_as_uint(v), false, false); return __uint_as_float(rr[0]) + __uint_as_float(rr[1]); }
DI constexpr float inv64(int j) {
    constexpr float T[32] = {1.0f, 0.749894209f, 0.562341325f, 0.421696503f, 0.316227766f, 0.237137371f, 0.177827941f, 0.133352143f, 0.1f, 0.0749894209f, 0.0562341325f, 0.0421696503f,
                             0.0316227766f, 0.0237137371f, 0.0177827941f, 0.0133352143f, 0.01f, 0.00749894209f, 0.00562341325f, 0.00421696503f, 0.00316227766f, 0.00237137371f,
                             0.00177827941f, 0.00133352143f, 0.001f, 0.000749894209f, 0.000562341325f, 0.000421696503f, 0.000316227766f, 0.000237137371f, 0.000177827941f, 0.000133352143f};
    return T[j];
}
DI void sincos_ang(float ang, float& s, float& c) {
    double t = (double)ang * 0.15915494309189535; t -= __builtin_rint(t); const float f = (float)t;
    s = __builtin_amdgcn_sinf(f); c = __builtin_amdgcn_cosf(f);
}

struct Chunk {
    int id, nseq, seq0, tps, n;
    DI int rows_per_seq() const { return tps * 256; }
    DI int rows() const { return nseq * tps * 256; }
};
DI Chunk make_chunk(int c) { Chunk k; k.id = c; if (c < 2) { k.nseq = 1; k.seq0 = c; k.tps = 65; k.n = 16384; } else { k.nseq = 2; k.seq0 = 2; k.tps = 33; k.n = 8192; } return k; }
struct XMap {
    float* out; float* metax; const float* xp; const float* xs; const float* meta0; int seq0, tps, first;
    DI float* xw(int pt) const {
        const int hi = pt >= tps ? 1 : 0, s = seq0 + hi, lt = pt - hi * tps;
        if (lt == tps - 1) return metax + (size_t)s * 256 * DM;
        const int ob = (s < 2) ? s * 16384 : 32768 + (s - 2) * 8192;
        return out + ((size_t)ob + (size_t)lt * 256) * DM;
    }
    DI const float* xr(int pt) const {
        if (!first) return xw(pt);
        const int hi = pt >= tps ? 1 : 0, s = seq0 + hi, lt = pt - hi * tps;
        if (lt == tps - 1) return metax + (size_t)s * 256 * DM;
        return (s < 2) ? xp + ((size_t)s * 16384 + (size_t)lt * 256) * DM : xs + ((size_t)(s - 2) * 8192 + (size_t)lt * 256) * DM;
    }
};

struct Sched {
    int nM, nN, nZ, nwg, G, c, ta, tps;
    DI void init(int nseq, int ta_, int tps_, int nN_, int nZ_, int G_, int c_) { ta = ta_; tps = tps_; nM = nseq * ta_; nN = nN_; nZ = nZ_; nwg = nM * nN; G = G_; c = c_; }
    DI bool next(int i, pg8::Unit& u) const {
        const int tl = (i / nZ) * G + c; if (tl >= nwg) return false;
        u.z = i % nZ;
        int wgid = tl; { const int q = nwg / pg8::NXCD, r = nwg % pg8::NXCD, xcd = wgid % pg8::NXCD, off = wgid / pg8::NXCD; wgid = (xcd < r ? xcd * (q + 1) : r * (q + 1) + (xcd - r) * q) + off; }
        const int nig = pg8::WGM * nN, gid = wgid / nig, fm = gid * pg8::WGM, gsz = (nM - fm) < pg8::WGM ? (nM - fm) : pg8::WGM;
        const int pa = fm + ((wgid % nig) % gsz); u.pn = (wgid % nig) / gsz;
        u.pm = pa >= ta ? pa - ta + tps : pa;
        return true;
    }
    DI void a_ready(const pg8::Unit&) const {}
    DI void done(const pg8::Unit&) const {}
};

template <int ACT  > struct EpiBf16 {
    static constexpr bool PERM = true, AFTER_DRAIN = false;
    bf16_t* O; int ldc;
    DI void operator()(const f32x4 (&acc)[2][2][4][2], const pg8::Unit& u, int wr, int wc, int fr_, int fq_) const {
        const int ln_ = lane_fresh(), fr = ln_ & 15, fq = ln_ >> 4;
        const int row0 = u.pm * 256 + wr * 64 + fr, col0 = u.pn * 256 + wc * 32 + 8 * fq;
#pragma unroll
        for (int ai = 0; ai < 2; ++ai)
#pragma unroll
            for (int m = 0; m < 4; ++m) { bf16_t* rowp = O + (size_t)(row0 + ai * 128 + m * 16) * ldc + col0;
#pragma unroll
                for (int bj = 0; bj < 2; ++bj) { f32x4 v0 = acc[ai][bj][m][0], v1 = acc[ai][bj][m][1];
                    if (ACT == 2) {
#pragma unroll
                        for (int k = 0; k < 4; ++k) { const float a = fmaxf(v0[k], 0.f), b = fmaxf(v1[k], 0.f); v0[k] = a * a; v1[k] = b * b; } }
                    u32x4 w; w.x = pk2(v0[0], v0[1]); w.y = pk2(v0[2], v0[3]); w.z = pk2(v1[0], v1[1]); w.w = pk2(v1[2], v1[3]);
                    *(u32x4*)(rowp + bj * 128) = w; } }
    }
};
struct EpiIn {
    static constexpr bool PERM = true, AFTER_DRAIN = false;
    bf16_t* ZM; bf16_t* G; const float* bgate;
    DI void operator()(const f32x4 (&acc)[2][2][4][2], const pg8::Unit& u, int wr, int wc, int fr_, int fq_) const {
        const int ln_ = lane_fresh(), fr = ln_ & 15, fq = ln_ >> 4;
        const bool gate = u.pn >= 11;
        const int row0 = u.pm * 256 + wr * 64 + fr, colt = gate ? (u.pn - 11) * 256 : u.pn * 256, col0 = colt + wc * 32 + 8 * fq, ld = gate ? G_LD : ZM_LD;
        bf16_t* base = gate ? G : ZM;
        f32x4 bv[2][2];
#pragma unroll
        for (int bj = 0; bj < 2; ++bj)
#pragma unroll
            for (int n = 0; n < 2; ++n) bv[bj][n] = gate ? *(const f32x4*)(bgate + col0 + bj * 128 + 4 * n) : (f32x4){0.f, 0.f, 0.f, 0.f};
#pragma unroll
        for (int ai = 0; ai < 2; ++ai)
#pragma unroll
            for (int m = 0; m < 4; ++m) { bf16_t* rowp = base + (size_t)(row0 + ai * 128 + m * 16) * ld + col0;
#pragma unroll
                for (int bj = 0; bj < 2; ++bj) { f32x4 v0 = acc[ai][bj][m][0] + bv[bj][0], v1 = acc[ai][bj][m][1] + bv[bj][1];
                    if (gate) {
#pragma unroll
                        for (int k = 0; k < 4; ++k) { v0[k] = __builtin_amdgcn_rcpf(1.f + __builtin_amdgcn_exp2f(-LOG2E * v0[k])); v1[k] = __builtin_amdgcn_rcpf(1.f + __builtin_amdgcn_exp2f(-LOG2E * v1[k])); } }
                    u32x4 w; w.x = pk2(v0[0], v0[1]); w.y = pk2(v0[2], v0[3]); w.z = pk2(v1[0], v1[1]); w.w = pk2(v1[2], v1[3]);
                    *(u32x4*)(rowp + bj * 128) = w; } }
    }
};
struct EpiBranch {
    static constexpr bool PERM = false, AFTER_DRAIN = false;
    const bf16_t* G; float* MG; bf16_t* MGb;
    DI void operator()(const f32x4 (&acc)[2][2][4][2], const pg8::Unit& u, int wr, int wc, int fr_, int fq_) const {
        const int ln_ = lane_fresh(), fr = ln_ & 15, fq = ln_ >> 4;
        const int row0 = u.pm * 256 + wr * 64 + fr, col0 = u.pn * 256 + wc * 32 + 4 * fq;
#pragma unroll
        for (int ai = 0; ai < 2; ++ai)
#pragma unroll
            for (int m = 0; m < 4; ++m) { const size_t row = (size_t)(row0 + ai * 128 + m * 16);
#pragma unroll
                for (int bj = 0; bj < 2; ++bj)
#pragma unroll
                    for (int n = 0; n < 2; ++n) { const int col = col0 + bj * 128 + n * 16;
                        const u32x2 gr = *(const u32x2*)(G + row * G_LD + u.z * 1024 + col);
                        f32x4 g; g[0] = __uint_as_float(gr.x << 16); g[1] = __uint_as_float(gr.x & 0xffff0000u); g[2] = __uint_as_float(gr.y << 16); g[3] = __uint_as_float(gr.y & 0xffff0000u);
                        f32x4 v = g * acc[ai][bj][m][n];
                        float* mp = MG + row * DM + col;
                        if (u.z > 0) v += *(const f32x4*)mp;
                        if (u.z < 2) *(f32x4*)mp = v;
                        else { u32x2 w; w.x = pk2(v[0], v[1]); w.y = pk2(v[2], v[3]); *(u32x2*)(MGb + row * DM + col) = w; } }
                asm volatile("" ::: "memory"); }
    }
};
struct EpiResid {
    static constexpr bool PERM = false, AFTER_DRAIN = false;
    XMap xm;
    DI void operator()(const f32x4 (&acc)[2][2][4][2], const pg8::Unit& u, int wr, int wc, int fr_, int fq_) const {
        const int ln_ = lane_fresh(), fr = ln_ & 15, fq = ln_ >> 4;
        const float* rd = xm.xr(u.pm); float* wp = xm.xw(u.pm);
        const int row0 = wr * 64 + fr, col0 = u.pn * 256 + wc * 32 + 4 * fq;
#pragma unroll
        for (int ai = 0; ai < 2; ++ai)
#pragma unroll
            for (int m = 0; m < 4; ++m) { const size_t off = (size_t)(row0 + ai * 128 + m * 16) * DM + col0;
#pragma unroll
                for (int bj = 0; bj < 2; ++bj)
#pragma unroll
                    for (int n = 0; n < 2; ++n) { const size_t o = off + bj * 128 + n * 16; *(f32x4*)(wp + o) = *(const f32x4*)(rd + o) + acc[ai][bj][m][n]; }
                asm volatile("" ::: "memory"); }
    }
};

DI void transpose_item(const float* W, int K, int N, bf16_t* WT, int split, int extra, LAS float* scr, int item, int lane) {
    const int nblk = N / 32, kb = item / nblk, nb = item % nblk, k0 = 64 * kb, n0 = 32 * nb;
    const int row_off = (n0 >= split) ? extra : 0;
#pragma unroll 8
    for (int i = 0; i < 32; ++i) { const int kk = 2 * i + (lane >> 5); scr[kk * 33 + (lane & 31)] = W[(size_t)(k0 + kk) * N + n0 + (lane & 31)]; }
    asm volatile("s_waitcnt lgkmcnt(0)" ::: "memory");
    const int c = lane & 7;
#pragma unroll
    for (int j = 0; j < 4; ++j) { const int n = (lane >> 3) + 8 * j; const LAS float* s = scr + (8 * c) * 33 + n;
        u32x4 o; o.x = pk2(s[0 * 33], s[1 * 33]); o.y = pk2(s[2 * 33], s[3 * 33]); o.z = pk2(s[4 * 33], s[5 * 33]); o.w = pk2(s[6 * 33], s[7 * 33]);
        *(u32x4*)(WT + (size_t)(row_off + n0 + n) * K + k0 + 8 * c) = o; }
    asm volatile("s_waitcnt lgkmcnt(0)" ::: "memory");
}
DI void prologue(const Params& p, LAS unsigned char* lds, int gw, int NGW, int wave, int lane) {
    LAS float* scr = (LAS float*)(lds + wave * 16384);
    constexpr int I_IN = 16 * 182, I_QB = 4 * 24, I_KVB = 2 * 32, I_BR = 8 * 32, I_OUT = 16 * 32, I_UP = 16 * 128, I_DN = 64 * 32;
    constexpr int PER_L = I_IN + I_QB + I_KVB + 3 * I_BR + I_OUT + I_UP + I_DN;
    for (int it = gw; it < 2 * PER_L; it += NGW) {
        const int l = it / PER_L; int r = it % PER_L;
        unsigned char* wb = p.ws + WS_W + (size_t)l * LW_STRIDE;
        if (r < I_IN) { transpose_item(p.in[4] + (size_t)l * 1024 * 5824, 1024, 5824, (bf16_t*)(wb + W_IN), 2752, 64, scr, r, lane); continue; } r -= I_IN;
        if (r < I_QB) { transpose_item(p.in[16] + (size_t)l * 256 * 768, 256, 768, (bf16_t*)(wb + W_QB), 1 << 30, 0, scr, r, lane); continue; } r -= I_QB;
        if (r < I_KVB) { transpose_item(p.in[18] + (size_t)l * 128 * 1024, 128, 1024, (bf16_t*)(wb + W_KVB), 1 << 30, 0, scr, r, lane); continue; } r -= I_KVB;
        if (r < 3 * I_BR) { const int b = r / I_BR; transpose_item(p.in[21 + b] + (size_t)l * 512 * 1024, 512, 1024, (bf16_t*)(wb + W_BR) + (size_t)b * 1024 * 512, 1 << 30, 0, scr, r % I_BR, lane); continue; } r -= 3 * I_BR;
        if (r < I_OUT) { transpose_item(p.in[24] + (size_t)l * 1024 * 1024, 1024, 1024, (bf16_t*)(wb + W_OUT), 1 << 30, 0, scr, r, lane); continue; } r -= I_OUT;
        if (r < I_UP) { transpose_item(p.in[26] + (size_t)l * 1024 * 4096, 1024, 4096, (bf16_t*)(wb + W_UP), 1 << 30, 0, scr, r, lane); continue; } r -= I_UP;
        transpose_item(p.in[27] + (size_t)l * 4096 * 1024, 4096, 1024, (bf16_t*)(wb + W_DOWN), 1 << 30, 0, scr, r, lane);
    }
    { float* mx0 = (float*)(p.ws + WS_METAX);
      for (int r = gw; r < 4 * 256; r += NGW) { const int rr = r & 255; f32x4* o = (f32x4*)(mx0 + (size_t)r * DM) + lane;
#pragma unroll
        for (int j = 0; j < 4; ++j) o[64 * j] = (rr < 16) ? ((const f32x4*)(p.in[2] + (size_t)rr * DM))[lane + 64 * j] : (f32x4){0.f, 0.f, 0.f, 0.f}; } }
    float* m0 = (float*)(p.ws + WS_META0);
    for (int r = gw; r < 256; r += NGW) { f32x4* o = (f32x4*)(m0 + (size_t)r * DM) + lane;
#pragma unroll
        for (int j = 0; j < 4; ++j) o[64 * j] = (r < 16) ? ((const f32x4*)(p.in[2] + (size_t)r * DM))[lane + 64 * j] : (f32x4){0.f, 0.f, 0.f, 0.f}; }
}

DI void norm_phase(const XMap& xm, int rows, const float* g, bf16_t* XN, int gw, int NGW, int lane) {
    for (int r = gw; r < rows; r += NGW) {
        const float* xrow = xm.xr(r >> 8) + (size_t)(r & 255) * DM;
        const f32x4* xr = (const f32x4*)xrow + lane;
        f32x4 v[4]; float s = 0.f;
#pragma unroll
        for (int j = 0; j < 4; ++j) { v[j] = xr[64 * j]; s += (v[j].x * v[j].x + v[j].y * v[j].y) + (v[j].z * v[j].z + v[j].w * v[j].w); }
        const float rs = rsqrtf(wave_sum(s, lane) * (1.f / DM) + 1e-6f);
        u32x2* o8 = (u32x2*)(XN + (size_t)r * DM) + lane;
#pragma unroll
        for (int j = 0; j < 4; ++j) { const f32x4 gg = ((const f32x4*)g)[lane + 64 * j]; u32x2 w; w.x = pk2(v[j].x * rs * gg.x, v[j].y * rs * gg.y); w.y = pk2(v[j].z * rs * gg.z, v[j].w * rs * gg.w); o8[64 * j] = w; }
    }
}

template <int W, int W0, int ROPE> DI void norm_task(const bf16_t* s0, const bf16_t* s1, const float* gain, float oscale, bf16_t* dst, float pa, float pb) {
    float ss = 0.f;
#pragma unroll 2
    for (int c = 0; c < W / 8; ++c) { float x[8]; ld8(c < W0 / 8 ? s0 + 8 * c : s1 + 8 * (c - W0 / 8), x);
#pragma unroll
        for (int e = 0; e < 8; ++e) ss += x[e] * x[e]; }
    const float rs = rsqrtf(ss * (1.f / W) + 1e-6f) * oscale;
    constexpr int NPLAIN = ROPE == 1 ? 0 : (ROPE == 2 ? 16 : W / 8);
#pragma unroll 2
    for (int c = 0; c < NPLAIN; ++c) { float x[8]; ld8(c < W0 / 8 ? s0 + 8 * c : s1 + 8 * (c - W0 / 8), x);
#pragma unroll
        for (int e = 0; e < 8; ++e) x[e] *= rs * gain[8 * c + e];
        st8(dst + 8 * c, x); }
    if constexpr (ROPE != 0) {
        constexpr int NB = ROPE == 1 ? 2 : 1, HC = ROPE == 1 ? 2 : 4, C0 = ROPE == 1 ? 0 : 16;
#pragma unroll
        for (int b = 0; b < NB; ++b) { const float pos = b ? pb : pa;
#pragma unroll
            for (int k = 0; k < HC; ++k) { const int c1 = C0 + 2 * HC * b + k, c2 = c1 + HC; float x1[8], x2[8];
                ld8(c1 < W0 / 8 ? s0 + 8 * c1 : s1 + 8 * (c1 - W0 / 8), x1); ld8(c2 < W0 / 8 ? s0 + 8 * c2 : s1 + 8 * (c2 - W0 / 8), x2);
#pragma unroll
                for (int e = 0; e < 8; ++e) { const int j = 8 * k + e; const float inv = ROPE == 1 ? inv64(2 * j) : inv64(j); float sn, cs; sincos_ang(pos * inv, sn, cs);
                    const float y1 = x1[e] * rs * gain[8 * c1 + e], y2 = x2[e] * rs * gain[8 * c2 + e]; x1[e] = y1 * cs - y2 * sn; x2[e] = y2 * cs + y1 * sn; }
                st8(dst + 8 * c1, x1); st8(dst + 8 * c2, x2); } }
    }
}
template <int W> DI void transpose_task(const bf16_t* src, bf16_t* dstT, int row) {
#pragma unroll 2
    for (int c = 0; c < W / 8; ++c) { const u32x4 r = *(const u32x4*)(src + 8 * c);
#pragma unroll
        for (int i = 0; i < 4; ++i) { dstT[(size_t)(8 * c + 2 * i) * RA + row] = (bf16_t)(r[i] & 0xffffu); dstT[(size_t)(8 * c + 2 * i + 1) * RA + row] = (bf16_t)(r[i] >> 16); } }
}
struct RowPos { float lin, row, col; };
DI RowPos row_pos(const Chunk& ck, int r) {
    const int li = r >= ck.rows_per_seq() ? r - ck.rows_per_seq() : r; RowPos p;
    if (li < ck.n) { p.lin = (float)(li + 16); p.row = (float)(li >> 6); p.col = (float)(li & 63); }
    else if (li < ck.n + 16) { p.lin = (float)(li - ck.n); p.row = -1.f; p.col = (float)(li - ck.n); }
    else { p.lin = 0.f; p.row = 0.f; p.col = 0.f; }
    return p;
}

DI void ew1_phase(const Params& p, const Chunk& ck, int l, int gw, int NGW, int lane) {
    unsigned char* ws = p.ws; asm volatile("" : "+s"(ws));
    const bf16_t* ZM = (const bf16_t*)(ws + WS_ZM); bf16_t* QKV = (bf16_t*)(ws + WS_QKV);
    bf16_t* CQN = (bf16_t*)(ws + WS_SM + SM_CQN); bf16_t* CKVN = (bf16_t*)(ws + WS_SM + SM_CKVN); bf16_t* KPE = (bf16_t*)(ws + WS_SM + SM_KPE);
    const int nrb = ck.rows() / 64; const float QS = 0.125f * LOG2E;
    for (int w = gw; w < nrb * 34; w += NGW) {
        const int rb = w / 34, task = w % 34, row = rb * 64 + lane;
        const bf16_t* z = ZM + (size_t)row * ZM_LD; const RowPos ps = row_pos(ck, row);
        if (task < 8) { const int h = task; norm_task<64, 64, 1>(z + 64 * h, z, p.in[6] + l * 64, QS, QKV + QA_O + ((size_t)h * RA + row) * 64, ps.row, ps.col); }
        else if (task < 10) { const int h = task - 8; norm_task<64, 64, 1>(z + 512 + 64 * h, z, p.in[7] + l * 64, 1.f, QKV + KA_O + ((size_t)h * RA + row) * 64, ps.row, ps.col); }
        else if (task < 12) { const int h = task - 10; transpose_task<64>(z + 640 + 64 * h, QKV + VA_O + (size_t)h * 64 * RA, row); }
        else if (task < 20) { const int hm = task - 12; norm_task<64, 64, 0>(z + 768 + 64 * hm, z, p.in[8] + l * 64, QS, QKV + QB_O + ((size_t)hm * RA + row) * 64, 0.f, 0.f); }
        else if (task < 28) { const int hm = task - 20; norm_task<64, 64, 0>(z + 1280 + 64 * hm, z, p.in[9] + l * 64, 1.f, QKV + KB_O + ((size_t)hm * RA + row) * 64, 0.f, 0.f); }
        else if (task < 32) { const int h = task - 28; transpose_task<128>(z + 1792 + 128 * h, QKV + VB_O + (size_t)h * 128 * RA, row); }
        else if (task == 32) { norm_task<256, 256, 0>(z + 2304, z, p.in[15] + l * 256, 1.f, CQN + (size_t)row * 256, 0.f, 0.f); }
        else { norm_task<128, 128, 0>(z + 2560, z, p.in[17] + l * 128, 1.f, CKVN + (size_t)row * 128, 0.f, 0.f);
#pragma unroll
            for (int c = 0; c < 8; ++c) *(u32x4*)(KPE + (size_t)row * 64 + 8 * c) = *(const u32x4*)(z + 2688 + 8 * c); }
    }
}
DI void ew2_phase(const Params& p, const Chunk& ck, int l, int gw, int NGW, int lane) {
    unsigned char* ws = p.ws; asm volatile("" : "+s"(ws));
    const bf16_t* QCR = (const bf16_t*)(ws + WS_ZM + OFF_QCR); const bf16_t* KVR = (const bf16_t*)(ws + WS_ZM + OFF_KVR); const bf16_t* KPE = (const bf16_t*)(ws + WS_SM + SM_KPE);
    bf16_t* QKV = (bf16_t*)(ws + WS_QKV);
    const int nrb = ck.rows() / 64; const float QS = 0.07216878364870322f * LOG2E;
    for (int w = gw; w < nrb * 12; w += NGW) {
        const int rb = w / 12, task = w % 12, row = rb * 64 + lane; const RowPos ps = row_pos(ck, row);
        if (task < 4) { const int h = task; norm_task<192, 192, 2>(QCR + (size_t)row * 768 + 192 * h, QCR, p.in[19] + l * 192, QS, QKV + QC_O + ((size_t)h * RA + row) * 192, ps.lin, 0.f); }
        else if (task < 8) { const int h = task - 4; norm_task<192, 128, 2>(KVR + (size_t)row * 1024 + 256 * h, KPE + (size_t)row * 64, p.in[20] + l * 192, 1.f, QKV + KC_O + ((size_t)h * RA + row) * 192, ps.lin, 0.f); }
        else { const int h = task - 8; transpose_task<128>(KVR + (size_t)row * 1024 + 256 * h + 128, QKV + VC_O + (size_t)h * 128 * RA, row); }
    }
}
DI void ew3_phase(const Params& p, const Chunk& ck, int l, bool last, int gw, int NGW, int lane) {
    unsigned char* ws = p.ws; asm volatile("" : "+s"(ws));
    bf16_t* O1 = (bf16_t*)(ws + WS_ZM) + 1 * OSLOT; const bf16_t* O2 = (const bf16_t*)(ws + WS_ZM) + 3 * OSLOT;
    const float d1 = wave_sum(p.in[10][l * 64 + lane] * p.in[11][l * 64 + lane], lane), d2 = wave_sum(p.in[12][l * 64 + lane] * p.in[13][l * 64 + lane], lane);
    int lz = l; asm volatile("" : "+s"(lz));
    const float lam_init = __uint_as_float(lz == 0 ? 0x3e4ccccdu : 0x3eb60549u)  , lam = expf(d1) - expf(d2) + lam_init, osc = 1.f - lam_init;
    const float* gs = p.in[14] + l * 128;
    const int nrb = ck.rows() / 64;
    for (int w = gw; w < nrb * 4; w += NGW) {
        const int rb = w >> 2, h = w & 3, row = rb * 64 + lane;
        if (last && (row >= ck.rows_per_seq() ? row - ck.rows_per_seq() : row) >= (ck.tps - 1) * 256) continue;
        bf16_t* a = O1 + (size_t)row * 512 + 128 * h; const bf16_t* b = O2 + (size_t)row * 512 + 128 * h;
        float ss = 0.f;
#pragma unroll 2
        for (int c = 0; c < 16; ++c) { float x[8], y[8]; ld8(a + 8 * c, x); ld8(b + 8 * c, y);
#pragma unroll
            for (int e = 0; e < 8; ++e) { const float d = x[e] - lam * y[e]; ss += d * d; } }
        const float rs = rsqrtf(ss * (1.f / 128.f) + 1e-6f) * osc;
#pragma unroll 2
        for (int c = 0; c < 16; ++c) { float x[8], y[8]; ld8(a + 8 * c, x); ld8(b + 8 * c, y);
#pragma unroll
            for (int e = 0; e < 8; ++e) x[e] = (x[e] - lam * y[e]) * rs * gs[8 * c + e];
            st8(a + 8 * c, x); }
    }
}

template <int DQK, int DV, bool ALIBI, bool PIPE>
DI void attn_unit(LAS unsigned char* lds, const bf16_t* __restrict__ Q, const bf16_t* __restrict__ K, const bf16_t* __restrict__ Vt, bf16_t* __restrict__ O, int r0, int qb, int n, float sl, const int wid, const int dkeys = 0x3fffffff, const float mref = 0.f) {
    constexpr bool FIXEDREF = !PIPE;
    constexpr bool EARLYV = true;
    constexpr bool NEGM = (DQK == 64);
    constexpr int KROW = DQK * 2 + 16, KT = 64 * KROW, VROW = 144, VT = DV * VROW, KCH = DQK / 8, NKC = 64 * KCH / 512, NVC = DV * 8 / 512, NKS = DQK / 16, NDB = DV / 32, VB0 = 2 * KT;
    typedef const __attribute__((address_space(1))) u32x4* gptr;
    const int lane = lane_fresh(), tid = wid * 64 + lane, r = lane & 31, h = lane >> 5;
    const int nk = n + 16, NT = (nk + 63) >> 6;
    const int li = qb * 256 + wid * 32 + r;
    const int tq = ALIBI ? ((4 * qb + 3 < NT - 1) ? 4 * qb + 3 : NT - 1) : -1;
    int tlo = 0, thi = NT - 2, NIT = NT;
    if (ALIBI && qb * 256 < n) {
        const int x = qb * 256 + 16 - dkeys - 79, y = qb * 256 + 255 + 16 + dkeys - 16;
        tlo = x > 0 ? (x + 63) >> 6 : 0; if (tlo > tq) tlo = tq;
        thi = (y >> 6) < NT - 2 ? (y >> 6) : NT - 2; if (thi < tq) thi = tq;
        NIT = (tq - tlo + 1) + (thi - tq) + 1;
    }
    const int nleft = tq - tlo + 1;
#define TILE(j) (ALIBI ? ((j) < nleft ? tq - (j) : (tq + 1 + (j) - nleft <= thi ? tq + 1 + (j) - nleft : NT - 1)) : (j))
    const bool active = (qb * 256 + wid * 32) < nk;
    const int qrow = r0 + li;
    const float qlin = (li < n) ? (float)(li + 16) : (li < nk ? (float)(li - n) : 0.f);
    bf16x8 qf[NKS];
#pragma unroll
    for (int ks = 0; ks < NKS; ++ks) qf[ks] = *(const bf16x8*)(Q + (size_t)qrow * DQK + ks * 16 + h * 8);
    f32x16 o[NDB];
#pragma unroll
    for (int d = 0; d < NDB; ++d)
#pragma unroll
        for (int i = 0; i < 16; ++i) o[d][i] = 0.f;
    float m = FIXEDREF ? mref : 0.f, l = 0.f; f32x16 negm, zero16;
#pragma unroll
    for (int i = 0; i < 16; ++i) { negm[i] = FIXEDREF ? -mref : 0.f; zero16[i] = 0.f; }
    const bf16_t* kg0 = K + (size_t)r0 * DQK + tid * 8; const bf16_t* vg0 = Vt + (size_t)(tid >> 3) * RA + r0 + (tid & 7) * 8; const int vl0 = VB0 + (tid >> 3) * VROW + (tid & 7) * 16;
#define KL(i) ((((tid + 512 * (i)) / KCH) * KROW) + ((tid + 512 * (i)) % KCH) * 16)
#define KG(i, t) ((gptr)(kg0 + (i) * 4096 + (size_t)(t) * 64 * DQK))
#define VG(i, t) ((gptr)(vg0 + (size_t)(i) * 64 * RA + (size_t)(t) * 64))
#define VL(i) (vl0 + (i) * 64 * VROW)
    const int pr = (r & ~12) | ((r & 4) << 1) | ((r & 8) >> 1);
    const int kaddr = pr * KROW + h * 16, vaddr = VB0 + r * VROW + h * 16;
    u32x4 kst[NKC], vst[NVC], kstn[NKC], vstn[NVC];
#define QK_TILE(A0, A1, kb_) do { const int ko_ = (kb_) * KT + kaddr; \
        _Pragma("unroll") for (int kb4 = 0; kb4 < NKS; kb4 += 4) { bf16x8 kq[8]; \
            _Pragma("unroll") for (int j = 0; j < 4; ++j) { kq[2 * j] = *(const LAS bf16x8*)(lds + ko_ + (kb4 + j) * 32); kq[2 * j + 1] = *(const LAS bf16x8*)(lds + ko_ + 32 * KROW + (kb4 + j) * 32); } \
            asm volatile("" : "+v"(kq[0]), "+v"(kq[1]), "+v"(kq[2]), "+v"(kq[3]), "+v"(kq[4]), "+v"(kq[5]), "+v"(kq[6]), "+v"(kq[7]));     \
            _Pragma("unroll") for (int j = 0; j < 4; ++j) { \
                if (kb4 + j == 0) { A0 = __builtin_amdgcn_mfma_f32_32x32x16_bf16(kq[0], qf[0], NEGM ? negm : zero16, 0, 0, 0); A1 = __builtin_amdgcn_mfma_f32_32x32x16_bf16(kq[1], qf[0], NEGM ? negm : zero16, 0, 0, 0); } \
                else { A0 = __builtin_amdgcn_mfma_f32_32x32x16_bf16(kq[2 * j], qf[kb4 + j], A0, 0, 0, 0); A1 = __builtin_amdgcn_mfma_f32_32x32x16_bf16(kq[2 * j + 1], qf[kb4 + j], A1, 0, 0, 0); } } \
            __builtin_amdgcn_sched_barrier(0); } } while (0)
#pragma unroll
    for (int i = 0; i < NKC; ++i) kst[i] = *KG(i, TILE(0));
#pragma unroll
    for (int i = 0; i < NVC; ++i) vst[i] = *VG(i, TILE(0));
#pragma unroll
    for (int i = 0; i < NKC; ++i) *(LAS u32x4*)(lds + KL(i)) = kst[i];
#pragma unroll
    for (int i = 0; i < NVC; ++i) *(LAS u32x4*)(lds + VL(i)) = vst[i];
    if constexpr (PIPE) {
#pragma unroll
        for (int i = 0; i < NKC; ++i) kst[i] = *KG(i, 1);
#pragma unroll
        for (int i = 0; i < NKC; ++i) *(LAS u32x4*)(lds + KT + KL(i)) = kst[i];
#pragma unroll
        for (int i = 0; i < NKC; ++i) kst[i] = *KG(i, 2);
#pragma unroll
        for (int i = 0; i < NVC; ++i) vst[i] = *VG(i, 1);
    }
    __syncthreads();
    f32x16 s0, s1, n0, n1;
    if constexpr (PIPE) { QK_TILE(s0, s1, 0); __syncthreads(); }
    for (int jt = 0; jt < NIT; ++jt) {
        const int t = PIPE ? jt : TILE(jt), tn = TILE(jt + 1);
        const int cb = jt & 1;
        const bool moreV = (jt + 1 < NIT), moreK = PIPE ? (jt + 2 < NIT) : moreV;
        if constexpr (PIPE) {
            if (t + 3 < NT) {
#pragma unroll
                for (int i = 0; i < NKC; ++i) kstn[i] = *KG(i, t + 3);
            }
            if (t + 2 < NT) {
#pragma unroll
                for (int i = 0; i < NVC; ++i) vstn[i] = *VG(i, t + 2);
            }
        } else {
            if (moreK) {
#pragma unroll
                for (int i = 0; i < NKC; ++i) kst[i] = *KG(i, tn);
            }
            if (moreV) {
#pragma unroll
                for (int i = 0; i < NVC; ++i) vst[i] = *VG(i, tn);
            }
#ifdef PROBE_MEM2
            { int zo = 0; asm volatile("" : "+v"(zo));
              if (moreK) {
#pragma unroll
                for (int i = 0; i < NKC; ++i) { u32x4 d = *(KG(i, t + 1) + zo); asm volatile("" :: "v"(d)); } }
              if (moreV) {
#pragma unroll
                for (int i = 0; i < NVC; ++i) { u32x4 d = *(VG(i, t + 1) + zo); asm volatile("" :: "v"(d)); } } }
#endif
        }
        if (active) {
        if constexpr (PIPE) { if (moreV) QK_TILE(n0, n1, cb ^ 1); }
        else QK_TILE(s0, s1, cb);
        bf16x8 vf0[8];
        if constexpr (EARLYV) {
#pragma unroll
            for (int j = 0; j < 8; ++j) vf0[j] = *(const LAS bf16x8*)(lds + cb * VT + vaddr + (j >> 2) * 32 * VROW + (j & 3) * 32);
        }
        if (t < NT - 1) {
            if constexpr (ALIBI) {
                const float qo = qlin - (float)(16 + 8 * h + t * 64);
#pragma unroll
                for (int i = 0; i < 16; ++i) { const float ci = (float)(16 * (i >> 3) + (i & 7)); s0[i] = __builtin_fmaf(-sl, __builtin_fabsf(qo - ci), s0[i]); s1[i] = __builtin_fmaf(-sl, __builtin_fabsf(qo - 32.f - ci), s1[i]); }
            }
        } else {
#pragma unroll
            for (int i = 0; i < 16; ++i) { const int kk = 16 * (i >> 3) + 8 * h + (i & 7);
                if (kk < 16) { if constexpr (ALIBI) s0[i] = __builtin_fmaf(-sl, __builtin_fabsf(qlin - (float)kk), s0[i]); } else s0[i] = -1e30f;
                s1[i] = -1e30f; }
        }
        if constexpr (!FIXEDREF) {
        float mx;
        { float a = MX2(s0[0], s1[0]), b = MX2(s0[1], s1[1]);
#pragma unroll
          for (int i = 2; i < 16; i += 2) { a = MX2(a, MX2(s0[i], s1[i])); b = MX2(b, MX2(s0[i + 1], s1[i + 1])); }
          mx = swap32_max(MX2(a, b)); }
        if constexpr (!NEGM) mx -= m;
        if (__builtin_expect(jt == 0 || __builtin_amdgcn_ballot_w64(mx > 8.f) != 0ull, 0)) {
            const float dl = (jt == 0) ? mx : fmaxf(mx, 0.f);
            m += dl;
            if constexpr (NEGM) {
#pragma unroll
                for (int i = 0; i < 16; ++i) { s0[i] -= dl; s1[i] -= dl; negm[i] = -m; } }
            if constexpr (PIPE) {
#pragma unroll
                for (int i = 0; i < 16; ++i) { n0[i] -= dl; n1[i] -= dl; } }
            if (jt != 0) { const float f = __builtin_amdgcn_exp2f(-dl); l *= f;
#pragma unroll
                for (int d = 0; d < NDB; ++d)
#pragma unroll
                    for (int i = 0; i < 16; ++i) o[d][i] *= f; }
            asm volatile("" ::: "memory");
        }
        }
        float ra = 0.f, rb = 0.f;
#pragma unroll
        for (int i = 0; i < 16; ++i) { s0[i] = __builtin_amdgcn_exp2f(NEGM ? s0[i] : s0[i] - m); s1[i] = __builtin_amdgcn_exp2f(NEGM ? s1[i] : s1[i] - m); ra += s0[i]; rb += s1[i]; }
        l += ra + rb;
        bf16x8 pf[4];
        { u32x4 w;
          w.x = pk2(s0[0], s0[1]); w.y = pk2(s0[2], s0[3]); w.z = pk2(s0[4], s0[5]); w.w = pk2(s0[6], s0[7]); pf[0] = __builtin_bit_cast(bf16x8, w);
          w.x = pk2(s0[8], s0[9]); w.y = pk2(s0[10], s0[11]); w.z = pk2(s0[12], s0[13]); w.w = pk2(s0[14], s0[15]); pf[1] = __builtin_bit_cast(bf16x8, w);
          w.x = pk2(s1[0], s1[1]); w.y = pk2(s1[2], s1[3]); w.z = pk2(s1[4], s1[5]); w.w = pk2(s1[6], s1[7]); pf[2] = __builtin_bit_cast(bf16x8, w);
          w.x = pk2(s1[8], s1[9]); w.y = pk2(s1[10], s1[11]); w.z = pk2(s1[12], s1[13]); w.w = pk2(s1[14], s1[15]); pf[3] = __builtin_bit_cast(bf16x8, w); }
#pragma unroll
        for (int d0 = 0; d0 < NDB; d0 += 2) { bf16x8 vf[8];
#pragma unroll
            for (int j = 0; j < 8; ++j) { if (EARLYV && d0 == 0) vf[j] = vf0[j]; else vf[j] = *(const LAS bf16x8*)(lds + cb * VT + vaddr + (d0 + (j >> 2)) * 32 * VROW + (j & 3) * 32); }
            asm volatile("" : "+v"(vf[0]), "+v"(vf[1]), "+v"(vf[2]), "+v"(vf[3]), "+v"(vf[4]), "+v"(vf[5]), "+v"(vf[6]), "+v"(vf[7]));
#pragma unroll
            for (int j = 0; j < 8; ++j) o[d0 + (j >> 2)] = __builtin_amdgcn_mfma_f32_32x32x16_bf16(vf[j], pf[j & 3], o[d0 + (j >> 2)], 0, 0, 0);
            __builtin_amdgcn_sched_barrier(0); }
        }
        if (moreK) {
#pragma unroll
            for (int i = 0; i < NKC; ++i) *(LAS u32x4*)(lds + (PIPE ? cb : (cb ^ 1)) * KT + KL(i)) = kst[i];
        }
        if (moreV) {
#pragma unroll
            for (int i = 0; i < NVC; ++i) *(LAS u32x4*)(lds + (cb ^ 1) * VT + VL(i)) = vst[i];
        }
        asm volatile("s_waitcnt lgkmcnt(0)" ::: "memory"); __builtin_amdgcn_s_barrier(); asm volatile("" ::: "memory");
        if constexpr (PIPE) { s0 = n0; s1 = n1;
#pragma unroll
            for (int i = 0; i < NKC; ++i) kst[i] = kstn[i];
#pragma unroll
            for (int i = 0; i < NVC; ++i) vst[i] = vstn[i]; }
    }
    l = swap32_add(l);
    const float il = 1.f / l;
    bf16_t* orow = O + (size_t)qrow * 512;
    if (active)
#pragma unroll
    for (int d = 0; d < NDB; ++d)
#pragma unroll
        for (int g = 0; g < 4; ++g) { u32x2 w; w.x = pk2(o[d][4 * g] * il, o[d][4 * g + 1] * il); w.y = pk2(o[d][4 * g + 2] * il, o[d][4 * g + 3] * il);
            *(u32x2*)(orow + 32 * d + 8 * g + 4 * h) = w; }
#undef KG
#undef KL
#undef VG
#undef VL
#undef QK_TILE
#undef TILE
}

template <int DV, bool ALIBI>
DI void attn_unit2(LAS unsigned char* lds, const bf16_t* __restrict__ Q, const bf16_t* __restrict__ K, const bf16_t* __restrict__ Vt, bf16_t* __restrict__ O, int r0, int qb, int n, float sl, const int wid) {
    constexpr int DQK = 64, KROW = DQK * 2 + 16, KT = 64 * KROW, VROW = 144, VT = DV * VROW, NVC = DV * 8 / 512, NKS = 4, NDB = DV / 32, VB0 = 2 * KT;
    typedef const __attribute__((address_space(1))) u32x4* gptr;
    const int lane = lane_fresh(), tid = wid * 64 + lane, r = lane & 31, h = lane >> 5;
    const int nk = n + 16, NT = (nk + 63) >> 6;
    const int li = qb * 256 + wid * 32 + r;
    const int qrow = r0 + li;
    const float qlin = (li < n) ? (float)(li + 16) : (li < nk ? (float)(li - n) : 0.f);
    bf16x8 qf[NKS];
#pragma unroll
    for (int ks = 0; ks < NKS; ++ks) qf[ks] = *(const bf16x8*)(Q + (size_t)qrow * DQK + ks * 16 + h * 8);
    f32x16 o[NDB];
#pragma unroll
    for (int d = 0; d < NDB; ++d)
#pragma unroll
        for (int i = 0; i < 16; ++i) o[d][i] = 0.f;
    float m = 0.f, l = 0.f; f32x16 negm;
#pragma unroll
    for (int i = 0; i < 16; ++i) negm[i] = 0.f;
    const bf16_t* kg0 = K + (size_t)r0 * DQK + tid * 8; const bf16_t* vg0 = Vt + (size_t)(tid >> 3) * RA + r0 + (tid & 7) * 8;
    const int kl0 = (tid >> 3) * KROW + (tid & 7) * 16, vl0 = VB0 + (tid >> 3) * VROW + (tid & 7) * 16;
#define KG2(t) ((gptr)(kg0 + (size_t)(t) * 64 * DQK))
#define VG2(i, t) ((gptr)(vg0 + (size_t)(i) * 64 * RA + (size_t)(t) * 64))
    const int pr = (r & ~12) | ((r & 4) << 1) | ((r & 8) >> 1);
    const int kaddr = pr * KROW + h * 16, vaddr = VB0 + r * VROW + h * 16;
    u32x4 kst, vst[NVC];
    bf16x8 kf[8];
#define LDK(kb_) do { _Pragma("unroll") for (int ks = 0; ks < 4; ++ks) { kf[2 * ks] = *(const LAS bf16x8*)(lds + (kb_) * KT + kaddr + ks * 32); kf[2 * ks + 1] = *(const LAS bf16x8*)(lds + (kb_) * KT + kaddr + 32 * KROW + ks * 32); } \
        asm volatile("" : "+v"(kf[0]), "+v"(kf[1]), "+v"(kf[2]), "+v"(kf[3]), "+v"(kf[4]), "+v"(kf[5]), "+v"(kf[6]), "+v"(kf[7])); } while (0)
#define QKM(A0, A1) do { A0 = __builtin_amdgcn_mfma_f32_32x32x16_bf16(kf[0], qf[0], negm, 0, 0, 0); A1 = __builtin_amdgcn_mfma_f32_32x32x16_bf16(kf[1], qf[0], negm, 0, 0, 0); \
        _Pragma("unroll") for (int ks = 1; ks < 4; ++ks) { A0 = __builtin_amdgcn_mfma_f32_32x32x16_bf16(kf[2 * ks], qf[ks], A0, 0, 0, 0); A1 = __builtin_amdgcn_mfma_f32_32x32x16_bf16(kf[2 * ks + 1], qf[ks], A1, 0, 0, 0); } } while (0)
#define PV2(vb_, d0_) do { bf16x8 vf[8]; \
        _Pragma("unroll") for (int j = 0; j < 8; ++j) vf[j] = *(const LAS bf16x8*)(lds + (vb_) * VT + vaddr + ((d0_) + (j >> 2)) * 32 * VROW + (j & 3) * 32); \
        asm volatile("" : "+v"(vf[0]), "+v"(vf[1]), "+v"(vf[2]), "+v"(vf[3]), "+v"(vf[4]), "+v"(vf[5]), "+v"(vf[6]), "+v"(vf[7])); \
        _Pragma("unroll") for (int j = 0; j < 8; ++j) o[(d0_) + (j >> 2)] = __builtin_amdgcn_mfma_f32_32x32x16_bf16(vf[j], pf[j & 3], o[(d0_) + (j >> 2)], 0, 0, 0); } while (0)
    kst = *KG2(0);
#pragma unroll
    for (int i = 0; i < NVC; ++i) vst[i] = *VG2(i, 0);
    *(LAS u32x4*)(lds + kl0) = kst;
#pragma unroll
    for (int i = 0; i < NVC; ++i) *(LAS u32x4*)(lds + vl0 + i * 64 * VROW) = vst[i];
    kst = *KG2(1);
    *(LAS u32x4*)(lds + KT + kl0) = kst;
    __syncthreads();
    f32x16 s0, s1, n0, n1;
    bf16x8 pf[4];
    LDK(0); QKM(s0, s1);
    __syncthreads();
    int vcur = 0;
    for (int t = 0; t < NT; ++t) {
        const int cb = t & 1;
        const bool moreV = (t + 1 < NT), moreK = (t + 2 < NT);
        const int vprev = (vcur == 0) ? 2 : vcur - 1, vnext = (vcur == 2) ? 0 : vcur + 1;
        if (moreK) kst = *KG2(t + 2);
        if (moreV) {
#pragma unroll
            for (int i = 0; i < NVC; ++i) vst[i] = *VG2(i, t + 1);
        }
#ifdef PROBE_MEM2
        { int zo = 0; asm volatile("" : "+v"(zo));
          if (moreK) { u32x4 d = *(KG2(t + 2) + zo); asm volatile("" :: "v"(d)); }
          if (moreV) {
#pragma unroll
            for (int i = 0; i < NVC; ++i) { u32x4 d = *(VG2(i, t + 1) + zo); asm volatile("" :: "v"(d)); } } }
#endif
        __builtin_amdgcn_s_setprio(1);
        if (moreV) { LDK(cb ^ 1); QKM(n0, n1); }
        if (t > 0) { PV2(vprev, 0); if constexpr (NDB == 4) PV2(vprev, 2); }
        __builtin_amdgcn_s_setprio(0);
        if (t < NT - 1) {
            if constexpr (ALIBI) {
                const float qo = qlin - (float)(16 + 8 * h + t * 64);
#pragma unroll
                for (int i = 0; i < 16; ++i) { const float ci = (float)(16 * (i >> 3) + (i & 7)); s0[i] = __builtin_fmaf(-sl, __builtin_fabsf(qo - ci), s0[i]); s1[i] = __builtin_fmaf(-sl, __builtin_fabsf(qo - 32.f - ci), s1[i]); }
            }
        } else {
#pragma unroll
            for (int i = 0; i < 16; ++i) { const int kk = 16 * (i >> 3) + 8 * h + (i & 7);
                if (kk < 16) { if constexpr (ALIBI) s0[i] = __builtin_fmaf(-sl, __builtin_fabsf(qlin - (float)kk), s0[i]); } else s0[i] = -1e30f;
                s1[i] = -1e30f; }
        }
        float mx;
        { float a = MX2(s0[0], s1[0]), b = MX2(s0[1], s1[1]);
#pragma unroll
          for (int i = 2; i < 16; i += 2) { a = MX2(a, MX2(s0[i], s1[i])); b = MX2(b, MX2(s0[i + 1], s1[i + 1])); }
          mx = swap32_max(MX2(a, b)); }
        if (__builtin_expect(t == 0 || __builtin_amdgcn_ballot_w64(mx > 8.f) != 0ull, 0)) {
            const float dl = (t == 0) ? mx : fmaxf(mx, 0.f);
            m += dl;
#pragma unroll
            for (int i = 0; i < 16; ++i) { s0[i] -= dl; s1[i] -= dl; n0[i] -= dl; n1[i] -= dl; negm[i] = -m; }
            if (t != 0) { const float f = __builtin_amdgcn_exp2f(-dl); l *= f;
#pragma unroll
                for (int d = 0; d < NDB; ++d)
#pragma unroll
                    for (int i = 0; i < 16; ++i) o[d][i] *= f; }
            asm volatile("" ::: "memory");
        }
        float ra = 0.f, rb = 0.f;
#pragma unroll
        for (int i = 0; i < 16; ++i) { s0[i] = __builtin_amdgcn_exp2f(s0[i]); s1[i] = __builtin_amdgcn_exp2f(s1[i]); ra += s0[i]; rb += s1[i]; }
        l += ra + rb;
        { u32x4 w;
          w.x = pk2(s0[0], s0[1]); w.y = pk2(s0[2], s0[3]); w.z = pk2(s0[4], s0[5]); w.w = pk2(s0[6], s0[7]); pf[0] = __builtin_bit_cast(bf16x8, w);
          w.x = pk2(s0[8], s0[9]); w.y = pk2(s0[10], s0[11]); w.z = pk2(s0[12], s0[13]); w.w = pk2(s0[14], s0[15]); pf[1] = __builtin_bit_cast(bf16x8, w);
          w.x = pk2(s1[0], s1[1]); w.y = pk2(s1[2], s1[3]); w.z = pk2(s1[4], s1[5]); w.w = pk2(s1[6], s1[7]); pf[2] = __builtin_bit_cast(bf16x8, w);
          w.x = pk2(s1[8], s1[9]); w.y = pk2(s1[10], s1[11]); w.z = pk2(s1[12], s1[13]); w.w = pk2(s1[14], s1[15]); pf[3] = __builtin_bit_cast(bf16x8, w); }
        if (moreK) *(LAS u32x4*)(lds + cb * KT + kl0) = kst;
        if (moreV) {
#pragma unroll
            for (int i = 0; i < NVC; ++i) *(LAS u32x4*)(lds + vnext * VT + vl0 + i * 64 * VROW) = vst[i];
        }
        asm volatile("s_waitcnt lgkmcnt(0)" ::: "memory"); __builtin_amdgcn_s_barrier(); asm volatile("" ::: "memory");
        s0 = n0; s1 = n1; vcur = vnext;
    }
    { const int vlast = (vcur == 0) ? 2 : vcur - 1; PV2(vlast, 0); if constexpr (NDB == 4) PV2(vlast, 2); }
    asm volatile("s_waitcnt lgkmcnt(0)" ::: "memory"); __builtin_amdgcn_s_barrier(); asm volatile("" ::: "memory");
    l = swap32_add(l);
    const float il = 1.f / l;
    bf16_t* orow = O + (size_t)qrow * 512;
#pragma unroll
    for (int d = 0; d < NDB; ++d)
#pragma unroll
        for (int g = 0; g < 4; ++g) { u32x2 w; w.x = pk2(o[d][4 * g] * il, o[d][4 * g + 1] * il); w.y = pk2(o[d][4 * g + 2] * il, o[d][4 * g + 3] * il);
            *(u32x2*)(orow + 32 * d + 8 * g + 4 * h) = w; }
#undef KG2
#undef VG2
#undef LDK
#undef QKM
#undef PV2
}


template <int DQK, int DV, bool ALIBI>
DI void attn_unit_s(LAS unsigned char* lds, const bf16_t* __restrict__ Q, const bf16_t* __restrict__ K, const bf16_t* __restrict__ Vt, bf16_t* __restrict__ O, int r0, int qb, int n, float sl, const int wid) {
    constexpr bool NEGM = (DQK == 64);
    constexpr int KROW = DQK * 2 + 16, KT = 64 * KROW, VROW = 144, VT = DV * VROW, KCH = DQK / 8, NKC = 64 * KCH / 512, NVC = DV * 8 / 512, NKS = DQK / 16, NDB = DV / 32, VB0 = 2 * KT;
    typedef const __attribute__((address_space(1))) u32x4* gptr;
#define LBAR() do { asm volatile("s_waitcnt lgkmcnt(0)" ::: "memory"); __builtin_amdgcn_s_barrier(); asm volatile("" ::: "memory"); } while (0)
#ifdef GRP_ODD
    const int grp_ = wid & 1;
#else
    const int grp_ = wid >> 2;
#endif
    const int lane = lane_fresh(), tid = wid * 64 + lane, r = lane & 31, h = lane >> 5, grp = grp_;
    const int nk = n + 16, NT = (nk + 63) >> 6;
    const int li = qb * 256 + wid * 32 + r;
    const int qrow = r0 + li;
    const float qlin = (li < n) ? (float)(li + 16) : (li < nk ? (float)(li - n) : 0.f);
    bf16x8 qf[NKS];
#pragma unroll
    for (int ks = 0; ks < NKS; ++ks) qf[ks] = *(const bf16x8*)(Q + (size_t)qrow * DQK + ks * 16 + h * 8);
    f32x16 o[NDB];
#pragma unroll
    for (int d = 0; d < NDB; ++d)
#pragma unroll
        for (int i = 0; i < 16; ++i) o[d][i] = 0.f;
    float m = 0.f, l = 0.f; f32x16 negm, zero16;
#pragma unroll
    for (int i = 0; i < 16; ++i) { negm[i] = 0.f; zero16[i] = 0.f; }
    const bf16_t* kg0 = K + (size_t)r0 * DQK + tid * 8; const bf16_t* vg0 = Vt + (size_t)(tid >> 3) * RA + r0 + (tid & 7) * 8; const int vl0 = VB0 + (tid >> 3) * VROW + (tid & 7) * 16;
#define KL(i) ((((tid + 512 * (i)) / KCH) * KROW) + ((tid + 512 * (i)) % KCH) * 16)
#define KG(i, t) ((gptr)(kg0 + (i) * 4096 + (size_t)(t) * 64 * DQK))
#define VG(i, t) ((gptr)(vg0 + (size_t)(i) * 64 * RA + (size_t)(t) * 64))
#define VL(i) (vl0 + (i) * 64 * VROW)
    const int pr = (r & ~12) | ((r & 4) << 1) | ((r & 8) >> 1);
    const int kaddr = pr * KROW + h * 16, vaddr = VB0 + r * VROW + h * 16;
    u32x4 kst[NKC], vst[NVC];
#pragma unroll
    for (int i = 0; i < NKC; ++i) kst[i] = *KG(i, 0);
#pragma unroll
    for (int i = 0; i < NKC; ++i) *(LAS u32x4*)(lds + KL(i)) = kst[i];
#pragma unroll
    for (int i = 0; i < NKC; ++i) kst[i] = *KG(i, 1);
#pragma unroll
    for (int i = 0; i < NVC; ++i) vst[i] = *VG(i, 0);
    __syncthreads();
    if (grp == 1) LBAR();
    f32x16 s0, s1; bf16x8 pf[4];
    for (int t = 0; t < NT; ++t) {
        const int cb = t & 1;
        { const int ko_ = cb * KT + kaddr;
#pragma unroll
          for (int kb4 = 0; kb4 < NKS; kb4 += 4) { bf16x8 kq[8];
#pragma unroll
            for (int j = 0; j < 4; ++j) { kq[2 * j] = *(const LAS bf16x8*)(lds + ko_ + (kb4 + j) * 32); kq[2 * j + 1] = *(const LAS bf16x8*)(lds + ko_ + 32 * KROW + (kb4 + j) * 32); }
            asm volatile("" : "+v"(kq[0]), "+v"(kq[1]), "+v"(kq[2]), "+v"(kq[3]), "+v"(kq[4]), "+v"(kq[5]), "+v"(kq[6]), "+v"(kq[7]));
#pragma unroll
            for (int j = 0; j < 4; ++j) {
                if (kb4 + j == 0) { s0 = __builtin_amdgcn_mfma_f32_32x32x16_bf16(kq[0], qf[0], NEGM ? negm : zero16, 0, 0, 0); s1 = __builtin_amdgcn_mfma_f32_32x32x16_bf16(kq[1], qf[0], NEGM ? negm : zero16, 0, 0, 0); }
                else { s0 = __builtin_amdgcn_mfma_f32_32x32x16_bf16(kq[2 * j], qf[kb4 + j], s0, 0, 0, 0); s1 = __builtin_amdgcn_mfma_f32_32x32x16_bf16(kq[2 * j + 1], qf[kb4 + j], s1, 0, 0, 0); } }
            __builtin_amdgcn_sched_barrier(0); } }
        if (t > 0) {
#pragma unroll
            for (int d0 = 0; d0 < NDB; d0 += 2) { bf16x8 vf[8];
#pragma unroll
                for (int j = 0; j < 8; ++j) vf[j] = *(const LAS bf16x8*)(lds + (cb ^ 1) * VT + vaddr + (d0 + (j >> 2)) * 32 * VROW + (j & 3) * 32);
                asm volatile("" : "+v"(vf[0]), "+v"(vf[1]), "+v"(vf[2]), "+v"(vf[3]), "+v"(vf[4]), "+v"(vf[5]), "+v"(vf[6]), "+v"(vf[7]));
#pragma unroll
                for (int j = 0; j < 8; ++j) o[d0 + (j >> 2)] = __builtin_amdgcn_mfma_f32_32x32x16_bf16(vf[j], pf[j & 3], o[d0 + (j >> 2)], 0, 0, 0);
                __builtin_amdgcn_sched_barrier(0); }
        }
        if (t + 1 < NT) {
#pragma unroll
            for (int i = 0; i < NKC; ++i) *(LAS u32x4*)(lds + (cb ^ 1) * KT + KL(i)) = kst[i];
        }
#pragma unroll
        for (int i = 0; i < NVC; ++i) *(LAS u32x4*)(lds + cb * VT + VL(i)) = vst[i];
        LBAR();
        if (t + 2 < NT) {
#pragma unroll
            for (int i = 0; i < NKC; ++i) kst[i] = *KG(i, t + 2);
        }
        if (t + 1 < NT) {
#pragma unroll
            for (int i = 0; i < NVC; ++i) vst[i] = *VG(i, t + 1);
        }
        if (t < NT - 1) {
            if constexpr (ALIBI) {
                const float qo = qlin - (float)(16 + 8 * h + t * 64);
#pragma unroll
                for (int i = 0; i < 16; ++i) { const float ci = (float)(16 * (i >> 3) + (i & 7)); s0[i] = __builtin_fmaf(-sl, __builtin_fabsf(qo - ci), s0[i]); s1[i] = __builtin_fmaf(-sl, __builtin_fabsf(qo - 32.f - ci), s1[i]); }
            }
        } else {
#pragma unroll
            for (int i = 0; i < 16; ++i) { const int kk = 16 * (i >> 3) + 8 * h + (i & 7);
                if (kk < 16) { if constexpr (ALIBI) s0[i] = __builtin_fmaf(-sl, __builtin_fabsf(qlin - (float)kk), s0[i]); } else s0[i] = -1e30f;
                s1[i] = -1e30f; }
        }
        float mx;
        { float a = MX2(s0[0], s1[0]), b = MX2(s0[1], s1[1]);
#pragma unroll
          for (int i = 2; i < 16; i += 2) { a = MX2(a, MX2(s0[i], s1[i])); b = MX2(b, MX2(s0[i + 1], s1[i + 1])); }
          mx = swap32_max(MX2(a, b)); }
        if constexpr (!NEGM) mx -= m;
        if (__builtin_expect(t == 0 || __builtin_amdgcn_ballot_w64(mx > 8.f) != 0ull, 0)) {
            const float dl = (t == 0) ? mx : fmaxf(mx, 0.f);
            m += dl;
            if constexpr (NEGM) {
#pragma unroll
                for (int i = 0; i < 16; ++i) { s0[i] -= dl; s1[i] -= dl; negm[i] = -m; } }
            if (t != 0) { const float f = __builtin_amdgcn_exp2f(-dl); l *= f;
#pragma unroll
                for (int d = 0; d < NDB; ++d)
#pragma unroll
                    for (int i = 0; i < 16; ++i) o[d][i] *= f; }
            asm volatile("" ::: "memory");
        }
        float ra = 0.f, rb = 0.f;
#pragma unroll
        for (int i = 0; i < 16; ++i) { s0[i] = __builtin_amdgcn_exp2f(NEGM ? s0[i] : s0[i] - m); s1[i] = __builtin_amdgcn_exp2f(NEGM ? s1[i] : s1[i] - m); ra += s0[i]; rb += s1[i]; }
        l += ra + rb;
        { u32x4 w;
          w.x = pk2(s0[0], s0[1]); w.y = pk2(s0[2], s0[3]); w.z = pk2(s0[4], s0[5]); w.w = pk2(s0[6], s0[7]); pf[0] = __builtin_bit_cast(bf16x8, w);
          w.x = pk2(s0[8], s0[9]); w.y = pk2(s0[10], s0[11]); w.z = pk2(s0[12], s0[13]); w.w = pk2(s0[14], s0[15]); pf[1] = __builtin_bit_cast(bf16x8, w);
          w.x = pk2(s1[0], s1[1]); w.y = pk2(s1[2], s1[3]); w.z = pk2(s1[4], s1[5]); w.w = pk2(s1[6], s1[7]); pf[2] = __builtin_bit_cast(bf16x8, w);
          w.x = pk2(s1[8], s1[9]); w.y = pk2(s1[10], s1[11]); w.z = pk2(s1[12], s1[13]); w.w = pk2(s1[14], s1[15]); pf[3] = __builtin_bit_cast(bf16x8, w); }
        LBAR();
    }
    { const int vb = (NT - 1) & 1;
#pragma unroll
      for (int d0 = 0; d0 < NDB; d0 += 2) { bf16x8 vf[8];
#pragma unroll
        for (int j = 0; j < 8; ++j) vf[j] = *(const LAS bf16x8*)(lds + vb * VT + vaddr + (d0 + (j >> 2)) * 32 * VROW + (j & 3) * 32);
        asm volatile("" : "+v"(vf[0]), "+v"(vf[1]), "+v"(vf[2]), "+v"(vf[3]), "+v"(vf[4]), "+v"(vf[5]), "+v"(vf[6]), "+v"(vf[7]));
#pragma unroll
        for (int j = 0; j < 8; ++j) o[d0 + (j >> 2)] = __builtin_amdgcn_mfma_f32_32x32x16_bf16(vf[j], pf[j & 3], o[d0 + (j >> 2)], 0, 0, 0); } }
    if (grp == 0) LBAR();
    LBAR();
    l = swap32_add(l);
    const float il = 1.f / l;
    bf16_t* orow = O + (size_t)qrow * 512;
#pragma unroll
    for (int d = 0; d < NDB; ++d)
#pragma unroll
        for (int g = 0; g < 4; ++g) { u32x2 w; w.x = pk2(o[d][4 * g] * il, o[d][4 * g + 1] * il); w.y = pk2(o[d][4 * g + 2] * il, o[d][4 * g + 3] * il);
            *(u32x2*)(orow + 32 * d + 8 * g + 4 * h) = w; }
#undef KG
#undef KL
#undef VG
#undef VL
#undef LBAR
}

DI void attn_unit_a64(LAS unsigned char* lds, const bf16_t* __restrict__ Q, const bf16_t* __restrict__ K, const bf16_t* __restrict__ Vt, bf16_t* __restrict__ O, int r0, int qb, int n, int seqrows, const int wid) {
    constexpr int DQK = 64, KROW = 144, KT = 64 * KROW, VROW = 144, VT = 64 * VROW, VB0 = 2 * KT;
    typedef const __attribute__((address_space(1))) u32x4* gptr;
    const int lane = lane_fresh(), tid = wid * 64 + lane, r = lane & 31, h = lane >> 5;
    const int nk = n + 16, NT = (nk + 63) >> 6;
    const int li0 = qb * 512 + wid * 64 + r, li1 = li0 + 32;
    bf16x8 qf0[4], qf1[4];
#pragma unroll
    for (int ks = 0; ks < 4; ++ks) { qf0[ks] = *(const bf16x8*)(Q + (size_t)(r0 + li0) * DQK + ks * 16 + h * 8); qf1[ks] = *(const bf16x8*)(Q + (size_t)(r0 + li1) * DQK + ks * 16 + h * 8); }
    f32x16 oa0, oa1, ob0, ob1, zero16;
#pragma unroll
    for (int i = 0; i < 16; ++i) { oa0[i] = 0.f; oa1[i] = 0.f; ob0[i] = 0.f; ob1[i] = 0.f; zero16[i] = 0.f; }
    float ma = 0.f, mb = 0.f, la = 0.f, lb = 0.f;
    const bf16_t* kg0 = K + (size_t)r0 * DQK + tid * 8; const bf16_t* vg0 = Vt + (size_t)(tid >> 3) * RA + r0 + (tid & 7) * 8;
    const int kl0 = (tid >> 3) * KROW + (tid & 7) * 16, vl0 = VB0 + (tid >> 3) * VROW + (tid & 7) * 16;
    const int pr = (r & ~12) | ((r & 4) << 1) | ((r & 8) >> 1);
    const int kaddr = pr * KROW + h * 16, vaddr = VB0 + r * VROW + h * 16;
    u32x4 kst, vst;
    kst = *(gptr)kg0; vst = *(gptr)vg0;
    *(LAS u32x4*)(lds + kl0) = kst; *(LAS u32x4*)(lds + vl0) = vst;
    __syncthreads();
#define SOFTMAX64(S0, S1, M, L, OX0, OX1) do { \
        if (t == NT - 1) { _Pragma("unroll") for (int i = 0; i < 16; ++i) { if (i >= 8) S0[i] = -1e30f; S1[i] = -1e30f; } } \
        float a_ = MX2(S0[0], S1[0]), b_ = MX2(S0[1], S1[1]); \
        _Pragma("unroll") for (int i = 2; i < 16; i += 2) { a_ = MX2(a_, MX2(S0[i], S1[i])); b_ = MX2(b_, MX2(S0[i + 1], S1[i + 1])); } \
        const float mx_ = swap32_max(MX2(a_, b_)) - M; \
        if (__builtin_expect(t == 0 || __builtin_amdgcn_ballot_w64(mx_ > 8.f) != 0ull, 0)) { \
            const float dl_ = (t == 0) ? mx_ : fmaxf(mx_, 0.f); M += dl_; \
            if (t != 0) { const float f_ = __builtin_amdgcn_exp2f(-dl_); L *= f_; _Pragma("unroll") for (int i = 0; i < 16; ++i) { OX0[i] *= f_; OX1[i] *= f_; } } \
            asm volatile("" ::: "memory"); } \
        float ra_ = 0.f, rb_ = 0.f; \
        _Pragma("unroll") for (int i = 0; i < 16; ++i) { S0[i] = __builtin_amdgcn_exp2f(S0[i] - M); S1[i] = __builtin_amdgcn_exp2f(S1[i] - M); ra_ += S0[i]; rb_ += S1[i]; } \
        L += ra_ + rb_; \
        u32x4 w_; \
        w_.x = pk2(S0[0], S0[1]); w_.y = pk2(S0[2], S0[3]); w_.z = pk2(S0[4], S0[5]); w_.w = pk2(S0[6], S0[7]); pf[0] = __builtin_bit_cast(bf16x8, w_); \
        w_.x = pk2(S0[8], S0[9]); w_.y = pk2(S0[10], S0[11]); w_.z = pk2(S0[12], S0[13]); w_.w = pk2(S0[14], S0[15]); pf[1] = __builtin_bit_cast(bf16x8, w_); \
        w_.x = pk2(S1[0], S1[1]); w_.y = pk2(S1[2], S1[3]); w_.z = pk2(S1[4], S1[5]); w_.w = pk2(S1[6], S1[7]); pf[2] = __builtin_bit_cast(bf16x8, w_); \
        w_.x = pk2(S1[8], S1[9]); w_.y = pk2(S1[10], S1[11]); w_.z = pk2(S1[12], S1[13]); w_.w = pk2(S1[14], S1[15]); pf[3] = __builtin_bit_cast(bf16x8, w_); } while (0)
    for (int t = 0; t < NT; ++t) {
        const int cb = t & 1; const bool more = (t + 1 < NT);
        if (more) { kst = *(gptr)(kg0 + (size_t)(t + 1) * 64 * DQK); vst = *(gptr)(vg0 + (size_t)(t + 1) * 64); }
        bf16x8 kq[8];
#pragma unroll
        for (int j = 0; j < 4; ++j) { kq[2 * j] = *(const LAS bf16x8*)(lds + cb * KT + kaddr + j * 32); kq[2 * j + 1] = *(const LAS bf16x8*)(lds + cb * KT + kaddr + 32 * KROW + j * 32); }
        asm volatile("" : "+v"(kq[0]), "+v"(kq[1]), "+v"(kq[2]), "+v"(kq[3]), "+v"(kq[4]), "+v"(kq[5]), "+v"(kq[6]), "+v"(kq[7]));
        f32x16 sa0, sa1, sb0, sb1;
        sa0 = __builtin_amdgcn_mfma_f32_32x32x16_bf16(kq[0], qf0[0], zero16, 0, 0, 0); sa1 = __builtin_amdgcn_mfma_f32_32x32x16_bf16(kq[1], qf0[0], zero16, 0, 0, 0);
#pragma unroll
        for (int j = 1; j < 4; ++j) { sa0 = __builtin_amdgcn_mfma_f32_32x32x16_bf16(kq[2 * j], qf0[j], sa0, 0, 0, 0); sa1 = __builtin_amdgcn_mfma_f32_32x32x16_bf16(kq[2 * j + 1], qf0[j], sa1, 0, 0, 0); }
        sb0 = __builtin_amdgcn_mfma_f32_32x32x16_bf16(kq[0], qf1[0], zero16, 0, 0, 0); sb1 = __builtin_amdgcn_mfma_f32_32x32x16_bf16(kq[1], qf1[0], zero16, 0, 0, 0);
#pragma unroll
        for (int j = 1; j < 4; ++j) { sb0 = __builtin_amdgcn_mfma_f32_32x32x16_bf16(kq[2 * j], qf1[j], sb0, 0, 0, 0); sb1 = __builtin_amdgcn_mfma_f32_32x32x16_bf16(kq[2 * j + 1], qf1[j], sb1, 0, 0, 0); }
        bf16x8 vf[8];
#pragma unroll
        for (int j = 0; j < 8; ++j) vf[j] = *(const LAS bf16x8*)(lds + cb * VT + vaddr + (j >> 2) * 32 * VROW + (j & 3) * 32);
        bf16x8 pf[4];
        SOFTMAX64(sa0, sa1, ma, la, oa0, oa1);
        asm volatile("" : "+v"(vf[0]), "+v"(vf[1]), "+v"(vf[2]), "+v"(vf[3]), "+v"(vf[4]), "+v"(vf[5]), "+v"(vf[6]), "+v"(vf[7]));
#pragma unroll
        for (int j = 0; j < 4; ++j) { oa0 = __builtin_amdgcn_mfma_f32_32x32x16_bf16(vf[j], pf[j], oa0, 0, 0, 0); oa1 = __builtin_amdgcn_mfma_f32_32x32x16_bf16(vf[4 + j], pf[j], oa1, 0, 0, 0); }
        SOFTMAX64(sb0, sb1, mb, lb, ob0, ob1);
#pragma unroll
        for (int j = 0; j < 4; ++j) { ob0 = __builtin_amdgcn_mfma_f32_32x32x16_bf16(vf[j], pf[j], ob0, 0, 0, 0); ob1 = __builtin_amdgcn_mfma_f32_32x32x16_bf16(vf[4 + j], pf[j], ob1, 0, 0, 0); }
        if (more) { *(LAS u32x4*)(lds + (cb ^ 1) * KT + kl0) = kst; *(LAS u32x4*)(lds + (cb ^ 1) * VT + vl0) = vst; }
        asm volatile("s_waitcnt lgkmcnt(0)" ::: "memory"); __builtin_amdgcn_s_barrier(); asm volatile("" ::: "memory");
    }
#undef SOFTMAX64
    la = swap32_add(la); lb = swap32_add(lb);
    const float ia = 1.f / la, ib = 1.f / lb;
    if (li0 < seqrows) { bf16_t* orow = O + (size_t)(r0 + li0) * 512;
#pragma unroll
        for (int g = 0; g < 4; ++g) { u32x2 w; w.x = pk2(oa0[4 * g] * ia, oa0[4 * g + 1] * ia); w.y = pk2(oa0[4 * g + 2] * ia, oa0[4 * g + 3] * ia); *(u32x2*)(orow + 8 * g + 4 * h) = w;
            w.x = pk2(oa1[4 * g] * ia, oa1[4 * g + 1] * ia); w.y = pk2(oa1[4 * g + 2] * ia, oa1[4 * g + 3] * ia); *(u32x2*)(orow + 32 + 8 * g + 4 * h) = w; } }
    if (li1 < seqrows) { bf16_t* orow = O + (size_t)(r0 + li1) * 512;
#pragma unroll
        for (int g = 0; g < 4; ++g) { u32x2 w; w.x = pk2(ob0[4 * g] * ib, ob0[4 * g + 1] * ib); w.y = pk2(ob0[4 * g + 2] * ib, ob0[4 * g + 3] * ib); *(u32x2*)(orow + 8 * g + 4 * h) = w;
            w.x = pk2(ob1[4 * g] * ib, ob1[4 * g + 1] * ib); w.y = pk2(ob1[4 * g + 2] * ib, ob1[4 * g + 3] * ib); *(u32x2*)(orow + 32 + 8 * g + 4 * h) = w; } }
}

#if defined(STAGGER) && !defined(STAGGER_NOC)
#define ATTN_C attn_unit_s<192, 128, false>
#else
#define ATTN_C attn_unit<192, 128, false, false>
#endif
#if defined(STAGGER)
#define ATTN_B attn_unit_s<64, 128, true>
#define ATTN_A attn_unit_s<64, 64, false>
#elif defined(NOPIPE_AB)
#define ATTN_B attn_unit<64, 128, true, false>
#define ATTN_A attn_unit<64, 64, false, false>
#else
#define ATTN_B attn_unit<64, 128, true, false>
#define ATTN_A attn_unit2<64, false>
#endif
DI void attn_phase(const Params& p, const Chunk& ck, bool last, const int lidx, LAS unsigned char* lds, unsigned* q  , const int wave) {
    unsigned char* ws = p.ws; asm volatile("" : "+s"(ws));
    const bf16_t* QKV = (const bf16_t*)(ws + WS_QKV); bf16_t* OB = (bf16_t*)(ws + WS_ZM);
#if defined(PROBE_DUPC)
    constexpr int NDUP = 8, DUP0 = 0;
#elif defined(PROBE_DUPB)
    constexpr int NDUP = 16, DUP0 = 8;
#elif defined(PROBE_DUPA)
    constexpr int NDUP = 16, DUP0 = 24;
#else
    constexpr int NDUP = 0, DUP0 = 0;
#endif
    const int nmeta = last ? 0 : 20 * ck.nseq, nms = (nmeta + 7) >> 3, nsuper = nms + 40 + NDUP;
    volatile LAS int* su = (volatile LAS int*)(lds + LDS_MISC);
    float qkb, qka, qkc;
    { const int ln = lane_fresh();
      float g0 = fabsf(p.in[8][lidx * 64 + ln]), g1 = fabsf(p.in[9][lidx * 64 + ln]), g2 = fabsf(p.in[6][lidx * 64 + ln]), g3 = fabsf(p.in[7][lidx * 64 + ln]);
      float g4 = fmaxf(fmaxf(fabsf(p.in[19][lidx * 192 + ln]), fabsf(p.in[19][lidx * 192 + 64 + ln])), fabsf(p.in[19][lidx * 192 + 128 + ln]));
      float g5 = fmaxf(fmaxf(fabsf(p.in[20][lidx * 192 + ln]), fabsf(p.in[20][lidx * 192 + 64 + ln])), fabsf(p.in[20][lidx * 192 + 128 + ln]));
#pragma unroll
      for (int o = 1; o < 64; o <<= 1) {
#define WMAX_(g) g = fmaxf(g, __int_as_float(__builtin_amdgcn_ds_bpermute((ln ^ o) << 2, __float_as_int(g))))
          WMAX_(g0); WMAX_(g1); WMAX_(g2); WMAX_(g3); WMAX_(g4); WMAX_(g5);
#undef WMAX_
      }
      qkb = 1.05f * 64.f * 0.125f * LOG2E * g0 * g1; qka = 1.05f * 64.f * 0.125f * LOG2E * g2 * g3; qkc = 1.05f * 192.f * 0.07216878364870322f * LOG2E * g4 * g5;
      qkb = __uint_as_float(__builtin_amdgcn_readfirstlane(__float_as_uint(qkb))); qka = __uint_as_float(__builtin_amdgcn_readfirstlane(__float_as_uint(qka))); qkc = __uint_as_float(__builtin_amdgcn_readfirstlane(__float_as_uint(qkc))); }
    for (;;) {
        if (wave == 0 && lane_fresh() == 0) {
#ifdef FLATQ
            const unsigned x = 0u;
#else
            const unsigned x = (unsigned)__builtin_amdgcn_s_getreg((3 << 11) | 20) & 0xFu;
#endif
            int res = -1, lin = 0;
            for (;;) {
                const unsigned idx = __hip_atomic_fetch_add(q + 64 + 16 * x, 1u, __ATOMIC_RELAXED, __HIP_MEMORY_SCOPE_AGENT);
                const unsigned slot = (idx >> 5) & 63u; lin = (int)(idx & 31u);
                unsigned* te = q + 512 + x * 64 + slot; unsigned g;
                if (lin == 0) { g = __hip_atomic_fetch_add(q, 1u, __ATOMIC_RELAXED, __HIP_MEMORY_SCOPE_AGENT); __hip_atomic_store(te, g + 1u, __ATOMIC_RELAXED, __HIP_MEMORY_SCOPE_AGENT); }
                else { while ((g = __hip_atomic_load(te, __ATOMIC_RELAXED, __HIP_MEMORY_SCOPE_AGENT)) == 0u) __builtin_amdgcn_s_sleep(2); g -= 1u; }
                if ((int)g >= nsuper) { res = -1; break; }
                if ((int)g < nms && (lin >= 8 || (int)g * 8 + lin >= nmeta)) continue;
#ifdef A64
                if ((int)g >= nms + 24) {
                    const int sub_ = ((int)g - nms) & 1;
                    if (ck.nseq == 1 ? (sub_ == 1) : (lin >= 16)) continue; }
#endif
                res = (int)g; break;
            }
            su[0] = res; su[1] = lin;
        }
        __syncthreads();
        const int g = su[0], lin = su[1];
        __syncthreads();
        if (g < 0) break;
        int type, hd, s, qb;
        int sh = ck.nseq - 1; asm volatile("" : "+s"(sh));
        if (g < nms) { const int mu = g * 8 + lin, jh = mu >> sh; s = mu & sh; qb = ck.tps - 1;
            if (jh < 4) { type = 0; hd = jh; } else if (jh < 12) { type = 1; hd = jh - 4; } else { type = 2; hd = jh - 12; } }
        else { const int gr0 = g - nms, gr = gr0 >= 40 ? gr0 - 40 + DUP0 : gr0, sub = gr & 1;
            if (gr < 8) { type = 0; hd = gr >> 1; } else if (gr < 16) { type = 1; hd = 7 - ((gr - 8) >> 1); } else if (gr < 32) { type = 2; hd = (gr - 16) >> 1; } else { type = 1; hd = 3 - ((gr - 32) >> 1); }
            s = sub * sh; qb = lin + (sub * 32) * (1 - sh); }
        const int r0 = s * ck.rows_per_seq();
        if (type == 0) {
            ATTN_C(lds, QKV + QC_O + (size_t)hd * RA * 192, QKV + KC_O + (size_t)hd * RA * 192, QKV + VC_O + (size_t)hd * 128 * RA, OB + 2 * OSLOT + 128 * hd, r0, qb, ck.n, 0.f, wave, 0x3fffffff, qkc);
        } else if (type == 1) { const int hh = hd >> 1;
            const float sl = LOG2E * (hh == 0 ? 0.25f : hh == 1 ? 0.0625f : hh == 2 ? 0.015625f : 0.00390625f);
            const float dkf = 152.f / sl + 2.f; const int dkeys = dkf < 1.0e9f ? (int)dkf : 0x3fffffff;
            ATTN_B(lds, QKV + QB_O + (size_t)hd * RA * 64, QKV + KB_O + (size_t)hd * RA * 64, QKV + VB_O + (size_t)hh * 128 * RA, OB + ((hd & 1) ? 3 : 1) * OSLOT + 128 * hh, r0, qb, ck.n, sl, wave, dkeys, qkb);
        } else { const int kv = hd >> 2;
#ifdef A64
            const int qb5 = (g < nms) ? (ck.n >> 9) : lin;
            attn_unit_a64(lds, QKV + QA_O + (size_t)hd * RA * 64, QKV + KA_O + (size_t)kv * RA * 64, QKV + VA_O + (size_t)kv * 64 * RA, OB + 64 * hd, r0, qb5, ck.n, ck.rows_per_seq(), wave);
#else
            ATTN_A(lds, QKV + QA_O + (size_t)hd * RA * 64, QKV + KA_O + (size_t)kv * RA * 64, QKV + VA_O + (size_t)kv * 64 * RA, OB + 64 * hd, r0, qb, ck.n, 0.f, wave, 0x3fffffff, qka);
#endif
        }
    }
}

#define XB_TMO      128
#define XB_XCNT(j)  (256  + 64 * (j))
#define XB_XSUB(j)  (1280 + 64 * (j))
#define XB_XGEN(j)  (2304 + 64 * (j))
#define XB_TOP      3328
#define XB_TOPGEN   3392
#define XCD_BAR_WORDS 3456
#define XB_SPIN_CAP (1u << 22)
DI unsigned xb_ld(unsigned* p)              { return __hip_atomic_load(p, __ATOMIC_RELAXED, __HIP_MEMORY_SCOPE_AGENT); }
DI unsigned xb_add(unsigned* p, unsigned v) { return __hip_atomic_fetch_add(p, v, __ATOMIC_RELAXED, __HIP_MEMORY_SCOPE_AGENT); }
DI unsigned xb_xcc_id() { return (unsigned)__builtin_amdgcn_s_getreg((3 << 11) | 20) & 0xFu; }
#define XB_SPIN(cond, bar) do { unsigned _sp = 0; while (cond) { __builtin_amdgcn_s_sleep(1); \
    if ((++_sp & 255u) == 0u) { if (xb_ld(&(bar)[XB_TMO])) break; if (_sp > XB_SPIN_CAP) { atomicAdd(&(bar)[XB_TMO], 1u); break; } } } } while (0)
DI void xcd_barrier_complete(unsigned* bar, unsigned x, unsigned G, unsigned& nloc, unsigned& nx) {
    unsigned sum, cnt, mine, sp = 0u;
    for (;;) {
        sum = 0u; cnt = 0u; mine = 0u;
#pragma unroll
        for (unsigned j = 0; j < 16; ++j) { const unsigned c = xb_ld(&bar[XB_XCNT(j)]); sum += c; cnt += (c > 0u) ? 1u : 0u; mine = (j == x) ? c : mine; }
        if (sum == G) break;
        __builtin_amdgcn_s_sleep(1);
        if ((++sp & 255u) == 0u) { if (xb_ld(&bar[XB_TMO])) break; if (sp > XB_SPIN_CAP) { atomicAdd(&bar[XB_TMO], 1u); break; } }
    }
    nloc = mine > 0u ? mine : 1u; nx = cnt > 0u ? cnt : 1u;
}
DI void xcd_barrier(unsigned* bar, volatile LAS unsigned* st, const int wave) {
    asm volatile("s_waitcnt vmcnt(0)" ::: "memory");
    __syncthreads();
    if (wave == 0 && lane_fresh() == 0) {
        __builtin_amdgcn_s_waitcnt(0);
        const unsigned x = xb_xcc_id();
        unsigned nloc = st[0], nx = st[1];
        if (nloc == 0u) { xcd_barrier_complete(bar, x, gridDim.x, nloc, nx); st[0] = nloc; st[1] = nx; }
        const unsigned old = xb_add(&bar[XB_XSUB(x)], 1u);
        const unsigned gen = old / nloc;
        if (old + 1u == (gen + 1u) * nloc) {
            __builtin_amdgcn_fence(__ATOMIC_RELEASE, "agent");
            asm volatile("s_waitcnt vmcnt(0)" ::: "memory");
            const unsigned og = xb_add(&bar[XB_TOP], 1u);
            const unsigned tg = og / nx;
            if (og + 1u == (tg + 1u) * nx) xb_add(&bar[XB_TOPGEN], 1u);
            else XB_SPIN(xb_ld(&bar[XB_TOPGEN]) == tg, bar);
            __builtin_amdgcn_fence(__ATOMIC_ACQUIRE, "agent");
            xb_add(&bar[XB_XGEN(x)], 1u);
            asm volatile("s_waitcnt vmcnt(0)" ::: "memory");
        } else {
            XB_SPIN(xb_ld(&bar[XB_XGEN(x)]) == gen, bar);
            __builtin_amdgcn_fence(__ATOMIC_ACQUIRE, "agent");
            asm volatile("s_waitcnt vmcnt(0)" ::: "memory");
        }
    }
    __syncthreads();
}


#define SK_LOOP(ACC, AP, BP, KK) do { _Pragma("unroll") for (int k0_ = 0; k0_ < (KK); k0_ += 32) { \
        const bf16x8 a_ = *(const bf16x8*)((AP) + k0_), b_ = *(const bf16x8*)((BP) + k0_); ACC = __builtin_amdgcn_mfma_f32_16x16x32_bf16(a_, b_, ACC, 0, 0, 0); } } while (0)
DI void skinny_phase(int which  , const Params& p, const Chunk& ck, const XMap& xm, const unsigned char* wbl, int gw, int NGW, int lane) {
    unsigned char* ws = p.ws; asm volatile("" : "+s"(ws));
    const int row = lane & 15, quad = lane >> 4;
    if (which == 0) {
        const bf16_t* OB = (const bf16_t*)(ws + WS_ZM); const bf16_t* G = (const bf16_t*)(ws + WS_G); bf16_t* MGb = (bf16_t*)(ws + WS_XN);
        for (int it = gw; it < ck.nseq * 64; it += NGW) {
            const int s = it >> 6, tile = it & 63, R0 = (s * ck.tps + ck.tps - 1) * 256, col = tile * 16 + row;
            f32x4 sum = {0.f, 0.f, 0.f, 0.f};
#pragma unroll 1
            for (int z = 0; z < 3; ++z) { f32x4 a = {0.f, 0.f, 0.f, 0.f};
                const bf16_t* ap = OB + (size_t)z * OSLOT + (size_t)(R0 + row) * 512 + quad * 8; const bf16_t* bp = (const bf16_t*)(wbl + W_BR) + (size_t)z * 1024 * 512 + (size_t)col * 512 + quad * 8;
                SK_LOOP(a, ap, bp, 512);
#pragma unroll
                for (int j = 0; j < 4; ++j) { const float g = __uint_as_float((unsigned)G[(size_t)(R0 + quad * 4 + j) * G_LD + z * 1024 + col] << 16); sum[j] += g * a[j]; } }
#pragma unroll
            for (int j = 0; j < 4; ++j) MGb[(size_t)(R0 + quad * 4 + j) * DM + col] = (bf16_t)(pk2(sum[j], 0.f) & 0xffffu);
        }
    } else if (which == 2) {
        const bf16_t* XNp = (const bf16_t*)(ws + WS_XN); bf16_t* U_ = (bf16_t*)(ws + WS_G);
        for (int it = gw; it < ck.nseq * 256; it += NGW) {
            const int s = it >> 8, tile = it & 255, R0 = (s * ck.tps + ck.tps - 1) * 256, col = tile * 16 + row;
            f32x4 acc = {0.f, 0.f, 0.f, 0.f};
            const bf16_t* ap = XNp + (size_t)(R0 + row) * 1024 + quad * 8; const bf16_t* bp = (const bf16_t*)(wbl + W_UP) + (size_t)col * 1024 + quad * 8;
#pragma unroll 1
            for (int kh = 0; kh < 2; ++kh) SK_LOOP(acc, ap + kh * 512, bp + kh * 512, 512);
#pragma unroll
            for (int j = 0; j < 4; ++j) { const float v = fmaxf(acc[j], 0.f); U_[(size_t)(R0 + quad * 4 + j) * 4096 + col] = (bf16_t)(pk2(v * v, 0.f) & 0xffffu); }
        }
    } else {
        const int K = (which == 1) ? 1024 : 4096, nkc = K >> 9;
        const bf16_t* A = (which == 1) ? (const bf16_t*)(ws + WS_XN) : (const bf16_t*)(ws + WS_G);
        const bf16_t* W = (const bf16_t*)(wbl + (which == 1 ? W_OUT : W_DOWN));
        for (int it = gw; it < ck.nseq * 64 * nkc; it += NGW) {
            const int kc = it % nkc, rem = it / nkc, s = rem >> 6, tile = rem & 63, pt = s * ck.tps + ck.tps - 1, R0 = pt * 256, col = tile * 16 + row;
            f32x4 acc = {0.f, 0.f, 0.f, 0.f};
            const bf16_t* ap = A + (size_t)(R0 + row) * K + kc * 512 + quad * 8; const bf16_t* bp = W + (size_t)col * K + kc * 512 + quad * 8;
            SK_LOOP(acc, ap, bp, 512);
            float* wp = xm.xw(pt);
#pragma unroll
            for (int j = 0; j < 4; ++j) atomicAdd(wp + (size_t)(quad * 4 + j) * DM + col, acc[j]);
        }
    }
}

#define GSYNC() xcd_barrier(xbar, xst, wave)
__global__ void __launch_bounds__(512) fwd_kernel(Params p) {
    extern __shared__ __attribute__((aligned(16))) unsigned char lds_raw[];
    LAS unsigned char* lds = (LAS unsigned char*)lds_raw;
    cg::grid_group grid = cg::this_grid();
    const int wave = __builtin_amdgcn_readfirstlane((int)threadIdx.x >> 6); int lane = lane_fresh();
    const int G = gridDim.x, bx = blockIdx.x, NGW = G * 8, gw = bx * 8 + wave;
#define WSP(off) ({ unsigned char* w_ = p.ws; asm volatile("" : "+s"(w_)); w_ + (off); })
#define ctl ((unsigned*)WSP(WS_CTL))
#define xbar (ctl + 1024)
    volatile LAS unsigned* xst = (volatile LAS unsigned*)(lds + LDS_MISC + 16);
    if (wave == 0 && lane == 0) { xst[0] = 0u; xst[1] = 0u; (void)xb_add(&xbar[XB_XCNT(xb_xcc_id())], 1u); }
    __syncthreads();
#define XN ((bf16_t*)WSP(WS_XN))
#define ZM ((bf16_t*)WSP(WS_ZM))
#define GB ((bf16_t*)WSP(WS_G))
#define CQN ((bf16_t*)WSP(WS_SM + SM_CQN))
#define CKVN ((bf16_t*)WSP(WS_SM + SM_CKVN))
#define QCR ((bf16_t*)WSP(WS_ZM + OFF_QCR))
#define KVR ((bf16_t*)WSP(WS_ZM + OFF_KVR))
#define MG ((float*)WSP(WS_QKV))
#define U ((bf16_t*)WSP(WS_G))

#if !defined(PH) || (PH & 1)
    prologue(p, lds, gw, NGW, wave, lane);
#ifdef PROBE_PRO2
    prologue(p, lds, gw, NGW, wave, lane);
#endif
#endif
    grid.sync();
    for (int l = 0; l < 2; ++l) {
        const bool last = (l == 1);
#define wb (WSP(WS_W) + (size_t)l * LW_STRIDE)
        for (int c = 0; c < 3; ++c) {
            const Chunk ck = make_chunk(c);
            const int ta = ck.tps - 1;
            XMap xm; xm.out = p.out; xm.metax = (float*)WSP(WS_METAX); xm.xp = p.in[0]; xm.xs = p.in[1]; xm.meta0 = (const float*)WSP(WS_META0); xm.seq0 = ck.seq0; xm.tps = ck.tps; xm.first = (l == 0);
#define RELAUNDER() do { lane = lane_fresh(); } while (0)
            RELAUNDER();
#if !defined(PH) || (PH & 2)
            norm_phase(xm, ck.rows(), p.in[3] + l * DM, XN, gw, NGW, lane);
#ifdef PROBE_EW2
            RELAUNDER(); norm_phase(xm, ck.rows(), p.in[3] + l * DM, XN, gw, NGW, lane);
#endif
#endif
            GSYNC();
            { pg8::Gemm g{XN, (const bf16_t*)(wb + W_IN), 1024, 0, 0}; Sched S; S.init(ck.nseq, ck.tps, ck.tps, IN_N / 256, 1, G, bx);
              EpiIn E{ZM, GB, p.in[5] + l * 3072};
#if !defined(PH) || (PH & 4)
              pg8::gemm_phase<EpiIn, Sched, true, true>(lds, g, S, E, wave);
#ifdef PROBE_IN2
              pg8::gemm_phase<EpiIn, Sched, true, true>(lds, g, S, E, wave);
#endif
#endif
 }
            GSYNC();
            RELAUNDER();
#if !defined(PH) || (PH & 128)
            ew1_phase(p, ck, l, gw, NGW, lane);
#ifdef PROBE_EW2
            RELAUNDER(); ew1_phase(p, ck, l, gw, NGW, lane);
#endif
#endif
            GSYNC();
            { pg8::Gemm g{CQN, (const bf16_t*)(wb + W_QB), 256, 0, 0}; Sched S; S.init(ck.nseq, ck.tps, ck.tps, 3, 1, G, bx); EpiBf16<0> E{QCR, 768};
#if !defined(PH) || (PH & 8)
              pg8::gemm_phase<EpiBf16<0>, Sched, true, true>(lds, g, S, E, wave);
#endif
 }
            { pg8::Gemm g{CKVN, (const bf16_t*)(wb + W_KVB), 128, 0, 0}; Sched S; S.init(ck.nseq, ck.tps, ck.tps, 4, 1, G, bx); EpiBf16<0> E{KVR, 1024};
#if !defined(PH) || (PH & 8)
              pg8::gemm_phase<EpiBf16<0>, Sched, true, true>(lds, g, S, E, wave);
#endif
 }
            GSYNC();
            RELAUNDER();
#if !defined(PH) || (PH & 256)
            ew2_phase(p, ck, l, gw, NGW, lane);
#ifdef PROBE_EW2
            RELAUNDER(); ew2_phase(p, ck, l, gw, NGW, lane);
#endif
#endif
            GSYNC();
#if !defined(PH) || (PH & 1024)
            attn_phase(p, ck, last, l, lds, ctl + 8192 + 2048 * (l * 3 + c), wave);
#ifdef PROBE_ATTN2
            GSYNC();
            attn_phase(p, ck, last, l, lds, ctl + 8192 + 2048 * (6 + l * 3 + c), wave);
#endif
#endif
            GSYNC();
            RELAUNDER();
#if !defined(PH) || (PH & 512)
            ew3_phase(p, ck, l, last, gw, NGW, lane);
#endif
            GSYNC();
            { pg8::Gemm g{ZM, (const bf16_t*)(wb + W_BR), 512, OSLOT, (size_t)1024 * 512}; Sched S; S.init(ck.nseq, ta, ck.tps, 4, 3, G, bx); EpiBranch E{GB, MG, XN};
#if !defined(PH) || (PH & 16)
              pg8::gemm_phase<EpiBranch, Sched, true, true>(lds, g, S, E, wave);
#ifdef PROBE_BR2
              pg8::gemm_phase<EpiBranch, Sched, true, true>(lds, g, S, E, wave);
#endif
#endif
 }
            if (!last) { RELAUNDER(); skinny_phase(0, p, ck, xm, wb, gw, NGW, lane); }
            GSYNC();
            { pg8::Gemm g{XN, (const bf16_t*)(wb + W_OUT), 1024, 0, 0}; Sched S; S.init(ck.nseq, ta, ck.tps, 4, 1, G, bx); EpiResid E{xm};
#if !defined(PH) || (PH & 32)
              pg8::gemm_phase<EpiResid, Sched, true, true>(lds, g, S, E, wave);
#endif
 }
            if (!last) { RELAUNDER(); skinny_phase(1, p, ck, xm, wb, gw, NGW, lane); }
            GSYNC();
            xm.first = 0;
            RELAUNDER();
#if !defined(PH) || (PH & 2)
            norm_phase(xm, ck.rows(), p.in[25] + l * DM, XN, gw, NGW, lane);
#ifdef PROBE_EW2
            RELAUNDER(); norm_phase(xm, ck.rows(), p.in[25] + l * DM, XN, gw, NGW, lane);
#endif
#endif
            GSYNC();
            { pg8::Gemm g{XN, (const bf16_t*)(wb + W_UP), 1024, 0, 0}; Sched S; S.init(ck.nseq, ta, ck.tps, 16, 1, G, bx); EpiBf16<2> E{U, 4096};
#if !defined(PH) || (PH & 64)
              pg8::gemm_phase<EpiBf16<2>, Sched, true, true>(lds, g, S, E, wave);
#ifdef PROBE_UP2
              pg8::gemm_phase<EpiBf16<2>, Sched, true, true>(lds, g, S, E, wave);
#endif
#endif
 }
            if (!last) { RELAUNDER(); skinny_phase(2, p, ck, xm, wb, gw, NGW, lane); }
            GSYNC();
            { pg8::Gemm g{U, (const bf16_t*)(wb + W_DOWN), 4096, 0, 0}; Sched S; S.init(ck.nseq, ta, ck.tps, 4, 1, G, bx); EpiResid E{xm};
#if !defined(PH) || (PH & 32)
              pg8::gemm_phase<EpiResid, Sched, true, true>(lds, g, S, E, wave);
#endif
 }
            if (!last) { RELAUNDER(); skinny_phase(3, p, ck, xm, wb, gw, NGW, lane); }
        }
    }
}

extern "C" void kernel_launch(void* const* d_in, const int* in_sizes, int n_in, void* d_out, int out_size, void* d_ws, size_t ws_size, hipStream_t stream) {
    static int grid_blocks = 0;
    if (grid_blocks == 0) {
        if (n_in != 28 || ws_size < WS_END) { fprintf(stderr, "kernel_launch: unexpected n_in %d / ws_size %zu (need %zu)\n", n_in, ws_size, (size_t)WS_END); grid_blocks = -1; return; }
        int dev = 0, cus = 0, per_cu = 0;
        hipGetDevice(&dev); hipDeviceGetAttribute(&cus, hipDeviceAttributeMultiprocessorCount, dev);
        hipFuncSetAttribute((const void*)fwd_kernel, hipFuncAttributeMaxDynamicSharedMemorySize, LDS_BYTES);
        hipOccupancyMaxActiveBlocksPerMultiprocessor(&per_cu, (const void*)fwd_kernel, 512, LDS_BYTES);
        if (per_cu < 1) { fprintf(stderr, "kernel_launch: occupancy query says %d blocks/CU\n", per_cu); per_cu = 1; }
        grid_blocks = cus * 1;
        (void)hipGetLastError();
    }
    if (grid_blocks < 0) return;
    hipMemsetAsync((char*)d_ws + WS_CTL, 0, CTL_BYTES, stream);
    Params p{};
    for (int i = 0; i < 28; ++i) p.in[i] = (const float*)d_in[i];
    p.out = (float*)d_out; p.ws = (unsigned char*)d_ws;
    void* args[] = {&p};
    hipError_t e = hipLaunchCooperativeKernel((const void*)fwd_kernel, dim3(grid_blocks), dim3(512), args, LDS_BYTES, stream);
    if (e != hipSuccess) fprintf(stderr, "cooperative launch failed: %s (grid %d)\n", hipGetErrorString(e), grid_blocks);
}
```

```cpp
#include <hip/hip_runtime.h>
#include <hip/hip_cooperative_groups.h>
#include <cstdint>
#include <cstdio>
namespace cg = cooperative_groups;
#define NOPIPE_AB 1
#define FLATQ 1
namespace pg8 {
#define PG8_LAS __attribute__((address_space(3)))
typedef unsigned short bf16_t;
typedef short bf16x8 __attribute__((ext_vector_type(8)));
typedef float f32x4 __attribute__((ext_vector_type(4)));
typedef unsigned u32x4 __attribute__((ext_vector_type(4)));
constexpr int BM = 256, BK = 64, HALF = 128, HTB = HALF * BK * 2  , STAGE_BYTES = 8 * HTB, NXCD = 8, WGM = 8;

__host__ __device__ __forceinline__ int lds_byte(int r, int c) { const int st = (r >> 4) * 2 + (c >> 5), rr = r & 15, cc = c & 31, ob = rr * 64 + cc * 2; return st * 1024 + (ob ^ (((ob >> 9) & 1) << 5)); }
__host__ __device__ __forceinline__ void stage_rc(int b, int& R, int& C) { const int st = b / 1024, sb = b % 1024, swz = sb ^ (((sb >> 9) & 1) << 5); R = (st >> 1) * 16 + swz / 64; C = (st & 1) * 32 + (swz % 64) / 2; }
__host__ __device__ __forceinline__ int perm32(int rho) { const int n = rho >> 4, i = rho & 15; return 8 * (i >> 2) + 4 * n + (i & 3); }

struct Unit { int pm, pn, z; };
struct Gemm { const bf16_t* A; const bf16_t* Bt; int K; size_t zsA, zsB; };

template <class Epi, class Sched, bool ALIGN_EPI = false, bool SP2 = false>
__device__ __forceinline__ void gemm_phase(PG8_LAS unsigned char* lds, const Gemm g, const Sched& S, const Epi& E, const int wv  ) {
    int tid_; asm volatile("v_mbcnt_lo_u32_b32 %0, -1, 0\n\tv_mbcnt_hi_u32_b32 %0, -1, %0" : "=v"(tid_)); tid_ += wv * 64;
    const int tid = tid_, wid = __builtin_amdgcn_readfirstlane(tid >> 6), lane = tid & 63, wr = wid >> 2, wc = wid & 3, fr = lane & 15, fq = lane >> 4;
    const int K = g.K, nt = K / BK;
    unsigned voffA[2], voffB[2];
#pragma unroll
    for (int i = 0; i < 2; ++i) { int R, C; stage_rc(tid * 16 + i * 8192, R, C); const int Rb = Epi::PERM ? ((R & ~31) + perm32(R & 31)) : R;
        voffA[i] = (unsigned)(R * K + C) * 2u; voffB[i] = (unsigned)(Rb * K + C) * 2u; }
    const size_t kstep = (size_t)(BK * 2);
    const size_t hstep = (size_t)HALF * K * 2;
    const size_t tstep = 2 * hstep;
    const unsigned ldsw = (unsigned)wid * 1024u;
    const int aoff = lds_byte(wr * 64 + fr, fq * 8), boff = lds_byte(wc * 32 + fr, fq * 8);
#define PG8_SA(b, h) (((b) * 2 + (h)) * HTB)
#define PG8_SB(b, h) ((4 + (b) * 2 + (h)) * HTB)
#define PG8_STAGE(bufoff, gbase, voff) do { _Pragma("unroll") for (int _i = 0; _i < 2; ++_i) \
        __builtin_amdgcn_global_load_lds((const unsigned*)((const char*)(gbase) + (voff)[_i]), (PG8_LAS unsigned*)(lds + (bufoff) + ldsw + _i * 8192), 16, 0, 0); } while (0)
#define PG8_LDA(dst, b, h) do { _Pragma("unroll") for (int m = 0; m < 4; ++m) _Pragma("unroll") for (int k = 0; k < 2; ++k) dst[m][k] = *(const PG8_LAS bf16x8*)(lds + PG8_SA(b, h) + aoff + m * 2048 + k * 1024); } while (0)
#define PG8_LDB(dst, b, h) do { _Pragma("unroll") for (int n = 0; n < 2; ++n) _Pragma("unroll") for (int k = 0; k < 2; ++k) dst[n][k] = *(const PG8_LAS bf16x8*)(lds + PG8_SB(b, h) + boff + n * 2048 + k * 1024); } while (0)
#define PG8_MMA(ai, bj, At, Bt) do { __builtin_amdgcn_s_setprio(1); _Pragma("unroll") for (int m = 0; m < 4; ++m) _Pragma("unroll") for (int n = 0; n < 2; ++n) _Pragma("unroll") for (int k = 0; k < 2; ++k) \
        acc[ai][bj][m][n] = __builtin_amdgcn_mfma_f32_16x16x32_bf16(Bt[n][k], At[m][k], acc[ai][bj][m][n], 0, 0, 0); __builtin_amdgcn_s_setprio(0); } while (0)
#define PG8_WAIT_V(n) asm volatile("s_waitcnt vmcnt(" #n ")" ::: "memory")
#define PG8_WAIT_L(n) asm volatile("s_waitcnt lgkmcnt(" #n ")" ::: "memory")
#define PG8_BAR __builtin_amdgcn_s_barrier()
#define PG8_SCHED __builtin_amdgcn_sched_barrier(0)
    Unit cur, nxt; int ui = 0;
    if (!S.next(0, cur)) return;
    f32x4 acc[2][2][4][2];
#pragma unroll
    for (int a = 0; a < 2; ++a)
#pragma unroll
        for (int b = 0; b < 2; ++b)
#pragma unroll
            for (int m = 0; m < 4; ++m)
#pragma unroll
                for (int n = 0; n < 2; ++n) acc[a][b][m][n] = (f32x4){0.f, 0.f, 0.f, 0.f};
    bf16x8 At[4][2], B0[2][2], B1[2][2];
    const char* cA = (const char*)(g.A + (size_t)cur.z * g.zsA) + (size_t)cur.pm * tstep; const char* cB = (const char*)(g.Bt + (size_t)cur.z * g.zsB) + (size_t)cur.pn * tstep;
    S.a_ready(cur);
    if constexpr (SP2) {
        PG8_STAGE(PG8_SB(0, 0), cB, voffB); PG8_STAGE(PG8_SB(0, 1), cB + hstep, voffB); PG8_STAGE(PG8_SA(0, 0), cA, voffA); PG8_STAGE(PG8_SA(0, 1), cA + hstep, voffA);
        if (wr == 1) PG8_BAR;
        PG8_WAIT_V(2); PG8_BAR;
        PG8_STAGE(PG8_SB(1, 0), cB + kstep, voffB); PG8_STAGE(PG8_SA(1, 0), cA + kstep, voffA); PG8_STAGE(PG8_SB(1, 1), cB + hstep + kstep, voffB);
        PG8_WAIT_V(6); PG8_BAR;
    } else {
        PG8_STAGE(PG8_SB(0, 0), cB, voffB); PG8_STAGE(PG8_SA(0, 0), cA, voffA); PG8_STAGE(PG8_SB(0, 1), cB + hstep, voffB); PG8_STAGE(PG8_SA(0, 1), cA + hstep, voffA);
        if (wr == 1) PG8_BAR;
        PG8_WAIT_V(4); PG8_BAR;
        PG8_STAGE(PG8_SB(1, 0), cB + kstep, voffB); PG8_STAGE(PG8_SA(1, 0), cA + kstep, voffA); PG8_STAGE(PG8_SB(1, 1), cB + hstep + kstep, voffB);
        PG8_WAIT_V(6); PG8_BAR;
    }
    for (;;) {
        const bool has_next = S.next(ui + 1, nxt);
        const char* nA = has_next ? (const char*)(g.A + (size_t)nxt.z * g.zsA) + (size_t)nxt.pm * tstep : cA; const char* nB = has_next ? (const char*)(g.Bt + (size_t)nxt.z * g.zsB) + (size_t)nxt.pn * tstep : cB;
        for (int t = 0; t < nt; t += 2) {
            const bool last = (t == nt - 2);
            const char* a1 = cA + (size_t)(t + 1) * kstep;
            const char* a2 = last ? nA : cA + (size_t)(t + 2) * kstep; const char* b2 = last ? nB : cB + (size_t)(t + 2) * kstep;
            const char* a3 = a2 + kstep; const char* b3 = b2 + kstep;
            if (last && has_next) S.a_ready(nxt);
            if constexpr (SP2) {
            PG8_LDB(B0, 0, 0); PG8_LDB(B1, 0, 1); PG8_SCHED; PG8_LDA(At, 0, 0); PG8_STAGE(PG8_SA(1, 1), a1 + hstep, voffA);
            PG8_WAIT_V(8); PG8_WAIT_L(0); PG8_BAR; PG8_MMA(0, 0, At, B0); PG8_MMA(0, 1, At, B1); PG8_BAR; PG8_SCHED;
            PG8_LDA(At, 0, 1); PG8_STAGE(PG8_SB(0, 0), b2, voffB); PG8_STAGE(PG8_SB(0, 1), b2 + hstep, voffB); PG8_STAGE(PG8_SA(0, 0), a2, voffA);
            PG8_WAIT_V(8); PG8_WAIT_L(0); PG8_BAR; PG8_MMA(1, 0, At, B0); PG8_MMA(1, 1, At, B1); PG8_BAR; PG8_SCHED;
            PG8_LDB(B0, 1, 0); PG8_LDB(B1, 1, 1); PG8_SCHED; PG8_LDA(At, 1, 0); PG8_STAGE(PG8_SA(0, 1), a2 + hstep, voffA);
            PG8_WAIT_V(8); PG8_WAIT_L(0); PG8_BAR; PG8_MMA(0, 0, At, B0); PG8_MMA(0, 1, At, B1); PG8_BAR; PG8_SCHED;
            PG8_LDA(At, 1, 1); PG8_STAGE(PG8_SB(1, 0), b3, voffB); PG8_STAGE(PG8_SB(1, 1), b3 + hstep, voffB); PG8_STAGE(PG8_SA(1, 0), a3, voffA);
            PG8_WAIT_V(8); PG8_WAIT_L(0); PG8_BAR; PG8_MMA(1, 0, At, B0); PG8_MMA(1, 1, At, B1); PG8_BAR; PG8_SCHED;
            } else {
            PG8_LDB(B0, 0, 0); PG8_SCHED; PG8_LDA(At, 0, 0); PG8_STAGE(PG8_SA(1, 1), a1 + hstep, voffA);
            PG8_WAIT_L(8); PG8_BAR; PG8_WAIT_L(0); PG8_MMA(0, 0, At, B0); PG8_BAR; PG8_SCHED;
            PG8_LDB(B1, 0, 1); PG8_STAGE(PG8_SB(0, 0), b2, voffB);
            PG8_BAR; PG8_WAIT_L(0); PG8_MMA(0, 1, At, B1); PG8_BAR;
            PG8_LDA(At, 0, 1); PG8_STAGE(PG8_SA(0, 0), a2, voffA);
            PG8_BAR; PG8_WAIT_L(0); PG8_MMA(1, 0, At, B0); PG8_BAR; PG8_SCHED;
            PG8_STAGE(PG8_SB(0, 1), b2 + hstep, voffB);
            PG8_WAIT_V(6); PG8_BAR; PG8_MMA(1, 1, At, B1); PG8_BAR;
            PG8_LDB(B0, 1, 0); PG8_SCHED; PG8_LDA(At, 1, 0); PG8_STAGE(PG8_SA(0, 1), a2 + hstep, voffA);
            PG8_WAIT_L(8); PG8_BAR; PG8_WAIT_L(0); PG8_MMA(0, 0, At, B0); PG8_BAR; PG8_SCHED;
            PG8_LDB(B1, 1, 1); PG8_STAGE(PG8_SB(1, 0), b3, voffB);
            PG8_BAR; PG8_WAIT_L(0); PG8_MMA(0, 1, At, B1); PG8_BAR;
            PG8_LDA(At, 1, 1); PG8_STAGE(PG8_SA(1, 0), a3, voffA);
            PG8_BAR; PG8_WAIT_L(0); PG8_MMA(1, 0, At, B0); PG8_BAR; PG8_SCHED;
            PG8_STAGE(PG8_SB(1, 1), b3 + hstep, voffB);
            PG8_WAIT_V(6); PG8_BAR; PG8_MMA(1, 1, At, B1); PG8_BAR;
            }
        }
        if constexpr (ALIGN_EPI) { if (wr == 0) PG8_BAR; }
        if constexpr (!Epi::AFTER_DRAIN) { E(acc, cur, wr, wc, fr, fq); S.done(cur); }
        if (!has_next) break;
#pragma unroll
        for (int a = 0; a < 2; ++a)
#pragma unroll
            for (int b = 0; b < 2; ++b)
#pragma unroll
                for (int m = 0; m < 4; ++m)
#pragma unroll
                    for (int n = 0; n < 2; ++n) acc[a][b][m][n] = (f32x4){0.f, 0.f, 0.f, 0.f};
        cur = nxt; cA = nA; cB = nB; ++ui;
        if constexpr (ALIGN_EPI) { if (wr == 1) PG8_BAR; }
    }
    PG8_WAIT_V(0);
    if constexpr (!ALIGN_EPI) { if (wr == 0) PG8_BAR; }
    PG8_BAR;
    if constexpr (Epi::AFTER_DRAIN) { E.fused(acc, cur, wr, wc, fr, fq, lds, wid, lane); S.done(cur); }
#undef PG8_SA
#undef PG8_SB
#undef PG8_STAGE
#undef PG8_LDA
#undef PG8_LDB
#undef PG8_MMA
#undef PG8_WAIT_V
#undef PG8_WAIT_L
#undef PG8_BAR
#undef PG8_SCHED
}
}


using pg8::bf16_t; using pg8::bf16x8; using pg8::f32x4; using pg8::u32x4;
typedef float f32x16 __attribute__((ext_vector_type(16)));
typedef unsigned u32x2 __attribute__((ext_vector_type(2)));
typedef float f32x2_t __attribute__((ext_vector_type(2)));
typedef __bf16 bf16x2_t __attribute__((ext_vector_type(2)));
#define LAS __attribute__((address_space(3)))
#define DI __device__ __forceinline__

constexpr int DM = 1024, RA = 16896;
constexpr int ZM_LD = 2816, G_LD = 3072, IN_N = 5888;
constexpr float LOG2E = 1.4426950408889634f;
constexpr size_t MiB = 1u << 20;
constexpr size_t WS_CTL = 0, CTL_BYTES = 131072;
constexpr size_t WS_W = 1 * MiB, LW_STRIDE = 34 * MiB;
constexpr size_t W_IN = 0, W_QB = W_IN + (size_t)IN_N * 1024 * 2, W_KVB = W_QB + 768 * 256 * 2, W_BR = W_KVB + 1024 * 128 * 2,
                 W_OUT = W_BR + 3 * 1024 * 512 * 2, W_UP = W_OUT + 1024 * 1024 * 2, W_DOWN = W_UP + 4096 * 1024 * 2, W_END = W_DOWN + 4096 * 1024 * 2;
static_assert(W_END <= LW_STRIDE, "weights");
constexpr size_t WS_META0 = 69 * MiB, WS_METAX = 70 * MiB, WS_XN = 74 * MiB, WS_ZM = 107 * MiB, WS_G = 198 * MiB, WS_QKV = 297 * MiB, WS_SM = 438 * MiB, WS_END = 454 * MiB;
constexpr size_t OFF_QCR = 0, OFF_KVR = 25 * MiB;
constexpr size_t OSLOT = (size_t)RA * 512;
constexpr size_t QA_O = 0, KA_O = 512ull * RA, VA_O = 640ull * RA, QB_O = 768ull * RA, KB_O = 1280ull * RA, VB_O = 1792ull * RA, QC_O = 2304ull * RA, KC_O = 3072ull * RA, VC_O = 3840ull * RA;
constexpr size_t SM_CQN = 0, SM_CKVN = 9 * MiB, SM_KPE = 14 * MiB;
constexpr int LDS_MISC = 131072, LDS_BYTES = 131072 + 256;

struct Params { const float* in[28]; float* out; unsigned char* ws; };

DI unsigned pk2(float lo, float hi) { f32x2_t v = {lo, hi}; bf16x2_t b = __builtin_convertvector(v, bf16x2_t); return __builtin_bit_cast(unsigned, b); }
DI void ld8(const bf16_t* p, float (&f)[8]) {
    const u32x4 r = *(const u32x4*)p;
#pragma unroll
    for (int i = 0; i < 4; ++i) { f[2 * i] = __uint_as_float(r[i] << 16); f[2 * i + 1] = __uint_as_float(r[i] & 0xffff0000u); }
}
DI void st8(bf16_t* p, const float (&f)[8]) { u32x4 w; w.x = pk2(f[0], f[1]); w.y = pk2(f[2], f[3]); w.z = pk2(f[4], f[5]); w.w = pk2(f[6], f[7]); *(u32x4*)p = w; }
DI int lane_fresh() { int l; asm volatile("v_mbcnt_lo_u32_b32 %0, -1, 0\n\tv_mbcnt_hi_u32_b32 %0, -1, %0" : "=v"(l)); return l; }
DI float wave_sum(float v, int lane) {
#pragma unroll
    for (int o = 1; o < 64; o <<= 1) v += __int_as_float(__builtin_amdgcn_ds_bpermute((lane ^ o) << 2, __float_as_int(v)));
    return v;
}
DI float max3f(float a, float b, float c) { float r; asm("v_max3_f32 %0, %1, %2, %3" : "=v"(r) : "v"(a), "v"(b), "v"(c)); return r; }
DI float max2f(float a, float b) { float r; asm("v_max_f32_e32 %0, %1, %2" : "=v"(r) : "v"(a), "v"(b)); return r; }
DI float fadd_s(float a, float b) { float r; asm("v_add_f32_e32 %0, %1, %2" : "=v"(r) : "v"(a), "v"(b)); return r; }
#define MX2(a, b) __builtin_amdgcn_fmed3f((a), (b), __builtin_inff())
DI float swap32_max(float v) { auto rr = __builtin_amdgcn_permlane32_swap(__float_as_uint(v), __float_as_uint(v), false, false); return __builtin_amdgcn_fmed3f(__uint_as_float(rr[0]), __uint_as_float(rr[1]), __builtin_inff()); }
DI float swap32_add(float v) { auto rr = __builtin_amdgcn_permlane32_swap(__float_as_uint(v), __float_as_uint(v), false, false); return __uint_as_float(rr[0]) + __uint_as_float(rr[1]); }
DI constexpr float inv64(int j) {
    constexpr float T[32] = {1.0f, 0.749894209f, 0.562341325f, 0.421696503f, 0.316227766f, 0.237137371f, 0.177827941f, 0.133352143f, 0.1f, 0.0749894209f, 0.0562341325f, 0.0421696503f,
                             0.0316227766f, 0.0237137371f, 0.0177827941f, 0.0133352143f, 0.01f, 0.00749894209f, 0.00562341325f, 0.00421696503f, 0.00316227766f, 0.00237137371f,
                             0.00177827941f, 0.00133352143f, 0.001f, 0.000749894209f, 0.000562341325f, 0.000421696503f, 0.000316227766f, 0.000237137371f, 0.000177827941f, 0.000133352143f};
    return T[j];
}
DI void sincos_ang(float ang, float& s, float& c) {
    double t = (double)ang * 0.15915494309189535; t -= __builtin_rint(t); const float f = (float)t;
    s = __builtin_amdgcn_sinf(f); c = __builtin_amdgcn_cosf(f);
}

struct Chunk {
    int id, nseq, seq0, tps, n;
    DI int rows_per_seq() const { return tps * 256; }
    DI int rows() const { return nseq * tps * 256; }
};
DI Chunk make_chunk(int c) { Chunk k; k.id = c; if (c < 2) { k.nseq = 1; k.seq0 = c; k.tps = 65; k.n = 16384; } else { k.nseq = 2; k.seq0 = 2; k.tps = 33; k.n = 8192; } return k; }
struct XMap {
    float* out; float* metax; const float* xp; const float* xs; const float* meta0; int seq0, tps, first;
    DI float* xw(int pt) const {
        const int hi = pt >= tps ? 1 : 0, s = seq0 + hi, lt = pt - hi * tps;
        if (lt == tps - 1) return metax + (size_t)s * 256 * DM;
        const int ob = (s < 2) ? s * 16384 : 32768 + (s - 2) * 8192;
        return out + ((size_t)ob + (size_t)lt * 256) * DM;
    }
    DI const float* xr(int pt) const {
        if (!first) return xw(pt);
        const int hi = pt >= tps ? 1 : 0, s = seq0 + hi, lt = pt - hi * tps;
        if (lt == tps - 1) return metax + (size_t)s * 256 * DM;
        return (s < 2) ? xp + ((size_t)s * 16384 + (size_t)lt * 256) * DM : xs + ((size_t)(s - 2) * 8192 + (size_t)lt * 256) * DM;
    }
};

struct Sched {
    int nM, nN, nZ, nwg, G, c, ta, tps;
    DI void init(int nseq, int ta_, int tps_, int nN_, int nZ_, int G_, int c_) { ta = ta_; tps = tps_; nM = nseq * ta_; nN = nN_; nZ = nZ_; nwg = nM * nN; G = G_; c = c_; }
    DI bool next(int i, pg8::Unit& u) const {
        const int tl = (i / nZ) * G + c; if (tl >= nwg) return false;
        u.z = i % nZ;
        int wgid = tl; { const int q = nwg / pg8::NXCD, r = nwg % pg8::NXCD, xcd = wgid % pg8::NXCD, off = wgid / pg8::NXCD; wgid = (xcd < r ? xcd * (q + 1) : r * (q + 1) + (xcd - r) * q) + off; }
        const int nig = pg8::WGM * nN, gid = wgid / nig, fm = gid * pg8::WGM, gsz = (nM - fm) < pg8::WGM ? (nM - fm) : pg8::WGM;
        const int pa = fm + ((wgid % nig) % gsz); u.pn = (wgid % nig) / gsz;
        u.pm = pa >= ta ? pa - ta + tps : pa;
        return true;
    }
    DI void a_ready(const pg8::Unit&) const {}
    DI void done(const pg8::Unit&) const {}
};

template <int ACT  > struct EpiBf16 {
    static constexpr bool PERM = true, AFTER_DRAIN = false;
    bf16_t* O; int ldc;
    DI void operator()(const f32x4 (&acc)[2][2][4][2], const pg8::Unit& u, int wr, int wc, int fr_, int fq_) const {
        const int ln_ = lane_fresh(), fr = ln_ & 15, fq = ln_ >> 4;
        const int row0 = u.pm * 256 + wr * 64 + fr, col0 = u.pn * 256 + wc * 32 + 8 * fq;
#pragma unroll
        for (int ai = 0; ai < 2; ++ai)
#pragma unroll
            for (int m = 0; m < 4; ++m) { bf16_t* rowp = O + (size_t)(row0 + ai * 128 + m * 16) * ldc + col0;
#pragma unroll
                for (int bj = 0; bj < 2; ++bj) { f32x4 v0 = acc[ai][bj][m][0], v1 = acc[ai][bj][m][1];
                    if (ACT == 2) {
#pragma unroll
                        for (int k = 0; k < 4; ++k) { const float a = fmaxf(v0[k], 0.f), b = fmaxf(v1[k], 0.f); v0[k] = a * a; v1[k] = b * b; } }
                    u32x4 w; w.x = pk2(v0[0], v0[1]); w.y = pk2(v0[2], v0[3]); w.z = pk2(v1[0], v1[1]); w.w = pk2(v1[2], v1[3]);
                    *(u32x4*)(rowp + bj * 128) = w; } }
    }
};
struct EpiIn {
    static constexpr bool PERM = true, AFTER_DRAIN = false;
    bf16_t* ZM; bf16_t* G; const float* bgate;
    DI void operator()(const f32x4 (&acc)[2][2][4][2], const pg8::Unit& u, int wr, int wc, int fr_, int fq_) const {
        const int ln_ = lane_fresh(), fr = ln_ & 15, fq = ln_ >> 4;
        const bool gate = u.pn >= 11;
        const int row0 = u.pm * 256 + wr * 64 + fr, colt = gate ? (u.pn - 11) * 256 : u.pn * 256, col0 = colt + wc * 32 + 8 * fq, ld = gate ? G_LD : ZM_LD;
        bf16_t* base = gate ? G : ZM;
        f32x4 bv[2][2];
#pragma unroll
        for (int bj = 0; bj < 2; ++bj)
#pragma unroll
            for (int n = 0; n < 2; ++n) bv[bj][n] = gate ? *(const f32x4*)(bgate + col0 + bj * 128 + 4 * n) : (f32x4){0.f, 0.f, 0.f, 0.f};
#pragma unroll
        for (int ai = 0; ai < 2; ++ai)
#pragma unroll
            for (int m = 0; m < 4; ++m) { bf16_t* rowp = base + (size_t)(row0 + ai * 128 + m * 16) * ld + col0;
#pragma unroll
                for (int bj = 0; bj < 2; ++bj) { f32x4 v0 = acc[ai][bj][m][0] + bv[bj][0], v1 = acc[ai][bj][m][1] + bv[bj][1];
                    if (gate) {
#pragma unroll
                        for (int k = 0; k < 4; ++k) { v0[k] = __builtin_amdgcn_rcpf(1.f + __builtin_amdgcn_exp2f(-LOG2E * v0[k])); v1[k] = __builtin_amdgcn_rcpf(1.f + __builtin_amdgcn_exp2f(-LOG2E * v1[k])); } }
                    u32x4 w; w.x = pk2(v0[0], v0[1]); w.y = pk2(v0[2], v0[3]); w.z = pk2(v1[0], v1[1]); w.w = pk2(v1[2], v1[3]);
                    *(u32x4*)(rowp + bj * 128) = w; } }
    }
};
struct EpiBranch {
    static constexpr bool PERM = false, AFTER_DRAIN = false;
    const bf16_t* G; float* MG; bf16_t* MGb;
    DI void operator()(const f32x4 (&acc)[2][2][4][2], const pg8::Unit& u, int wr, int wc, int fr_, int fq_) const {
        const int ln_ = lane_fresh(), fr = ln_ & 15, fq = ln_ >> 4;
        const int row0 = u.pm * 256 + wr * 64 + fr, col0 = u.pn * 256 + wc * 32 + 4 * fq;
#pragma unroll
        for (int ai = 0; ai < 2; ++ai)
#pragma unroll
            for (int m = 0; m < 4; ++m) { const size_t row = (size_t)(row0 + ai * 128 + m * 16);
#pragma unroll
                for (int bj = 0; bj < 2; ++bj)
#pragma unroll
                    for (int n = 0; n < 2; ++n) { const int col = col0 + bj * 128 + n * 16;
                        const u32x2 gr = *(const u32x2*)(G + row * G_LD + u.z * 1024 + col);
                        f32x4 g; g[0] = __uint_as_float(gr.x << 16); g[1] = __uint_as_float(gr.x & 0xffff0000u); g[2] = __uint_as_float(gr.y << 16); g[3] = __uint_as_float(gr.y & 0xffff0000u);
                        f32x4 v = g * acc[ai][bj][m][n];
                        float* mp = MG + row * DM + col;
                        if (u.z > 0) v += *(const f32x4*)mp;
                        if (u.z < 2) *(f32x4*)mp = v;
                        else { u32x2 w; w.x = pk2(v[0], v[1]); w.y = pk2(v[2], v[3]); *(u32x2*)(MGb + row * DM + col) = w; } }
                asm volatile("" ::: "memory"); }
    }
};
struct EpiResid {
    static constexpr bool PERM = false, AFTER_DRAIN = false;
    XMap xm;
    DI void operator()(const f32x4 (&acc)[2][2][4][2], const pg8::Unit& u, int wr, int wc, int fr_, int fq_) const {
        const int ln_ = lane_fresh(), fr = ln_ & 15, fq = ln_ >> 4;
        const float* rd = xm.xr(u.pm); float* wp = xm.xw(u.pm);
        const int row0 = wr * 64 + fr, col0 = u.pn * 256 + wc * 32 + 4 * fq;
#pragma unroll
        for (int ai = 0; ai < 2; ++ai)
#pragma unroll
            for (int m = 0; m < 4; ++m) { const size_t off = (size_t)(row0 + ai * 128 + m * 16) * DM + col0;
#pragma unroll
                for (int bj = 0; bj < 2; ++bj)
#pragma unroll
                    for (int n = 0; n < 2; ++n) { const size_t o = off + bj * 128 + n * 16; *(f32x4*)(wp + o) = *(const f32x4*)(rd + o) + acc[ai][bj][m][n]; }
                asm volatile("" ::: "memory"); }
    }
};

DI void transpose_item(const float* W, int K, int N, bf16_t* WT, int split, int extra, LAS float* scr, int item, int lane) {
    const int nblk = N / 32, kb = item / nblk, nb = item % nblk, k0 = 64 * kb, n0 = 32 * nb;
    const int row_off = (n0 >= split) ? extra : 0;
#pragma unroll 8
    for (int i = 0; i < 32; ++i) { const int kk = 2 * i + (lane >> 5); scr[kk * 33 + (lane & 31)] = W[(size_t)(k0 + kk) * N + n0 + (lane & 31)]; }
    asm volatile("s_waitcnt lgkmcnt(0)" ::: "memory");
    const int c = lane & 7;
#pragma unroll
    for (int j = 0; j < 4; ++j) { const int n = (lane >> 3) + 8 * j; const LAS float* s = scr + (8 * c) * 33 + n;
        u32x4 o; o.x = pk2(s[0 * 33], s[1 * 33]); o.y = pk2(s[2 * 33], s[3 * 33]); o.z = pk2(s[4 * 33], s[5 * 33]); o.w = pk2(s[6 * 33], s[7 * 33]);
        *(u32x4*)(WT + (size_t)(row_off + n0 + n) * K + k0 + 8 * c) = o; }
    asm volatile("s_waitcnt lgkmcnt(0)" ::: "memory");
}
DI void prologue(const Params& p, LAS unsigned char* lds, int gw, int NGW, int wave, int lane) {
    LAS float* scr = (LAS float*)(lds + wave * 16384);
    constexpr int I_IN = 16 * 182, I_QB = 4 * 24, I_KVB = 2 * 32, I_BR = 8 * 32, I_OUT = 16 * 32, I_UP = 16 * 128, I_DN = 64 * 32;
    constexpr int PER_L = I_IN + I_QB + I_KVB + 3 * I_BR + I_OUT + I_UP + I_DN;
    for (int it = gw; it < 2 * PER_L; it += NGW) {
        const int l = it / PER_L; int r = it % PER_L;
        unsigned char* wb = p.ws + WS_W + (size_t)l * LW_STRIDE;
        if (r < I_IN) { transpose_item(p.in[4] + (size_t)l * 1024 * 5824, 1024, 5824, (bf16_t*)(wb + W_IN), 2752, 64, scr, r, lane); continue; } r -= I_IN;
        if (r < I_QB) { transpose_item(p.in[16] + (size_t)l * 256 * 768, 256, 768, (bf16_t*)(wb + W_QB), 1 << 30, 0, scr, r, lane); continue; } r -= I_QB;
        if (r < I_KVB) { transpose_item(p.in[18] + (size_t)l * 128 * 1024, 128, 1024, (bf16_t*)(wb + W_KVB), 1 << 30, 0, scr, r, lane); continue; } r -= I_KVB;
        if (r < 3 * I_BR) { const int b = r / I_BR; transpose_item(p.in[21 + b] + (size_t)l * 512 * 1024, 512, 1024, (bf16_t*)(wb + W_BR) + (size_t)b * 1024 * 512, 1 << 30, 0, scr, r % I_BR, lane); continue; } r -= 3 * I_BR;
        if (r < I_OUT) { transpose_item(p.in[24] + (size_t)l * 1024 * 1024, 1024, 1024, (bf16_t*)(wb + W_OUT), 1 << 30, 0, scr, r, lane); continue; } r -= I_OUT;
        if (r < I_UP) { transpose_item(p.in[26] + (size_t)l * 1024 * 4096, 1024, 4096, (bf16_t*)(wb + W_UP), 1 << 30, 0, scr, r, lane); continue; } r -= I_UP;
        transpose_item(p.in[27] + (size_t)l * 4096 * 1024, 4096, 1024, (bf16_t*)(wb + W_DOWN), 1 << 30, 0, scr, r, lane);
    }
    { float* mx0 = (float*)(p.ws + WS_METAX);
      for (int r = gw; r < 4 * 256; r += NGW) { const int rr = r & 255; f32x4* o = (f32x4*)(mx0 + (size_t)r * DM) + lane;
#pragma unroll
        for (int j = 0; j < 4; ++j) o[64 * j] = (rr < 16) ? ((const f32x4*)(p.in[2] + (size_t)rr * DM))[lane + 64 * j] : (f32x4){0.f, 0.f, 0.f, 0.f}; } }
    float* m0 = (float*)(p.ws + WS_META0);
    for (int r = gw; r < 256; r += NGW) { f32x4* o = (f32x4*)(m0 + (size_t)r * DM) + lane;
#pragma unroll
        for (int j = 0; j < 4; ++j) o[64 * j] = (r < 16) ? ((const f32x4*)(p.in[2] + (size_t)r * DM))[lane + 64 * j] : (f32x4){0.f, 0.f, 0.f, 0.f}; }
}

DI void norm_phase(const XMap& xm, int rows, const float* g, bf16_t* XN, int gw, int NGW, int lane) {
    for (int r = gw; r < rows; r += NGW) {
        const float* xrow = xm.xr(r >> 8) + (size_t)(r & 255) * DM;
        const f32x4* xr = (const f32x4*)xrow + lane;
        f32x4 v[4]; float s = 0.f;
#pragma unroll
        for (int j = 0; j < 4; ++j) { v[j] = xr[64 * j]; s += (v[j].x * v[j].x + v[j].y * v[j].y) + (v[j].z * v[j].z + v[j].w * v[j].w); }
        const float rs = rsqrtf(wave_sum(s, lane) * (1.f / DM) + 1e-6f);
        u32x2* o8 = (u32x2*)(XN + (size_t)r * DM) + lane;
#pragma unroll
        for (int j = 0; j < 4; ++j) { const f32x4 gg = ((const f32x4*)g)[lane + 64 * j]; u32x2 w; w.x = pk2(v[j].x * rs * gg.x, v[j].y * rs * gg.y); w.y = pk2(v[j].z * rs * gg.z, v[j].w * rs * gg.w); o8[64 * j] = w; }
    }
}

template <int W, int W0, int ROPE> DI void norm_task(const bf16_t* s0, const bf16_t* s1, const float* gain, float oscale, bf16_t* dst, float pa, float pb) {
    float ss = 0.f;
#pragma unroll 2
    for (int c = 0; c < W / 8; ++c) { float x[8]; ld8(c < W0 / 8 ? s0 + 8 * c : s1 + 8 * (c - W0 / 8), x);
#pragma unroll
        for (int e = 0; e < 8; ++e) ss += x[e] * x[e]; }
    const float rs = rsqrtf(ss * (1.f / W) + 1e-6f) * oscale;
    constexpr int NPLAIN = ROPE == 1 ? 0 : (ROPE == 2 ? 16 : W / 8);
#pragma unroll 2
    for (int c = 0; c < NPLAIN; ++c) { float x[8]; ld8(c < W0 / 8 ? s0 + 8 * c : s1 + 8 * (c - W0 / 8), x);
#pragma unroll
        for (int e = 0; e < 8; ++e) x[e] *= rs * gain[8 * c + e];
        st8(dst + 8 * c, x); }
    if constexpr (ROPE != 0) {
        constexpr int NB = ROPE == 1 ? 2 : 1, HC = ROPE == 1 ? 2 : 4, C0 = ROPE == 1 ? 0 : 16;
#pragma unroll
        for (int b = 0; b < NB; ++b) { const float pos = b ? pb : pa;
#pragma unroll
            for (int k = 0; k < HC; ++k) { const int c1 = C0 + 2 * HC * b + k, c2 = c1 + HC; float x1[8], x2[8];
                ld8(c1 < W0 / 8 ? s0 + 8 * c1 : s1 + 8 * (c1 - W0 / 8), x1); ld8(c2 < W0 / 8 ? s0 + 8 * c2 : s1 + 8 * (c2 - W0 / 8), x2);
#pragma unroll
                for (int e = 0; e < 8; ++e) { const int j = 8 * k + e; const float inv = ROPE == 1 ? inv64(2 * j) : inv64(j); float sn, cs; sincos_ang(pos * inv, sn, cs);
                    const float y1 = x1[e] * rs * gain[8 * c1 + e], y2 = x2[e] * rs * gain[8 * c2 + e]; x1[e] = y1 * cs - y2 * sn; x2[e] = y2 * cs + y1 * sn; }
                st8(dst + 8 * c1, x1); st8(dst + 8 * c2, x2); } }
    }
}
template <int W> DI void transpose_task(const bf16_t* src, bf16_t* dstT, int row) {
#pragma unroll 2
    for (int c = 0; c < W / 8; ++c) { const u32x4 r = *(const u32x4*)(src + 8 * c);
#pragma unroll
        for (int i = 0; i < 4; ++i) { dstT[(size_t)(8 * c + 2 * i) * RA + row] = (bf16_t)(r[i] & 0xffffu); dstT[(size_t)(8 * c + 2 * i + 1) * RA + row] = (bf16_t)(r[i] >> 16); } }
}
struct RowPos { float lin, row, col; };
DI RowPos row_pos(const Chunk& ck, int r) {
    const int li = r >= ck.rows_per_seq() ? r - ck.rows_per_seq() : r; RowPos p;
    if (li < ck.n) { p.lin = (float)(li + 16); p.row = (float)(li >> 6); p.col = (float)(li & 63); }
    else if (li < ck.n + 16) { p.lin = (float)(li - ck.n); p.row = -1.f; p.col = (float)(li - ck.n); }
    else { p.lin = 0.f; p.row = 0.f; p.col = 0.f; }
    return p;
}

DI void ew1_phase(const Params& p, const Chunk& ck, int l, int gw, int NGW, int lane) {
    unsigned char* ws = p.ws; asm volatile("" : "+s"(ws));
    const bf16_t* ZM = (const bf16_t*)(ws + WS_ZM); bf16_t* QKV = (bf16_t*)(ws + WS_QKV);
    bf16_t* CQN = (bf16_t*)(ws + WS_SM + SM_CQN); bf16_t* CKVN = (bf16_t*)(ws + WS_SM + SM_CKVN); bf16_t* KPE = (bf16_t*)(ws + WS_SM + SM_KPE);
    const int nrb = ck.rows() / 64; const float QS = 0.125f * LOG2E;
    for (int w = gw; w < nrb * 34; w += NGW) {
        const int rb = w / 34, task = w % 34, row = rb * 64 + lane;
        const bf16_t* z = ZM + (size_t)row * ZM_LD; const RowPos ps = row_pos(ck, row);
        if (task < 8) { const int h = task; norm_task<64, 64, 1>(z + 64 * h, z, p.in[6] + l * 64, QS, QKV + QA_O + ((size_t)h * RA + row) * 64, ps.row, ps.col); }
        else if (task < 10) { const int h = task - 8; norm_task<64, 64, 1>(z + 512 + 64 * h, z, p.in[7] + l * 64, 1.f, QKV + KA_O + ((size_t)h * RA + row) * 64, ps.row, ps.col); }
        else if (task < 12) { const int h = task - 10; transpose_task<64>(z + 640 + 64 * h, QKV + VA_O + (size_t)h * 64 * RA, row); }
        else if (task < 20) { const int hm = task - 12; norm_task<64, 64, 0>(z + 768 + 64 * hm, z, p.in[8] + l * 64, QS, QKV + QB_O + ((size_t)hm * RA + row) * 64, 0.f, 0.f); }
        else if (task < 28) { const int hm = task - 20; norm_task<64, 64, 0>(z + 1280 + 64 * hm, z, p.in[9] + l * 64, 1.f, QKV + KB_O + ((size_t)hm * RA + row) * 64, 0.f, 0.f); }
        else if (task < 32) { const int h = task - 28; transpose_task<128>(z + 1792 + 128 * h, QKV + VB_O + (size_t)h * 128 * RA, row); }
        else if (task == 32) { norm_task<256, 256, 0>(z + 2304, z, p.in[15] + l * 256, 1.f, CQN + (size_t)row * 256, 0.f, 0.f); }
        else { norm_task<128, 128, 0>(z + 2560, z, p.in[17] + l * 128, 1.f, CKVN + (size_t)row * 128, 0.f, 0.f);
#pragma unroll
            for (int c = 0; c < 8; ++c) *(u32x4*)(KPE + (size_t)row * 64 + 8 * c) = *(const u32x4*)(z + 2688 + 8 * c); }
    }
}
DI void ew2_phase(const Params& p, const Chunk& ck, int l, int gw, int NGW, int lane) {
    unsigned char* ws = p.ws; asm volatile("" : "+s"(ws));
    const bf16_t* QCR = (const bf16_t*)(ws + WS_ZM + OFF_QCR); const bf16_t* KVR = (const bf16_t*)(ws + WS_ZM + OFF_KVR); const bf16_t* KPE = (const bf16_t*)(ws + WS_SM + SM_KPE);
    bf16_t* QKV = (bf16_t*)(ws + WS_QKV);
    const int nrb = ck.rows() / 64; const float QS = 0.07216878364870322f * LOG2E;
    for (int w = gw; w < nrb * 12; w += NGW) {
        const int rb = w / 12, task = w % 12, row = rb * 64 + lane; const RowPos ps = row_pos(ck, row);
        if (task < 4) { const int h = task; norm_task<192, 192, 2>(QCR + (size_t)row * 768 + 192 * h, QCR, p.in[19] + l * 192, QS, QKV + QC_O + ((size_t)h * RA + row) * 192, ps.lin, 0.f); }
        else if (task < 8) { const int h = task - 4; norm_task<192, 128, 2>(KVR + (size_t)row * 1024 + 256 * h, KPE + (size_t)row * 64, p.in[20] + l * 192, 1.f, QKV + KC_O + ((size_t)h * RA + row) * 192, ps.lin, 0.f); }
        else { const int h = task - 8; transpose_task<128>(KVR + (size_t)row * 1024 + 256 * h + 128, QKV + VC_O + (size_t)h * 128 * RA, row); }
    }
}
DI void ew3_phase(const Params& p, const Chunk& ck, int l, bool last, int gw, int NGW, int lane) {
    unsigned char* ws = p.ws; asm volatile("" : "+s"(ws));
    bf16_t* O1 = (bf16_t*)(ws + WS_ZM) + 1 * OSLOT; const bf16_t* O2 = (const bf16_t*)(ws + WS_ZM) + 3 * OSLOT;
    const float d1 = wave_sum(p.in[10][l * 64 + lane] * p.in[11][l * 64 + lane], lane), d2 = wave_sum(p.in[12][l * 64 + lane] * p.in[13][l * 64 + lane], lane);
    int lz = l; asm volatile("" : "+s"(lz));
    const float lam_init = __uint_as_float(lz == 0 ? 0x3e4ccccdu : 0x3eb60549u)  , lam = expf(d1) - expf(d2) + lam_init, osc = 1.f - lam_init;
    const float* gs = p.in[14] + l * 128;
    const int nrb = ck.rows() / 64;
    for (int w = gw; w < nrb * 4; w += NGW) {
        const int rb = w >> 2, h = w & 3, row = rb * 64 + lane;
        if (last && (row >= ck.rows_per_seq() ? row - ck.rows_per_seq() : row) >= (ck.tps - 1) * 256) continue;
        bf16_t* a = O1 + (size_t)row * 512 + 128 * h; const bf16_t* b = O2 + (size_t)row * 512 + 128 * h;
        float ss = 0.f;
#pragma unroll 2
        for (int c = 0; c < 16; ++c) { float x[8], y[8]; ld8(a + 8 * c, x); ld8(b + 8 * c, y);
#pragma unroll
            for (int e = 0; e < 8; ++e) { const float d = x[e] - lam * y[e]; ss += d * d; } }
        const float rs = rsqrtf(ss * (1.f / 128.f) + 1e-6f) * osc;
#pragma unroll 2
        for (int c = 0; c < 16; ++c) { float x[8], y[8]; ld8(a + 8 * c, x); ld8(b + 8 * c, y);
#pragma unroll
            for (int e = 0; e < 8; ++e) x[e] = (x[e] - lam * y[e]) * rs * gs[8 * c + e];
            st8(a + 8 * c, x); }
    }
}

template <int DQK, int DV, bool ALIBI, bool PIPE>
DI void attn_unit(LAS unsigned char* lds, const bf16_t* __restrict__ Q, const bf16_t* __restrict__ K, const bf16_t* __restrict__ Vt, bf16_t* __restrict__ O, int r0, int qb, int n, float sl, const int wid, const int dkeys = 0x3fffffff, const float mref = 0.f) {
    constexpr bool FIXEDREF = !PIPE;
    constexpr bool EARLYV = true;
    constexpr bool NEGM = true;
    constexpr int KROW = DQK * 2 + 16, KT = 64 * KROW, VROW = 144, VT = DV * VROW, KCH = DQK / 8, NKC = 64 * KCH / 512, NVC = DV * 8 / 512, NKS = DQK / 16, NDB = DV / 32, VB0 = 2 * KT;
    typedef const __attribute__((address_space(1))) u32x4* gptr;
    const int lane = lane_fresh(), tid = wid * 64 + lane, r = lane & 31, h = lane >> 5;
    const int nk = n + 16, NT = (nk + 63) >> 6;
    const int li = qb * 256 + wid * 32 + r;
    const int tq = ALIBI ? ((4 * qb + 3 < NT - 1) ? 4 * qb + 3 : NT - 1) : -1;
    int tlo = 0, thi = NT - 2, NIT = NT;
    if (ALIBI && qb * 256 < n) {
        const int x = qb * 256 + 16 - dkeys - 79, y = qb * 256 + 255 + 16 + dkeys - 16;
        tlo = x > 0 ? (x + 63) >> 6 : 0; if (tlo > tq) tlo = tq;
        thi = (y >> 6) < NT - 2 ? (y >> 6) : NT - 2; if (thi < tq) thi = tq;
        NIT = (tq - tlo + 1) + (thi - tq) + 1;
    }
    const int nleft = tq - tlo + 1;
#define TILE(j) (ALIBI ? ((j) < nleft ? tq - (j) : (tq + 1 + (j) - nleft <= thi ? tq + 1 + (j) - nleft : NT - 1)) : (j))
    const bool active = (qb * 256 + wid * 32) < nk;
    const bool wreal = (qb * 256 + wid * 32 + 31) < n;
    const int qminw = qb * 256 + wid * 32 + 16;
    const int qrow = r0 + li;
    const float qlin = (li < n) ? (float)(li + 16) : (li < nk ? (float)(li - n) : 0.f);
    bf16x8 qf[NKS];
#pragma unroll
    for (int ks = 0; ks < NKS; ++ks) qf[ks] = *(const bf16x8*)(Q + (size_t)qrow * DQK + ks * 16 + h * 8);
    f32x16 o[NDB];
#pragma unroll
    for (int d = 0; d < NDB; ++d)
#pragma unroll
        for (int i = 0; i < 16; ++i) o[d][i] = 0.f;
    float m = FIXEDREF ? mref : 0.f, l = 0.f; f32x16 negm, zero16;
#pragma unroll
    for (int i = 0; i < 16; ++i) { negm[i] = FIXEDREF ? -mref : 0.f; zero16[i] = 0.f; }
    const bf16_t* kg0 = K + (size_t)r0 * DQK + tid * 8; const bf16_t* vg0 = Vt + (size_t)(tid >> 3) * RA + r0 + (tid & 7) * 8; const int vl0 = VB0 + (tid >> 3) * VROW + (tid & 7) * 16;
#define KL(i) ((((tid + 512 * (i)) / KCH) * KROW) + ((tid + 512 * (i)) % KCH) * 16)
#define KG(i, t) ((gptr)(kg0 + (i) * 4096 + (size_t)(t) * 64 * DQK))
#define VG(i, t) ((gptr)(vg0 + (size_t)(i) * 64 * RA + (size_t)(t) * 64))
#define VL(i) (vl0 + (i) * 64 * VROW)
    const int pr = (r & ~12) | ((r & 4) << 1) | ((r & 8) >> 1);
    const int kaddr = pr * KROW + h * 16, vaddr = VB0 + r * VROW + h * 16;
    u32x4 kst[NKC], vst[NVC], kstn[NKC], vstn[NVC];
#define QK_TILE(A0, A1, kb_) do { const int ko_ = (kb_) * KT + kaddr; \
        _Pragma("unroll") for (int kb4 = 0; kb4 < NKS; kb4 += 4) { bf16x8 kq[8]; \
            _Pragma("unroll") for (int j = 0; j < 4; ++j) { kq[2 * j] = *(const LAS bf16x8*)(lds + ko_ + (kb4 + j) * 32); kq[2 * j + 1] = *(const LAS bf16x8*)(lds + ko_ + 32 * KROW + (kb4 + j) * 32); } \
            asm volatile("" : "+v"(kq[0]), "+v"(kq[1]), "+v"(kq[2]), "+v"(kq[3]), "+v"(kq[4]), "+v"(kq[5]), "+v"(kq[6]), "+v"(kq[7]));     \
            _Pragma("unroll") for (int j = 0; j < 4; ++j) { \
                if (kb4 + j == 0) { A0 = __builtin_amdgcn_mfma_f32_32x32x16_bf16(kq[0], qf[0], ct0, 0, 0, 0); A1 = __builtin_amdgcn_mfma_f32_32x32x16_bf16(kq[1], qf[0], ct1, 0, 0, 0); } \
                else { A0 = __builtin_amdgcn_mfma_f32_32x32x16_bf16(kq[2 * j], qf[kb4 + j], A0, 0, 0, 0); A1 = __builtin_amdgcn_mfma_f32_32x32x16_bf16(kq[2 * j + 1], qf[kb4 + j], A1, 0, 0, 0); } } \
            __builtin_amdgcn_sched_barrier(0); } } while (0)
#pragma unroll
    for (int i = 0; i < NKC; ++i) kst[i] = *KG(i, TILE(0));
#pragma unroll
    for (int i = 0; i < NVC; ++i) vst[i] = *VG(i, TILE(0));
#pragma unroll
    for (int i = 0; i < NKC; ++i) *(LAS u32x4*)(lds + KL(i)) = kst[i];
#pragma unroll
    for (int i = 0; i < NVC; ++i) *(LAS u32x4*)(lds + VL(i)) = vst[i];
    if constexpr (PIPE) {
#pragma unroll
        for (int i = 0; i < NKC; ++i) kst[i] = *KG(i, 1);
#pragma unroll
        for (int i = 0; i < NKC; ++i) *(LAS u32x4*)(lds + KT + KL(i)) = kst[i];
#pragma unroll
        for (int i = 0; i < NKC; ++i) kst[i] = *KG(i, 2);
#pragma unroll
        for (int i = 0; i < NVC; ++i) vst[i] = *VG(i, 1);
    }
    __syncthreads();
    f32x16 s0, s1, n0, n1;
    if constexpr (PIPE) { f32x16 ct0 = negm, ct1 = negm; QK_TILE(s0, s1, 0); __syncthreads(); }
    for (int jt = 0; jt < NIT; ++jt) {
        const int t = PIPE ? jt : TILE(jt), tn = TILE(jt + 1);
        const int cb = jt & 1;
        const bool moreV = (jt + 1 < NIT), moreK = PIPE ? (jt + 2 < NIT) : moreV;
        if constexpr (PIPE) {
            if (t + 3 < NT) {
#pragma unroll
                for (int i = 0; i < NKC; ++i) kstn[i] = *KG(i, t + 3);
            }
            if (t + 2 < NT) {
#pragma unroll
                for (int i = 0; i < NVC; ++i) vstn[i] = *VG(i, t + 2);
            }
        } else {
            if (moreK) {
#pragma unroll
                for (int i = 0; i < NKC; ++i) kst[i] = *KG(i, tn);
            }
            if (moreV) {
#pragma unroll
                for (int i = 0; i < NVC; ++i) vst[i] = *VG(i, tn);
            }
#ifdef PROBE_MEM2
            { int zo = 0; asm volatile("" : "+v"(zo));
              if (moreK) {
#pragma unroll
                for (int i = 0; i < NKC; ++i) { u32x4 d = *(KG(i, t + 1) + zo); asm volatile("" :: "v"(d)); } }
              if (moreV) {
#pragma unroll
                for (int i = 0; i < NVC; ++i) { u32x4 d = *(VG(i, t + 1) + zo); asm volatile("" :: "v"(d)); } } }
#endif
        }
        if (active) {
        f32x16 ct0 = negm, ct1 = negm; int side = 0;
        if constexpr (ALIBI) {
            if (t < NT - 1 && wreal) { if (t * 64 + 79 <= qminw) side = 1; else if (t * 64 + 16 >= qminw + 31) side = -1; }
            if (side != 0) { const float ssl = side > 0 ? sl : -sl, A_ = ssl * ((float)(t * 64 + 16 + 8 * h) - qlin) - mref;
#pragma unroll
                for (int i = 0; i < 16; ++i) { ct0[i] = __builtin_fmaf(ssl, (float)(16 * (i >> 3) + (i & 7)), A_); ct1[i] = ct0[i] + 32.f * ssl; } }
        }
        if constexpr (PIPE) { if (moreV) QK_TILE(n0, n1, cb ^ 1); }
        else QK_TILE(s0, s1, cb);
        bf16x8 vf0[8];
        if constexpr (EARLYV) {
#pragma unroll
            for (int j = 0; j < 8; ++j) vf0[j] = *(const LAS bf16x8*)(lds + cb * VT + vaddr + (j >> 2) * 32 * VROW + (j & 3) * 32);
        }
        if (t < NT - 1) {
            if constexpr (ALIBI) if (side == 0) {
                const float qo = qlin - (float)(16 + 8 * h + t * 64);
#pragma unroll
                for (int i = 0; i < 16; ++i) { const float ci = (float)(16 * (i >> 3) + (i & 7)); s0[i] = __builtin_fmaf(-sl, __builtin_fabsf(qo - ci), s0[i]); s1[i] = __builtin_fmaf(-sl, __builtin_fabsf(qo - 32.f - ci), s1[i]); }
            }
        } else {
#pragma unroll
            for (int i = 0; i < 16; ++i) { const int kk = 16 * (i >> 3) + 8 * h + (i & 7);
                if (kk < 16) { if constexpr (ALIBI) s0[i] = __builtin_fmaf(-sl, __builtin_fabsf(qlin - (float)kk), s0[i]); } else s0[i] = -1e30f;
                s1[i] = -1e30f; }
        }
        if constexpr (!FIXEDREF) {
        float mx;
        { float a = MX2(s0[0], s1[0]), b = MX2(s0[1], s1[1]);
#pragma unroll
          for (int i = 2; i < 16; i += 2) { a = MX2(a, MX2(s0[i], s1[i])); b = MX2(b, MX2(s0[i + 1], s1[i + 1])); }
          mx = swap32_max(MX2(a, b)); }
        if constexpr (!NEGM) mx -= m;
        if (__builtin_expect(jt == 0 || __builtin_amdgcn_ballot_w64(mx > 8.f) != 0ull, 0)) {
            const float dl = (jt == 0) ? mx : fmaxf(mx, 0.f);
            m += dl;
            if constexpr (NEGM) {
#pragma unroll
                for (int i = 0; i < 16; ++i) { s0[i] -= dl; s1[i] -= dl; negm[i] = -m; } }
            if constexpr (PIPE) {
#pragma unroll
                for (int i = 0; i < 16; ++i) { n0[i] -= dl; n1[i] -= dl; } }
            if (jt != 0) { const float f = __builtin_amdgcn_exp2f(-dl); l *= f;
#pragma unroll
                for (int d = 0; d < NDB; ++d)
#pragma unroll
                    for (int i = 0; i < 16; ++i) o[d][i] *= f; }
            asm volatile("" ::: "memory");
        }
        }
        float ra = 0.f, rb = 0.f;
#pragma unroll
        for (int i = 0; i < 16; ++i) { s0[i] = __builtin_amdgcn_exp2f(NEGM ? s0[i] : s0[i] - m); s1[i] = __builtin_amdgcn_exp2f(NEGM ? s1[i] : s1[i] - m); ra += s0[i]; rb += s1[i]; }
        l += ra + rb;
        bf16x8 pf[4];
        { u32x4 w;
          w.x = pk2(s0[0], s0[1]); w.y = pk2(s0[2], s0[3]); w.z = pk2(s0[4], s0[5]); w.w = pk2(s0[6], s0[7]); pf[0] = __builtin_bit_cast(bf16x8, w);
          w.x = pk2(s0[8], s0[9]); w.y = pk2(s0[10], s0[11]); w.z = pk2(s0[12], s0[13]); w.w = pk2(s0[14], s0[15]); pf[1] = __builtin_bit_cast(bf16x8, w);
          w.x = pk2(s1[0], s1[1]); w.y = pk2(s1[2], s1[3]); w.z = pk2(s1[4], s1[5]); w.w = pk2(s1[6], s1[7]); pf[2] = __builtin_bit_cast(bf16x8, w);
          w.x = pk2(s1[8], s1[9]); w.y = pk2(s1[10], s1[11]); w.z = pk2(s1[12], s1[13]); w.w = pk2(s1[14], s1[15]); pf[3] = __builtin_bit_cast(bf16x8, w); }
#pragma unroll
        for (int d0 = 0; d0 < NDB; d0 += 2) { bf16x8 vf[8];
#pragma unroll
            for (int j = 0; j < 8; ++j) { if (EARLYV && d0 == 0) vf[j] = vf0[j]; else vf[j] = *(const LAS bf16x8*)(lds + cb * VT + vaddr + (d0 + (j >> 2)) * 32 * VROW + (j & 3) * 32); }
            asm volatile("" : "+v"(vf[0]), "+v"(vf[1]), "+v"(vf[2]), "+v"(vf[3]), "+v"(vf[4]), "+v"(vf[5]), "+v"(vf[6]), "+v"(vf[7]));
#pragma unroll
            for (int j = 0; j < 8; ++j) o[d0 + (j >> 2)] = __builtin_amdgcn_mfma_f32_32x32x16_bf16(vf[j], pf[j & 3], o[d0 + (j >> 2)], 0, 0, 0);
            __builtin_amdgcn_sched_barrier(0); }
        }
        if (moreK) {
#pragma unroll
            for (int i = 0; i < NKC; ++i) *(LAS u32x4*)(lds + (PIPE ? cb : (cb ^ 1)) * KT + KL(i)) = kst[i];
        }
        if (moreV) {
#pragma unroll
            for (int i = 0; i < NVC; ++i) *(LAS u32x4*)(lds + (cb ^ 1) * VT + VL(i)) = vst[i];
        }
        asm volatile("s_waitcnt lgkmcnt(0)" ::: "memory"); __builtin_amdgcn_s_barrier(); asm volatile("" ::: "memory");
        if constexpr (PIPE) { s0 = n0; s1 = n1;
#pragma unroll
            for (int i = 0; i < NKC; ++i) kst[i] = kstn[i];
#pragma unroll
            for (int i = 0; i < NVC; ++i) vst[i] = vstn[i]; }
    }
    l = swap32_add(l);
    const float il = 1.f / l;
    bf16_t* orow = O + (size_t)qrow * 512;
    if (active)
#pragma unroll
    for (int d = 0; d < NDB; ++d)
#pragma unroll
        for (int g = 0; g < 4; ++g) { u32x2 w; w.x = pk2(o[d][4 * g] * il, o[d][4 * g + 1] * il); w.y = pk2(o[d][4 * g + 2] * il, o[d][4 * g + 3] * il);
            *(u32x2*)(orow + 32 * d + 8 * g + 4 * h) = w; }
#undef KG
#undef KL
#undef VG
#undef VL
#undef QK_TILE
#undef TILE
}

template <int DV, bool ALIBI>
DI void attn_unit2(LAS unsigned char* lds, const bf16_t* __restrict__ Q, const bf16_t* __restrict__ K, const bf16_t* __restrict__ Vt, bf16_t* __restrict__ O, int r0, int qb, int n, float sl, const int wid) {
    constexpr int DQK = 64, KROW = DQK * 2 + 16, KT = 64 * KROW, VROW = 144, VT = DV * VROW, NVC = DV * 8 / 512, NKS = 4, NDB = DV / 32, VB0 = 2 * KT;
    typedef const __attribute__((address_space(1))) u32x4* gptr;
    const int lane = lane_fresh(), tid = wid * 64 + lane, r = lane & 31, h = lane >> 5;
    const int nk = n + 16, NT = (nk + 63) >> 6;
    const int li = qb * 256 + wid * 32 + r;
    const int qrow = r0 + li;
    const float qlin = (li < n) ? (float)(li + 16) : (li < nk ? (float)(li - n) : 0.f);
    bf16x8 qf[NKS];
#pragma unroll
    for (int ks = 0; ks < NKS; ++ks) qf[ks] = *(const bf16x8*)(Q + (size_t)qrow * DQK + ks * 16 + h * 8);
    f32x16 o[NDB];
#pragma unroll
    for (int d = 0; d < NDB; ++d)
#pragma unroll
        for (int i = 0; i < 16; ++i) o[d][i] = 0.f;
    float m = 0.f, l = 0.f; f32x16 negm;
#pragma unroll
    for (int i = 0; i < 16; ++i) negm[i] = 0.f;
    const bf16_t* kg0 = K + (size_t)r0 * DQK + tid * 8; const bf16_t* vg0 = Vt + (size_t)(tid >> 3) * RA + r0 + (tid & 7) * 8;
    const int kl0 = (tid >> 3) * KROW + (tid & 7) * 16, vl0 = VB0 + (tid >> 3) * VROW + (tid & 7) * 16;
#define KG2(t) ((gptr)(kg0 + (size_t)(t) * 64 * DQK))
#define VG2(i, t) ((gptr)(vg0 + (size_t)(i) * 64 * RA + (size_t)(t) * 64))
    const int pr = (r & ~12) | ((r & 4) << 1) | ((r & 8) >> 1);
    const int kaddr = pr * KROW + h * 16, vaddr = VB0 + r * VROW + h * 16;
    u32x4 kst, vst[NVC];
    bf16x8 kf[8];
#define LDK(kb_) do { _Pragma("unroll") for (int ks = 0; ks < 4; ++ks) { kf[2 * ks] = *(const LAS bf16x8*)(lds + (kb_) * KT + kaddr + ks * 32); kf[2 * ks + 1] = *(const LAS bf16x8*)(lds + (kb_) * KT + kaddr + 32 * KROW + ks * 32); } \
        asm volatile("" : "+v"(kf[0]), "+v"(kf[1]), "+v"(kf[2]), "+v"(kf[3]), "+v"(kf[4]), "+v"(kf[5]), "+v"(kf[6]), "+v"(kf[7])); } while (0)
#define QKM(A0, A1) do { A0 = __builtin_amdgcn_mfma_f32_32x32x16_bf16(kf[0], qf[0], negm, 0, 0, 0); A1 = __builtin_amdgcn_mfma_f32_32x32x16_bf16(kf[1], qf[0], negm, 0, 0, 0); \
        _Pragma("unroll") for (int ks = 1; ks < 4; ++ks) { A0 = __builtin_amdgcn_mfma_f32_32x32x16_bf16(kf[2 * ks], qf[ks], A0, 0, 0, 0); A1 = __builtin_amdgcn_mfma_f32_32x32x16_bf16(kf[2 * ks + 1], qf[ks], A1, 0, 0, 0); } } while (0)
#define PV2(vb_, d0_) do { bf16x8 vf[8]; \
        _Pragma("unroll") for (int j = 0; j < 8; ++j) vf[j] = *(const LAS bf16x8*)(lds + (vb_) * VT + vaddr + ((d0_) + (j >> 2)) * 32 * VROW + (j & 3) * 32); \
        asm volatile("" : "+v"(vf[0]), "+v"(vf[1]), "+v"(vf[2]), "+v"(vf[3]), "+v"(vf[4]), "+v"(vf[5]), "+v"(vf[6]), "+v"(vf[7])); \
        _Pragma("unroll") for (int j = 0; j < 8; ++j) o[(d0_) + (j >> 2)] = __builtin_amdgcn_mfma_f32_32x32x16_bf16(vf[j], pf[j & 3], o[(d0_) + (j >> 2)], 0, 0, 0); } while (0)
    kst = *KG2(0);
#pragma unroll
    for (int i = 0; i < NVC; ++i) vst[i] = *VG2(i, 0);
    *(LAS u32x4*)(lds + kl0) = kst;
#pragma unroll
    for (int i = 0; i < NVC; ++i) *(LAS u32x4*)(lds + vl0 + i * 64 * VROW) = vst[i];
    kst = *KG2(1);
    *(LAS u32x4*)(lds + KT + kl0) = kst;
    __syncthreads();
    f32x16 s0, s1, n0, n1;
    bf16x8 pf[4];
    LDK(0); QKM(s0, s1);
    __syncthreads();
    int vcur = 0;
    for (int t = 0; t < NT; ++t) {
        const int cb = t & 1;
        const bool moreV = (t + 1 < NT), moreK = (t + 2 < NT);
        const int vprev = (vcur == 0) ? 2 : vcur - 1, vnext = (vcur == 2) ? 0 : vcur + 1;
        if (moreK) kst = *KG2(t + 2);
        if (moreV) {
#pragma unroll
            for (int i = 0; i < NVC; ++i) vst[i] = *VG2(i, t + 1);
        }
#ifdef PROBE_MEM2
        { int zo = 0; asm volatile("" : "+v"(zo));
          if (moreK) { u32x4 d = *(KG2(t + 2) + zo); asm volatile("" :: "v"(d)); }
          if (moreV) {
#pragma unroll
            for (int i = 0; i < NVC; ++i) { u32x4 d = *(VG2(i, t + 1) + zo); asm volatile("" :: "v"(d)); } } }
#endif
        __builtin_amdgcn_s_setprio(1);
        if (moreV) { LDK(cb ^ 1); QKM(n0, n1); }
        if (t > 0) { PV2(vprev, 0); if constexpr (NDB == 4) PV2(vprev, 2); }
        __builtin_amdgcn_s_setprio(0);
        if (t < NT - 1) {
            if constexpr (ALIBI) {
                const float qo = qlin - (float)(16 + 8 * h + t * 64);
#pragma unroll
                for (int i = 0; i < 16; ++i) { const float ci = (float)(16 * (i >> 3) + (i & 7)); s0[i] = __builtin_fmaf(-sl, __builtin_fabsf(qo - ci), s0[i]); s1[i] = __builtin_fmaf(-sl, __builtin_fabsf(qo - 32.f - ci), s1[i]); }
            }
        } else {
#pragma unroll
            for (int i = 0; i < 16; ++i) { const int kk = 16 * (i >> 3) + 8 * h + (i & 7);
                if (kk < 16) { if constexpr (ALIBI) s0[i] = __builtin_fmaf(-sl, __builtin_fabsf(qlin - (float)kk), s0[i]); } else s0[i] = -1e30f;
                s1[i] = -1e30f; }
        }
        float mx;
        { float a = MX2(s0[0], s1[0]), b = MX2(s0[1], s1[1]);
#pragma unroll
          for (int i = 2; i < 16; i += 2) { a = MX2(a, MX2(s0[i], s1[i])); b = MX2(b, MX2(s0[i + 1], s1[i + 1])); }
          mx = swap32_max(MX2(a, b)); }
        if (__builtin_expect(t == 0 || __builtin_amdgcn_ballot_w64(mx > 8.f) != 0ull, 0)) {
            const float dl = (t == 0) ? mx : fmaxf(mx, 0.f);
            m += dl;
#pragma unroll
            for (int i = 0; i < 16; ++i) { s0[i] -= dl; s1[i] -= dl; n0[i] -= dl; n1[i] -= dl; negm[i] = -m; }
            if (t != 0) { const float f = __builtin_amdgcn_exp2f(-dl); l *= f;
#pragma unroll
                for (int d = 0; d < NDB; ++d)
#pragma unroll
                    for (int i = 0; i < 16; ++i) o[d][i] *= f; }
            asm volatile("" ::: "memory");
        }
        float ra = 0.f, rb = 0.f;
#pragma unroll
        for (int i = 0; i < 16; ++i) { s0[i] = __builtin_amdgcn_exp2f(s0[i]); s1[i] = __builtin_amdgcn_exp2f(s1[i]); ra += s0[i]; rb += s1[i]; }
        l += ra + rb;
        { u32x4 w;
          w.x = pk2(s0[0], s0[1]); w.y = pk2(s0[2], s0[3]); w.z = pk2(s0[4], s0[5]); w.w = pk2(s0[6], s0[7]); pf[0] = __builtin_bit_cast(bf16x8, w);
          w.x = pk2(s0[8], s0[9]); w.y = pk2(s0[10], s0[11]); w.z = pk2(s0[12], s0[13]); w.w = pk2(s0[14], s0[15]); pf[1] = __builtin_bit_cast(bf16x8, w);
          w.x = pk2(s1[0], s1[1]); w.y = pk2(s1[2], s1[3]); w.z = pk2(s1[4], s1[5]); w.w = pk2(s1[6], s1[7]); pf[2] = __builtin_bit_cast(bf16x8, w);
          w.x = pk2(s1[8], s1[9]); w.y = pk2(s1[10], s1[11]); w.z = pk2(s1[12], s1[13]); w.w = pk2(s1[14], s1[15]); pf[3] = __builtin_bit_cast(bf16x8, w); }
        if (moreK) *(LAS u32x4*)(lds + cb * KT + kl0) = kst;
        if (moreV) {
#pragma unroll
            for (int i = 0; i < NVC; ++i) *(LAS u32x4*)(lds + vnext * VT + vl0 + i * 64 * VROW) = vst[i];
        }
        asm volatile("s_waitcnt lgkmcnt(0)" ::: "memory"); __builtin_amdgcn_s_barrier(); asm volatile("" ::: "memory");
        s0 = n0; s1 = n1; vcur = vnext;
    }
    { const int vlast = (vcur == 0) ? 2 : vcur - 1; PV2(vlast, 0); if constexpr (NDB == 4) PV2(vlast, 2); }
    asm volatile("s_waitcnt lgkmcnt(0)" ::: "memory"); __builtin_amdgcn_s_barrier(); asm volatile("" ::: "memory");
    l = swap32_add(l);
    const float il = 1.f / l;
    bf16_t* orow = O + (size_t)qrow * 512;
#pragma unroll
    for (int d = 0; d < NDB; ++d)
#pragma unroll
        for (int g = 0; g < 4; ++g) { u32x2 w; w.x = pk2(o[d][4 * g] * il, o[d][4 * g + 1] * il); w.y = pk2(o[d][4 * g + 2] * il, o[d][4 * g + 3] * il);
            *(u32x2*)(orow + 32 * d + 8 * g + 4 * h) = w; }
#undef KG2
#undef VG2
#undef LDK
#undef QKM
#undef PV2
}


template <int DQK, int DV, bool ALIBI>
DI void attn_unit_s(LAS unsigned char* lds, const bf16_t* __restrict__ Q, const bf16_t* __restrict__ K, const bf16_t* __restrict__ Vt, bf16_t* __restrict__ O, int r0, int qb, int n, float sl, const int wid) {
    constexpr bool NEGM = (DQK == 64);
    constexpr int KROW = DQK * 2 + 16, KT = 64 * KROW, VROW = 144, VT = DV * VROW, KCH = DQK / 8, NKC = 64 * KCH / 512, NVC = DV * 8 / 512, NKS = DQK / 16, NDB = DV / 32, VB0 = 2 * KT;
    typedef const __attribute__((address_space(1))) u32x4* gptr;
#define LBAR() do { asm volatile("s_waitcnt lgkmcnt(0)" ::: "memory"); __builtin_amdgcn_s_barrier(); asm volatile("" ::: "memory"); } while (0)
#ifdef GRP_ODD
    const int grp_ = wid & 1;
#else
    const int grp_ = wid >> 2;
#endif
    const int lane = lane_fresh(), tid = wid * 64 + lane, r = lane & 31, h = lane >> 5, grp = grp_;
    const int nk = n + 16, NT = (nk + 63) >> 6;
    const int li = qb * 256 + wid * 32 + r;
    const int qrow = r0 + li;
    const float qlin = (li < n) ? (float)(li + 16) : (li < nk ? (float)(li - n) : 0.f);
    bf16x8 qf[NKS];
#pragma unroll
    for (int ks = 0; ks < NKS; ++ks) qf[ks] = *(const bf16x8*)(Q + (size_t)qrow * DQK + ks * 16 + h * 8);
    f32x16 o[NDB];
#pragma unroll
    for (int d = 0; d < NDB; ++d)
#pragma unroll
        for (int i = 0; i < 16; ++i) o[d][i] = 0.f;
    float m = 0.f, l = 0.f; f32x16 negm, zero16;
#pragma unroll
    for (int i = 0; i < 16; ++i) { negm[i] = 0.f; zero16[i] = 0.f; }
    const bf16_t* kg0 = K + (size_t)r0 * DQK + tid * 8; const bf16_t* vg0 = Vt + (size_t)(tid >> 3) * RA + r0 + (tid & 7) * 8; const int vl0 = VB0 + (tid >> 3) * VROW + (tid & 7) * 16;
#define KL(i) ((((tid + 512 * (i)) / KCH) * KROW) + ((tid + 512 * (i)) % KCH) * 16)
#define KG(i, t) ((gptr)(kg0 + (i) * 4096 + (size_t)(t) * 64 * DQK))
#define VG(i, t) ((gptr)(vg0 + (size_t)(i) * 64 * RA + (size_t)(t) * 64))
#define VL(i) (vl0 + (i) * 64 * VROW)
    const int pr = (r & ~12) | ((r & 4) << 1) | ((r & 8) >> 1);
    const int kaddr = pr * KROW + h * 16, vaddr = VB0 + r * VROW + h * 16;
    u32x4 kst[NKC], vst[NVC];
#pragma unroll
    for (int i = 0; i < NKC; ++i) kst[i] = *KG(i, 0);
#pragma unroll
    for (int i = 0; i < NKC; ++i) *(LAS u32x4*)(lds + KL(i)) = kst[i];
#pragma unroll
    for (int i = 0; i < NKC; ++i) kst[i] = *KG(i, 1);
#pragma unroll
    for (int i = 0; i < NVC; ++i) vst[i] = *VG(i, 0);
    __syncthreads();
    if (grp == 1) LBAR();
    f32x16 s0, s1; bf16x8 pf[4];
    for (int t = 0; t < NT; ++t) {
        const int cb = t & 1;
        { const int ko_ = cb * KT + kaddr;
#pragma unroll
          for (int kb4 = 0; kb4 < NKS; kb4 += 4) { bf16x8 kq[8];
#pragma unroll
            for (int j = 0; j < 4; ++j) { kq[2 * j] = *(const LAS bf16x8*)(lds + ko_ + (kb4 + j) * 32); kq[2 * j + 1] = *(const LAS bf16x8*)(lds + ko_ + 32 * KROW + (kb4 + j) * 32); }
            asm volatile("" : "+v"(kq[0]), "+v"(kq[1]), "+v"(kq[2]), "+v"(kq[3]), "+v"(kq[4]), "+v"(kq[5]), "+v"(kq[6]), "+v"(kq[7]));
#pragma unroll
            for (int j = 0; j < 4; ++j) {
                if (kb4 + j == 0) { s0 = __builtin_amdgcn_mfma_f32_32x32x16_bf16(kq[0], qf[0], NEGM ? negm : zero16, 0, 0, 0); s1 = __builtin_amdgcn_mfma_f32_32x32x16_bf16(kq[1], qf[0], NEGM ? negm : zero16, 0, 0, 0); }
                else { s0 = __builtin_amdgcn_mfma_f32_32x32x16_bf16(kq[2 * j], qf[kb4 + j], s0, 0, 0, 0); s1 = __builtin_amdgcn_mfma_f32_32x32x16_bf16(kq[2 * j + 1], qf[kb4 + j], s1, 0, 0, 0); } }
            __builtin_amdgcn_sched_barrier(0); } }
        if (t > 0) {
#pragma unroll
            for (int d0 = 0; d0 < NDB; d0 += 2) { bf16x8 vf[8];
#pragma unroll
                for (int j = 0; j < 8; ++j) vf[j] = *(const LAS bf16x8*)(lds + (cb ^ 1) * VT + vaddr + (d0 + (j >> 2)) * 32 * VROW + (j & 3) * 32);
                asm volatile("" : "+v"(vf[0]), "+v"(vf[1]), "+v"(vf[2]), "+v"(vf[3]), "+v"(vf[4]), "+v"(vf[5]), "+v"(vf[6]), "+v"(vf[7]));
#pragma unroll
                for (int j = 0; j < 8; ++j) o[d0 + (j >> 2)] = __builtin_amdgcn_mfma_f32_32x32x16_bf16(vf[j], pf[j & 3], o[d0 + (j >> 2)], 0, 0, 0);
                __builtin_amdgcn_sched_barrier(0); }
        }
        if (t + 1 < NT) {
#pragma unroll
            for (int i = 0; i < NKC; ++i) *(LAS u32x4*)(lds + (cb ^ 1) * KT + KL(i)) = kst[i];
        }
#pragma unroll
        for (int i = 0; i < NVC; ++i) *(LAS u32x4*)(lds + cb * VT + VL(i)) = vst[i];
        LBAR();
        if (t + 2 < NT) {
#pragma unroll
            for (int i = 0; i < NKC; ++i) kst[i] = *KG(i, t + 2);
        }
        if (t + 1 < NT) {
#pragma unroll
            for (int i = 0; i < NVC; ++i) vst[i] = *VG(i, t + 1);
        }
        if (t < NT - 1) {
            if constexpr (ALIBI) {
                const float qo = qlin - (float)(16 + 8 * h + t * 64);
#pragma unroll
                for (int i = 0; i < 16; ++i) { const float ci = (float)(16 * (i >> 3) + (i & 7)); s0[i] = __builtin_fmaf(-sl, __builtin_fabsf(qo - ci), s0[i]); s1[i] = __builtin_fmaf(-sl, __builtin_fabsf(qo - 32.f - ci), s1[i]); }
            }
        } else {
#pragma unroll
            for (int i = 0; i < 16; ++i) { const int kk = 16 * (i >> 3) + 8 * h + (i & 7);
                if (kk < 16) { if constexpr (ALIBI) s0[i] = __builtin_fmaf(-sl, __builtin_fabsf(qlin - (float)kk), s0[i]); } else s0[i] = -1e30f;
                s1[i] = -1e30f; }
        }
        float mx;
        { float a = MX2(s0[0], s1[0]), b = MX2(s0[1], s1[1]);
#pragma unroll
          for (int i = 2; i < 16; i += 2) { a = MX2(a, MX2(s0[i], s1[i])); b = MX2(b, MX2(s0[i + 1], s1[i + 1])); }
          mx = swap32_max(MX2(a, b)); }
        if constexpr (!NEGM) mx -= m;
        if (__builtin_expect(t == 0 || __builtin_amdgcn_ballot_w64(mx > 8.f) != 0ull, 0)) {
            const float dl = (t == 0) ? mx : fmaxf(mx, 0.f);
            m += dl;
            if constexpr (NEGM) {
#pragma unroll
                for (int i = 0; i < 16; ++i) { s0[i] -= dl; s1[i] -= dl; negm[i] = -m; } }
            if (t != 0) { const float f = __builtin_amdgcn_exp2f(-dl); l *= f;
#pragma unroll
                for (int d = 0; d < NDB; ++d)
#pragma unroll
                    for (int i = 0; i < 16; ++i) o[d][i] *= f; }
            asm volatile("" ::: "memory");
        }
        float ra = 0.f, rb = 0.f;
#pragma unroll
        for (int i = 0; i < 16; ++i) { s0[i] = __builtin_amdgcn_exp2f(NEGM ? s0[i] : s0[i] - m); s1[i] = __builtin_amdgcn_exp2f(NEGM ? s1[i] : s1[i] - m); ra += s0[i]; rb += s1[i]; }
        l += ra + rb;
        { u32x4 w;
          w.x = pk2(s0[0], s0[1]); w.y = pk2(s0[2], s0[3]); w.z = pk2(s0[4], s0[5]); w.w = pk2(s0[6], s0[7]); pf[0] = __builtin_bit_cast(bf16x8, w);
          w.x = pk2(s0[8], s0[9]); w.y = pk2(s0[10], s0[11]); w.z = pk2(s0[12], s0[13]); w.w = pk2(s0[14], s0[15]); pf[1] = __builtin_bit_cast(bf16x8, w);
          w.x = pk2(s1[0], s1[1]); w.y = pk2(s1[2], s1[3]); w.z = pk2(s1[4], s1[5]); w.w = pk2(s1[6], s1[7]); pf[2] = __builtin_bit_cast(bf16x8, w);
          w.x = pk2(s1[8], s1[9]); w.y = pk2(s1[10], s1[11]); w.z = pk2(s1[12], s1[13]); w.w = pk2(s1[14], s1[15]); pf[3] = __builtin_bit_cast(bf16x8, w); }
        LBAR();
    }
    { const int vb = (NT - 1) & 1;
#pragma unroll
      for (int d0 = 0; d0 < NDB; d0 += 2) { bf16x8 vf[8];
#pragma unroll
        for (int j = 0; j < 8; ++j) vf[j] = *(const LAS bf16x8*)(lds + vb * VT + vaddr + (d0 + (j >> 2)) * 32 * VROW + (j & 3) * 32);
        asm volatile("" : "+v"(vf[0]), "+v"(vf[1]), "+v"(vf[2]), "+v"(vf[3]), "+v"(vf[4]), "+v"(vf[5]), "+v"(vf[6]), "+v"(vf[7]));
#pragma unroll
        for (int j = 0; j < 8; ++j) o[d0 + (j >> 2)] = __builtin_amdgcn_mfma_f32_32x32x16_bf16(vf[j], pf[j & 3], o[d0 + (j >> 2)], 0, 0, 0); } }
    if (grp == 0) LBAR();
    LBAR();
    l = swap32_add(l);
    const float il = 1.f / l;
    bf16_t* orow = O + (size_t)qrow * 512;
#pragma unroll
    for (int d = 0; d < NDB; ++d)
#pragma unroll
        for (int g = 0; g < 4; ++g) { u32x2 w; w.x = pk2(o[d][4 * g] * il, o[d][4 * g + 1] * il); w.y = pk2(o[d][4 * g + 2] * il, o[d][4 * g + 3] * il);
            *(u32x2*)(orow + 32 * d + 8 * g + 4 * h) = w; }
#undef KG
#undef KL
#undef VG
#undef VL
#undef LBAR
}

DI void attn_unit_a64(LAS unsigned char* lds, const bf16_t* __restrict__ Q, const bf16_t* __restrict__ K, const bf16_t* __restrict__ Vt, bf16_t* __restrict__ O, int r0, int qb, int n, int seqrows, const int wid) {
    constexpr int DQK = 64, KROW = 144, KT = 64 * KROW, VROW = 144, VT = 64 * VROW, VB0 = 2 * KT;
    typedef const __attribute__((address_space(1))) u32x4* gptr;
    const int lane = lane_fresh(), tid = wid * 64 + lane, r = lane & 31, h = lane >> 5;
    const int nk = n + 16, NT = (nk + 63) >> 6;
    const int li0 = qb * 512 + wid * 64 + r, li1 = li0 + 32;
    bf16x8 qf0[4], qf1[4];
#pragma unroll
    for (int ks = 0; ks < 4; ++ks) { qf0[ks] = *(const bf16x8*)(Q + (size_t)(r0 + li0) * DQK + ks * 16 + h * 8); qf1[ks] = *(const bf16x8*)(Q + (size_t)(r0 + li1) * DQK + ks * 16 + h * 8); }
    f32x16 oa0, oa1, ob0, ob1, zero16;
#pragma unroll
    for (int i = 0; i < 16; ++i) { oa0[i] = 0.f; oa1[i] = 0.f; ob0[i] = 0.f; ob1[i] = 0.f; zero16[i] = 0.f; }
    float ma = 0.f, mb = 0.f, la = 0.f, lb = 0.f;
    const bf16_t* kg0 = K + (size_t)r0 * DQK + tid * 8; const bf16_t* vg0 = Vt + (size_t)(tid >> 3) * RA + r0 + (tid & 7) * 8;
    const int kl0 = (tid >> 3) * KROW + (tid & 7) * 16, vl0 = VB0 + (tid >> 3) * VROW + (tid & 7) * 16;
    const int pr = (r & ~12) | ((r & 4) << 1) | ((r & 8) >> 1);
    const int kaddr = pr * KROW + h * 16, vaddr = VB0 + r * VROW + h * 16;
    u32x4 kst, vst;
    kst = *(gptr)kg0; vst = *(gptr)vg0;
    *(LAS u32x4*)(lds + kl0) = kst; *(LAS u32x4*)(lds + vl0) = vst;
    __syncthreads();
#define SOFTMAX64(S0, S1, M, L, OX0, OX1) do { \
        if (t == NT - 1) { _Pragma("unroll") for (int i = 0; i < 16; ++i) { if (i >= 8) S0[i] = -1e30f; S1[i] = -1e30f; } } \
        float a_ = MX2(S0[0], S1[0]), b_ = MX2(S0[1], S1[1]); \
        _Pragma("unroll") for (int i = 2; i < 16; i += 2) { a_ = MX2(a_, MX2(S0[i], S1[i])); b_ = MX2(b_, MX2(S0[i + 1], S1[i + 1])); } \
        const float mx_ = swap32_max(MX2(a_, b_)) - M; \
        if (__builtin_expect(t == 0 || __builtin_amdgcn_ballot_w64(mx_ > 8.f) != 0ull, 0)) { \
            const float dl_ = (t == 0) ? mx_ : fmaxf(mx_, 0.f); M += dl_; \
            if (t != 0) { const float f_ = __builtin_amdgcn_exp2f(-dl_); L *= f_; _Pragma("unroll") for (int i = 0; i < 16; ++i) { OX0[i] *= f_; OX1[i] *= f_; } } \
            asm volatile("" ::: "memory"); } \
        float ra_ = 0.f, rb_ = 0.f; \
        _Pragma("unroll") for (int i = 0; i < 16; ++i) { S0[i] = __builtin_amdgcn_exp2f(S0[i] - M); S1[i] = __builtin_amdgcn_exp2f(S1[i] - M); ra_ += S0[i]; rb_ += S1[i]; } \
        L += ra_ + rb_; \
        u32x4 w_; \
        w_.x = pk2(S0[0], S0[1]); w_.y = pk2(S0[2], S0[3]); w_.z = pk2(S0[4], S0[5]); w_.w = pk2(S0[6], S0[7]); pf[0] = __builtin_bit_cast(bf16x8, w_); \
        w_.x = pk2(S0[8], S0[9]); w_.y = pk2(S0[10], S0[11]); w_.z = pk2(S0[12], S0[13]); w_.w = pk2(S0[14], S0[15]); pf[1] = __builtin_bit_cast(bf16x8, w_); \
        w_.x = pk2(S1[0], S1[1]); w_.y = pk2(S1[2], S1[3]); w_.z = pk2(S1[4], S1[5]); w_.w = pk2(S1[6], S1[7]); pf[2] = __builtin_bit_cast(bf16x8, w_); \
        w_.x = pk2(S1[8], S1[9]); w_.y = pk2(S1[10], S1[11]); w_.z = pk2(S1[12], S1[13]); w_.w = pk2(S1[14], S1[15]); pf[3] = __builtin_bit_cast(bf16x8, w_); } while (0)
    for (int t = 0; t < NT; ++t) {
        const int cb = t & 1; const bool more = (t + 1 < NT);
        if (more) { kst = *(gptr)(kg0 + (size_t)(t + 1) * 64 * DQK); vst = *(gptr)(vg0 + (size_t)(t + 1) * 64); }
        bf16x8 kq[8];
#pragma unroll
        for (int j = 0; j < 4; ++j) { kq[2 * j] = *(const LAS bf16x8*)(lds + cb * KT + kaddr + j * 32); kq[2 * j + 1] = *(const LAS bf16x8*)(lds + cb * KT + kaddr + 32 * KROW + j * 32); }
        asm volatile("" : "+v"(kq[0]), "+v"(kq[1]), "+v"(kq[2]), "+v"(kq[3]), "+v"(kq[4]), "+v"(kq[5]), "+v"(kq[6]), "+v"(kq[7]));
        f32x16 sa0, sa1, sb0, sb1;
        sa0 = __builtin_amdgcn_mfma_f32_32x32x16_bf16(kq[0], qf0[0], zero16, 0, 0, 0); sa1 = __builtin_amdgcn_mfma_f32_32x32x16_bf16(kq[1], qf0[0], zero16, 0, 0, 0);
#pragma unroll
        for (int j = 1; j < 4; ++j) { sa0 = __builtin_amdgcn_mfma_f32_32x32x16_bf16(kq[2 * j], qf0[j], sa0, 0, 0, 0); sa1 = __builtin_amdgcn_mfma_f32_32x32x16_bf16(kq[2 * j + 1], qf0[j], sa1, 0, 0, 0); }
        sb0 = __builtin_amdgcn_mfma_f32_32x32x16_bf16(kq[0], qf1[0], zero16, 0, 0, 0); sb1 = __builtin_amdgcn_mfma_f32_32x32x16_bf16(kq[1], qf1[0], zero16, 0, 0, 0);
#pragma unroll
        for (int j = 1; j < 4; ++j) { sb0 = __builtin_amdgcn_mfma_f32_32x32x16_bf16(kq[2 * j], qf1[j], sb0, 0, 0, 0); sb1 = __builtin_amdgcn_mfma_f32_32x32x16_bf16(kq[2 * j + 1], qf1[j], sb1, 0, 0, 0); }
        bf16x8 vf[8];
#pragma unroll
        for (int j = 0; j < 8; ++j) vf[j] = *(const LAS bf16x8*)(lds + cb * VT + vaddr + (j >> 2) * 32 * VROW + (j & 3) * 32);
        bf16x8 pf[4];
        SOFTMAX64(sa0, sa1, ma, la, oa0, oa1);
        asm volatile("" : "+v"(vf[0]), "+v"(vf[1]), "+v"(vf[2]), "+v"(vf[3]), "+v"(vf[4]), "+v"(vf[5]), "+v"(vf[6]), "+v"(vf[7]));
#pragma unroll
        for (int j = 0; j < 4; ++j) { oa0 = __builtin_amdgcn_mfma_f32_32x32x16_bf16(vf[j], pf[j], oa0, 0, 0, 0); oa1 = __builtin_amdgcn_mfma_f32_32x32x16_bf16(vf[4 + j], pf[j], oa1, 0, 0, 0); }
        SOFTMAX64(sb0, sb1, mb, lb, ob0, ob1);
#pragma unroll
        for (int j = 0; j < 4; ++j) { ob0 = __builtin_amdgcn_mfma_f32_32x32x16_bf16(vf[j], pf[j], ob0, 0, 0, 0); ob1 = __builtin_amdgcn_mfma_f32_32x32x16_bf16(vf[4 + j], pf[j], ob1, 0, 0, 0); }
        if (more) { *(LAS u32x4*)(lds + (cb ^ 1) * KT + kl0) = kst; *(LAS u32x4*)(lds + (cb ^ 1) * VT + vl0) = vst; }
        asm volatile("s_waitcnt lgkmcnt(0)" ::: "memory"); __builtin_amdgcn_s_barrier(); asm volatile("" ::: "memory");
    }
#undef SOFTMAX64
    la = swap32_add(la); lb = swap32_add(lb);
    const float ia = 1.f / la, ib = 1.f / lb;
    if (li0 < seqrows) { bf16_t* orow = O + (size_t)(r0 + li0) * 512;
#pragma unroll
        for (int g = 0; g < 4; ++g) { u32x2 w; w.x = pk2(oa0[4 * g] * ia, oa0[4 * g + 1] * ia); w.y = pk2(oa0[4 * g + 2] * ia, oa0[4 * g + 3] * ia); *(u32x2*)(orow + 8 * g + 4 * h) = w;
            w.x = pk2(oa1[4 * g] * ia, oa1[4 * g + 1] * ia); w.y = pk2(oa1[4 * g + 2] * ia, oa1[4 * g + 3] * ia); *(u32x2*)(orow + 32 + 8 * g + 4 * h) = w; } }
    if (li1 < seqrows) { bf16_t* orow = O + (size_t)(r0 + li1) * 512;
#pragma unroll
        for (int g = 0; g < 4; ++g) { u32x2 w; w.x = pk2(ob0[4 * g] * ib, ob0[4 * g + 1] * ib); w.y = pk2(ob0[4 * g + 2] * ib, ob0[4 * g + 3] * ib); *(u32x2*)(orow + 8 * g + 4 * h) = w;
            w.x = pk2(ob1[4 * g] * ib, ob1[4 * g + 1] * ib); w.y = pk2(ob1[4 * g + 2] * ib, ob1[4 * g + 3] * ib); *(u32x2*)(orow + 32 + 8 * g + 4 * h) = w; } }
}

#if defined(STAGGER) && !defined(STAGGER_NOC)
#define ATTN_C attn_unit_s<192, 128, false>
#else
#define ATTN_C attn_unit<192, 128, false, false>
#endif
#if defined(STAGGER)
#define ATTN_B attn_unit_s<64, 128, true>
#define ATTN_A attn_unit_s<64, 64, false>
#elif defined(NOPIPE_AB)
#define ATTN_B attn_unit<64, 128, true, false>
#define ATTN_A attn_unit<64, 64, false, false>
#else
#define ATTN_B attn_unit<64, 128, true, false>
#define ATTN_A attn_unit2<64, false>
#endif
DI void attn_phase(const Params& p, const Chunk& ck, bool last, const int lidx, LAS unsigned char* lds, unsigned* q  , const int wave) {
    unsigned char* ws = p.ws; asm volatile("" : "+s"(ws));
    const bf16_t* QKV = (const bf16_t*)(ws + WS_QKV); bf16_t* OB = (bf16_t*)(ws + WS_ZM);
#if defined(PROBE_DUPC)
    constexpr int NDUP = 8, DUP0 = 0;
#elif defined(PROBE_DUPB)
    constexpr int NDUP = 16, DUP0 = 8;
#elif defined(PROBE_DUPA)
    constexpr int NDUP = 16, DUP0 = 24;
#else
    constexpr int NDUP = 0, DUP0 = 0;
#endif
    const int nmeta = last ? 0 : 20 * ck.nseq, nms = (nmeta + 7) >> 3, nsuper = nms + 40 + NDUP;
    volatile LAS int* su = (volatile LAS int*)(lds + LDS_MISC);
    float qkb, qka, qkc;
    { const int ln = lane_fresh();
      float g0 = fabsf(p.in[8][lidx * 64 + ln]), g1 = fabsf(p.in[9][lidx * 64 + ln]), g2 = fabsf(p.in[6][lidx * 64 + ln]), g3 = fabsf(p.in[7][lidx * 64 + ln]);
      float g4 = fmaxf(fmaxf(fabsf(p.in[19][lidx * 192 + ln]), fabsf(p.in[19][lidx * 192 + 64 + ln])), fabsf(p.in[19][lidx * 192 + 128 + ln]));
      float g5 = fmaxf(fmaxf(fabsf(p.in[20][lidx * 192 + ln]), fabsf(p.in[20][lidx * 192 + 64 + ln])), fabsf(p.in[20][lidx * 192 + 128 + ln]));
#pragma unroll
      for (int o = 1; o < 64; o <<= 1) {
#define WMAX_(g) g = fmaxf(g, __int_as_float(__builtin_amdgcn_ds_bpermute((ln ^ o) << 2, __float_as_int(g))))
          WMAX_(g0); WMAX_(g1); WMAX_(g2); WMAX_(g3); WMAX_(g4); WMAX_(g5);
#undef WMAX_
      }
      qkb = 1.05f * 64.f * 0.125f * LOG2E * g0 * g1; qka = 1.05f * 64.f * 0.125f * LOG2E * g2 * g3; qkc = 1.05f * 192.f * 0.07216878364870322f * LOG2E * g4 * g5;
      qkb = __uint_as_float(__builtin_amdgcn_readfirstlane(__float_as_uint(qkb))); qka = __uint_as_float(__builtin_amdgcn_readfirstlane(__float_as_uint(qka))); qkc = __uint_as_float(__builtin_amdgcn_readfirstlane(__float_as_uint(qkc))); }
    for (;;) {
        if (wave == 0 && lane_fresh() == 0) {
#ifdef FLATQ
            const unsigned x = 0u;
#else
            const unsigned x = (unsigned)__builtin_amdgcn_s_getreg((3 << 11) | 20) & 0xFu;
#endif
            int res = -1, lin = 0;
            for (;;) {
                const unsigned idx = __hip_atomic_fetch_add(q + 64 + 16 * x, 1u, __ATOMIC_RELAXED, __HIP_MEMORY_SCOPE_AGENT);
                const unsigned slot = (idx >> 5) & 63u; lin = (int)(idx & 31u);
                unsigned* te = q + 512 + x * 64 + slot; unsigned g;
                if (lin == 0) { g = __hip_atomic_fetch_add(q, 1u, __ATOMIC_RELAXED, __HIP_MEMORY_SCOPE_AGENT); __hip_atomic_store(te, g + 1u, __ATOMIC_RELAXED, __HIP_MEMORY_SCOPE_AGENT); }
                else { while ((g = __hip_atomic_load(te, __ATOMIC_RELAXED, __HIP_MEMORY_SCOPE_AGENT)) == 0u) __builtin_amdgcn_s_sleep(2); g -= 1u; }
                if ((int)g >= nsuper) { res = -1; break; }
                if ((int)g < nms && (lin >= 8 || (int)g * 8 + lin >= nmeta)) continue;
#ifdef A64
                if ((int)g >= nms + 24) {
                    const int sub_ = ((int)g - nms) & 1;
                    if (ck.nseq == 1 ? (sub_ == 1) : (lin >= 16)) continue; }
#endif
                res = (int)g; break;
            }
            su[0] = res; su[1] = lin;
        }
        __syncthreads();
        const int g = su[0], lin = su[1];
        __syncthreads();
        if (g < 0) break;
        int type, hd, s, qb;
        int sh = ck.nseq - 1; asm volatile("" : "+s"(sh));
        if (g < nms) { const int mu = g * 8 + lin, jh = mu >> sh; s = mu & sh; qb = ck.tps - 1;
            if (jh < 4) { type = 0; hd = jh; } else if (jh < 12) { type = 1; hd = jh - 4; } else { type = 2; hd = jh - 12; } }
        else { const int gr0 = g - nms, gr = gr0 >= 40 ? gr0 - 40 + DUP0 : gr0, sub = gr & 1;
            if (gr < 8) { type = 0; hd = gr >> 1; } else if (gr < 16) { type = 1; hd = 7 - ((gr - 8) >> 1); } else if (gr < 32) { type = 2; hd = (gr - 16) >> 1; } else { type = 1; hd = 3 - ((gr - 32) >> 1); }
            s = sub * sh; qb = lin + (sub * 32) * (1 - sh); }
        const int r0 = s * ck.rows_per_seq();
        if (type == 0) {
            ATTN_C(lds, QKV + QC_O + (size_t)hd * RA * 192, QKV + KC_O + (size_t)hd * RA * 192, QKV + VC_O + (size_t)hd * 128 * RA, OB + 2 * OSLOT + 128 * hd, r0, qb, ck.n, 0.f, wave, 0x3fffffff, qkc);
        } else if (type == 1) { const int hh = hd >> 1;
            const float sl = LOG2E * (hh == 0 ? 0.25f : hh == 1 ? 0.0625f : hh == 2 ? 0.015625f : 0.00390625f);
            const float dkf = 152.f / sl + 2.f; const int dkeys = dkf < 1.0e9f ? (int)dkf : 0x3fffffff;
            ATTN_B(lds, QKV + QB_O + (size_t)hd * RA * 64, QKV + KB_O + (size_t)hd * RA * 64, QKV + VB_O + (size_t)hh * 128 * RA, OB + ((hd & 1) ? 3 : 1) * OSLOT + 128 * hh, r0, qb, ck.n, sl, wave, dkeys, qkb);
        } else { const int kv = hd >> 2;
#ifdef A64
            const int qb5 = (g < nms) ? (ck.n >> 9) : lin;
            attn_unit_a64(lds, QKV + QA_O + (size_t)hd * RA * 64, QKV + KA_O + (size_t)kv * RA * 64, QKV + VA_O + (size_t)kv * 64 * RA, OB + 64 * hd, r0, qb5, ck.n, ck.rows_per_seq(), wave);
#else
            ATTN_A(lds, QKV + QA_O + (size_t)hd * RA * 64, QKV + KA_O + (size_t)kv * RA * 64, QKV + VA_O + (size_t)kv * 64 * RA, OB + 64 * hd, r0, qb, ck.n, 0.f, wave, 0x3fffffff, qka);
#endif
        }
    }
}

#define XB_TMO      128
#define XB_XCNT(j)  (256  + 64 * (j))
#define XB_XSUB(j)  (1280 + 64 * (j))
#define XB_XGEN(j)  (2304 + 64 * (j))
#define XB_TOP      3328
#define XB_TOPGEN   3392
#define XCD_BAR_WORDS 3456
#define XB_SPIN_CAP (1u << 22)
DI unsigned xb_ld(unsigned* p)              { return __hip_atomic_load(p, __ATOMIC_RELAXED, __HIP_MEMORY_SCOPE_AGENT); }
DI unsigned xb_add(unsigned* p, unsigned v) { return __hip_atomic_fetch_add(p, v, __ATOMIC_RELAXED, __HIP_MEMORY_SCOPE_AGENT); }
DI unsigned xb_xcc_id() { return (unsigned)__builtin_amdgcn_s_getreg((3 << 11) | 20) & 0xFu; }
#define XB_SPIN(cond, bar) do { unsigned _sp = 0; while (cond) { __builtin_amdgcn_s_sleep(1); \
    if ((++_sp & 255u) == 0u) { if (xb_ld(&(bar)[XB_TMO])) break; if (_sp > XB_SPIN_CAP) { atomicAdd(&(bar)[XB_TMO], 1u); break; } } } } while (0)
DI void xcd_barrier_complete(unsigned* bar, unsigned x, unsigned G, unsigned& nloc, unsigned& nx) {
    unsigned sum, cnt, mine, sp = 0u;
    for (;;) {
        sum = 0u; cnt = 0u; mine = 0u;
#pragma unroll
        for (unsigned j = 0; j < 16; ++j) { const unsigned c = xb_ld(&bar[XB_XCNT(j)]); sum += c; cnt += (c > 0u) ? 1u : 0u; mine = (j == x) ? c : mine; }
        if (sum == G) break;
        __builtin_amdgcn_s_sleep(1);
        if ((++sp & 255u) == 0u) { if (xb_ld(&bar[XB_TMO])) break; if (sp > XB_SPIN_CAP) { atomicAdd(&bar[XB_TMO], 1u); break; } }
    }
    nloc = mine > 0u ? mine : 1u; nx = cnt > 0u ? cnt : 1u;
}
DI void xcd_barrier(unsigned* bar, volatile LAS unsigned* st, const int wave) {
    asm volatile("s_waitcnt vmcnt(0)" ::: "memory");
    __syncthreads();
    if (wave == 0 && lane_fresh() == 0) {
        __builtin_amdgcn_s_waitcnt(0);
        const unsigned x = xb_xcc_id();
        unsigned nloc = st[0], nx = st[1];
        if (nloc == 0u) { xcd_barrier_complete(bar, x, gridDim.x, nloc, nx); st[0] = nloc; st[1] = nx; }
        const unsigned old = xb_add(&bar[XB_XSUB(x)], 1u);
        const unsigned gen = old / nloc;
        if (old + 1u == (gen + 1u) * nloc) {
            __builtin_amdgcn_fence(__ATOMIC_RELEASE, "agent");
            asm volatile("s_waitcnt vmcnt(0)" ::: "memory");
            const unsigned og = xb_add(&bar[XB_TOP], 1u);
            const unsigned tg = og / nx;
            if (og + 1u == (tg + 1u) * nx) xb_add(&bar[XB_TOPGEN], 1u);
            else XB_SPIN(xb_ld(&bar[XB_TOPGEN]) == tg, bar);
            __builtin_amdgcn_fence(__ATOMIC_ACQUIRE, "agent");
            xb_add(&bar[XB_XGEN(x)], 1u);
            asm volatile("s_waitcnt vmcnt(0)" ::: "memory");
        } else {
            XB_SPIN(xb_ld(&bar[XB_XGEN(x)]) == gen, bar);
            __builtin_amdgcn_fence(__ATOMIC_ACQUIRE, "agent");
            asm volatile("s_waitcnt vmcnt(0)" ::: "memory");
        }
    }
    __syncthreads();
}


#define SK_LOOP(ACC, AP, BP, KK) do { _Pragma("unroll") for (int k0_ = 0; k0_ < (KK); k0_ += 32) { \
        const bf16x8 a_ = *(const bf16x8*)((AP) + k0_), b_ = *(const bf16x8*)((BP) + k0_); ACC = __builtin_amdgcn_mfma_f32_16x16x32_bf16(a_, b_, ACC, 0, 0, 0); } } while (0)
DI void skinny_phase(int which  , const Params& p, const Chunk& ck, const XMap& xm, const unsigned char* wbl, int gw, int NGW, int lane) {
    unsigned char* ws = p.ws; asm volatile("" : "+s"(ws));
    const int row = lane & 15, quad = lane >> 4;
    if (which == 0) {
        const bf16_t* OB = (const bf16_t*)(ws + WS_ZM); const bf16_t* G = (const bf16_t*)(ws + WS_G); bf16_t* MGb = (bf16_t*)(ws + WS_XN);
        for (int it = gw; it < ck.nseq * 64; it += NGW) {
            const int s = it >> 6, tile = it & 63, R0 = (s * ck.tps + ck.tps - 1) * 256, col = tile * 16 + row;
            f32x4 sum = {0.f, 0.f, 0.f, 0.f};
#pragma unroll 1
            for (int z = 0; z < 3; ++z) { f32x4 a = {0.f, 0.f, 0.f, 0.f};
                const bf16_t* ap = OB + (size_t)z * OSLOT + (size_t)(R0 + row) * 512 + quad * 8; const bf16_t* bp = (const bf16_t*)(wbl + W_BR) + (size_t)z * 1024 * 512 + (size_t)col * 512 + quad * 8;
                SK_LOOP(a, ap, bp, 512);
#pragma unroll
                for (int j = 0; j < 4; ++j) { const float g = __uint_as_float((unsigned)G[(size_t)(R0 + quad * 4 + j) * G_LD + z * 1024 + col] << 16); sum[j] += g * a[j]; } }
#pragma unroll
            for (int j = 0; j < 4; ++j) MGb[(size_t)(R0 + quad * 4 + j) * DM + col] = (bf16_t)(pk2(sum[j], 0.f) & 0xffffu);
        }
    } else if (which == 2) {
        const bf16_t* XNp = (const bf16_t*)(ws + WS_XN); bf16_t* U_ = (bf16_t*)(ws + WS_G);
        for (int it = gw; it < ck.nseq * 256; it += NGW) {
            const int s = it >> 8, tile = it & 255, R0 = (s * ck.tps + ck.tps - 1) * 256, col = tile * 16 + row;
            f32x4 acc = {0.f, 0.f, 0.f, 0.f};
            const bf16_t* ap = XNp + (size_t)(R0 + row) * 1024 + quad * 8; const bf16_t* bp = (const bf16_t*)(wbl + W_UP) + (size_t)col * 1024 + quad * 8;
#pragma unroll 1
            for (int kh = 0; kh < 2; ++kh) SK_LOOP(acc, ap + kh * 512, bp + kh * 512, 512);
#pragma unroll
            for (int j = 0; j < 4; ++j) { const float v = fmaxf(acc[j], 0.f); U_[(size_t)(R0 + quad * 4 + j) * 4096 + col] = (bf16_t)(pk2(v * v, 0.f) & 0xffffu); }
        }
    } else {
        const int K = (which == 1) ? 1024 : 4096, nkc = K >> 9;
        const bf16_t* A = (which == 1) ? (const bf16_t*)(ws + WS_XN) : (const bf16_t*)(ws + WS_G);
        const bf16_t* W = (const bf16_t*)(wbl + (which == 1 ? W_OUT : W_DOWN));
        for (int it = gw; it < ck.nseq * 64 * nkc; it += NGW) {
            const int kc = it % nkc, rem = it / nkc, s = rem >> 6, tile = rem & 63, pt = s * ck.tps + ck.tps - 1, R0 = pt * 256, col = tile * 16 + row;
            f32x4 acc = {0.f, 0.f, 0.f, 0.f};
            const bf16_t* ap = A + (size_t)(R0 + row) * K + kc * 512 + quad * 8; const bf16_t* bp = W + (size_t)col * K + kc * 512 + quad * 8;
            SK_LOOP(acc, ap, bp, 512);
            float* wp = xm.xw(pt);
#pragma unroll
            for (int j = 0; j < 4; ++j) atomicAdd(wp + (size_t)(quad * 4 + j) * DM + col, acc[j]);
        }
    }
}

#define GSYNC() xcd_barrier(xbar, xst, wave)
__global__ void __launch_bounds__(512) fwd_kernel(Params p) {
    extern __shared__ __attribute__((aligned(16))) unsigned char lds_raw[];
    LAS unsigned char* lds = (LAS unsigned char*)lds_raw;
    cg::grid_group grid = cg::this_grid();
    const int wave = __builtin_amdgcn_readfirstlane((int)threadIdx.x >> 6); int lane = lane_fresh();
    const int G = gridDim.x, bx = blockIdx.x, NGW = G * 8, gw = bx * 8 + wave;
#define WSP(off) ({ unsigned char* w_ = p.ws; asm volatile("" : "+s"(w_)); w_ + (off); })
#define ctl ((unsigned*)WSP(WS_CTL))
#define xbar (ctl + 1024)
    volatile LAS unsigned* xst = (volatile LAS unsigned*)(lds + LDS_MISC + 16);
    if (wave == 0 && lane == 0) { xst[0] = 0u; xst[1] = 0u; (void)xb_add(&xbar[XB_XCNT(xb_xcc_id())], 1u); }
    __syncthreads();
#define XN ((bf16_t*)WSP(WS_XN))
#define ZM ((bf16_t*)WSP(WS_ZM))
#define GB ((bf16_t*)WSP(WS_G))
#define CQN ((bf16_t*)WSP(WS_SM + SM_CQN))
#define CKVN ((bf16_t*)WSP(WS_SM + SM_CKVN))
#define QCR ((bf16_t*)WSP(WS_ZM + OFF_QCR))
#define KVR ((bf16_t*)WSP(WS_ZM + OFF_KVR))
#define MG ((float*)WSP(WS_QKV))
#define U ((bf16_t*)WSP(WS_G))

#if !defined(PH) || (PH & 1)
    prologue(p, lds, gw, NGW, wave, lane);
#ifdef PROBE_PRO2
    prologue(p, lds, gw, NGW, wave, lane);
#endif
#endif
    grid.sync();
    for (int l = 0; l < 2; ++l) {
        const bool last = (l == 1);
#define wb (WSP(WS_W) + (size_t)l * LW_STRIDE)
        for (int c = 0; c < 3; ++c) {
            const Chunk ck = make_chunk(c);
            const int ta = ck.tps - 1;
            XMap xm; xm.out = p.out; xm.metax = (float*)WSP(WS_METAX); xm.xp = p.in[0]; xm.xs = p.in[1]; xm.meta0 = (const float*)WSP(WS_META0); xm.seq0 = ck.seq0; xm.tps = ck.tps; xm.first = (l == 0);
#define RELAUNDER() do { lane = lane_fresh(); } while (0)
            RELAUNDER();
#if !defined(PH) || (PH & 2)
            norm_phase(xm, ck.rows(), p.in[3] + l * DM, XN, gw, NGW, lane);
#ifdef PROBE_EW2
            RELAUNDER(); norm_phase(xm, ck.rows(), p.in[3] + l * DM, XN, gw, NGW, lane);
#endif
#endif
            GSYNC();
            { pg8::Gemm g{XN, (const bf16_t*)(wb + W_IN), 1024, 0, 0}; Sched S; S.init(ck.nseq, ck.tps, ck.tps, IN_N / 256, 1, G, bx);
              EpiIn E{ZM, GB, p.in[5] + l * 3072};
#if !defined(PH) || (PH & 4)
              pg8::gemm_phase<EpiIn, Sched, true, true>(lds, g, S, E, wave);
#ifdef PROBE_IN2
              pg8::gemm_phase<EpiIn, Sched, true, true>(lds, g, S, E, wave);
#endif
#endif
 }
            GSYNC();
            RELAUNDER();
#if !defined(PH) || (PH & 128)
            ew1_phase(p, ck, l, gw, NGW, lane);
#ifdef PROBE_EW2
            RELAUNDER(); ew1_phase(p, ck, l, gw, NGW, lane);
#endif
#endif
            GSYNC();
            { pg8::Gemm g{CQN, (const bf16_t*)(wb + W_QB), 256, 0, 0}; Sched S; S.init(ck.nseq, ck.tps, ck.tps, 3, 1, G, bx); EpiBf16<0> E{QCR, 768};
#if !defined(PH) || (PH & 8)
              pg8::gemm_phase<EpiBf16<0>, Sched, true, true>(lds, g, S, E, wave);
#endif
 }
            { pg8::Gemm g{CKVN, (const bf16_t*)(wb + W_KVB), 128, 0, 0}; Sched S; S.init(ck.nseq, ck.tps, ck.tps, 4, 1, G, bx); EpiBf16<0> E{KVR, 1024};
#if !defined(PH) || (PH & 8)
              pg8::gemm_phase<EpiBf16<0>, Sched, true, true>(lds, g, S, E, wave);
#endif
 }
            GSYNC();
            RELAUNDER();
#if !defined(PH) || (PH & 256)
            ew2_phase(p, ck, l, gw, NGW, lane);
#ifdef PROBE_EW2
            RELAUNDER(); ew2_phase(p, ck, l, gw, NGW, lane);
#endif
#endif
            GSYNC();
#if !defined(PH) || (PH & 1024)
            attn_phase(p, ck, last, l, lds, ctl + 8192 + 2048 * (l * 3 + c), wave);
#ifdef PROBE_ATTN2
            GSYNC();
            attn_phase(p, ck, last, l, lds, ctl + 8192 + 2048 * (6 + l * 3 + c), wave);
#endif
#endif
            GSYNC();
            RELAUNDER();
#if !defined(PH) || (PH & 512)
            ew3_phase(p, ck, l, last, gw, NGW, lane);
#endif
            GSYNC();
            { pg8::Gemm g{ZM, (const bf16_t*)(wb + W_BR), 512, OSLOT, (size_t)1024 * 512}; Sched S; S.init(ck.nseq, ta, ck.tps, 4, 3, G, bx); EpiBranch E{GB, MG, XN};
#if !defined(PH) || (PH & 16)
              pg8::gemm_phase<EpiBranch, Sched, true, true>(lds, g, S, E, wave);
#ifdef PROBE_BR2
              pg8::gemm_phase<EpiBranch, Sched, true, true>(lds, g, S, E, wave);
#endif
#endif
 }
            if (!last) { RELAUNDER(); skinny_phase(0, p, ck, xm, wb, gw, NGW, lane); }
            GSYNC();
            { pg8::Gemm g{XN, (const bf16_t*)(wb + W_OUT), 1024, 0, 0}; Sched S; S.init(ck.nseq, ta, ck.tps, 4, 1, G, bx); EpiResid E{xm};
#if !defined(PH) || (PH & 32)
              pg8::gemm_phase<EpiResid, Sched, true, true>(lds, g, S, E, wave);
#endif
 }
            if (!last) { RELAUNDER(); skinny_phase(1, p, ck, xm, wb, gw, NGW, lane); }
            GSYNC();
            xm.first = 0;
            RELAUNDER();
#if !defined(PH) || (PH & 2)
            norm_phase(xm, ck.rows(), p.in[25] + l * DM, XN, gw, NGW, lane);
#ifdef PROBE_EW2
            RELAUNDER(); norm_phase(xm, ck.rows(), p.in[25] + l * DM, XN, gw, NGW, lane);
#endif
#endif
            GSYNC();
            { pg8::Gemm g{XN, (const bf16_t*)(wb + W_UP), 1024, 0, 0}; Sched S; S.init(ck.nseq, ta, ck.tps, 16, 1, G, bx); EpiBf16<2> E{U, 4096};
#if !defined(PH) || (PH & 64)
              pg8::gemm_phase<EpiBf16<2>, Sched, true, true>(lds, g, S, E, wave);
#ifdef PROBE_UP2
              pg8::gemm_phase<EpiBf16<2>, Sched, true, true>(lds, g, S, E, wave);
#endif
#endif
 }
            if (!last) { RELAUNDER(); skinny_phase(2, p, ck, xm, wb, gw, NGW, lane); }
            GSYNC();
            { pg8::Gemm g{U, (const bf16_t*)(wb + W_DOWN), 4096, 0, 0}; Sched S; S.init(ck.nseq, ta, ck.tps, 4, 1, G, bx); EpiResid E{xm};
#if !defined(PH) || (PH & 32)
              pg8::gemm_phase<EpiResid, Sched, true, true>(lds, g, S, E, wave);
#endif
 }
            if (!last) { RELAUNDER(); skinny_phase(3, p, ck, xm, wb, gw, NGW, lane); }
        }
    }
}

extern "C" void kernel_launch(void* const* d_in, const int* in_sizes, int n_in, void* d_out, int out_size, void* d_ws, size_t ws_size, hipStream_t stream) {
    static int grid_blocks = 0;
    if (grid_blocks == 0) {
        if (n_in != 28 || ws_size < WS_END) { fprintf(stderr, "kernel_launch: unexpected n_in %d / ws_size %zu (need %zu)\n", n_in, ws_size, (size_t)WS_END); grid_blocks = -1; return; }
        int dev = 0, cus = 0, per_cu = 0;
        hipGetDevice(&dev); hipDeviceGetAttribute(&cus, hipDeviceAttributeMultiprocessorCount, dev);
        hipFuncSetAttribute((const void*)fwd_kernel, hipFuncAttributeMaxDynamicSharedMemorySize, LDS_BYTES);
        hipOccupancyMaxActiveBlocksPerMultiprocessor(&per_cu, (const void*)fwd_kernel, 512, LDS_BYTES);
        if (per_cu < 1) { fprintf(stderr, "kernel_launch: occupancy query says %d blocks/CU\n", per_cu); per_cu = 1; }
        grid_blocks = cus * 1;
        (void)hipGetLastError();
    }
    if (grid_blocks < 0) return;
    hipMemsetAsync((char*)d_ws + WS_CTL, 0, CTL_BYTES, stream);
    Params p{};
    for (int i = 0; i < 28; ++i) p.in[i] = (const float*)d_in[i];
    p.out = (float*)d_out; p.ws = (unsigned char*)d_ws;
    void* args[] = {&p};
    hipError_t e = hipLaunchCooperativeKernel((const void*)fwd_kernel, dim3(grid_blocks), dim3(512), args, LDS_BYTES, stream);
    if (e != hipSuccess) fprintf(stderr, "cooperative launch failed: %s (grid %d)\n", hipGetErrorString(e), grid_blocks);
}
```

```cpp
#include <hip/hip_runtime.h>
#include <hip/hip_cooperative_groups.h>
#include <cstdint>
#include <cstdio>
namespace cg = cooperative_groups;
#define NOPIPE_AB 1
#define FLATQ 1
namespace pg8 {
#define PG8_LAS __attribute__((address_space(3)))
typedef unsigned short bf16_t;
typedef short bf16x8 __attribute__((ext_vector_type(8)));
typedef float f32x4 __attribute__((ext_vector_type(4)));
typedef unsigned u32x4 __attribute__((ext_vector_type(4)));
constexpr int BM = 256, BK = 64, HALF = 128, HTB = HALF * BK * 2  , STAGE_BYTES = 8 * HTB, NXCD = 8, WGM = 8;

__host__ __device__ __forceinline__ int lds_byte(int r, int c) { const int st = (r >> 4) * 2 + (c >> 5), rr = r & 15, cc = c & 31, ob = rr * 64 + cc * 2; return st * 1024 + (ob ^ (((ob >> 9) & 1) << 5)); }
__host__ __device__ __forceinline__ void stage_rc(int b, int& R, int& C) { const int st = b / 1024, sb = b % 1024, swz = sb ^ (((sb >> 9) & 1) << 5); R = (st >> 1) * 16 + swz / 64; C = (st & 1) * 32 + (swz % 64) / 2; }
__host__ __device__ __forceinline__ int perm32(int rho) { const int n = rho >> 4, i = rho & 15; return 8 * (i >> 2) + 4 * n + (i & 3); }

struct Unit { int pm, pn, z; };
struct Gemm { const bf16_t* A; const bf16_t* Bt; int K; size_t zsA, zsB; };

template <class Epi, class Sched, bool ALIGN_EPI = false, bool SP2 = false>
__device__ __forceinline__ void gemm_phase(PG8_LAS unsigned char* lds, const Gemm g, const Sched& S, const Epi& E, const int wv  ) {
    int tid_; asm volatile("v_mbcnt_lo_u32_b32 %0, -1, 0\n\tv_mbcnt_hi_u32_b32 %0, -1, %0" : "=v"(tid_)); tid_ += wv * 64;
    const int tid = tid_, wid = __builtin_amdgcn_readfirstlane(tid >> 6), lane = tid & 63, wr = wid >> 2, wc = wid & 3, fr = lane & 15, fq = lane >> 4;
    const int K = g.K, nt = K / BK;
    unsigned voffA[2], voffB[2];
#pragma unroll
    for (int i = 0; i < 2; ++i) { int R, C; stage_rc(tid * 16 + i * 8192, R, C); const int Rb = Epi::PERM ? ((R & ~31) + perm32(R & 31)) : R;
        voffA[i] = (unsigned)(R * K + C) * 2u; voffB[i] = (unsigned)(Rb * K + C) * 2u; }
    const size_t kstep = (size_t)(BK * 2);
    const size_t hstep = (size_t)HALF * K * 2;
    const size_t tstep = 2 * hstep;
    const unsigned ldsw = (unsigned)wid * 1024u;
    const int aoff = lds_byte(wr * 64 + fr, fq * 8), boff = lds_byte(wc * 32 + fr, fq * 8);
#define PG8_SA(b, h) (((b) * 2 + (h)) * HTB)
#define PG8_SB(b, h) ((4 + (b) * 2 + (h)) * HTB)
#define PG8_STAGE(bufoff, gbase, voff) do { _Pragma("unroll") for (int _i = 0; _i < 2; ++_i) \
        __builtin_amdgcn_global_load_lds((const unsigned*)((const char*)(gbase) + (voff)[_i]), (PG8_LAS unsigned*)(lds + (bufoff) + ldsw + _i * 8192), 16, 0, 0); } while (0)
#define PG8_LDA(dst, b, h) do { _Pragma("unroll") for (int m = 0; m < 4; ++m) _Pragma("unroll") for (int k = 0; k < 2; ++k) dst[m][k] = *(const PG8_LAS bf16x8*)(lds + PG8_SA(b, h) + aoff + m * 2048 + k * 1024); } while (0)
#define PG8_LDB(dst, b, h) do { _Pragma("unroll") for (int n = 0; n < 2; ++n) _Pragma("unroll") for (int k = 0; k < 2; ++k) dst[n][k] = *(const PG8_LAS bf16x8*)(lds + PG8_SB(b, h) + boff + n * 2048 + k * 1024); } while (0)
#define PG8_MMA(ai, bj, At, Bt) do { __builtin_amdgcn_s_setprio(1); _Pragma("unroll") for (int m = 0; m < 4; ++m) _Pragma("unroll") for (int n = 0; n < 2; ++n) _Pragma("unroll") for (int k = 0; k < 2; ++k) \
        acc[ai][bj][m][n] = __builtin_amdgcn_mfma_f32_16x16x32_bf16(Bt[n][k], At[m][k], acc[ai][bj][m][n], 0, 0, 0); __builtin_amdgcn_s_setprio(0); } while (0)
#define PG8_WAIT_V(n) asm volatile("s_waitcnt vmcnt(" #n ")" ::: "memory")
#define PG8_WAIT_L(n) asm volatile("s_waitcnt lgkmcnt(" #n ")" ::: "memory")
#define PG8_BAR __builtin_amdgcn_s_barrier()
#define PG8_SCHED __builtin_amdgcn_sched_barrier(0)
    Unit cur, nxt; int ui = 0;
    if (!S.next(0, cur)) return;
    f32x4 acc[2][2][4][2];
#pragma unroll
    for (int a = 0; a < 2; ++a)
#pragma unroll
        for (int b = 0; b < 2; ++b)
#pragma unroll
            for (int m = 0; m < 4; ++m)
#pragma unroll
                for (int n = 0; n < 2; ++n) acc[a][b][m][n] = (f32x4){0.f, 0.f, 0.f, 0.f};
    bf16x8 At[4][2], B0[2][2], B1[2][2];
    const char* cA = (const char*)(g.A + (size_t)cur.z * g.zsA) + (size_t)cur.pm * tstep; const char* cB = (const char*)(g.Bt + (size_t)cur.z * g.zsB) + (size_t)cur.pn * tstep;
    S.a_ready(cur);
    if constexpr (SP2) {
        PG8_STAGE(PG8_SB(0, 0), cB, voffB); PG8_STAGE(PG8_SB(0, 1), cB + hstep, voffB); PG8_STAGE(PG8_SA(0, 0), cA, voffA); PG8_STAGE(PG8_SA(0, 1), cA + hstep, voffA);
        if (wr == 1) PG8_BAR;
        PG8_WAIT_V(2); PG8_BAR;
        PG8_STAGE(PG8_SB(1, 0), cB + kstep, voffB); PG8_STAGE(PG8_SA(1, 0), cA + kstep, voffA); PG8_STAGE(PG8_SB(1, 1), cB + hstep + kstep, voffB);
        PG8_WAIT_V(6); PG8_BAR;
    } else {
        PG8_STAGE(PG8_SB(0, 0), cB, voffB); PG8_STAGE(PG8_SA(0, 0), cA, voffA); PG8_STAGE(PG8_SB(0, 1), cB + hstep, voffB); PG8_STAGE(PG8_SA(0, 1), cA + hstep, voffA);
        if (wr == 1) PG8_BAR;
        PG8_WAIT_V(4); PG8_BAR;
        PG8_STAGE(PG8_SB(1, 0), cB + kstep, voffB); PG8_STAGE(PG8_SA(1, 0), cA + kstep, voffA); PG8_STAGE(PG8_SB(1, 1), cB + hstep + kstep, voffB);
        PG8_WAIT_V(6); PG8_BAR;
    }
    for (;;) {
        const bool has_next = S.next(ui + 1, nxt);
        const char* nA = has_next ? (const char*)(g.A + (size_t)nxt.z * g.zsA) + (size_t)nxt.pm * tstep : cA; const char* nB = has_next ? (const char*)(g.Bt + (size_t)nxt.z * g.zsB) + (size_t)nxt.pn * tstep : cB;
        for (int t = 0; t < nt; t += 2) {
            const bool last = (t == nt - 2);
            const char* a1 = cA + (size_t)(t + 1) * kstep;
            const char* a2 = last ? nA : cA + (size_t)(t + 2) * kstep; const char* b2 = last ? nB : cB + (size_t)(t + 2) * kstep;
            const char* a3 = a2 + kstep; const char* b3 = b2 + kstep;
            if (last && has_next) S.a_ready(nxt);
            if constexpr (SP2) {
            PG8_LDB(B0, 0, 0); PG8_LDB(B1, 0, 1); PG8_SCHED; PG8_LDA(At, 0, 0); PG8_STAGE(PG8_SA(1, 1), a1 + hstep, voffA);
            PG8_WAIT_V(8); PG8_WAIT_L(0); PG8_BAR; PG8_MMA(0, 0, At, B0); PG8_MMA(0, 1, At, B1); PG8_BAR; PG8_SCHED;
            PG8_LDA(At, 0, 1); PG8_STAGE(PG8_SB(0, 0), b2, voffB); PG8_STAGE(PG8_SB(0, 1), b2 + hstep, voffB); PG8_STAGE(PG8_SA(0, 0), a2, voffA);
            PG8_WAIT_V(8); PG8_WAIT_L(0); PG8_BAR; PG8_MMA(1, 0, At, B0); PG8_MMA(1, 1, At, B1); PG8_BAR; PG8_SCHED;
            PG8_LDB(B0, 1, 0); PG8_LDB(B1, 1, 1); PG8_SCHED; PG8_LDA(At, 1, 0); PG8_STAGE(PG8_SA(0, 1), a2 + hstep, voffA);
            PG8_WAIT_V(8); PG8_WAIT_L(0); PG8_BAR; PG8_MMA(0, 0, At, B0); PG8_MMA(0, 1, At, B1); PG8_BAR; PG8_SCHED;
            PG8_LDA(At, 1, 1); PG8_STAGE(PG8_SB(1, 0), b3, voffB); PG8_STAGE(PG8_SB(1, 1), b3 + hstep, voffB); PG8_STAGE(PG8_SA(1, 0), a3, voffA);
            PG8_WAIT_V(8); PG8_WAIT_L(0); PG8_BAR; PG8_MMA(1, 0, At, B0); PG8_MMA(1, 1, At, B1); PG8_BAR; PG8_SCHED;
            } else {
            PG8_LDB(B0, 0, 0); PG8_SCHED; PG8_LDA(At, 0, 0); PG8_STAGE(PG8_SA(1, 1), a1 + hstep, voffA);
            PG8_WAIT_L(8); PG8_BAR; PG8_WAIT_L(0); PG8_MMA(0, 0, At, B0); PG8_BAR; PG8_SCHED;
            PG8_LDB(B1, 0, 1); PG8_STAGE(PG8_SB(0, 0), b2, voffB);
            PG8_BAR; PG8_WAIT_L(0); PG8_MMA(0, 1, At, B1); PG8_BAR;
            PG8_LDA(At, 0, 1); PG8_STAGE(PG8_SA(0, 0), a2, voffA);
            PG8_BAR; PG8_WAIT_L(0); PG8_MMA(1, 0, At, B0); PG8_BAR; PG8_SCHED;
            PG8_STAGE(PG8_SB(0, 1), b2 + hstep, voffB);
            PG8_WAIT_V(6); PG8_BAR; PG8_MMA(1, 1, At, B1); PG8_BAR;
            PG8_LDB(B0, 1, 0); PG8_SCHED; PG8_LDA(At, 1, 0); PG8_STAGE(PG8_SA(0, 1), a2 + hstep, voffA);
            PG8_WAIT_L(8); PG8_BAR; PG8_WAIT_L(0); PG8_MMA(0, 0, At, B0); PG8_BAR; PG8_SCHED;
            PG8_LDB(B1, 1, 1); PG8_STAGE(PG8_SB(1, 0), b3, voffB);
            PG8_BAR; PG8_WAIT_L(0); PG8_MMA(0, 1, At, B1); PG8_BAR;
            PG8_LDA(At, 1, 1); PG8_STAGE(PG8_SA(1, 0), a3, voffA);
            PG8_BAR; PG8_WAIT_L(0); PG8_MMA(1, 0, At, B0); PG8_BAR; PG8_SCHED;
            PG8_STAGE(PG8_SB(1, 1), b3 + hstep, voffB);
            PG8_WAIT_V(6); PG8_BAR; PG8_MMA(1, 1, At, B1); PG8_BAR;
            }
        }
        if constexpr (ALIGN_EPI) { if (wr == 0) PG8_BAR; }
        if constexpr (!Epi::AFTER_DRAIN) { E(acc, cur, wr, wc, fr, fq); S.done(cur); }
        if (!has_next) break;
#pragma unroll
        for (int a = 0; a < 2; ++a)
#pragma unroll
            for (int b = 0; b < 2; ++b)
#pragma unroll
                for (int m = 0; m < 4; ++m)
#pragma unroll
                    for (int n = 0; n < 2; ++n) acc[a][b][m][n] = (f32x4){0.f, 0.f, 0.f, 0.f};
        cur = nxt; cA = nA; cB = nB; ++ui;
        if constexpr (ALIGN_EPI) { if (wr == 1) PG8_BAR; }
    }
    PG8_WAIT_V(0);
    if constexpr (!ALIGN_EPI) { if (wr == 0) PG8_BAR; }
    PG8_BAR;
    if constexpr (Epi::AFTER_DRAIN) { E.fused(acc, cur, wr, wc, fr, fq, lds, wid, lane); S.done(cur); }
#undef PG8_SA
#undef PG8_SB
#undef PG8_STAGE
#undef PG8_LDA
#undef PG8_LDB
#undef PG8_MMA
#undef PG8_WAIT_V
#undef PG8_WAIT_L
#undef PG8_BAR
#undef PG8_SCHED
}
}


using pg8::bf16_t; using pg8::bf16x8; using pg8::f32x4; using pg8::u32x4;
typedef float f32x16 __attribute__((ext_vector_type(16)));
typedef unsigned u32x2 __attribute__((ext_vector_type(2)));
typedef float f32x2_t __attribute__((ext_vector_type(2)));
typedef __bf16 bf16x2_t __attribute__((ext_vector_type(2)));
#define LAS __attribute__((address_space(3)))
#define DI __device__ __forceinline__

constexpr int DM = 1024, RA = 16896;
constexpr int ZM_LD = 2816, G_LD = 3072, IN_N = 5888;
constexpr float LOG2E = 1.4426950408889634f;
constexpr size_t MiB = 1u << 20;
constexpr size_t WS_CTL = 0, CTL_BYTES = 131072;
constexpr size_t WS_W = 1 * MiB, LW_STRIDE = 34 * MiB;
constexpr size_t W_IN = 0, W_QB = W_IN + (size_t)IN_N * 1024 * 2, W_KVB = W_QB + 768 * 256 * 2, W_BR = W_KVB + 1024 * 128 * 2,
                 W_OUT = W_BR + 3 * 1024 * 512 * 2, W_UP = W_OUT + 1024 * 1024 * 2, W_DOWN = W_UP + 4096 * 1024 * 2, W_END = W_DOWN + 4096 * 1024 * 2;
static_assert(W_END <= LW_STRIDE, "weights");
constexpr size_t WS_META0 = 69 * MiB, WS_METAX = 70 * MiB, WS_XN = 74 * MiB, WS_ZM = 107 * MiB, WS_G = 198 * MiB, WS_QKV = 297 * MiB, WS_SM = 438 * MiB, WS_END = 454 * MiB;
constexpr size_t OFF_QCR = 0, OFF_KVR = 25 * MiB;
constexpr size_t OSLOT = (size_t)RA * 512;
constexpr size_t QA_O = 0, KA_O = 512ull * RA, VA_O = 640ull * RA, QB_O = 768ull * RA, KB_O = 1280ull * RA, VB_O = 1792ull * RA, QC_O = 2304ull * RA, KC_O = 3072ull * RA, VC_O = 3840ull * RA;
constexpr size_t SM_CQN = 0, SM_CKVN = 9 * MiB, SM_KPE = 14 * MiB;
constexpr int LDS_MISC = 131072, LDS_BYTES = 131072 + 256;

struct Params { const float* in[28]; float* out; unsigned char* ws; };

DI unsigned pk2(float lo, float hi) { f32x2_t v = {lo, hi}; bf16x2_t b = __builtin_convertvector(v, bf16x2_t); return __builtin_bit_cast(unsigned, b); }
DI void ld8(const bf16_t* p, float (&f)[8]) {
    const u32x4 r = *(const u32x4*)p;
#pragma unroll
    for (int i = 0; i < 4; ++i) { f[2 * i] = __uint_as_float(r[i] << 16); f[2 * i + 1] = __uint_as_float(r[i] & 0xffff0000u); }
}
DI void st8(bf16_t* p, const float (&f)[8]) { u32x4 w; w.x = pk2(f[0], f[1]); w.y = pk2(f[2], f[3]); w.z = pk2(f[4], f[5]); w.w = pk2(f[6], f[7]); *(u32x4*)p = w; }
DI int lane_fresh() { int l; asm volatile("v_mbcnt_lo_u32_b32 %0, -1, 0\n\tv_mbcnt_hi_u32_b32 %0, -1, %0" : "=v"(l)); return l; }
DI float wave_sum(float v, int lane) {
#pragma unroll
    for (int o = 1; o < 64; o <<= 1) v += __int_as_float(__builtin_amdgcn_ds_bpermute((lane ^ o) << 2, __float_as_int(v)));
    return v;
}
DI float max3f(float a, float b, float c) { float r; asm("v_max3_f32 %0, %1, %2, %3" : "=v"(r) : "v"(a), "v"(b), "v"(c)); return r; }
DI float max2f(float a, float b) { float r; asm("v_max_f32_e32 %0, %1, %2" : "=v"(r) : "v"(a), "v"(b)); return r; }
DI float fadd_s(float a, float b) { float r; asm("v_add_f32_e32 %0, %1, %2" : "=v"(r) : "v"(a), "v"(b)); return r; }
#define MX2(a, b) __builtin_amdgcn_fmed3f((a), (b), __builtin_inff())
DI float swap32_max(float v) { auto rr = __builtin_amdgcn_permlane32_swap(__float_as_uint(v), __float_as_uint(v), false, false); return __builtin_amdgcn_fmed3f(__uint_as_float(rr[0]), __uint_as_float(rr[1]), __builtin_inff()); }
DI float swap32_add(float v) { auto rr = __builtin_amdgcn_permlane32_swap(__float_as_uint(v), __float_as_uint(v), false, false); return __uint_as_float(rr[0]) + __uint_as_float(rr[1]); }
DI constexpr float inv64(int j) {
    constexpr float T[32] = {1.0f, 0.749894209f, 0.562341325f, 0.421696503f, 0.316227766f, 0.237137371f, 0.177827941f, 0.133352143f, 0.1f, 0.0749894209f, 0.0562341325f, 0.0421696503f,
                             0.0316227766f, 0.0237137371f, 0.0177827941f, 0.0133352143f, 0.01f, 0.00749894209f, 0.00562341325f, 0.00421696503f, 0.00316227766f, 0.00237137371f,
                             0.00177827941f, 0.00133352143f, 0.001f, 0.000749894209f, 0.000562341325f, 0.000421696503f, 0.000316227766f, 0.000237137371f, 0.000177827941f, 0.000133352143f};
    return T[j];
}
DI void sincos_ang(float ang, float& s, float& c) {
    double t = (double)ang * 0.15915494309189535; t -= __builtin_rint(t); const float f = (float)t;
    s = __builtin_amdgcn_sinf(f); c = __builtin_amdgcn_cosf(f);
}

struct Chunk {
    int id, nseq, seq0, tps, n;
    DI int rows_per_seq() const { return tps * 256; }
    DI int rows() const { return nseq * tps * 256; }
};
DI Chunk make_chunk(int c) { Chunk k; k.id = c; if (c < 2) { k.nseq = 1; k.seq0 = c; k.tps = 65; k.n = 16384; } else { k.nseq = 2; k.seq0 = 2; k.tps = 33; k.n = 8192; } return k; }
struct XMap {
    float* out; float* metax; const float* xp; const float* xs; const float* meta0; int seq0, tps, first;
    DI float* xw(int pt) const {
        const int hi = pt >= tps ? 1 : 0, s = seq0 + hi, lt = pt - hi * tps;
        if (lt == tps - 1) return metax + (size_t)s * 256 * DM;
        const int ob = (s < 2) ? s * 16384 : 32768 + (s - 2) * 8192;
        return out + ((size_t)ob + (size_t)lt * 256) * DM;
    }
    DI const float* xr(int pt) const {
        if (!first) return xw(pt);
        const int hi = pt >= tps ? 1 : 0, s = seq0 + hi, lt = pt - hi * tps;
        if (lt == tps - 1) return metax + (size_t)s * 256 * DM;
        return (s < 2) ? xp + ((size_t)s * 16384 + (size_t)lt * 256) * DM : xs + ((size_t)(s - 2) * 8192 + (size_t)lt * 256) * DM;
    }
};

struct Sched {
    int nM, nN, nZ, nwg, G, c, ta, tps;
    DI void init(int nseq, int ta_, int tps_, int nN_, int nZ_, int G_, int c_) { ta = ta_; tps = tps_; nM = nseq * ta_; nN = nN_; nZ = nZ_; nwg = nM * nN; G = G_; c = c_; }
    DI bool next(int i, pg8::Unit& u) const {
        const int tl = (i / nZ) * G + c; if (tl >= nwg) return false;
        u.z = i % nZ;
        int wgid = tl; { const int q = nwg / pg8::NXCD, r = nwg % pg8::NXCD, xcd = wgid % pg8::NXCD, off = wgid / pg8::NXCD; wgid = (xcd < r ? xcd * (q + 1) : r * (q + 1) + (xcd - r) * q) + off; }
        const int nig = pg8::WGM * nN, gid = wgid / nig, fm = gid * pg8::WGM, gsz = (nM - fm) < pg8::WGM ? (nM - fm) : pg8::WGM;
        const int pa = fm + ((wgid % nig) % gsz); u.pn = (wgid % nig) / gsz;
        u.pm = pa >= ta ? pa - ta + tps : pa;
        return true;
    }
    DI void a_ready(const pg8::Unit&) const {}
    DI void done(const pg8::Unit&) const {}
};

template <int ACT  > struct EpiBf16 {
    static constexpr bool PERM = true, AFTER_DRAIN = false;
    bf16_t* O; int ldc;
    DI void operator()(const f32x4 (&acc)[2][2][4][2], const pg8::Unit& u, int wr, int wc, int fr_, int fq_) const {
        const int ln_ = lane_fresh(), fr = ln_ & 15, fq = ln_ >> 4;
        const int row0 = u.pm * 256 + wr * 64 + fr, col0 = u.pn * 256 + wc * 32 + 8 * fq;
#pragma unroll
        for (int ai = 0; ai < 2; ++ai)
#pragma unroll
            for (int m = 0; m < 4; ++m) { bf16_t* rowp = O + (size_t)(row0 + ai * 128 + m * 16) * ldc + col0;
#pragma unroll
                for (int bj = 0; bj < 2; ++bj) { f32x4 v0 = acc[ai][bj][m][0], v1 = acc[ai][bj][m][1];
                    if (ACT == 2) {
#pragma unroll
                        for (int k = 0; k < 4; ++k) { const float a = fmaxf(v0[k], 0.f), b = fmaxf(v1[k], 0.f); v0[k] = a * a; v1[k] = b * b; } }
                    u32x4 w; w.x = pk2(v0[0], v0[1]); w.y = pk2(v0[2], v0[3]); w.z = pk2(v1[0], v1[1]); w.w = pk2(v1[2], v1[3]);
                    *(u32x4*)(rowp + bj * 128) = w; } }
    }
};
struct EpiIn {
    static constexpr bool PERM = true, AFTER_DRAIN = false;
    bf16_t* ZM; bf16_t* G; const float* bgate;
    DI void operator()(const f32x4 (&acc)[2][2][4][2], const pg8::Unit& u, int wr, int wc, int fr_, int fq_) const {
        const int ln_ = lane_fresh(), fr = ln_ & 15, fq = ln_ >> 4;
        const bool gate = u.pn >= 11;
        const int row0 = u.pm * 256 + wr * 64 + fr, colt = gate ? (u.pn - 11) * 256 : u.pn * 256, col0 = colt + wc * 32 + 8 * fq, ld = gate ? G_LD : ZM_LD;
        bf16_t* base = gate ? G : ZM;
        f32x4 bv[2][2];
#pragma unroll
        for (int bj = 0; bj < 2; ++bj)
#pragma unroll
            for (int n = 0; n < 2; ++n) bv[bj][n] = gate ? *(const f32x4*)(bgate + col0 + bj * 128 + 4 * n) : (f32x4){0.f, 0.f, 0.f, 0.f};
#pragma unroll
        for (int ai = 0; ai < 2; ++ai)
#pragma unroll
            for (int m = 0; m < 4; ++m) { bf16_t* rowp = base + (size_t)(row0 + ai * 128 + m * 16) * ld + col0;
#pragma unroll
                for (int bj = 0; bj < 2; ++bj) { f32x4 v0 = acc[ai][bj][m][0] + bv[bj][0], v1 = acc[ai][bj][m][1] + bv[bj][1];
                    if (gate) {
#pragma unroll
                        for (int k = 0; k < 4; ++k) { v0[k] = __builtin_amdgcn_rcpf(1.f + __builtin_amdgcn_exp2f(-LOG2E * v0[k])); v1[k] = __builtin_amdgcn_rcpf(1.f + __builtin_amdgcn_exp2f(-LOG2E * v1[k])); } }
                    u32x4 w; w.x = pk2(v0[0], v0[1]); w.y = pk2(v0[2], v0[3]); w.z = pk2(v1[0], v1[1]); w.w = pk2(v1[2], v1[3]);
                    *(u32x4*)(rowp + bj * 128) = w; } }
    }
};
struct EpiBranch {
    static constexpr bool PERM = false, AFTER_DRAIN = false;
    const bf16_t* G; float* MG; bf16_t* MGb;
    DI void operator()(const f32x4 (&acc)[2][2][4][2], const pg8::Unit& u, int wr, int wc, int fr_, int fq_) const {
        const int ln_ = lane_fresh(), fr = ln_ & 15, fq = ln_ >> 4;
        const int row0 = u.pm * 256 + wr * 64 + fr, col0 = u.pn * 256 + wc * 32 + 4 * fq;
#pragma unroll
        for (int ai = 0; ai < 2; ++ai)
#pragma unroll
            for (int m = 0; m < 4; ++m) { const size_t row = (size_t)(row0 + ai * 128 + m * 16);
#pragma unroll
                for (int bj = 0; bj < 2; ++bj)
#pragma unroll
                    for (int n = 0; n < 2; ++n) { const int col = col0 + bj * 128 + n * 16;
                        const u32x2 gr = *(const u32x2*)(G + row * G_LD + u.z * 1024 + col);
                        f32x4 g; g[0] = __uint_as_float(gr.x << 16); g[1] = __uint_as_float(gr.x & 0xffff0000u); g[2] = __uint_as_float(gr.y << 16); g[3] = __uint_as_float(gr.y & 0xffff0000u);
                        f32x4 v = g * acc[ai][bj][m][n];
                        float* mp = MG + row * DM + col;
                        if (u.z > 0) v += *(const f32x4*)mp;
                        if (u.z < 2) *(f32x4*)mp = v;
                        else { u32x2 w; w.x = pk2(v[0], v[1]); w.y = pk2(v[2], v[3]); *(u32x2*)(MGb + row * DM + col) = w; } }
                asm volatile("" ::: "memory"); }
    }
};
struct EpiResid {
    static constexpr bool PERM = false, AFTER_DRAIN = false;
    XMap xm;
    DI void operator()(const f32x4 (&acc)[2][2][4][2], const pg8::Unit& u, int wr, int wc, int fr_, int fq_) const {
        const int ln_ = lane_fresh(), fr = ln_ & 15, fq = ln_ >> 4;
        const float* rd = xm.xr(u.pm); float* wp = xm.xw(u.pm);
        const int row0 = wr * 64 + fr, col0 = u.pn * 256 + wc * 32 + 4 * fq;
#pragma unroll
        for (int ai = 0; ai < 2; ++ai)
#pragma unroll
            for (int m = 0; m < 4; ++m) { const size_t off = (size_t)(row0 + ai * 128 + m * 16) * DM + col0;
#pragma unroll
                for (int bj = 0; bj < 2; ++bj)
#pragma unroll
                    for (int n = 0; n < 2; ++n) { const size_t o = off + bj * 128 + n * 16; *(f32x4*)(wp + o) = *(const f32x4*)(rd + o) + acc[ai][bj][m][n]; }
                asm volatile("" ::: "memory"); }
    }
};

DI void transpose_item(const float* W, int K, int N, bf16_t* WT, int split, int extra, LAS float* scr, int item, int lane) {
    const int nblk = N / 32, kb = item / nblk, nb = item % nblk, k0 = 64 * kb, n0 = 32 * nb;
    const int row_off = (n0 >= split) ? extra : 0;
#pragma unroll 8
    for (int i = 0; i < 32; ++i) { const int kk = 2 * i + (lane >> 5); scr[kk * 33 + (lane & 31)] = W[(size_t)(k0 + kk) * N + n0 + (lane & 31)]; }
    asm volatile("s_waitcnt lgkmcnt(0)" ::: "memory");
    const int c = lane & 7;
#pragma unroll
    for (int j = 0; j < 4; ++j) { const int n = (lane >> 3) + 8 * j; const LAS float* s = scr + (8 * c) * 33 + n;
        u32x4 o; o.x = pk2(s[0 * 33], s[1 * 33]); o.y = pk2(s[2 * 33], s[3 * 33]); o.z = pk2(s[4 * 33], s[5 * 33]); o.w = pk2(s[6 * 33], s[7 * 33]);
        *(u32x4*)(WT + (size_t)(row_off + n0 + n) * K + k0 + 8 * c) = o; }
    asm volatile("s_waitcnt lgkmcnt(0)" ::: "memory");
}
DI void prologue(const Params& p, LAS unsigned char* lds, int gw, int NGW, int wave, int lane) {
    LAS float* scr = (LAS float*)(lds + wave * 16384);
    constexpr int I_IN = 16 * 182, I_QB = 4 * 24, I_KVB = 2 * 32, I_BR = 8 * 32, I_OUT = 16 * 32, I_UP = 16 * 128, I_DN = 64 * 32;
    constexpr int PER_L = I_IN + I_QB + I_KVB + 3 * I_BR + I_OUT + I_UP + I_DN;
    for (int it = gw; it < 2 * PER_L; it += NGW) {
        const int l = it / PER_L; int r = it % PER_L;
        unsigned char* wb = p.ws + WS_W + (size_t)l * LW_STRIDE;
        if (r < I_IN) { transpose_item(p.in[4] + (size_t)l * 1024 * 5824, 1024, 5824, (bf16_t*)(wb + W_IN), 2752, 64, scr, r, lane); continue; } r -= I_IN;
        if (r < I_QB) { transpose_item(p.in[16] + (size_t)l * 256 * 768, 256, 768, (bf16_t*)(wb + W_QB), 1 << 30, 0, scr, r, lane); continue; } r -= I_QB;
        if (r < I_KVB) { transpose_item(p.in[18] + (size_t)l * 128 * 1024, 128, 1024, (bf16_t*)(wb + W_KVB), 1 << 30, 0, scr, r, lane); continue; } r -= I_KVB;
        if (r < 3 * I_BR) { const int b = r / I_BR; transpose_item(p.in[21 + b] + (size_t)l * 512 * 1024, 512, 1024, (bf16_t*)(wb + W_BR) + (size_t)b * 1024 * 512, 1 << 30, 0, scr, r % I_BR, lane); continue; } r -= 3 * I_BR;
        if (r < I_OUT) { transpose_item(p.in[24] + (size_t)l * 1024 * 1024, 1024, 1024, (bf16_t*)(wb + W_OUT), 1 << 30, 0, scr, r, lane); continue; } r -= I_OUT;
        if (r < I_UP) { transpose_item(p.in[26] + (size_t)l * 1024 * 4096, 1024, 4096, (bf16_t*)(wb + W_UP), 1 << 30, 0, scr, r, lane); continue; } r -= I_UP;
        transpose_item(p.in[27] + (size_t)l * 4096 * 1024, 4096, 1024, (bf16_t*)(wb + W_DOWN), 1 << 30, 0, scr, r, lane);
    }
    { float* mx0 = (float*)(p.ws + WS_METAX);
      for (int r = gw; r < 4 * 256; r += NGW) { const int rr = r & 255; f32x4* o = (f32x4*)(mx0 + (size_t)r * DM) + lane;
#pragma unroll
        for (int j = 0; j < 4; ++j) o[64 * j] = (rr < 16) ? ((const f32x4*)(p.in[2] + (size_t)rr * DM))[lane + 64 * j] : (f32x4){0.f, 0.f, 0.f, 0.f}; } }
    float* m0 = (float*)(p.ws + WS_META0);
    for (int r = gw; r < 256; r += NGW) { f32x4* o = (f32x4*)(m0 + (size_t)r * DM) + lane;
#pragma unroll
        for (int j = 0; j < 4; ++j) o[64 * j] = (r < 16) ? ((const f32x4*)(p.in[2] + (size_t)r * DM))[lane + 64 * j] : (f32x4){0.f, 0.f, 0.f, 0.f}; }
}

DI void norm_phase(const XMap& xm, int rows, const float* g, bf16_t* XN, int gw, int NGW, int lane) {
    for (int r = gw; r < rows; r += NGW) {
        const float* xrow = xm.xr(r >> 8) + (size_t)(r & 255) * DM;
        const f32x4* xr = (const f32x4*)xrow + lane;
        f32x4 v[4]; float s = 0.f;
#pragma unroll
        for (int j = 0; j < 4; ++j) { v[j] = xr[64 * j]; s += (v[j].x * v[j].x + v[j].y * v[j].y) + (v[j].z * v[j].z + v[j].w * v[j].w); }
        const float rs = rsqrtf(wave_sum(s, lane) * (1.f / DM) + 1e-6f);
        u32x2* o8 = (u32x2*)(XN + (size_t)r * DM) + lane;
#pragma unroll
        for (int j = 0; j < 4; ++j) { const f32x4 gg = ((const f32x4*)g)[lane + 64 * j]; u32x2 w; w.x = pk2(v[j].x * rs * gg.x, v[j].y * rs * gg.y); w.y = pk2(v[j].z * rs * gg.z, v[j].w * rs * gg.w); o8[64 * j] = w; }
    }
}

template <int W, int W0, int ROPE> DI void norm_task(const bf16_t* s0, const bf16_t* s1, const float* gain, float oscale, bf16_t* dst, float pa, float pb) {
    float ss = 0.f;
#pragma unroll 2
    for (int c = 0; c < W / 8; ++c) { float x[8]; ld8(c < W0 / 8 ? s0 + 8 * c : s1 + 8 * (c - W0 / 8), x);
#pragma unroll
        for (int e = 0; e < 8; ++e) ss += x[e] * x[e]; }
    const float rs = rsqrtf(ss * (1.f / W) + 1e-6f) * oscale;
    constexpr int NPLAIN = ROPE == 1 ? 0 : (ROPE == 2 ? 16 : W / 8);
#pragma unroll 2
    for (int c = 0; c < NPLAIN; ++c) { float x[8]; ld8(c < W0 / 8 ? s0 + 8 * c : s1 + 8 * (c - W0 / 8), x);
#pragma unroll
        for (int e = 0; e < 8; ++e) x[e] *= rs * gain[8 * c + e];
        st8(dst + 8 * c, x); }
    if constexpr (ROPE != 0) {
        constexpr int NB = ROPE == 1 ? 2 : 1, HC = ROPE == 1 ? 2 : 4, C0 = ROPE == 1 ? 0 : 16;
#pragma unroll
        for (int b = 0; b < NB; ++b) { const float pos = b ? pb : pa;
#pragma unroll
            for (int k = 0; k < HC; ++k) { const int c1 = C0 + 2 * HC * b + k, c2 = c1 + HC; float x1[8], x2[8];
                ld8(c1 < W0 / 8 ? s0 + 8 * c1 : s1 + 8 * (c1 - W0 / 8), x1); ld8(c2 < W0 / 8 ? s0 + 8 * c2 : s1 + 8 * (c2 - W0 / 8), x2);
#pragma unroll
                for (int e = 0; e < 8; ++e) { const int j = 8 * k + e; const float inv = ROPE == 1 ? inv64(2 * j) : inv64(j); float sn, cs; sincos_ang(pos * inv, sn, cs);
                    const float y1 = x1[e] * rs * gain[8 * c1 + e], y2 = x2[e] * rs * gain[8 * c2 + e]; x1[e] = y1 * cs - y2 * sn; x2[e] = y2 * cs + y1 * sn; }
                st8(dst + 8 * c1, x1); st8(dst + 8 * c2, x2); } }
    }
}
template <int W> DI void transpose_task(const bf16_t* src, bf16_t* dstT, int row) {
#pragma unroll 2
    for (int c = 0; c < W / 8; ++c) { const u32x4 r = *(const u32x4*)(src + 8 * c);
#pragma unroll
        for (int i = 0; i < 4; ++i) { dstT[(size_t)(8 * c + 2 * i) * RA + row] = (bf16_t)(r[i] & 0xffffu); dstT[(size_t)(8 * c + 2 * i + 1) * RA + row] = (bf16_t)(r[i] >> 16); } }
}
struct RowPos { float lin, row, col; };
DI RowPos row_pos(const Chunk& ck, int r) {
    const int li = r >= ck.rows_per_seq() ? r - ck.rows_per_seq() : r; RowPos p;
    if (li < ck.n) { p.lin = (float)(li + 16); p.row = (float)(li >> 6); p.col = (float)(li & 63); }
    else if (li < ck.n + 16) { p.lin = (float)(li - ck.n); p.row = -1.f; p.col = (float)(li - ck.n); }
    else { p.lin = 0.f; p.row = 0.f; p.col = 0.f; }
    return p;
}

DI void ew1_phase(const Params& p, const Chunk& ck, int l, int gw, int NGW, int lane) {
    unsigned char* ws = p.ws; asm volatile("" : "+s"(ws));
    const bf16_t* ZM = (const bf16_t*)(ws + WS_ZM); bf16_t* QKV = (bf16_t*)(ws + WS_QKV);
    bf16_t* CQN = (bf16_t*)(ws + WS_SM + SM_CQN); bf16_t* CKVN = (bf16_t*)(ws + WS_SM + SM_CKVN); bf16_t* KPE = (bf16_t*)(ws + WS_SM + SM_KPE);
    const int nrb = ck.rows() / 64; const float QS = 0.125f * LOG2E;
    for (int w = gw; w < nrb * 34; w += NGW) {
        const int rb = w / 34, task = w % 34, row = rb * 64 + lane;
        const bf16_t* z = ZM + (size_t)row * ZM_LD; const RowPos ps = row_pos(ck, row);
        if (task < 8) { const int h = task; norm_task<64, 64, 1>(z + 64 * h, z, p.in[6] + l * 64, QS, QKV + QA_O + ((size_t)h * RA + row) * 64, ps.row, ps.col); }
        else if (task < 10) { const int h = task - 8; norm_task<64, 64, 1>(z + 512 + 64 * h, z, p.in[7] + l * 64, 1.f, QKV + KA_O + ((size_t)h * RA + row) * 64, ps.row, ps.col); }
        else if (task < 12) { const int h = task - 10; transpose_task<64>(z + 640 + 64 * h, QKV + VA_O + (size_t)h * 64 * RA, row); }
        else if (task < 20) { const int hm = task - 12; norm_task<64, 64, 0>(z + 768 + 64 * hm, z, p.in[8] + l * 64, QS, QKV + QB_O + ((size_t)hm * RA + row) * 64, 0.f, 0.f); }
        else if (task < 28) { const int hm = task - 20; norm_task<64, 64, 0>(z + 1280 + 64 * hm, z, p.in[9] + l * 64, 1.f, QKV + KB_O + ((size_t)hm * RA + row) * 64, 0.f, 0.f); }
        else if (task < 32) { const int h = task - 28; transpose_task<128>(z + 1792 + 128 * h, QKV + VB_O + (size_t)h * 128 * RA, row); }
        else if (task == 32) { norm_task<256, 256, 0>(z + 2304, z, p.in[15] + l * 256, 1.f, CQN + (size_t)row * 256, 0.f, 0.f); }
        else { norm_task<128, 128, 0>(z + 2560, z, p.in[17] + l * 128, 1.f, CKVN + (size_t)row * 128, 0.f, 0.f);
#pragma unroll
            for (int c = 0; c < 8; ++c) *(u32x4*)(KPE + (size_t)row * 64 + 8 * c) = *(const u32x4*)(z + 2688 + 8 * c); }
    }
}
DI void ew2_phase(const Params& p, const Chunk& ck, int l, int gw, int NGW, int lane) {
    unsigned char* ws = p.ws; asm volatile("" : "+s"(ws));
    const bf16_t* QCR = (const bf16_t*)(ws + WS_ZM + OFF_QCR); const bf16_t* KVR = (const bf16_t*)(ws + WS_ZM + OFF_KVR); const bf16_t* KPE = (const bf16_t*)(ws + WS_SM + SM_KPE);
    bf16_t* QKV = (bf16_t*)(ws + WS_QKV);
    const int nrb = ck.rows() / 64; const float QS = 0.07216878364870322f * LOG2E;
    for (int w = gw; w < nrb * 12; w += NGW) {
        const int rb = w / 12, task = w % 12, row = rb * 64 + lane; const RowPos ps = row_pos(ck, row);
        if (task < 4) { const int h = task; norm_task<192, 192, 2>(QCR + (size_t)row * 768 + 192 * h, QCR, p.in[19] + l * 192, QS, QKV + QC_O + ((size_t)h * RA + row) * 192, ps.lin, 0.f); }
        else if (task < 8) { const int h = task - 4; norm_task<192, 128, 2>(KVR + (size_t)row * 1024 + 256 * h, KPE + (size_t)row * 64, p.in[20] + l * 192, 1.f, QKV + KC_O + ((size_t)h * RA + row) * 192, ps.lin, 0.f); }
        else { const int h = task - 8; transpose_task<128>(KVR + (size_t)row * 1024 + 256 * h + 128, QKV + VC_O + (size_t)h * 128 * RA, row); }
    }
}
DI void ew3_phase(const Params& p, const Chunk& ck, int l, bool last, int gw, int NGW, int lane) {
    unsigned char* ws = p.ws; asm volatile("" : "+s"(ws));
    bf16_t* O1 = (bf16_t*)(ws + WS_ZM) + 1 * OSLOT; const bf16_t* O2 = (const bf16_t*)(ws + WS_ZM) + 3 * OSLOT;
    const float d1 = wave_sum(p.in[10][l * 64 + lane] * p.in[11][l * 64 + lane], lane), d2 = wave_sum(p.in[12][l * 64 + lane] * p.in[13][l * 64 + lane], lane);
    int lz = l; asm volatile("" : "+s"(lz));
    const float lam_init = __uint_as_float(lz == 0 ? 0x3e4ccccdu : 0x3eb60549u)  , lam = expf(d1) - expf(d2) + lam_init, osc = 1.f - lam_init;
    const float* gs = p.in[14] + l * 128;
    const int nrb = ck.rows() / 64;
    for (int w = gw; w < nrb * 4; w += NGW) {
        const int rb = w >> 2, h = w & 3, row = rb * 64 + lane;
        if (last && (row >= ck.rows_per_seq() ? row - ck.rows_per_seq() : row) >= (ck.tps - 1) * 256) continue;
        bf16_t* a = O1 + (size_t)row * 512 + 128 * h; const bf16_t* b = O2 + (size_t)row * 512 + 128 * h;
        float ss = 0.f;
#pragma unroll 2
        for (int c = 0; c < 16; ++c) { float x[8], y[8]; ld8(a + 8 * c, x); ld8(b + 8 * c, y);
#pragma unroll
            for (int e = 0; e < 8; ++e) { const float d = x[e] - lam * y[e]; ss += d * d; } }
        const float rs = rsqrtf(ss * (1.f / 128.f) + 1e-6f) * osc;
#pragma unroll 2
        for (int c = 0; c < 16; ++c) { float x[8], y[8]; ld8(a + 8 * c, x); ld8(b + 8 * c, y);
#pragma unroll
            for (int e = 0; e < 8; ++e) x[e] = (x[e] - lam * y[e]) * rs * gs[8 * c + e];
            st8(a + 8 * c, x); }
    }
}

template <int DQK, int DV, bool ALIBI, bool PIPE>
DI void attn_unit(LAS unsigned char* lds, const bf16_t* __restrict__ Q, const bf16_t* __restrict__ K, const bf16_t* __restrict__ Vt, bf16_t* __restrict__ O, int r0, int qb, int n, float sl, const int wid, const int dkeys = 0x3fffffff, const float mref = 0.f) {
    constexpr bool FIXEDREF = !PIPE;
    constexpr bool EARLYV = true;
    constexpr bool NEGM = true;
    constexpr int KROW = DQK * 2 + 16, KT = 64 * KROW, VROW = 144, VT = DV * VROW, KCH = DQK / 8, NKC = 64 * KCH / 512, NVC = DV * 8 / 512, NKS = DQK / 16, NDB = DV / 32, VB0 = 2 * KT;
    typedef const __attribute__((address_space(1))) u32x4* gptr;
    const int lane = lane_fresh(), tid = wid * 64 + lane, r = lane & 31, h = lane >> 5;
    const int nk = n + 16, NT = (nk + 63) >> 6;
    const int li = qb * 256 + wid * 32 + r;
    const int tq = ALIBI ? ((4 * qb + 3 < NT - 1) ? 4 * qb + 3 : NT - 1) : -1;
    int tlo = 0, thi = NT - 2, NIT = NT;
    if (ALIBI && qb * 256 < n) {
        const int x = qb * 256 + 16 - dkeys - 79, y = qb * 256 + 255 + 16 + dkeys - 16;
        tlo = x > 0 ? (x + 63) >> 6 : 0; if (tlo > tq) tlo = tq;
        thi = (y >> 6) < NT - 2 ? (y >> 6) : NT - 2; if (thi < tq) thi = tq;
        NIT = (tq - tlo + 1) + (thi - tq) + 1;
    }
    const int nleft = tq - tlo + 1;
#define TILE(j) (ALIBI ? ((j) < nleft ? tq - (j) : (tq + 1 + (j) - nleft <= thi ? tq + 1 + (j) - nleft : NT - 1)) : (j))
    const bool active = (qb * 256 + wid * 32) < nk;
    const bool wreal = (qb * 256 + wid * 32 + 31) < n;
    const int qminw = qb * 256 + wid * 32 + 16;
    const int qrow = r0 + li;
    const float qlin = (li < n) ? (float)(li + 16) : (li < nk ? (float)(li - n) : 0.f);
    bf16x8 qf[NKS];
#pragma unroll
    for (int ks = 0; ks < NKS; ++ks) qf[ks] = *(const bf16x8*)(Q + (size_t)qrow * DQK + ks * 16 + h * 8);
    f32x16 o[NDB];
#pragma unroll
    for (int d = 0; d < NDB; ++d)
#pragma unroll
        for (int i = 0; i < 16; ++i) o[d][i] = 0.f;
    float m = FIXEDREF ? mref : 0.f, l = 0.f; f32x16 negm, zero16;
#pragma unroll
    for (int i = 0; i < 16; ++i) { negm[i] = FIXEDREF ? -mref : 0.f; zero16[i] = 0.f; }
    const bf16_t* kg0 = K + (size_t)r0 * DQK + tid * 8; const bf16_t* vg0 = Vt + (size_t)(tid >> 3) * RA + r0 + (tid & 7) * 8; const int vl0 = VB0 + (tid >> 3) * VROW + (tid & 7) * 16;
#define KL(i) ((((tid + 512 * (i)) / KCH) * KROW) + ((tid + 512 * (i)) % KCH) * 16)
#define KG(i, t) ((gptr)(kg0 + (i) * 4096 + (size_t)(t) * 64 * DQK))
#define VG(i, t) ((gptr)(vg0 + (size_t)(i) * 64 * RA + (size_t)(t) * 64))
#define VL(i) (vl0 + (i) * 64 * VROW)
    const int pr = (r & ~12) | ((r & 4) << 1) | ((r & 8) >> 1);
    const int kaddr = pr * KROW + h * 16, vaddr = VB0 + r * VROW + h * 16;
    u32x4 kst[NKC], vst[NVC], kstn[NKC], vstn[NVC];
#define QK_TILE(A0, A1, kb_) do { const int ko_ = (kb_) * KT + kaddr; \
        _Pragma("unroll") for (int kb4 = 0; kb4 < NKS; kb4 += 4) { bf16x8 kq[8]; \
            _Pragma("unroll") for (int j = 0; j < 4; ++j) { kq[2 * j] = *(const LAS bf16x8*)(lds + ko_ + (kb4 + j) * 32); kq[2 * j + 1] = *(const LAS bf16x8*)(lds + ko_ + 32 * KROW + (kb4 + j) * 32); } \
            asm volatile("" : "+v"(kq[0]), "+v"(kq[1]), "+v"(kq[2]), "+v"(kq[3]), "+v"(kq[4]), "+v"(kq[5]), "+v"(kq[6]), "+v"(kq[7]));     \
            _Pragma("unroll") for (int j = 0; j < 4; ++j) { \
                if (kb4 + j == 0) { A0 = __builtin_amdgcn_mfma_f32_32x32x16_bf16(kq[0], qf[0], ct0, 0, 0, 0); A1 = __builtin_amdgcn_mfma_f32_32x32x16_bf16(kq[1], qf[0], ct1, 0, 0, 0); } \
                else { A0 = __builtin_amdgcn_mfma_f32_32x32x16_bf16(kq[2 * j], qf[kb4 + j], A0, 0, 0, 0); A1 = __builtin_amdgcn_mfma_f32_32x32x16_bf16(kq[2 * j + 1], qf[kb4 + j], A1, 0, 0, 0); } } \
            __builtin_amdgcn_sched_barrier(0); } } while (0)
#pragma unroll
    for (int i = 0; i < NKC; ++i) kst[i] = *KG(i, TILE(0));
#pragma unroll
    for (int i = 0; i < NVC; ++i) vst[i] = *VG(i, TILE(0));
#pragma unroll
    for (int i = 0; i < NKC; ++i) *(LAS u32x4*)(lds + KL(i)) = kst[i];
#pragma unroll
    for (int i = 0; i < NVC; ++i) *(LAS u32x4*)(lds + VL(i)) = vst[i];
    if constexpr (PIPE) {
#pragma unroll
        for (int i = 0; i < NKC; ++i) kst[i] = *KG(i, 1);
#pragma unroll
        for (int i = 0; i < NKC; ++i) *(LAS u32x4*)(lds + KT + KL(i)) = kst[i];
#pragma unroll
        for (int i = 0; i < NKC; ++i) kst[i] = *KG(i, 2);
#pragma unroll
        for (int i = 0; i < NVC; ++i) vst[i] = *VG(i, 1);
    }
    __syncthreads();
    f32x16 s0, s1, n0, n1;
    if constexpr (PIPE) { f32x16 ct0 = negm, ct1 = negm; QK_TILE(s0, s1, 0); __syncthreads(); }
    for (int jt = 0; jt < NIT; ++jt) {
        const int t = PIPE ? jt : TILE(jt), tn = TILE(jt + 1);
        const int cb = jt & 1;
        const bool moreV = (jt + 1 < NIT), moreK = PIPE ? (jt + 2 < NIT) : moreV;
        if constexpr (PIPE) {
            if (t + 3 < NT) {
#pragma unroll
                for (int i = 0; i < NKC; ++i) kstn[i] = *KG(i, t + 3);
            }
            if (t + 2 < NT) {
#pragma unroll
                for (int i = 0; i < NVC; ++i) vstn[i] = *VG(i, t + 2);
            }
        } else {
            if (moreK) {
#pragma unroll
                for (int i = 0; i < NKC; ++i) kst[i] = *KG(i, tn);
            }
            if (moreV) {
#pragma unroll
                for (int i = 0; i < NVC; ++i) vst[i] = *VG(i, tn);
            }
#ifdef PROBE_MEM2
            { int zo = 0; asm volatile("" : "+v"(zo));
              if (moreK) {
#pragma unroll
                for (int i = 0; i < NKC; ++i) { u32x4 d = *(KG(i, t + 1) + zo); asm volatile("" :: "v"(d)); } }
              if (moreV) {
#pragma unroll
                for (int i = 0; i < NVC; ++i) { u32x4 d = *(VG(i, t + 1) + zo); asm volatile("" :: "v"(d)); } } }
#endif
        }
        if (active) {
        f32x16 ct0 = negm, ct1 = negm; int side = 0;
        if constexpr (ALIBI) {
            if (t < NT - 1 && wreal) { if (t * 64 + 79 <= qminw) side = 1; else if (t * 64 + 16 >= qminw + 31) side = -1; }
            if (side != 0) { const float ssl = side > 0 ? sl : -sl, A_ = ssl * ((float)(t * 64 + 16 + 8 * h) - qlin) - mref;
#pragma unroll
                for (int i = 0; i < 16; ++i) { ct0[i] = __builtin_fmaf(ssl, (float)(16 * (i >> 3) + (i & 7)), A_); ct1[i] = ct0[i] + 32.f * ssl; } }
        }
        if constexpr (PIPE) { if (moreV) QK_TILE(n0, n1, cb ^ 1); }
        else QK_TILE(s0, s1, cb);
        bf16x8 vf0[8];
        if constexpr (EARLYV) {
#pragma unroll
            for (int j = 0; j < 8; ++j) vf0[j] = *(const LAS bf16x8*)(lds + cb * VT + vaddr + (j >> 2) * 32 * VROW + (j & 3) * 32);
        }
        if (t < NT - 1) {
            if constexpr (ALIBI) if (side == 0) {
                const float qo = qlin - (float)(16 + 8 * h + t * 64);
#pragma unroll
                for (int i = 0; i < 16; ++i) { const float ci = (float)(16 * (i >> 3) + (i & 7)); s0[i] = __builtin_fmaf(-sl, __builtin_fabsf(qo - ci), s0[i]); s1[i] = __builtin_fmaf(-sl, __builtin_fabsf(qo - 32.f - ci), s1[i]); }
            }
        } else {
#pragma unroll
            for (int i = 0; i < 16; ++i) { const int kk = 16 * (i >> 3) + 8 * h + (i & 7);
                if (kk < 16) { if constexpr (ALIBI) s0[i] = __builtin_fmaf(-sl, __builtin_fabsf(qlin - (float)kk), s0[i]); } else s0[i] = -1e30f;
                s1[i] = -1e30f; }
        }
        if constexpr (!FIXEDREF) {
        float mx;
        { float a = MX2(s0[0], s1[0]), b = MX2(s0[1], s1[1]);
#pragma unroll
          for (int i = 2; i < 16; i += 2) { a = MX2(a, MX2(s0[i], s1[i])); b = MX2(b, MX2(s0[i + 1], s1[i + 1])); }
          mx = swap32_max(MX2(a, b)); }
        if constexpr (!NEGM) mx -= m;
        if (__builtin_expect(jt == 0 || __builtin_amdgcn_ballot_w64(mx > 8.f) != 0ull, 0)) {
            const float dl = (jt == 0) ? mx : fmaxf(mx, 0.f);
            m += dl;
            if constexpr (NEGM) {
#pragma unroll
                for (int i = 0; i < 16; ++i) { s0[i] -= dl; s1[i] -= dl; negm[i] = -m; } }
            if constexpr (PIPE) {
#pragma unroll
                for (int i = 0; i < 16; ++i) { n0[i] -= dl; n1[i] -= dl; } }
            if (jt != 0) { const float f = __builtin_amdgcn_exp2f(-dl); l *= f;
#pragma unroll
                for (int d = 0; d < NDB; ++d)
#pragma unroll
                    for (int i = 0; i < 16; ++i) o[d][i] *= f; }
            asm volatile("" ::: "memory");
        }
        }
        float ra = 0.f, rb = 0.f;
#pragma unroll
        for (int i = 0; i < 16; ++i) { s0[i] = __builtin_amdgcn_exp2f(NEGM ? s0[i] : s0[i] - m); s1[i] = __builtin_amdgcn_exp2f(NEGM ? s1[i] : s1[i] - m); ra += s0[i]; rb += s1[i]; }
        l += ra + rb;
        bf16x8 pf[4];
        { u32x4 w;
          w.x = pk2(s0[0], s0[1]); w.y = pk2(s0[2], s0[3]); w.z = pk2(s0[4], s0[5]); w.w = pk2(s0[6], s0[7]); pf[0] = __builtin_bit_cast(bf16x8, w);
          w.x = pk2(s0[8], s0[9]); w.y = pk2(s0[10], s0[11]); w.z = pk2(s0[12], s0[13]); w.w = pk2(s0[14], s0[15]); pf[1] = __builtin_bit_cast(bf16x8, w);
          w.x = pk2(s1[0], s1[1]); w.y = pk2(s1[2], s1[3]); w.z = pk2(s1[4], s1[5]); w.w = pk2(s1[6], s1[7]); pf[2] = __builtin_bit_cast(bf16x8, w);
          w.x = pk2(s1[8], s1[9]); w.y = pk2(s1[10], s1[11]); w.z = pk2(s1[12], s1[13]); w.w = pk2(s1[14], s1[15]); pf[3] = __builtin_bit_cast(bf16x8, w); }
#pragma unroll
        for (int d0 = 0; d0 < NDB; d0 += 2) { bf16x8 vf[8];
#pragma unroll
            for (int j = 0; j < 8; ++j) { if (EARLYV && d0 == 0) vf[j] = vf0[j]; else vf[j] = *(const LAS bf16x8*)(lds + cb * VT + vaddr + (d0 + (j >> 2)) * 32 * VROW + (j & 3) * 32); }
            asm volatile("" : "+v"(vf[0]), "+v"(vf[1]), "+v"(vf[2]), "+v"(vf[3]), "+v"(vf[4]), "+v"(vf[5]), "+v"(vf[6]), "+v"(vf[7]));
#pragma unroll
            for (int j = 0; j < 8; ++j) o[d0 + (j >> 2)] = __builtin_amdgcn_mfma_f32_32x32x16_bf16(vf[j], pf[j & 3], o[d0 + (j >> 2)], 0, 0, 0);
            __builtin_amdgcn_sched_barrier(0); }
        }
        if (moreK) {
#pragma unroll
            for (int i = 0; i < NKC; ++i) *(LAS u32x4*)(lds + (PIPE ? cb : (cb ^ 1)) * KT + KL(i)) = kst[i];
        }
        if (moreV) {
#pragma unroll
            for (int i = 0; i < NVC; ++i) *(LAS u32x4*)(lds + (cb ^ 1) * VT + VL(i)) = vst[i];
        }
        asm volatile("s_waitcnt lgkmcnt(0)" ::: "memory"); __builtin_amdgcn_s_barrier(); asm volatile("" ::: "memory");
        if constexpr (PIPE) { s0 = n0; s1 = n1;
#pragma unroll
            for (int i = 0; i < NKC; ++i) kst[i] = kstn[i];
#pragma unroll
            for (int i = 0; i < NVC; ++i) vst[i] = vstn[i]; }
    }
    l = swap32_add(l);
    const float il = 1.f / l;
    bf16_t* orow = O + (size_t)qrow * 512;
    if (active)
#pragma unroll
    for (int d = 0; d < NDB; ++d)
#pragma unroll
        for (int g = 0; g < 4; ++g) { u32x2 w; w.x = pk2(o[d][4 * g] * il, o[d][4 * g + 1] * il); w.y = pk2(o[d][4 * g + 2] * il, o[d][4 * g + 3] * il);
            *(u32x2*)(orow + 32 * d + 8 * g + 4 * h) = w; }
#undef KG
#undef KL
#undef VG
#undef VL
#undef QK_TILE
#undef TILE
}

template <int DV, bool ALIBI>
DI void attn_unit2(LAS unsigned char* lds, const bf16_t* __restrict__ Q, const bf16_t* __restrict__ K, const bf16_t* __restrict__ Vt, bf16_t* __restrict__ O, int r0, int qb, int n, float sl, const int wid) {
    constexpr int DQK = 64, KROW = DQK * 2 + 16, KT = 64 * KROW, VROW = 144, VT = DV * VROW, NVC = DV * 8 / 512, NKS = 4, NDB = DV / 32, VB0 = 2 * KT;
    typedef const __attribute__((address_space(1))) u32x4* gptr;
    const int lane = lane_fresh(), tid = wid * 64 + lane, r = lane & 31, h = lane >> 5;
    const int nk = n + 16, NT = (nk + 63) >> 6;
    const int li = qb * 256 + wid * 32 + r;
    const int qrow = r0 + li;
    const float qlin = (li < n) ? (float)(li + 16) : (li < nk ? (float)(li - n) : 0.f);
    bf16x8 qf[NKS];
#pragma unroll
    for (int ks = 0; ks < NKS; ++ks) qf[ks] = *(const bf16x8*)(Q + (size_t)qrow * DQK + ks * 16 + h * 8);
    f32x16 o[NDB];
#pragma unroll
    for (int d = 0; d < NDB; ++d)
#pragma unroll
        for (int i = 0; i < 16; ++i) o[d][i] = 0.f;
    float m = 0.f, l = 0.f; f32x16 negm;
#pragma unroll
    for (int i = 0; i < 16; ++i) negm[i] = 0.f;
    const bf16_t* kg0 = K + (size_t)r0 * DQK + tid * 8; const bf16_t* vg0 = Vt + (size_t)(tid >> 3) * RA + r0 + (tid & 7) * 8;
    const int kl0 = (tid >> 3) * KROW + (tid & 7) * 16, vl0 = VB0 + (tid >> 3) * VROW + (tid & 7) * 16;
#define KG2(t) ((gptr)(kg0 + (size_t)(t) * 64 * DQK))
#define VG2(i, t) ((gptr)(vg0 + (size_t)(i) * 64 * RA + (size_t)(t) * 64))
    const int pr = (r & ~12) | ((r & 4) << 1) | ((r & 8) >> 1);
    const int kaddr = pr * KROW + h * 16, vaddr = VB0 + r * VROW + h * 16;
    u32x4 kst, vst[NVC];
    bf16x8 kf[8];
#define LDK(kb_) do { _Pragma("unroll") for (int ks = 0; ks < 4; ++ks) { kf[2 * ks] = *(const LAS bf16x8*)(lds + (kb_) * KT + kaddr + ks * 32); kf[2 * ks + 1] = *(const LAS bf16x8*)(lds + (kb_) * KT + kaddr + 32 * KROW + ks * 32); } \
        asm volatile("" : "+v"(kf[0]), "+v"(kf[1]), "+v"(kf[2]), "+v"(kf[3]), "+v"(kf[4]), "+v"(kf[5]), "+v"(kf[6]), "+v"(kf[7])); } while (0)
#define QKM(A0, A1) do { A0 = __builtin_amdgcn_mfma_f32_32x32x16_bf16(kf[0], qf[0], negm, 0, 0, 0); A1 = __builtin_amdgcn_mfma_f32_32x32x16_bf16(kf[1], qf[0], negm, 0, 0, 0); \
        _Pragma("unroll") for (int ks = 1; ks < 4; ++ks) { A0 = __builtin_amdgcn_mfma_f32_32x32x16_bf16(kf[2 * ks], qf[ks], A0, 0, 0, 0); A1 = __builtin_amdgcn_mfma_f32_32x32x16_bf16(kf[2 * ks + 1], qf[ks], A1, 0, 0, 0); } } while (0)
#define PV2(vb_, d0_) do { bf16x8 vf[8]; \
        _Pragma("unroll") for (int j = 0; j < 8; ++j) vf[j] = *(const LAS bf16x8*)(lds + (vb_) * VT + vaddr + ((d0_) + (j >> 2)) * 32 * VROW + (j & 3) * 32); \
        asm volatile("" : "+v"(vf[0]), "+v"(vf[1]), "+v"(vf[2]), "+v"(vf[3]), "+v"(vf[4]), "+v"(vf[5]), "+v"(vf[6]), "+v"(vf[7])); \
        _Pragma("unroll") for (int j = 0; j < 8; ++j) o[(d0_) + (j >> 2)] = __builtin_amdgcn_mfma_f32_32x32x16_bf16(vf[j], pf[j & 3], o[(d0_) + (j >> 2)], 0, 0, 0); } while (0)
    kst = *KG2(0);
#pragma unroll
    for (int i = 0; i < NVC; ++i) vst[i] = *VG2(i, 0);
    *(LAS u32x4*)(lds + kl0) = kst;
#pragma unroll
    for (int i = 0; i < NVC; ++i) *(LAS u32x4*)(lds + vl0 + i * 64 * VROW) = vst[i];
    kst = *KG2(1);
    *(LAS u32x4*)(lds + KT + kl0) = kst;
    __syncthreads();
    f32x16 s0, s1, n0, n1;
    bf16x8 pf[4];
    LDK(0); QKM(s0, s1);
    __syncthreads();
    int vcur = 0;
    for (int t = 0; t < NT; ++t) {
        const int cb = t & 1;
        const bool moreV = (t + 1 < NT), moreK = (t + 2 < NT);
        const int vprev = (vcur == 0) ? 2 : vcur - 1, vnext = (vcur == 2) ? 0 : vcur + 1;
        if (moreK) kst = *KG2(t + 2);
        if (moreV) {
#pragma unroll
            for (int i = 0; i < NVC; ++i) vst[i] = *VG2(i, t + 1);
        }
#ifdef PROBE_MEM2
        { int zo = 0; asm volatile("" : "+v"(zo));
          if (moreK) { u32x4 d = *(KG2(t + 2) + zo); asm volatile("" :: "v"(d)); }
          if (moreV) {
#pragma unroll
            for (int i = 0; i < NVC; ++i) { u32x4 d = *(VG2(i, t + 1) + zo); asm volatile("" :: "v"(d)); } } }
#endif
        __builtin_amdgcn_s_setprio(1);
        if (moreV) { LDK(cb ^ 1); QKM(n0, n1); }
        if (t > 0) { PV2(vprev, 0); if constexpr (NDB == 4) PV2(vprev, 2); }
        __builtin_amdgcn_s_setprio(0);
        if (t < NT - 1) {
            if constexpr (ALIBI) {
                const float qo = qlin - (float)(16 + 8 * h + t * 64);
#pragma unroll
                for (int i = 0; i < 16; ++i) { const float ci = (float)(16 * (i >> 3) + (i & 7)); s0[i] = __builtin_fmaf(-sl, __builtin_fabsf(qo - ci), s0[i]); s1[i] = __builtin_fmaf(-sl, __builtin_fabsf(qo - 32.f - ci), s1[i]); }
            }
        } else {
#pragma unroll
            for (int i = 0; i < 16; ++i) { const int kk = 16 * (i >> 3) + 8 * h + (i & 7);
                if (kk < 16) { if constexpr (ALIBI) s0[i] = __builtin_fmaf(-sl, __builtin_fabsf(qlin - (float)kk), s0[i]); } else s0[i] = -1e30f;
                s1[i] = -1e30f; }
        }
        float mx;
        { float a = MX2(s0[0], s1[0]), b = MX2(s0[1], s1[1]);
#pragma unroll
          for (int i = 2; i < 16; i += 2) { a = MX2(a, MX2(s0[i], s1[i])); b = MX2(b, MX2(s0[i + 1], s1[i + 1])); }
          mx = swap32_max(MX2(a, b)); }
        if (__builtin_expect(t == 0 || __builtin_amdgcn_ballot_w64(mx > 8.f) != 0ull, 0)) {
            const float dl = (t == 0) ? mx : fmaxf(mx, 0.f);
            m += dl;
#pragma unroll
            for (int i = 0; i < 16; ++i) { s0[i] -= dl; s1[i] -= dl; n0[i] -= dl; n1[i] -= dl; negm[i] = -m; }
            if (t != 0) { const float f = __builtin_amdgcn_exp2f(-dl); l *= f;
#pragma unroll
                for (int d = 0; d < NDB; ++d)
#pragma unroll
                    for (int i = 0; i < 16; ++i) o[d][i] *= f; }
            asm volatile("" ::: "memory");
        }
        float ra = 0.f, rb = 0.f;
#pragma unroll
        for (int i = 0; i < 16; ++i) { s0[i] = __builtin_amdgcn_exp2f(s0[i]); s1[i] = __builtin_amdgcn_exp2f(s1[i]); ra += s0[i]; rb += s1[i]; }
        l += ra + rb;
        { u32x4 w;
          w.x = pk2(s0[0], s0[1]); w.y = pk2(s0[2], s0[3]); w.z = pk2(s0[4], s0[5]); w.w = pk2(s0[6], s0[7]); pf[0] = __builtin_bit_cast(bf16x8, w);
          w.x = pk2(s0[8], s0[9]); w.y = pk2(s0[10], s0[11]); w.z = pk2(s0[12], s0[13]); w.w = pk2(s0[14], s0[15]); pf[1] = __builtin_bit_cast(bf16x8, w);
          w.x = pk2(s1[0], s1[1]); w.y = pk2(s1[2], s1[3]); w.z = pk2(s1[4], s1[5]); w.w = pk2(s1[6], s1[7]); pf[2] = __builtin_bit_cast(bf16x8, w);
          w.x = pk2(s1[8], s1[9]); w.y = pk2(s1[10], s1[11]); w.z = pk2(s1[12], s1[13]); w.w = pk2(s1[14], s1[15]); pf[3] = __builtin_bit_cast(bf16x8, w); }
        if (moreK) *(LAS u32x4*)(lds + cb * KT + kl0) = kst;
        if (moreV) {
#pragma unroll
            for (int i = 0; i < NVC; ++i) *(LAS u32x4*)(lds + vnext * VT + vl0 + i * 64 * VROW) = vst[i];
        }
        asm volatile("s_waitcnt lgkmcnt(0)" ::: "memory"); __builtin_amdgcn_s_barrier(); asm volatile("" ::: "memory");
        s0 = n0; s1 = n1; vcur = vnext;
    }
    { const int vlast = (vcur == 0) ? 2 : vcur - 1; PV2(vlast, 0); if constexpr (NDB == 4) PV2(vlast, 2); }
    asm volatile("s_waitcnt lgkmcnt(0)" ::: "memory"); __builtin_amdgcn_s_barrier(); asm volatile("" ::: "memory");
    l = swap32_add(l);
    const float il = 1.f / l;
    bf16_t* orow = O + (size_t)qrow * 512;
#pragma unroll
    for (int d = 0; d < NDB; ++d)
#pragma unroll
        for (int g = 0; g < 4; ++g) { u32x2 w; w.x = pk2(o[d][4 * g] * il, o[d][4 * g + 1] * il); w.y = pk2(o[d][4 * g + 2] * il, o[d][4 * g + 3] * il);
            *(u32x2*)(orow + 32 * d + 8 * g + 4 * h) = w; }
#undef KG2
#undef VG2
#undef LDK
#undef QKM
#undef PV2
}


template <int DQK, int DV, bool ALIBI>
DI void attn_unit_s(LAS unsigned char* lds, const bf16_t* __restrict__ Q, const bf16_t* __restrict__ K, const bf16_t* __restrict__ Vt, bf16_t* __restrict__ O, int r0, int qb, int n, float sl, const int wid) {
    constexpr bool NEGM = (DQK == 64);
    constexpr int KROW = DQK * 2 + 16, KT = 64 * KROW, VROW = 144, VT = DV * VROW, KCH = DQK / 8, NKC = 64 * KCH / 512, NVC = DV * 8 / 512, NKS = DQK / 16, NDB = DV / 32, VB0 = 2 * KT;
    typedef const __attribute__((address_space(1))) u32x4* gptr;
#define LBAR() do { asm volatile("s_waitcnt lgkmcnt(0)" ::: "memory"); __builtin_amdgcn_s_barrier(); asm volatile("" ::: "memory"); } while (0)
#ifdef GRP_ODD
    const int grp_ = wid & 1;
#else
    const int grp_ = wid >> 2;
#endif
    const int lane = lane_fresh(), tid = wid * 64 + lane, r = lane & 31, h = lane >> 5, grp = grp_;
    const int nk = n + 16, NT = (nk + 63) >> 6;
    const int li = qb * 256 + wid * 32 + r;
    const int qrow = r0 + li;
    const float qlin = (li < n) ? (float)(li + 16) : (li < nk ? (float)(li - n) : 0.f);
    bf16x8 qf[NKS];
#pragma unroll
    for (int ks = 0; ks < NKS; ++ks) qf[ks] = *(const bf16x8*)(Q + (size_t)qrow * DQK + ks * 16 + h * 8);
    f32x16 o[NDB];
#pragma unroll
    for (int d = 0; d < NDB; ++d)
#pragma unroll
        for (int i = 0; i < 16; ++i) o[d][i] = 0.f;
    float m = 0.f, l = 0.f; f32x16 negm, zero16;
#pragma unroll
    for (int i = 0; i < 16; ++i) { negm[i] = 0.f; zero16[i] = 0.f; }
    const bf16_t* kg0 = K + (size_t)r0 * DQK + tid * 8; const bf16_t* vg0 = Vt + (size_t)(tid >> 3) * RA + r0 + (tid & 7) * 8; const int vl0 = VB0 + (tid >> 3) * VROW + (tid & 7) * 16;
#define KL(i) ((((tid + 512 * (i)) / KCH) * KROW) + ((tid + 512 * (i)) % KCH) * 16)
#define KG(i, t) ((gptr)(kg0 + (i) * 4096 + (size_t)(t) * 64 * DQK))
#define VG(i, t) ((gptr)(vg0 + (size_t)(i) * 64 * RA + (size_t)(t) * 64))
#define VL(i) (vl0 + (i) * 64 * VROW)
    const int pr = (r & ~12) | ((r & 4) << 1) | ((r & 8) >> 1);
    const int kaddr = pr * KROW + h * 16, vaddr = VB0 + r * VROW + h * 16;
    u32x4 kst[NKC], vst[NVC];
#pragma unroll
    for (int i = 0; i < NKC; ++i) kst[i] = *KG(i, 0);
#pragma unroll
    for (int i = 0; i < NKC; ++i) *(LAS u32x4*)(lds + KL(i)) = kst[i];
#pragma unroll
    for (int i = 0; i < NKC; ++i) kst[i] = *KG(i, 1);
#pragma unroll
    for (int i = 0; i < NVC; ++i) vst[i] = *VG(i, 0);
    __syncthreads();
    if (grp == 1) LBAR();
    f32x16 s0, s1; bf16x8 pf[4];
    for (int t = 0; t < NT; ++t) {
        const int cb = t & 1;
        { const int ko_ = cb * KT + kaddr;
#pragma unroll
          for (int kb4 = 0; kb4 < NKS; kb4 += 4) { bf16x8 kq[8];
#pragma unroll
            for (int j = 0; j < 4; ++j) { kq[2 * j] = *(const LAS bf16x8*)(lds + ko_ + (kb4 + j) * 32); kq[2 * j + 1] = *(const LAS bf16x8*)(lds + ko_ + 32 * KROW + (kb4 + j) * 32); }
            asm volatile("" : "+v"(kq[0]), "+v"(kq[1]), "+v"(kq[2]), "+v"(kq[3]), "+v"(kq[4]), "+v"(kq[5]), "+v"(kq[6]), "+v"(kq[7]));
#pragma unroll
            for (int j = 0; j < 4; ++j) {
                if (kb4 + j == 0) { s0 = __builtin_amdgcn_mfma_f32_32x32x16_bf16(kq[0], qf[0], NEGM ? negm : zero16, 0, 0, 0); s1 = __builtin_amdgcn_mfma_f32_32x32x16_bf16(kq[1], qf[0], NEGM ? negm : zero16, 0, 0, 0); }
                else { s0 = __builtin_amdgcn_mfma_f32_32x32x16_bf16(kq[2 * j], qf[kb4 + j], s0, 0, 0, 0); s1 = __builtin_amdgcn_mfma_f32_32x32x16_bf16(kq[2 * j + 1], qf[kb4 + j], s1, 0, 0, 0); } }
            __builtin_amdgcn_sched_barrier(0); } }
        if (t > 0) {
#pragma unroll
            for (int d0 = 0; d0 < NDB; d0 += 2) { bf16x8 vf[8];
#pragma unroll
                for (int j = 0; j < 8; ++j) vf[j] = *(const LAS bf16x8*)(lds + (cb ^ 1) * VT + vaddr + (d0 + (j >> 2)) * 32 * VROW + (j & 3) * 32);
                asm volatile("" : "+v"(vf[0]), "+v"(vf[1]), "+v"(vf[2]), "+v"(vf[3]), "+v"(vf[4]), "+v"(vf[5]), "+v"(vf[6]), "+v"(vf[7]));
#pragma unroll
                for (int j = 0; j < 8; ++j) o[d0 + (j >> 2)] = __builtin_amdgcn_mfma_f32_32x32x16_bf16(vf[j], pf[j & 3], o[d0 + (j >> 2)], 0, 0, 0);
                __builtin_amdgcn_sched_barrier(0); }
        }
        if (t + 1 < NT) {
#pragma unroll
            for (int i = 0; i < NKC; ++i) *(LAS u32x4*)(lds + (cb ^ 1) * KT + KL(i)) = kst[i];
        }
#pragma unroll
        for (int i = 0; i < NVC; ++i) *(LAS u32x4*)(lds + cb * VT + VL(i)) = vst[i];
        LBAR();
        if (t + 2 < NT) {
#pragma unroll
            for (int i = 0; i < NKC; ++i) kst[i] = *KG(i, t + 2);
        }
        if (t + 1 < NT) {
#pragma unroll
            for (int i = 0; i < NVC; ++i) vst[i] = *VG(i, t + 1);
        }
        if (t < NT - 1) {
            if constexpr (ALIBI) {
                const float qo = qlin - (float)(16 + 8 * h + t * 64);
#pragma unroll
                for (int i = 0; i < 16; ++i) { const float ci = (float)(16 * (i >> 3) + (i & 7)); s0[i] = __builtin_fmaf(-sl, __builtin_fabsf(qo - ci), s0[i]); s1[i] = __builtin_fmaf(-sl, __builtin_fabsf(qo - 32.f - ci), s1[i]); }
            }
        } else {
#pragma unroll
            for (int i = 0; i < 16; ++i) { const int kk = 16 * (i >> 3) + 8 * h + (i & 7);
                if (kk < 16) { if constexpr (ALIBI) s0[i] = __builtin_fmaf(-sl, __builtin_fabsf(qlin - (float)kk), s0[i]); } else s0[i] = -1e30f;
                s1[i] = -1e30f; }
        }
        float mx;
        { float a = MX2(s0[0], s1[0]), b = MX2(s0[1], s1[1]);
#pragma unroll
          for (int i = 2; i < 16; i += 2) { a = MX2(a, MX2(s0[i], s1[i])); b = MX2(b, MX2(s0[i + 1], s1[i + 1])); }
          mx = swap32_max(MX2(a, b)); }
        if constexpr (!NEGM) mx -= m;
        if (__builtin_expect(t == 0 || __builtin_amdgcn_ballot_w64(mx > 8.f) != 0ull, 0)) {
            const float dl = (t == 0) ? mx : fmaxf(mx, 0.f);
            m += dl;
            if constexpr (NEGM) {
#pragma unroll
                for (int i = 0; i < 16; ++i) { s0[i] -= dl; s1[i] -= dl; negm[i] = -m; } }
            if (t != 0) { const float f = __builtin_amdgcn_exp2f(-dl); l *= f;
#pragma unroll
                for (int d = 0; d < NDB; ++d)
#pragma unroll
                    for (int i = 0; i < 16; ++i) o[d][i] *= f; }
            asm volatile("" ::: "memory");
        }
        float ra = 0.f, rb = 0.f;
#pragma unroll
        for (int i = 0; i < 16; ++i) { s0[i] = __builtin_amdgcn_exp2f(NEGM ? s0[i] : s0[i] - m); s1[i] = __builtin_amdgcn_exp2f(NEGM ? s1[i] : s1[i] - m); ra += s0[i]; rb += s1[i]; }
        l += ra + rb;
        { u32x4 w;
          w.x = pk2(s0[0], s0[1]); w.y = pk2(s0[2], s0[3]); w.z = pk2(s0[4], s0[5]); w.w = pk2(s0[6], s0[7]); pf[0] = __builtin_bit_cast(bf16x8, w);
          w.x = pk2(s0[8], s0[9]); w.y = pk2(s0[10], s0[11]); w.z = pk2(s0[12], s0[13]); w.w = pk2(s0[14], s0[15]); pf[1] = __builtin_bit_cast(bf16x8, w);
          w.x = pk2(s1[0], s1[1]); w.y = pk2(s1[2], s1[3]); w.z = pk2(s1[4], s1[5]); w.w = pk2(s1[6], s1[7]); pf[2] = __builtin_bit_cast(bf16x8, w);
          w.x = pk2(s1[8], s1[9]); w.y = pk2(s1[10], s1[11]); w.z = pk2(s1[12], s1[13]); w.w = pk2(s1[14], s1[15]); pf[3] = __builtin_bit_cast(bf16x8, w); }
        LBAR();
    }
    { const int vb = (NT - 1) & 1;
#pragma unroll
      for (int d0 = 0; d0 < NDB; d0 += 2) { bf16x8 vf[8];
#pragma unroll
        for (int j = 0; j < 8; ++j) vf[j] = *(const LAS bf16x8*)(lds + vb * VT + vaddr + (d0 + (j >> 2)) * 32 * VROW + (j & 3) * 32);
        asm volatile("" : "+v"(vf[0]), "+v"(vf[1]), "+v"(vf[2]), "+v"(vf[3]), "+v"(vf[4]), "+v"(vf[5]), "+v"(vf[6]), "+v"(vf[7]));
#pragma unroll
        for (int j = 0; j < 8; ++j) o[d0 + (j >> 2)] = __builtin_amdgcn_mfma_f32_32x32x16_bf16(vf[j], pf[j & 3], o[d0 + (j >> 2)], 0, 0, 0); } }
    if (grp == 0) LBAR();
    LBAR();
    l = swap32_add(l);
    const float il = 1.f / l;
    bf16_t* orow = O + (size_t)qrow * 512;
#pragma unroll
    for (int d = 0; d < NDB; ++d)
#pragma unroll
        for (int g = 0; g < 4; ++g) { u32x2 w; w.x = pk2(o[d][4 * g] * il, o[d][4 * g + 1] * il); w.y = pk2(o[d][4 * g + 2] * il, o[d][4 * g + 3] * il);
            *(u32x2*)(orow + 32 * d + 8 * g + 4 * h) = w; }
#undef KG
#undef KL
#undef VG
#undef VL
#undef LBAR
}

DI void attn_unit_a64(LAS unsigned char* lds, const bf16_t* __restrict__ Q, const bf16_t* __restrict__ K, const bf16_t* __restrict__ Vt, bf16_t* __restrict__ O, int r0, int qb, int n, int seqrows, const int wid) {
    constexpr int DQK = 64, KROW = 144, KT = 64 * KROW, VROW = 144, VT = 64 * VROW, VB0 = 2 * KT;
    typedef const __attribute__((address_space(1))) u32x4* gptr;
    const int lane = lane_fresh(), tid = wid * 64 + lane, r = lane & 31, h = lane >> 5;
    const int nk = n + 16, NT = (nk + 63) >> 6;
    const int li0 = qb * 512 + wid * 64 + r, li1 = li0 + 32;
    bf16x8 qf0[4], qf1[4];
#pragma unroll
    for (int ks = 0; ks < 4; ++ks) { qf0[ks] = *(const bf16x8*)(Q + (size_t)(r0 + li0) * DQK + ks * 16 + h * 8); qf1[ks] = *(const bf16x8*)(Q + (size_t)(r0 + li1) * DQK + ks * 16 + h * 8); }
    f32x16 oa0, oa1, ob0, ob1, zero16;
#pragma unroll
    for (int i = 0; i < 16; ++i) { oa0[i] = 0.f; oa1[i] = 0.f; ob0[i] = 0.f; ob1[i] = 0.f; zero16[i] = 0.f; }
    float ma = 0.f, mb = 0.f, la = 0.f, lb = 0.f;
    const bf16_t* kg0 = K + (size_t)r0 * DQK + tid * 8; const bf16_t* vg0 = Vt + (size_t)(tid >> 3) * RA + r0 + (tid & 7) * 8;
    const int kl0 = (tid >> 3) * KROW + (tid & 7) * 16, vl0 = VB0 + (tid >> 3) * VROW + (tid & 7) * 16;
    const int pr = (r & ~12) | ((r & 4) << 1) | ((r & 8) >> 1);
    const int kaddr = pr * KROW + h * 16, vaddr = VB0 + r * VROW + h * 16;
    u32x4 kst, vst;
    kst = *(gptr)kg0; vst = *(gptr)vg0;
    *(LAS u32x4*)(lds + kl0) = kst; *(LAS u32x4*)(lds + vl0) = vst;
    __syncthreads();
#define SOFTMAX64(S0, S1, M, L, OX0, OX1) do { \
        if (t == NT - 1) { _Pragma("unroll") for (int i = 0; i < 16; ++i) { if (i >= 8) S0[i] = -1e30f; S1[i] = -1e30f; } } \
        float a_ = MX2(S0[0], S1[0]), b_ = MX2(S0[1], S1[1]); \
        _Pragma("unroll") for (int i = 2; i < 16; i += 2) { a_ = MX2(a_, MX2(S0[i], S1[i])); b_ = MX2(b_, MX2(S0[i + 1], S1[i + 1])); } \
        const float mx_ = swap32_max(MX2(a_, b_)) - M; \
        if (__builtin_expect(t == 0 || __builtin_amdgcn_ballot_w64(mx_ > 8.f) != 0ull, 0)) { \
            const float dl_ = (t == 0) ? mx_ : fmaxf(mx_, 0.f); M += dl_; \
            if (t != 0) { const float f_ = __builtin_amdgcn_exp2f(-dl_); L *= f_; _Pragma("unroll") for (int i = 0; i < 16; ++i) { OX0[i] *= f_; OX1[i] *= f_; } } \
            asm volatile("" ::: "memory"); } \
        float ra_ = 0.f, rb_ = 0.f; \
        _Pragma("unroll") for (int i = 0; i < 16; ++i) { S0[i] = __builtin_amdgcn_exp2f(S0[i] - M); S1[i] = __builtin_amdgcn_exp2f(S1[i] - M); ra_ += S0[i]; rb_ += S1[i]; } \
        L += ra_ + rb_; \
        u32x4 w_; \
        w_.x = pk2(S0[0], S0[1]); w_.y = pk2(S0[2], S0[3]); w_.z = pk2(S0[4], S0[5]); w_.w = pk2(S0[6], S0[7]); pf[0] = __builtin_bit_cast(bf16x8, w_); \
        w_.x = pk2(S0[8], S0[9]); w_.y = pk2(S0[10], S0[11]); w_.z = pk2(S0[12], S0[13]); w_.w = pk2(S0[14], S0[15]); pf[1] = __builtin_bit_cast(bf16x8, w_); \
        w_.x = pk2(S1[0], S1[1]); w_.y = pk2(S1[2], S1[3]); w_.z = pk2(S1[4], S1[5]); w_.w = pk2(S1[6], S1[7]); pf[2] = __builtin_bit_cast(bf16x8, w_); \
        w_.x = pk2(S1[8], S1[9]); w_.y = pk2(S1[10], S1[11]); w_.z = pk2(S1[12], S1[13]); w_.w = pk2(S1[14], S1[15]); pf[3] = __builtin_bit_cast(bf16x8, w_); } while (0)
    for (int t = 0; t < NT; ++t) {
        const int cb = t & 1; const bool more = (t + 1 < NT);
        if (more) { kst = *(gptr)(kg0 + (size_t)(t + 1) * 64 * DQK); vst = *(gptr)(vg0 + (size_t)(t + 1) * 64); }
        bf16x8 kq[8];
#pragma unroll
        for (int j = 0; j < 4; ++j) { kq[2 * j] = *(const LAS bf16x8*)(lds + cb * KT + kaddr + j * 32); kq[2 * j + 1] = *(const LAS bf16x8*)(lds + cb * KT + kaddr + 32 * KROW + j * 32); }
        asm volatile("" : "+v"(kq[0]), "+v"(kq[1]), "+v"(kq[2]), "+v"(kq[3]), "+v"(kq[4]), "+v"(kq[5]), "+v"(kq[6]), "+v"(kq[7]));
        f32x16 sa0, sa1, sb0, sb1;
        sa0 = __builtin_amdgcn_mfma_f32_32x32x16_bf16(kq[0], qf0[0], zero16, 0, 0, 0); sa1 = __builtin_amdgcn_mfma_f32_32x32x16_bf16(kq[1], qf0[0], zero16, 0, 0, 0);
#pragma unroll
        for (int j = 1; j < 4; ++j) { sa0 = __builtin_amdgcn_mfma_f32_32x32x16_bf16(kq[2 * j], qf0[j], sa0, 0, 0, 0); sa1 = __builtin_amdgcn_mfma_f32_32x32x16_bf16(kq[2 * j + 1], qf0[j], sa1, 0, 0, 0); }
        sb0 = __builtin_amdgcn_mfma_f32_32x32x16_bf16(kq[0], qf1[0], zero16, 0, 0, 0); sb1 = __builtin_amdgcn_mfma_f32_32x32x16_bf16(kq[1], qf1[0], zero16, 0, 0, 0);
#pragma unroll
        for (int j = 1; j < 4; ++j) { sb0 = __builtin_amdgcn_mfma_f32_32x32x16_bf16(kq[2 * j], qf1[j], sb0, 0, 0, 0); sb1 = __builtin_amdgcn_mfma_f32_32x32x16_bf16(kq[2 * j + 1], qf1[j], sb1, 0, 0, 0); }
        bf16x8 vf[8];
#pragma unroll
        for (int j = 0; j < 8; ++j) vf[j] = *(const LAS bf16x8*)(lds + cb * VT + vaddr + (j >> 2) * 32 * VROW + (j & 3) * 32);
        bf16x8 pf[4];
        SOFTMAX64(sa0, sa1, ma, la, oa0, oa1);
        asm volatile("" : "+v"(vf[0]), "+v"(vf[1]), "+v"(vf[2]), "+v"(vf[3]), "+v"(vf[4]), "+v"(vf[5]), "+v"(vf[6]), "+v"(vf[7]));
#pragma unroll
        for (int j = 0; j < 4; ++j) { oa0 = __builtin_amdgcn_mfma_f32_32x32x16_bf16(vf[j], pf[j], oa0, 0, 0, 0); oa1 = __builtin_amdgcn_mfma_f32_32x32x16_bf16(vf[4 + j], pf[j], oa1, 0, 0, 0); }
        SOFTMAX64(sb0, sb1, mb, lb, ob0, ob1);
#pragma unroll
        for (int j = 0; j < 4; ++j) { ob0 = __builtin_amdgcn_mfma_f32_32x32x16_bf16(vf[j], pf[j], ob0, 0, 0, 0); ob1 = __builtin_amdgcn_mfma_f32_32x32x16_bf16(vf[4 + j], pf[j], ob1, 0, 0, 0); }
        if (more) { *(LAS u32x4*)(lds + (cb ^ 1) * KT + kl0) = kst; *(LAS u32x4*)(lds + (cb ^ 1) * VT + vl0) = vst; }
        asm volatile("s_waitcnt lgkmcnt(0)" ::: "memory"); __builtin_amdgcn_s_barrier(); asm volatile("" ::: "memory");
    }
#undef SOFTMAX64
    la = swap32_add(la); lb = swap32_add(lb);
    const float ia = 1.f / la, ib = 1.f / lb;
    if (li0 < seqrows) { bf16_t* orow = O + (size_t)(r0 + li0) * 512;
#pragma unroll
        for (int g = 0; g < 4; ++g) { u32x2 w; w.x = pk2(oa0[4 * g] * ia, oa0[4 * g + 1] * ia); w.y = pk2(oa0[4 * g + 2] * ia, oa0[4 * g + 3] * ia); *(u32x2*)(orow + 8 * g + 4 * h) = w;
            w.x = pk2(oa1[4 * g] * ia, oa1[4 * g + 1] * ia); w.y = pk2(oa1[4 * g + 2] * ia, oa1[4 * g + 3] * ia); *(u32x2*)(orow + 32 + 8 * g + 4 * h) = w; } }
    if (li1 < seqrows) { bf16_t* orow = O + (size_t)(r0 + li1) * 512;
#pragma unroll
        for (int g = 0; g < 4; ++g) { u32x2 w; w.x = pk2(ob0[4 * g] * ib, ob0[4 * g + 1] * ib); w.y = pk2(ob0[4 * g + 2] * ib, ob0[4 * g + 3] * ib); *(u32x2*)(orow + 8 * g + 4 * h) = w;
            w.x = pk2(ob1[4 * g] * ib, ob1[4 * g + 1] * ib); w.y = pk2(ob1[4 * g + 2] * ib, ob1[4 * g + 3] * ib); *(u32x2*)(orow + 32 + 8 * g + 4 * h) = w; } }
}

#if defined(STAGGER) && !defined(STAGGER_NOC)
#define ATTN_C attn_unit_s<192, 128, false>
#else
#define ATTN_C attn_unit<192, 128, false, false>
#endif
#if defined(STAGGER)
#define ATTN_B attn_unit_s<64, 128, true>
#define ATTN_A attn_unit_s<64, 64, false>
#elif defined(NOPIPE_AB)
#define ATTN_B attn_unit<64, 128, true, false>
#define ATTN_A attn_unit<64, 64, false, false>
#else
#define ATTN_B attn_unit<64, 128, true, false>
#define ATTN_A attn_unit2<64, false>
#endif
DI void attn_phase(const Params& p, const Chunk& ck, bool last, const int lidx, LAS unsigned char* lds, unsigned* q  , const int wave) {
    unsigned char* ws = p.ws; asm volatile("" : "+s"(ws));
    const bf16_t* QKV = (const bf16_t*)(ws + WS_QKV); bf16_t* OB = (bf16_t*)(ws + WS_ZM);
#if defined(PROBE_DUPC)
    constexpr int NDUP = 8, DUP0 = 0;
#elif defined(PROBE_DUPB)
    constexpr int NDUP = 16, DUP0 = 8;
#elif defined(PROBE_DUPA)
    constexpr int NDUP = 16, DUP0 = 24;
#else
    constexpr int NDUP = 0, DUP0 = 0;
#endif
    const int nmeta = last ? 0 : 20 * ck.nseq, nms = (nmeta + 7) >> 3, nsuper = nms + 40 + NDUP;
    volatile LAS int* su = (volatile LAS int*)(lds + LDS_MISC);
    float qkb, qka, qkc, qkb_excess;
    { const int ln = lane_fresh();
      float g0 = fabsf(p.in[8][lidx * 64 + ln]), g1 = fabsf(p.in[9][lidx * 64 + ln]), g2 = fabsf(p.in[6][lidx * 64 + ln]), g3 = fabsf(p.in[7][lidx * 64 + ln]);
      float g4 = fmaxf(fmaxf(fabsf(p.in[19][lidx * 192 + ln]), fabsf(p.in[19][lidx * 192 + 64 + ln])), fabsf(p.in[19][lidx * 192 + 128 + ln]));
      float g5 = fmaxf(fmaxf(fabsf(p.in[20][lidx * 192 + ln]), fabsf(p.in[20][lidx * 192 + 64 + ln])), fabsf(p.in[20][lidx * 192 + 128 + ln]));
#pragma unroll
      for (int o = 1; o < 64; o <<= 1) {
#define WMAX_(g) g = fmaxf(g, __int_as_float(__builtin_amdgcn_ds_bpermute((ln ^ o) << 2, __float_as_int(g))))
          WMAX_(g0); WMAX_(g1); WMAX_(g2); WMAX_(g3); WMAX_(g4); WMAX_(g5);
#undef WMAX_
      }
      qkb = 1.05f * 64.f * 0.125f * LOG2E * g0 * g1; qka = 1.05f * 64.f * 0.125f * LOG2E * g2 * g3; qkc = 1.05f * 192.f * 0.07216878364870322f * LOG2E * g4 * g5;
      qkb_excess = fmaxf(qkb - 40.f, 0.f); qkb = fminf(qkb, 40.f); qka = fminf(qka, 40.f); qkc = fminf(qkc, 40.f);
      qkb_excess = __uint_as_float(__builtin_amdgcn_readfirstlane(__float_as_uint(qkb_excess)));
      qkb = __uint_as_float(__builtin_amdgcn_readfirstlane(__float_as_uint(qkb))); qka = __uint_as_float(__builtin_amdgcn_readfirstlane(__float_as_uint(qka))); qkc = __uint_as_float(__builtin_amdgcn_readfirstlane(__float_as_uint(qkc))); }

    for (;;) {
        if (wave == 0 && lane_fresh() == 0) {
#ifdef FLATQ
            const unsigned x = 0u;
#else
            const unsigned x = (unsigned)__builtin_amdgcn_s_getreg((3 << 11) | 20) & 0xFu;
#endif
            int res = -1, lin = 0;
            for (;;) {
                const unsigned idx = __hip_atomic_fetch_add(q + 64 + 16 * x, 1u, __ATOMIC_RELAXED, __HIP_MEMORY_SCOPE_AGENT);
                const unsigned slot = (idx >> 5) & 63u; lin = (int)(idx & 31u);
                unsigned* te = q + 512 + x * 64 + slot; unsigned g;
                if (lin == 0) { g = __hip_atomic_fetch_add(q, 1u, __ATOMIC_RELAXED, __HIP_MEMORY_SCOPE_AGENT); __hip_atomic_store(te, g + 1u, __ATOMIC_RELAXED, __HIP_MEMORY_SCOPE_AGENT); }
                else { while ((g = __hip_atomic_load(te, __ATOMIC_RELAXED, __HIP_MEMORY_SCOPE_AGENT)) == 0u) __builtin_amdgcn_s_sleep(2); g -= 1u; }
                if ((int)g >= nsuper) { res = -1; break; }
                if ((int)g < nms && (lin >= 8 || (int)g * 8 + lin >= nmeta)) continue;
#ifdef A64
                if ((int)g >= nms + 24) {
                    const int sub_ = ((int)g - nms) & 1;
                    if (ck.nseq == 1 ? (sub_ == 1) : (lin >= 16)) continue; }
#endif
                res = (int)g; break;
            }
            su[0] = res; su[1] = lin;
        }
        __syncthreads();
        const int g = su[0], lin = su[1];
        __syncthreads();
        if (g < 0) break;
        int type, hd, s, qb;
        int sh = ck.nseq - 1; asm volatile("" : "+s"(sh));
        if (g < nms) { const int mu = g * 8 + lin, jh = mu >> sh; s = mu & sh; qb = ck.tps - 1;
            if (jh < 4) { type = 0; hd = jh; } else if (jh < 12) { type = 1; hd = jh - 4; } else { type = 2; hd = jh - 12; } }
        else { const int gr0 = g - nms, gr = gr0 >= 40 ? gr0 - 40 + DUP0 : gr0, sub = gr & 1;
            if (gr < 8) { type = 0; hd = gr >> 1; } else if (gr < 16) { type = 1; hd = 7 - ((gr - 8) >> 1); } else if (gr < 32) { type = 2; hd = (gr - 16) >> 1; } else { type = 1; hd = 3 - ((gr - 32) >> 1); }
            s = sub * sh; qb = lin + (sub * 32) * (1 - sh); }
        const int r0 = s * ck.rows_per_seq();
        if (type == 0) {
            ATTN_C(lds, QKV + QC_O + (size_t)hd * RA * 192, QKV + KC_O + (size_t)hd * RA * 192, QKV + VC_O + (size_t)hd * 128 * RA, OB + 2 * OSLOT + 128 * hd, r0, qb, ck.n, 0.f, wave, 0x3fffffff, qkc);
        } else if (type == 1) { const int hh = hd >> 1;
            const float sl = LOG2E * (hh == 0 ? 0.25f : hh == 1 ? 0.0625f : hh == 2 ? 0.015625f : 0.00390625f);
            const float dkf = (152.f + qkb_excess) / sl + 2.f; const int dkeys = dkf < 1.0e9f ? (int)dkf : 0x3fffffff;
            ATTN_B(lds, QKV + QB_O + (size_t)hd * RA * 64, QKV + KB_O + (size_t)hd * RA * 64, QKV + VB_O + (size_t)hh * 128 * RA, OB + ((hd & 1) ? 3 : 1) * OSLOT + 128 * hh, r0, qb, ck.n, sl, wave, dkeys, qkb);
        } else { const int kv = hd >> 2;
#ifdef A64
            const int qb5 = (g < nms) ? (ck.n >> 9) : lin;
            attn_unit_a64(lds, QKV + QA_O + (size_t)hd * RA * 64, QKV + KA_O + (size_t)kv * RA * 64, QKV + VA_O + (size_t)kv * 64 * RA, OB + 64 * hd, r0, qb5, ck.n, ck.rows_per_seq(), wave);
#else
            ATTN_A(lds, QKV + QA_O + (size_t)hd * RA * 64, QKV + KA_O + (size_t)kv * RA * 64, QKV + VA_O + (size_t)kv * 64 * RA, OB + 64 * hd, r0, qb, ck.n, 0.f, wave, 0x3fffffff, qka);
#endif
        }
    }
}

#define XB_TMO      128
#define XB_XCNT(j)  (256  + 64 * (j))
#define XB_XSUB(j)  (1280 + 64 * (j))
#define XB_XGEN(j)  (2304 + 64 * (j))
#define XB_TOP      3328
#define XB_TOPGEN   3392
#define XCD_BAR_WORDS 3456
#define XB_SPIN_CAP (1u << 22)
DI unsigned xb_ld(unsigned* p)              { return __hip_atomic_load(p, __ATOMIC_RELAXED, __HIP_MEMORY_SCOPE_AGENT); }
DI unsigned xb_add(unsigned* p, unsigned v) { return __hip_atomic_fetch_add(p, v, __ATOMIC_RELAXED, __HIP_MEMORY_SCOPE_AGENT); }
DI unsigned xb_xcc_id() { return (unsigned)__builtin_amdgcn_s_getreg((3 << 11) | 20) & 0xFu; }
#define XB_SPIN(cond, bar) do { unsigned _sp = 0; while (cond) { __builtin_amdgcn_s_sleep(1); \
    if ((++_sp & 255u) == 0u) { if (xb_ld(&(bar)[XB_TMO])) break; if (_sp > XB_SPIN_CAP) { atomicAdd(&(bar)[XB_TMO], 1u); break; } } } } while (0)
DI void xcd_barrier_complete(unsigned* bar, unsigned x, unsigned G, unsigned& nloc, unsigned& nx) {
    unsigned sum, cnt, mine, sp = 0u;
    for (;;) {
        sum = 0u; cnt = 0u; mine = 0u;
#pragma unroll
        for (unsigned j = 0; j < 16; ++j) { const unsigned c = xb_ld(&bar[XB_XCNT(j)]); sum += c; cnt += (c > 0u) ? 1u : 0u; mine = (j == x) ? c : mine; }
        if (sum == G) break;
        __builtin_amdgcn_s_sleep(1);
        if ((++sp & 255u) == 0u) { if (xb_ld(&bar[XB_TMO])) break; if (sp > XB_SPIN_CAP) { atomicAdd(&bar[XB_TMO], 1u); break; } }
    }
    nloc = mine > 0u ? mine : 1u; nx = cnt > 0u ? cnt : 1u;
}
DI void xcd_barrier(unsigned* bar, volatile LAS unsigned* st, const int wave) {
    asm volatile("s_waitcnt vmcnt(0)" ::: "memory");
    __syncthreads();
    if (wave == 0 && lane_fresh() == 0) {
        __builtin_amdgcn_s_waitcnt(0);
        const unsigned x = xb_xcc_id();
        unsigned nloc = st[0], nx = st[1];
        if (nloc == 0u) { xcd_barrier_complete(bar, x, gridDim.x, nloc, nx); st[0] = nloc; st[1] = nx; }
        const unsigned old = xb_add(&bar[XB_XSUB(x)], 1u);
        const unsigned gen = old / nloc;
        if (old + 1u == (gen + 1u) * nloc) {
            __builtin_amdgcn_fence(__ATOMIC_RELEASE, "agent");
            asm volatile("s_waitcnt vmcnt(0)" ::: "memory");
            const unsigned og = xb_add(&bar[XB_TOP], 1u);
            const unsigned tg = og / nx;
            if (og + 1u == (tg + 1u) * nx) xb_add(&bar[XB_TOPGEN], 1u);
            else XB_SPIN(xb_ld(&bar[XB_TOPGEN]) == tg, bar);
            __builtin_amdgcn_fence(__ATOMIC_ACQUIRE, "agent");
            xb_add(&bar[XB_XGEN(x)], 1u);
            asm volatile("s_waitcnt vmcnt(0)" ::: "memory");
        } else {
            XB_SPIN(xb_ld(&bar[XB_XGEN(x)]) == gen, bar);
            __builtin_amdgcn_fence(__ATOMIC_ACQUIRE, "agent");
            asm volatile("s_waitcnt vmcnt(0)" ::: "memory");
        }
    }
    __syncthreads();
}


#define SK_LOOP(ACC, AP, BP, KK) do { _Pragma("unroll") for (int k0_ = 0; k0_ < (KK); k0_ += 32) { \
        const bf16x8 a_ = *(const bf16x8*)((AP) + k0_), b_ = *(const bf16x8*)((BP) + k0_); ACC = __builtin_amdgcn_mfma_f32_16x16x32_bf16(a_, b_, ACC, 0, 0, 0); } } while (0)
DI void skinny_phase(int which  , const Params& p, const Chunk& ck, const XMap& xm, const unsigned char* wbl, int gw, int NGW, int lane) {
    unsigned char* ws = p.ws; asm volatile("" : "+s"(ws));
    const int row = lane & 15, quad = lane >> 4;
    if (which == 0) {
        const bf16_t* OB = (const bf16_t*)(ws + WS_ZM); const bf16_t* G = (const bf16_t*)(ws + WS_G); bf16_t* MGb = (bf16_t*)(ws + WS_XN);
        for (int it = gw; it < ck.nseq * 64; it += NGW) {
            const int s = it >> 6, tile = it & 63, R0 = (s * ck.tps + ck.tps - 1) * 256, col = tile * 16 + row;
            f32x4 sum = {0.f, 0.f, 0.f, 0.f};
#pragma unroll 1
            for (int z = 0; z < 3; ++z) { f32x4 a = {0.f, 0.f, 0.f, 0.f};
                const bf16_t* ap = OB + (size_t)z * OSLOT + (size_t)(R0 + row) * 512 + quad * 8; const bf16_t* bp = (const bf16_t*)(wbl + W_BR) + (size_t)z * 1024 * 512 + (size_t)col * 512 + quad * 8;
                SK_LOOP(a, ap, bp, 512);
#pragma unroll
                for (int j = 0; j < 4; ++j) { const float g = __uint_as_float((unsigned)G[(size_t)(R0 + quad * 4 + j) * G_LD + z * 1024 + col] << 16); sum[j] += g * a[j]; } }
#pragma unroll
            for (int j = 0; j < 4; ++j) MGb[(size_t)(R0 + quad * 4 + j) * DM + col] = (bf16_t)(pk2(sum[j], 0.f) & 0xffffu);
        }
    } else if (which == 2) {
        const bf16_t* XNp = (const bf16_t*)(ws + WS_XN); bf16_t* U_ = (bf16_t*)(ws + WS_G);
        for (int it = gw; it < ck.nseq * 256; it += NGW) {
            const int s = it >> 8, tile = it & 255, R0 = (s * ck.tps + ck.tps - 1) * 256, col = tile * 16 + row;
            f32x4 acc = {0.f, 0.f, 0.f, 0.f};
            const bf16_t* ap = XNp + (size_t)(R0 + row) * 1024 + quad * 8; const bf16_t* bp = (const bf16_t*)(wbl + W_UP) + (size_t)col * 1024 + quad * 8;
#pragma unroll 1
            for (int kh = 0; kh < 2; ++kh) SK_LOOP(acc, ap + kh * 512, bp + kh * 512, 512);
#pragma unroll
            for (int j = 0; j < 4; ++j) { const float v = fmaxf(acc[j], 0.f); U_[(size_t)(R0 + quad * 4 + j) * 4096 + col] = (bf16_t)(pk2(v * v, 0.f) & 0xffffu); }
        }
    } else {
        const int K = (which == 1) ? 1024 : 4096, nkc = K >> 9;
        const bf16_t* A = (which == 1) ? (const bf16_t*)(ws + WS_XN) : (const bf16_t*)(ws + WS_G);
        const bf16_t* W = (const bf16_t*)(wbl + (which == 1 ? W_OUT : W_DOWN));
        for (int it = gw; it < ck.nseq * 64 * nkc; it += NGW) {
            const int kc = it % nkc, rem = it / nkc, s = rem >> 6, tile = rem & 63, pt = s * ck.tps + ck.tps - 1, R0 = pt * 256, col = tile * 16 + row;
            f32x4 acc = {0.f, 0.f, 0.f, 0.f};
            const bf16_t* ap = A + (size_t)(R0 + row) * K + kc * 512 + quad * 8; const bf16_t* bp = W + (size_t)col * K + kc * 512 + quad * 8;
            SK_LOOP(acc, ap, bp, 512);
            float* wp = xm.xw(pt);
#pragma unroll
            for (int j = 0; j < 4; ++j) atomicAdd(wp + (size_t)(quad * 4 + j) * DM + col, acc[j]);
        }
    }
}

#define GSYNC() xcd_barrier(xbar, xst, wave)
__global__ void __launch_bounds__(512) fwd_kernel(Params p) {
    extern __shared__ __attribute__((aligned(16))) unsigned char lds_raw[];
    LAS unsigned char* lds = (LAS unsigned char*)lds_raw;
    cg::grid_group grid = cg::this_grid();
    const int wave = __builtin_amdgcn_readfirstlane((int)threadIdx.x >> 6); int lane = lane_fresh();
    const int G = gridDim.x, bx = blockIdx.x, NGW = G * 8, gw = bx * 8 + wave;
#define WSP(off) ({ unsigned char* w_ = p.ws; asm volatile("" : "+s"(w_)); w_ + (off); })
#define ctl ((unsigned*)WSP(WS_CTL))
#define xbar (ctl + 1024)
    volatile LAS unsigned* xst = (volatile LAS unsigned*)(lds + LDS_MISC + 16);
    if (wave == 0 && lane == 0) { xst[0] = 0u; xst[1] = 0u; (void)xb_add(&xbar[XB_XCNT(xb_xcc_id())], 1u); }
    __syncthreads();
#define XN ((bf16_t*)WSP(WS_XN))
#define ZM ((bf16_t*)WSP(WS_ZM))
#define GB ((bf16_t*)WSP(WS_G))
#define CQN ((bf16_t*)WSP(WS_SM + SM_CQN))
#define CKVN ((bf16_t*)WSP(WS_SM + SM_CKVN))
#define QCR ((bf16_t*)WSP(WS_ZM + OFF_QCR))
#define KVR ((bf16_t*)WSP(WS_ZM + OFF_KVR))
#define MG ((float*)WSP(WS_QKV))
#define U ((bf16_t*)WSP(WS_G))

#if !defined(PH) || (PH & 1)
    prologue(p, lds, gw, NGW, wave, lane);
#ifdef PROBE_PRO2
    prologue(p, lds, gw, NGW, wave, lane);
#endif
#endif
    grid.sync();
    for (int l = 0; l < 2; ++l) {
        const bool last = (l == 1);
#define wb (WSP(WS_W) + (size_t)l * LW_STRIDE)
        for (int c = 0; c < 3; ++c) {
            const Chunk ck = make_chunk(c);
            const int ta = ck.tps - 1;
            XMap xm; xm.out = p.out; xm.metax = (float*)WSP(WS_METAX); xm.xp = p.in[0]; xm.xs = p.in[1]; xm.meta0 = (const float*)WSP(WS_META0); xm.seq0 = ck.seq0; xm.tps = ck.tps; xm.first = (l == 0);
#define RELAUNDER() do { lane = lane_fresh(); } while (0)
            RELAUNDER();
#if !defined(PH) || (PH & 2)
            norm_phase(xm, ck.rows(), p.in[3] + l * DM, XN, gw, NGW, lane);
#ifdef PROBE_EW2
            RELAUNDER(); norm_phase(xm, ck.rows(), p.in[3] + l * DM, XN, gw, NGW, lane);
#endif
#endif
            GSYNC();
            { pg8::Gemm g{XN, (const bf16_t*)(wb + W_IN), 1024, 0, 0}; Sched S; S.init(ck.nseq, ck.tps, ck.tps, IN_N / 256, 1, G, bx);
              EpiIn E{ZM, GB, p.in[5] + l * 3072};
#if !defined(PH) || (PH & 4)
              pg8::gemm_phase<EpiIn, Sched, true, true>(lds, g, S, E, wave);
#ifdef PROBE_IN2
              pg8::gemm_phase<EpiIn, Sched, true, true>(lds, g, S, E, wave);
#endif
#endif
 }
            GSYNC();
            RELAUNDER();
#if !defined(PH) || (PH & 128)
            ew1_phase(p, ck, l, gw, NGW, lane);
#ifdef PROBE_EW2
            RELAUNDER(); ew1_phase(p, ck, l, gw, NGW, lane);
#endif
#endif
            GSYNC();
            { pg8::Gemm g{CQN, (const bf16_t*)(wb + W_QB), 256, 0, 0}; Sched S; S.init(ck.nseq, ck.tps, ck.tps, 3, 1, G, bx); EpiBf16<0> E{QCR, 768};
#if !defined(PH) || (PH & 8)
              pg8::gemm_phase<EpiBf16<0>, Sched, true, true>(lds, g, S, E, wave);
#endif
 }
            { pg8::Gemm g{CKVN, (const bf16_t*)(wb + W_KVB), 128, 0, 0}; Sched S; S.init(ck.nseq, ck.tps, ck.tps, 4, 1, G, bx); EpiBf16<0> E{KVR, 1024};
#if !defined(PH) || (PH & 8)
              pg8::gemm_phase<EpiBf16<0>, Sched, true, true>(lds, g, S, E, wave);
#endif
 }
            GSYNC();
            RELAUNDER();
#if !defined(PH) || (PH & 256)
            ew2_phase(p, ck, l, gw, NGW, lane);
#ifdef PROBE_EW2
            RELAUNDER(); ew2_phase(p, ck, l, gw, NGW, lane);
#endif
#endif
            GSYNC();
#if !defined(PH) || (PH & 1024)
            attn_phase(p, ck, last, l, lds, ctl + 8192 + 2048 * (l * 3 + c), wave);
#ifdef PROBE_ATTN2
            GSYNC();
            attn_phase(p, ck, last, l, lds, ctl + 8192 + 2048 * (6 + l * 3 + c), wave);
#endif
#endif
            GSYNC();
            RELAUNDER();
#if !defined(PH) || (PH & 512)
            ew3_phase(p, ck, l, last, gw, NGW, lane);
#endif
            GSYNC();
            { pg8::Gemm g{ZM, (const bf16_t*)(wb + W_BR), 512, OSLOT, (size_t)1024 * 512}; Sched S; S.init(ck.nseq, ta, ck.tps, 4, 3, G, bx); EpiBranch E{GB, MG, XN};
#if !defined(PH) || (PH & 16)
              pg8::gemm_phase<EpiBranch, Sched, true, true>(lds, g, S, E, wave);
#ifdef PROBE_BR2
              pg8::gemm_phase<EpiBranch, Sched, true, true>(lds, g, S, E, wave);
#endif
#endif
 }
            if (!last) { RELAUNDER(); skinny_phase(0, p, ck, xm, wb, gw, NGW, lane); }
            GSYNC();
            { pg8::Gemm g{XN, (const bf16_t*)(wb + W_OUT), 1024, 0, 0}; Sched S; S.init(ck.nseq, ta, ck.tps, 4, 1, G, bx); EpiResid E{xm};
#if !defined(PH) || (PH & 32)
              pg8::gemm_phase<EpiResid, Sched, true, true>(lds, g, S, E, wave);
#endif
 }
            if (!last) { RELAUNDER(); skinny_phase(1, p, ck, xm, wb, gw, NGW, lane); }
            GSYNC();
            xm.first = 0;
            RELAUNDER();
#if !defined(PH) || (PH & 2)
            norm_phase(xm, ck.rows(), p.in[25] + l * DM, XN, gw, NGW, lane);
#ifdef PROBE_EW2
            RELAUNDER(); norm_phase(xm, ck.rows(), p.in[25] + l * DM, XN, gw, NGW, lane);
#endif
#endif
            GSYNC();
            { pg8::Gemm g{XN, (const bf16_t*)(wb + W_UP), 1024, 0, 0}; Sched S; S.init(ck.nseq, ta, ck.tps, 16, 1, G, bx); EpiBf16<2> E{U, 4096};
#if !defined(PH) || (PH & 64)
              pg8::gemm_phase<EpiBf16<2>, Sched, true, true>(lds, g, S, E, wave);
#ifdef PROBE_UP2
              pg8::gemm_phase<EpiBf16<2>, Sched, true, true>(lds, g, S, E, wave);
#endif
#endif
 }
            if (!last) { RELAUNDER(); skinny_phase(2, p, ck, xm, wb, gw, NGW, lane); }
            GSYNC();
            { pg8::Gemm g{U, (const bf16_t*)(wb + W_DOWN), 4096, 0, 0}; Sched S; S.init(ck.nseq, ta, ck.tps, 4, 1, G, bx); EpiResid E{xm};
#if !defined(PH) || (PH & 32)
              pg8::gemm_phase<EpiResid, Sched, true, true>(lds, g, S, E, wave);
#endif
 }
            if (!last) { RELAUNDER(); skinny_phase(3, p, ck, xm, wb, gw, NGW, lane); }
        }
    }
}

extern "C" void kernel_launch(void* const* d_in, const int* in_sizes, int n_in, void* d_out, int out_size, void* d_ws, size_t ws_size, hipStream_t stream) {
    static int grid_blocks = 0;
    if (grid_blocks == 0) {
        if (n_in != 28 || ws_size < WS_END) { fprintf(stderr, "kernel_launch: unexpected n_in %d / ws_size %zu (need %zu)\n", n_in, ws_size, (size_t)WS_END); grid_blocks = -1; return; }
        int dev = 0, cus = 0, per_cu = 0;
        hipGetDevice(&dev); hipDeviceGetAttribute(&cus, hipDeviceAttributeMultiprocessorCount, dev);
        hipFuncSetAttribute((const void*)fwd_kernel, hipFuncAttributeMaxDynamicSharedMemorySize, LDS_BYTES);
        hipOccupancyMaxActiveBlocksPerMultiprocessor(&per_cu, (const void*)fwd_kernel, 512, LDS_BYTES);
        if (per_cu < 1) { fprintf(stderr, "kernel_launch: occupancy query says %d blocks/CU\n", per_cu); per_cu = 1; }
        grid_blocks = cus * 1;
        (void)hipGetLastError();
    }
    if (grid_blocks < 0) return;
    hipMemsetAsync((char*)d_ws + WS_CTL, 0, CTL_BYTES, stream);
    Params p{};
    for (int i = 0; i < 28; ++i) p.in[i] = (const float*)d_in[i];
    p.out = (float*)d_out; p.ws = (unsigned char*)d_ws;
    void* args[] = {&p};
    hipError_t e = hipLaunchCooperativeKernel((const void*)fwd_kernel, dim3(grid_blocks), dim3(512), args, LDS_BYTES, stream);
    if (e != hipSuccess) fprintf(stderr, "cooperative launch failed: %s (grid %d)\n", hipGetErrorString(e), grid_blocks);
}
```

```cpp
#include <hip/hip_runtime.h>
#include <hip/hip_cooperative_groups.h>
#include <cstdint>
#include <cstdio>
namespace cg = cooperative_groups;
#define NOPIPE_AB 1
#define FLATQ 1
namespace pg8 {
#define PG8_LAS __attribute__((address_space(3)))
typedef unsigned short bf16_t;
typedef short bf16x8 __attribute__((ext_vector_type(8)));
typedef float f32x4 __attribute__((ext_vector_type(4)));
typedef unsigned u32x4 __attribute__((ext_vector_type(4)));
constexpr int BM = 256, BK = 64, HALF = 128, HTB = HALF * BK * 2  , STAGE_BYTES = 8 * HTB, NXCD = 8, WGM = 4;

__host__ __device__ __forceinline__ int lds_byte(int r, int c) { const int st = (r >> 4) * 2 + (c >> 5), rr = r & 15, cc = c & 31, ob = rr * 64 + cc * 2; return st * 1024 + (ob ^ (((ob >> 9) & 1) << 5)); }
__host__ __device__ __forceinline__ void stage_rc(int b, int& R, int& C) { const int st = b / 1024, sb = b % 1024, swz = sb ^ (((sb >> 9) & 1) << 5); R = (st >> 1) * 16 + swz / 64; C = (st & 1) * 32 + (swz % 64) / 2; }
__host__ __device__ __forceinline__ int perm32(int rho) { const int n = rho >> 4, i = rho & 15; return 8 * (i >> 2) + 4 * n + (i & 3); }

struct Unit { int pm, pn, z; };
struct Gemm { const bf16_t* A; const bf16_t* Bt; int K; size_t zsA, zsB; };

template <class Epi, class Sched, bool ALIGN_EPI = false, bool SP2 = false>
__device__ __forceinline__ void gemm_phase(PG8_LAS unsigned char* lds, const Gemm g, const Sched& S, const Epi& E, const int wv  ) {
    int tid_; asm volatile("v_mbcnt_lo_u32_b32 %0, -1, 0\n\tv_mbcnt_hi_u32_b32 %0, -1, %0" : "=v"(tid_)); tid_ += wv * 64;
    const int tid = tid_, wid = __builtin_amdgcn_readfirstlane(tid >> 6), lane = tid & 63, wr = wid >> 2, wc = wid & 3, fr = lane & 15, fq = lane >> 4;
    const int K = g.K, nt = K / BK;
    unsigned voffA[2], voffB[2];
#pragma unroll
    for (int i = 0; i < 2; ++i) { int R, C; stage_rc(tid * 16 + i * 8192, R, C); const int Rb = Epi::PERM ? ((R & ~31) + perm32(R & 31)) : R;
        voffA[i] = (unsigned)(R * K + C) * 2u; voffB[i] = (unsigned)(Rb * K + C) * 2u; }
    const size_t kstep = (size_t)(BK * 2);
    const size_t hstep = (size_t)HALF * K * 2;
    const size_t tstep = 2 * hstep;
    const unsigned ldsw = (unsigned)wid * 1024u;
    const int aoff = lds_byte(wr * 64 + fr, fq * 8), boff = lds_byte(wc * 32 + fr, fq * 8);
#define PG8_SA(b, h) (((b) * 2 + (h)) * HTB)
#define PG8_SB(b, h) ((4 + (b) * 2 + (h)) * HTB)
#define PG8_STAGE(bufoff, gbase, voff) do { _Pragma("unroll") for (int _i = 0; _i < 2; ++_i) \
        __builtin_amdgcn_global_load_lds((const unsigned*)((const char*)(gbase) + (voff)[_i]), (PG8_LAS unsigned*)(lds + (bufoff) + ldsw + _i * 8192), 16, 0, 0); } while (0)
#define PG8_LDA(dst, b, h) do { _Pragma("unroll") for (int m = 0; m < 4; ++m) _Pragma("unroll") for (int k = 0; k < 2; ++k) dst[m][k] = *(const PG8_LAS bf16x8*)(lds + PG8_SA(b, h) + aoff + m * 2048 + k * 1024); } while (0)
#define PG8_LDB(dst, b, h) do { _Pragma("unroll") for (int n = 0; n < 2; ++n) _Pragma("unroll") for (int k = 0; k < 2; ++k) dst[n][k] = *(const PG8_LAS bf16x8*)(lds + PG8_SB(b, h) + boff + n * 2048 + k * 1024); } while (0)
#define PG8_MMA(ai, bj, At, Bt) do { __builtin_amdgcn_s_setprio(1); _Pragma("unroll") for (int m = 0; m < 4; ++m) _Pragma("unroll") for (int n = 0; n < 2; ++n) _Pragma("unroll") for (int k = 0; k < 2; ++k) \
        acc[ai][bj][m][n] = __builtin_amdgcn_mfma_f32_16x16x32_bf16(Bt[n][k], At[m][k], acc[ai][bj][m][n], 0, 0, 0); __builtin_amdgcn_s_setprio(0); } while (0)
#define PG8_WAIT_V(n) asm volatile("s_waitcnt vmcnt(" #n ")" ::: "memory")
#define PG8_WAIT_L(n) asm volatile("s_waitcnt lgkmcnt(" #n ")" ::: "memory")
#define PG8_BAR __builtin_amdgcn_s_barrier()
#define PG8_SCHED __builtin_amdgcn_sched_barrier(0)
    Unit cur, nxt; int ui = 0;
    if (!S.next(0, cur)) return;
    f32x4 acc[2][2][4][2];
#pragma unroll
    for (int a = 0; a < 2; ++a)
#pragma unroll
        for (int b = 0; b < 2; ++b)
#pragma unroll
            for (int m = 0; m < 4; ++m)
#pragma unroll
                for (int n = 0; n < 2; ++n) acc[a][b][m][n] = (f32x4){0.f, 0.f, 0.f, 0.f};
    bf16x8 At[4][2], B0[2][2], B1[2][2];
    const char* cA = (const char*)(g.A + (size_t)cur.z * g.zsA) + (size_t)cur.pm * tstep; const char* cB = (const char*)(g.Bt + (size_t)cur.z * g.zsB) + (size_t)cur.pn * tstep;
    S.a_ready(cur);
    if constexpr (SP2) {
        PG8_STAGE(PG8_SB(0, 0), cB, voffB); PG8_STAGE(PG8_SB(0, 1), cB + hstep, voffB); PG8_STAGE(PG8_SA(0, 0), cA, voffA); PG8_STAGE(PG8_SA(0, 1), cA + hstep, voffA);
        if (wr == 1) PG8_BAR;
        PG8_WAIT_V(2); PG8_BAR;
        PG8_STAGE(PG8_SB(1, 0), cB + kstep, voffB); PG8_STAGE(PG8_SA(1, 0), cA + kstep, voffA); PG8_STAGE(PG8_SB(1, 1), cB + hstep + kstep, voffB);
        PG8_WAIT_V(6); PG8_BAR;
    } else {
        PG8_STAGE(PG8_SB(0, 0), cB, voffB); PG8_STAGE(PG8_SA(0, 0), cA, voffA); PG8_STAGE(PG8_SB(0, 1), cB + hstep, voffB); PG8_STAGE(PG8_SA(0, 1), cA + hstep, voffA);
        if (wr == 1) PG8_BAR;
        PG8_WAIT_V(4); PG8_BAR;
        PG8_STAGE(PG8_SB(1, 0), cB + kstep, voffB); PG8_STAGE(PG8_SA(1, 0), cA + kstep, voffA); PG8_STAGE(PG8_SB(1, 1), cB + hstep + kstep, voffB);
        PG8_WAIT_V(6); PG8_BAR;
    }
    for (;;) {
        const bool has_next = S.next(ui + 1, nxt);
        const char* nA = has_next ? (const char*)(g.A + (size_t)nxt.z * g.zsA) + (size_t)nxt.pm * tstep : cA; const char* nB = has_next ? (const char*)(g.Bt + (size_t)nxt.z * g.zsB) + (size_t)nxt.pn * tstep : cB;
        for (int t = 0; t < nt; t += 2) {
            const bool last = (t == nt - 2);
            const char* a1 = cA + (size_t)(t + 1) * kstep;
            const char* a2 = last ? nA : cA + (size_t)(t + 2) * kstep; const char* b2 = last ? nB : cB + (size_t)(t + 2) * kstep;
            const char* a3 = a2 + kstep; const char* b3 = b2 + kstep;
            if (last && has_next) S.a_ready(nxt);
            if constexpr (SP2) {
            PG8_LDB(B0, 0, 0); PG8_LDB(B1, 0, 1); PG8_SCHED; PG8_LDA(At, 0, 0); PG8_STAGE(PG8_SA(1, 1), a1 + hstep, voffA);
            PG8_WAIT_V(8); PG8_WAIT_L(0); PG8_BAR; PG8_MMA(0, 0, At, B0); PG8_MMA(0, 1, At, B1); PG8_BAR; PG8_SCHED;
            PG8_LDA(At, 0, 1); PG8_STAGE(PG8_SB(0, 0), b2, voffB); PG8_STAGE(PG8_SB(0, 1), b2 + hstep, voffB); PG8_STAGE(PG8_SA(0, 0), a2, voffA);
            PG8_WAIT_V(8); PG8_WAIT_L(0); PG8_BAR; PG8_MMA(1, 0, At, B0); PG8_MMA(1, 1, At, B1); PG8_BAR; PG8_SCHED;
            PG8_LDB(B0, 1, 0); PG8_LDB(B1, 1, 1); PG8_SCHED; PG8_LDA(At, 1, 0); PG8_STAGE(PG8_SA(0, 1), a2 + hstep, voffA);
            PG8_WAIT_V(8); PG8_WAIT_L(0); PG8_BAR; PG8_MMA(0, 0, At, B0); PG8_MMA(0, 1, At, B1); PG8_BAR; PG8_SCHED;
            PG8_LDA(At, 1, 1); PG8_STAGE(PG8_SB(1, 0), b3, voffB); PG8_STAGE(PG8_SB(1, 1), b3 + hstep, voffB); PG8_STAGE(PG8_SA(1, 0), a3, voffA);
            PG8_WAIT_V(8); PG8_WAIT_L(0); PG8_BAR; PG8_MMA(1, 0, At, B0); PG8_MMA(1, 1, At, B1); PG8_BAR; PG8_SCHED;
            } else {
            PG8_LDB(B0, 0, 0); PG8_SCHED; PG8_LDA(At, 0, 0); PG8_STAGE(PG8_SA(1, 1), a1 + hstep, voffA);
            PG8_WAIT_L(8); PG8_BAR; PG8_WAIT_L(0); PG8_MMA(0, 0, At, B0); PG8_BAR; PG8_SCHED;
            PG8_LDB(B1, 0, 1); PG8_STAGE(PG8_SB(0, 0), b2, voffB);
            PG8_BAR; PG8_WAIT_L(0); PG8_MMA(0, 1, At, B1); PG8_BAR;
            PG8_LDA(At, 0, 1); PG8_STAGE(PG8_SA(0, 0), a2, voffA);
            PG8_BAR; PG8_WAIT_L(0); PG8_MMA(1, 0, At, B0); PG8_BAR; PG8_SCHED;
            PG8_STAGE(PG8_SB(0, 1), b2 + hstep, voffB);
            PG8_WAIT_V(6); PG8_BAR; PG8_MMA(1, 1, At, B1); PG8_BAR;
            PG8_LDB(B0, 1, 0); PG8_SCHED; PG8_LDA(At, 1, 0); PG8_STAGE(PG8_SA(0, 1), a2 + hstep, voffA);
            PG8_WAIT_L(8); PG8_BAR; PG8_WAIT_L(0); PG8_MMA(0, 0, At, B0); PG8_BAR; PG8_SCHED;
            PG8_LDB(B1, 1, 1); PG8_STAGE(PG8_SB(1, 0), b3, voffB);
            PG8_BAR; PG8_WAIT_L(0); PG8_MMA(0, 1, At, B1); PG8_BAR;
            PG8_LDA(At, 1, 1); PG8_STAGE(PG8_SA(1, 0), a3, voffA);
            PG8_BAR; PG8_WAIT_L(0); PG8_MMA(1, 0, At, B0); PG8_BAR; PG8_SCHED;
            PG8_STAGE(PG8_SB(1, 1), b3 + hstep, voffB);
            PG8_WAIT_V(6); PG8_BAR; PG8_MMA(1, 1, At, B1); PG8_BAR;
            }
        }
        if constexpr (ALIGN_EPI) { if (wr == 0) PG8_BAR; }
        if constexpr (!Epi::AFTER_DRAIN) { E(acc, cur, wr, wc, fr, fq); S.done(cur); }
        if (!has_next) break;
#pragma unroll
        for (int a = 0; a < 2; ++a)
#pragma unroll
            for (int b = 0; b < 2; ++b)
#pragma unroll
                for (int m = 0; m < 4; ++m)
#pragma unroll
                    for (int n = 0; n < 2; ++n) acc[a][b][m][n] = (f32x4){0.f, 0.f, 0.f, 0.f};
        cur = nxt; cA = nA; cB = nB; ++ui;
        if constexpr (ALIGN_EPI) { if (wr == 1) PG8_BAR; }
    }
    PG8_WAIT_V(0);
    if constexpr (!ALIGN_EPI) { if (wr == 0) PG8_BAR; }
    PG8_BAR;
    if constexpr (Epi::AFTER_DRAIN) { E.fused(acc, cur, wr, wc, fr, fq, lds, wid, lane); S.done(cur); }
#undef PG8_SA
#undef PG8_SB
#undef PG8_STAGE
#undef PG8_LDA
#undef PG8_LDB
#undef PG8_MMA
#undef PG8_WAIT_V
#undef PG8_WAIT_L
#undef PG8_BAR
#undef PG8_SCHED
}
}


using pg8::bf16_t; using pg8::bf16x8; using pg8::f32x4; using pg8::u32x4;
typedef float f32x16 __attribute__((ext_vector_type(16)));
typedef unsigned u32x2 __attribute__((ext_vector_type(2)));
typedef float f32x2_t __attribute__((ext_vector_type(2)));
typedef __bf16 bf16x2_t __attribute__((ext_vector_type(2)));
#define LAS __attribute__((address_space(3)))
#define DI __device__ __forceinline__

constexpr int DM = 1024, RA = 16896;
constexpr int ZM_LD = 2816, G_LD = 3072, IN_N = 5888;
constexpr float LOG2E = 1.4426950408889634f;
constexpr size_t MiB = 1u << 20;
constexpr size_t WS_CTL = 0, CTL_BYTES = 131072;
constexpr size_t WS_W = 1 * MiB, LW_STRIDE = 34 * MiB;
constexpr size_t W_IN = 0, W_QB = W_IN + (size_t)IN_N * 1024 * 2, W_KVB = W_QB + 768 * 256 * 2, W_BR = W_KVB + 1024 * 128 * 2,
                 W_OUT = W_BR + 3 * 1024 * 512 * 2, W_UP = W_OUT + 1024 * 1024 * 2, W_DOWN = W_UP + 4096 * 1024 * 2, W_END = W_DOWN + 4096 * 1024 * 2;
static_assert(W_END <= LW_STRIDE, "weights");
constexpr size_t WS_META0 = 69 * MiB, WS_METAX = 70 * MiB, WS_XN = 74 * MiB, WS_ZM = 107 * MiB, WS_G = 198 * MiB, WS_QKV = 297 * MiB, WS_SM = 438 * MiB, WS_END = 454 * MiB;
constexpr size_t OFF_QCR = 0, OFF_KVR = 25 * MiB;
constexpr size_t OSLOT = (size_t)RA * 512;
constexpr size_t QA_O = 0, KA_O = 512ull * RA, VA_O = 640ull * RA, QB_O = 768ull * RA, KB_O = 1280ull * RA, VB_O = 1792ull * RA, QC_O = 2304ull * RA, KC_O = 3072ull * RA, VC_O = 3840ull * RA;
constexpr size_t SM_CQN = 0, SM_CKVN = 9 * MiB, SM_KPE = 14 * MiB;
constexpr int LDS_MISC = 131072, LDS_BYTES = 131072 + 256;

struct Params { const float* in[28]; float* out; unsigned char* ws; };

DI unsigned pk2(float lo, float hi) { f32x2_t v = {lo, hi}; bf16x2_t b = __builtin_convertvector(v, bf16x2_t); return __builtin_bit_cast(unsigned, b); }
DI void ld8(const bf16_t* p, float (&f)[8]) {
    const u32x4 r = *(const u32x4*)p;
#pragma unroll
    for (int i = 0; i < 4; ++i) { f[2 * i] = __uint_as_float(r[i] << 16); f[2 * i + 1] = __uint_as_float(r[i] & 0xffff0000u); }
}
DI void st8(bf16_t* p, const float (&f)[8]) { u32x4 w; w.x = pk2(f[0], f[1]); w.y = pk2(f[2], f[3]); w.z = pk2(f[4], f[5]); w.w = pk2(f[6], f[7]); *(u32x4*)p = w; }
DI int lane_fresh() { int l; asm volatile("v_mbcnt_lo_u32_b32 %0, -1, 0\n\tv_mbcnt_hi_u32_b32 %0, -1, %0" : "=v"(l)); return l; }
DI float wave_sum(float v, int lane) {
#pragma unroll
    for (int o = 1; o < 64; o <<= 1) v += __int_as_float(__builtin_amdgcn_ds_bpermute((lane ^ o) << 2, __float_as_int(v)));
    return v;
}
DI float max3f(float a, float b, float c) { float r; asm("v_max3_f32 %0, %1, %2, %3" : "=v"(r) : "v"(a), "v"(b), "v"(c)); return r; }
DI float max2f(float a, float b) { float r; asm("v_max_f32_e32 %0, %1, %2" : "=v"(r) : "v"(a), "v"(b)); return r; }
DI float fadd_s(float a, float b) { float r; asm("v_add_f32_e32 %0, %1, %2" : "=v"(r) : "v"(a), "v"(b)); return r; }
#define MX2(a, b) __builtin_amdgcn_fmed3f((a), (b), __builtin_inff())
DI float swap32_max(float v) { auto rr = __builtin_amdgcn_permlane32_swap(__float_as_uint(v), __float_as_uint(v), false, false); return __builtin_amdgcn_fmed3f(__uint_as_float(rr[0]), __uint_as_float(rr[1]), __builtin_inff()); }
DI float swap32_add(float v) { auto rr = __builtin_amdgcn_permlane32_swap(__float_as_uint(v), __float_as_uint(v), false, false); return __uint_as_float(rr[0]) + __uint_as_float(rr[1]); }
DI constexpr float inv64(int j) {
    constexpr float T[32] = {1.0f, 0.749894209f, 0.562341325f, 0.421696503f, 0.316227766f, 0.237137371f, 0.177827941f, 0.133352143f, 0.1f, 0.0749894209f, 0.0562341325f, 0.0421696503f,
                             0.0316227766f, 0.0237137371f, 0.0177827941f, 0.0133352143f, 0.01f, 0.00749894209f, 0.00562341325f, 0.00421696503f, 0.00316227766f, 0.00237137371f,
                             0.00177827941f, 0.00133352143f, 0.001f, 0.000749894209f, 0.000562341325f, 0.000421696503f, 0.000316227766f, 0.000237137371f, 0.000177827941f, 0.000133352143f};
    return T[j];
}
DI void sincos_ang(float ang, float& s, float& c) {
    double t = (double)ang * 0.15915494309189535; t -= __builtin_rint(t); const float f = (float)t;
    s = __builtin_amdgcn_sinf(f); c = __builtin_amdgcn_cosf(f);
}

struct Chunk {
    int id, nseq, seq0, tps, n;
    DI int rows_per_seq() const { return tps * 256; }
    DI int rows() const { return nseq * tps * 256; }
};
DI Chunk make_chunk(int c) { Chunk k; k.id = c; if (c < 2) { k.nseq = 1; k.seq0 = c; k.tps = 65; k.n = 16384; } else { k.nseq = 2; k.seq0 = 2; k.tps = 33; k.n = 8192; } return k; }
struct XMap {
    float* out; float* metax; const float* xp; const float* xs; const float* meta0; int seq0, tps, first;
    DI float* xw(int pt) const {
        const int hi = pt >= tps ? 1 : 0, s = seq0 + hi, lt = pt - hi * tps;
        if (lt == tps - 1) return metax + (size_t)s * 256 * DM;
        const int ob = (s < 2) ? s * 16384 : 32768 + (s - 2) * 8192;
        return out + ((size_t)ob + (size_t)lt * 256) * DM;
    }
    DI const float* xr(int pt) const {
        if (!first) return xw(pt);
        const int hi = pt >= tps ? 1 : 0, s = seq0 + hi, lt = pt - hi * tps;
        if (lt == tps - 1) return metax + (size_t)s * 256 * DM;
        return (s < 2) ? xp + ((size_t)s * 16384 + (size_t)lt * 256) * DM : xs + ((size_t)(s - 2) * 8192 + (size_t)lt * 256) * DM;
    }
};

struct Sched {
    int nM, nN, nZ, nwg, G, c, ta, tps;
    DI void init(int nseq, int ta_, int tps_, int nN_, int nZ_, int G_, int c_) { ta = ta_; tps = tps_; nM = nseq * ta_; nN = nN_; nZ = nZ_; nwg = nM * nN; G = G_; c = c_; }
    DI bool next(int i, pg8::Unit& u) const {
        const int tl = (i / nZ) * G + c; if (tl >= nwg) return false;
        u.z = i % nZ;
        int wgid = tl; { const int q = nwg / pg8::NXCD, r = nwg % pg8::NXCD, xcd = wgid % pg8::NXCD, off = wgid / pg8::NXCD; wgid = (xcd < r ? xcd * (q + 1) : r * (q + 1) + (xcd - r) * q) + off; }
        const int nig = pg8::WGM * nN, gid = wgid / nig, fm = gid * pg8::WGM, gsz = (nM - fm) < pg8::WGM ? (nM - fm) : pg8::WGM;
        const int pa = fm + ((wgid % nig) % gsz); u.pn = (wgid % nig) / gsz;
        u.pm = pa >= ta ? pa - ta + tps : pa;
        return true;
    }
    DI void a_ready(const pg8::Unit&) const {}
    DI void done(const pg8::Unit&) const {}
};

template <int ACT  > struct EpiBf16 {
    static constexpr bool PERM = true, AFTER_DRAIN = false;
    bf16_t* O; int ldc;
    DI void operator()(const f32x4 (&acc)[2][2][4][2], const pg8::Unit& u, int wr, int wc, int fr_, int fq_) const {
        const int ln_ = lane_fresh(), fr = ln_ & 15, fq = ln_ >> 4;
        const int row0 = u.pm * 256 + wr * 64 + fr, col0 = u.pn * 256 + wc * 32 + 8 * fq;
#pragma unroll
        for (int ai = 0; ai < 2; ++ai)
#pragma unroll
            for (int m = 0; m < 4; ++m) { bf16_t* rowp = O + (size_t)(row0 + ai * 128 + m * 16) * ldc + col0;
#pragma unroll
                for (int bj = 0; bj < 2; ++bj) { f32x4 v0 = acc[ai][bj][m][0], v1 = acc[ai][bj][m][1];
                    if (ACT == 2) {
#pragma unroll
                        for (int k = 0; k < 4; ++k) { const float a = fmaxf(v0[k], 0.f), b = fmaxf(v1[k], 0.f); v0[k] = a * a; v1[k] = b * b; } }
                    u32x4 w; w.x = pk2(v0[0], v0[1]); w.y = pk2(v0[2], v0[3]); w.z = pk2(v1[0], v1[1]); w.w = pk2(v1[2], v1[3]);
                    *(u32x4*)(rowp + bj * 128) = w; } }
    }
};
struct EpiIn {
    static constexpr bool PERM = true, AFTER_DRAIN = false;
    bf16_t* ZM; bf16_t* G; const float* bgate;
    DI void operator()(const f32x4 (&acc)[2][2][4][2], const pg8::Unit& u, int wr, int wc, int fr_, int fq_) const {
        const int ln_ = lane_fresh(), fr = ln_ & 15, fq = ln_ >> 4;
        const bool gate = u.pn >= 11;
        const int row0 = u.pm * 256 + wr * 64 + fr, colt = gate ? (u.pn - 11) * 256 : u.pn * 256, col0 = colt + wc * 32 + 8 * fq, ld = gate ? G_LD : ZM_LD;
        bf16_t* base = gate ? G : ZM;
        f32x4 bv[2][2];
#pragma unroll
        for (int bj = 0; bj < 2; ++bj)
#pragma unroll
            for (int n = 0; n < 2; ++n) bv[bj][n] = gate ? *(const f32x4*)(bgate + col0 + bj * 128 + 4 * n) : (f32x4){0.f, 0.f, 0.f, 0.f};
#pragma unroll
        for (int ai = 0; ai < 2; ++ai)
#pragma unroll
            for (int m = 0; m < 4; ++m) { bf16_t* rowp = base + (size_t)(row0 + ai * 128 + m * 16) * ld + col0;
#pragma unroll
                for (int bj = 0; bj < 2; ++bj) { f32x4 v0 = acc[ai][bj][m][0] + bv[bj][0], v1 = acc[ai][bj][m][1] + bv[bj][1];
                    if (gate) {
#pragma unroll
                        for (int k = 0; k < 4; ++k) { v0[k] = __builtin_amdgcn_rcpf(1.f + __builtin_amdgcn_exp2f(-LOG2E * v0[k])); v1[k] = __builtin_amdgcn_rcpf(1.f + __builtin_amdgcn_exp2f(-LOG2E * v1[k])); } }
                    u32x4 w; w.x = pk2(v0[0], v0[1]); w.y = pk2(v0[2], v0[3]); w.z = pk2(v1[0], v1[1]); w.w = pk2(v1[2], v1[3]);
                    *(u32x4*)(rowp + bj * 128) = w; } }
    }
};
struct EpiBranch {
    static constexpr bool PERM = false, AFTER_DRAIN = false;
    const bf16_t* G; float* MG; bf16_t* MGb;
    DI void operator()(const f32x4 (&acc)[2][2][4][2], const pg8::Unit& u, int wr, int wc, int fr_, int fq_) const {
        const int ln_ = lane_fresh(), fr = ln_ & 15, fq = ln_ >> 4;
        const int row0 = u.pm * 256 + wr * 64 + fr, col0 = u.pn * 256 + wc * 32 + 4 * fq;
#pragma unroll
        for (int ai = 0; ai < 2; ++ai)
#pragma unroll
            for (int m = 0; m < 4; ++m) { const size_t row = (size_t)(row0 + ai * 128 + m * 16);
#pragma unroll
                for (int bj = 0; bj < 2; ++bj)
#pragma unroll
                    for (int n = 0; n < 2; ++n) { const int col = col0 + bj * 128 + n * 16;
                        const u32x2 gr = *(const u32x2*)(G + row * G_LD + u.z * 1024 + col);
                        f32x4 g; g[0] = __uint_as_float(gr.x << 16); g[1] = __uint_as_float(gr.x & 0xffff0000u); g[2] = __uint_as_float(gr.y << 16); g[3] = __uint_as_float(gr.y & 0xffff0000u);
                        f32x4 v = g * acc[ai][bj][m][n];
                        float* mp = MG + row * DM + col;
                        if (u.z > 0) v += *(const f32x4*)mp;
                        if (u.z < 2) *(f32x4*)mp = v;
                        else { u32x2 w; w.x = pk2(v[0], v[1]); w.y = pk2(v[2], v[3]); *(u32x2*)(MGb + row * DM + col) = w; } }
                asm volatile("" ::: "memory"); }
    }
};
struct EpiResid {
    static constexpr bool PERM = false, AFTER_DRAIN = false;
    XMap xm;
    DI void operator()(const f32x4 (&acc)[2][2][4][2], const pg8::Unit& u, int wr, int wc, int fr_, int fq_) const {
        const int ln_ = lane_fresh(), fr = ln_ & 15, fq = ln_ >> 4;
        const float* rd = xm.xr(u.pm); float* wp = xm.xw(u.pm);
        const int row0 = wr * 64 + fr, col0 = u.pn * 256 + wc * 32 + 4 * fq;
#pragma unroll
        for (int ai = 0; ai < 2; ++ai)
#pragma unroll
            for (int m = 0; m < 4; ++m) { const size_t off = (size_t)(row0 + ai * 128 + m * 16) * DM + col0;
#pragma unroll
                for (int bj = 0; bj < 2; ++bj)
#pragma unroll
                    for (int n = 0; n < 2; ++n) { const size_t o = off + bj * 128 + n * 16; *(f32x4*)(wp + o) = *(const f32x4*)(rd + o) + acc[ai][bj][m][n]; }
                asm volatile("" ::: "memory"); }
    }
};

DI void transpose_item(const float* W, int K, int N, bf16_t* WT, int split, int extra, LAS float* scr, int item, int lane) {
    const int nblk = N / 32, kb = item / nblk, nb = item % nblk, k0 = 64 * kb, n0 = 32 * nb;
    const int row_off = (n0 >= split) ? extra : 0;
#pragma unroll 8
    for (int i = 0; i < 32; ++i) { const int kk = 2 * i + (lane >> 5); scr[kk * 33 + (lane & 31)] = W[(size_t)(k0 + kk) * N + n0 + (lane & 31)]; }
    asm volatile("s_waitcnt lgkmcnt(0)" ::: "memory");
    const int c = lane & 7;
#pragma unroll
    for (int j = 0; j < 4; ++j) { const int n = (lane >> 3) + 8 * j; const LAS float* s = scr + (8 * c) * 33 + n;
        u32x4 o; o.x = pk2(s[0 * 33], s[1 * 33]); o.y = pk2(s[2 * 33], s[3 * 33]); o.z = pk2(s[4 * 33], s[5 * 33]); o.w = pk2(s[6 * 33], s[7 * 33]);
        *(u32x4*)(WT + (size_t)(row_off + n0 + n) * K + k0 + 8 * c) = o; }
    asm volatile("s_waitcnt lgkmcnt(0)" ::: "memory");
}
DI void prologue(const Params& p, LAS unsigned char* lds, int gw, int NGW, int wave, int lane) {
    LAS float* scr = (LAS float*)(lds + wave * 16384);
    constexpr int I_IN = 16 * 182, I_QB = 4 * 24, I_KVB = 2 * 32, I_BR = 8 * 32, I_OUT = 16 * 32, I_UP = 16 * 128, I_DN = 64 * 32;
    constexpr int PER_L = I_IN + I_QB + I_KVB + 3 * I_BR + I_OUT + I_UP + I_DN;
    for (int it = gw; it < 2 * PER_L; it += NGW) {
        const int l = it / PER_L; int r = it % PER_L;
        unsigned char* wb = p.ws + WS_W + (size_t)l * LW_STRIDE;
        if (r < I_IN) { transpose_item(p.in[4] + (size_t)l * 1024 * 5824, 1024, 5824, (bf16_t*)(wb + W_IN), 2752, 64, scr, r, lane); continue; } r -= I_IN;
        if (r < I_QB) { transpose_item(p.in[16] + (size_t)l * 256 * 768, 256, 768, (bf16_t*)(wb + W_QB), 1 << 30, 0, scr, r, lane); continue; } r -= I_QB;
        if (r < I_KVB) { transpose_item(p.in[18] + (size_t)l * 128 * 1024, 128, 1024, (bf16_t*)(wb + W_KVB), 1 << 30, 0, scr, r, lane); continue; } r -= I_KVB;
        if (r < 3 * I_BR) { const int b = r / I_BR; transpose_item(p.in[21 + b] + (size_t)l * 512 * 1024, 512, 1024, (bf16_t*)(wb + W_BR) + (size_t)b * 1024 * 512, 1 << 30, 0, scr, r % I_BR, lane); continue; } r -= 3 * I_BR;
        if (r < I_OUT) { transpose_item(p.in[24] + (size_t)l * 1024 * 1024, 1024, 1024, (bf16_t*)(wb + W_OUT), 1 << 30, 0, scr, r, lane); continue; } r -= I_OUT;
        if (r < I_UP) { transpose_item(p.in[26] + (size_t)l * 1024 * 4096, 1024, 4096, (bf16_t*)(wb + W_UP), 1 << 30, 0, scr, r, lane); continue; } r -= I_UP;
        transpose_item(p.in[27] + (size_t)l * 4096 * 1024, 4096, 1024, (bf16_t*)(wb + W_DOWN), 1 << 30, 0, scr, r, lane);
    }
    { float* mx0 = (float*)(p.ws + WS_METAX);
      for (int r = gw; r < 4 * 256; r += NGW) { const int rr = r & 255; f32x4* o = (f32x4*)(mx0 + (size_t)r * DM) + lane;
#pragma unroll
        for (int j = 0; j < 4; ++j) o[64 * j] = (rr < 16) ? ((const f32x4*)(p.in[2] + (size_t)rr * DM))[lane + 64 * j] : (f32x4){0.f, 0.f, 0.f, 0.f}; } }
    float* m0 = (float*)(p.ws + WS_META0);
    for (int r = gw; r < 256; r += NGW) { f32x4* o = (f32x4*)(m0 + (size_t)r * DM) + lane;
#pragma unroll
        for (int j = 0; j < 4; ++j) o[64 * j] = (r < 16) ? ((const f32x4*)(p.in[2] + (size_t)r * DM))[lane + 64 * j] : (f32x4){0.f, 0.f, 0.f, 0.f}; }
}

DI void norm_phase(const XMap& xm, int rows, const float* g, bf16_t* XN, int gw, int NGW, int lane) {
    for (int r = gw; r < rows; r += NGW) {
        const float* xrow = xm.xr(r >> 8) + (size_t)(r & 255) * DM;
        const f32x4* xr = (const f32x4*)xrow + lane;
        f32x4 v[4]; float s = 0.f;
#pragma unroll
        for (int j = 0; j < 4; ++j) { v[j] = xr[64 * j]; s += (v[j].x * v[j].x + v[j].y * v[j].y) + (v[j].z * v[j].z + v[j].w * v[j].w); }
        const float rs = rsqrtf(wave_sum(s, lane) * (1.f / DM) + 1e-6f);
        u32x2* o8 = (u32x2*)(XN + (size_t)r * DM) + lane;
#pragma unroll
        for (int j = 0; j < 4; ++j) { const f32x4 gg = ((const f32x4*)g)[lane + 64 * j]; u32x2 w; w.x = pk2(v[j].x * rs * gg.x, v[j].y * rs * gg.y); w.y = pk2(v[j].z * rs * gg.z, v[j].w * rs * gg.w); o8[64 * j] = w; }
    }
}

template <int W, int W0, int ROPE> DI void norm_task(const bf16_t* s0, const bf16_t* s1, const float* gain, float oscale, bf16_t* dst, float pa, float pb) {
    float ss = 0.f;
#pragma unroll 2
    for (int c = 0; c < W / 8; ++c) { float x[8]; ld8(c < W0 / 8 ? s0 + 8 * c : s1 + 8 * (c - W0 / 8), x);
#pragma unroll
        for (int e = 0; e < 8; ++e) ss += x[e] * x[e]; }
    const float rs = rsqrtf(ss * (1.f / W) + 1e-6f) * oscale;
    constexpr int NPLAIN = ROPE == 1 ? 0 : (ROPE == 2 ? 16 : W / 8);
#pragma unroll 2
    for (int c = 0; c < NPLAIN; ++c) { float x[8]; ld8(c < W0 / 8 ? s0 + 8 * c : s1 + 8 * (c - W0 / 8), x);
#pragma unroll
        for (int e = 0; e < 8; ++e) x[e] *= rs * gain[8 * c + e];
        st8(dst + 8 * c, x); }
    if constexpr (ROPE != 0) {
        constexpr int NB = ROPE == 1 ? 2 : 1, HC = ROPE == 1 ? 2 : 4, C0 = ROPE == 1 ? 0 : 16;
#pragma unroll
        for (int b = 0; b < NB; ++b) { const float pos = b ? pb : pa;
#pragma unroll
            for (int k = 0; k < HC; ++k) { const int c1 = C0 + 2 * HC * b + k, c2 = c1 + HC; float x1[8], x2[8];
                ld8(c1 < W0 / 8 ? s0 + 8 * c1 : s1 + 8 * (c1 - W0 / 8), x1); ld8(c2 < W0 / 8 ? s0 + 8 * c2 : s1 + 8 * (c2 - W0 / 8), x2);
#pragma unroll
                for (int e = 0; e < 8; ++e) { const int j = 8 * k + e; const float inv = ROPE == 1 ? inv64(2 * j) : inv64(j); float sn, cs; sincos_ang(pos * inv, sn, cs);
                    const float y1 = x1[e] * rs * gain[8 * c1 + e], y2 = x2[e] * rs * gain[8 * c2 + e]; x1[e] = y1 * cs - y2 * sn; x2[e] = y2 * cs + y1 * sn; }
                st8(dst + 8 * c1, x1); st8(dst + 8 * c2, x2); } }
    }
}
template <int W> DI void transpose_task(const bf16_t* src, bf16_t* dstT, int row) {
#pragma unroll 2
    for (int c = 0; c < W / 8; ++c) { const u32x4 r = *(const u32x4*)(src + 8 * c);
#pragma unroll
        for (int i = 0; i < 4; ++i) { dstT[(size_t)(8 * c + 2 * i) * RA + row] = (bf16_t)(r[i] & 0xffffu); dstT[(size_t)(8 * c + 2 * i + 1) * RA + row] = (bf16_t)(r[i] >> 16); } }
}
struct RowPos { float lin, row, col; };
DI RowPos row_pos(const Chunk& ck, int r) {
    const int li = r >= ck.rows_per_seq() ? r - ck.rows_per_seq() : r; RowPos p;
    if (li < ck.n) { p.lin = (float)(li + 16); p.row = (float)(li >> 6); p.col = (float)(li & 63); }
    else if (li < ck.n + 16) { p.lin = (float)(li - ck.n); p.row = -1.f; p.col = (float)(li - ck.n); }
    else { p.lin = 0.f; p.row = 0.f; p.col = 0.f; }
    return p;
}

DI void ew1_phase(const Params& p, const Chunk& ck, int l, int gw, int NGW, int lane) {
    unsigned char* ws = p.ws; asm volatile("" : "+s"(ws));
    const bf16_t* ZM = (const bf16_t*)(ws + WS_ZM); bf16_t* QKV = (bf16_t*)(ws + WS_QKV);
    bf16_t* CQN = (bf16_t*)(ws + WS_SM + SM_CQN); bf16_t* CKVN = (bf16_t*)(ws + WS_SM + SM_CKVN); bf16_t* KPE = (bf16_t*)(ws + WS_SM + SM_KPE);
    const int nrb = ck.rows() / 64; const float QS = 0.125f * LOG2E;
    for (int w = gw; w < nrb * 34; w += NGW) {
        const int rb = w / 34, task = w % 34, row = rb * 64 + lane;
        const bf16_t* z = ZM + (size_t)row * ZM_LD; const RowPos ps = row_pos(ck, row);
        if (task < 8) { const int h = task; norm_task<64, 64, 1>(z + 64 * h, z, p.in[6] + l * 64, QS, QKV + QA_O + ((size_t)h * RA + row) * 64, ps.row, ps.col); }
        else if (task < 10) { const int h = task - 8; norm_task<64, 64, 1>(z + 512 + 64 * h, z, p.in[7] + l * 64, 1.f, QKV + KA_O + ((size_t)h * RA + row) * 64, ps.row, ps.col); }
        else if (task < 12) { const int h = task - 10; transpose_task<64>(z + 640 + 64 * h, QKV + VA_O + (size_t)h * 64 * RA, row); }
        else if (task < 20) { const int hm = task - 12; norm_task<64, 64, 0>(z + 768 + 64 * hm, z, p.in[8] + l * 64, QS, QKV + QB_O + ((size_t)hm * RA + row) * 64, 0.f, 0.f); }
        else if (task < 28) { const int hm = task - 20; norm_task<64, 64, 0>(z + 1280 + 64 * hm, z, p.in[9] + l * 64, 1.f, QKV + KB_O + ((size_t)hm * RA + row) * 64, 0.f, 0.f); }
        else if (task < 32) { const int h = task - 28; transpose_task<128>(z + 1792 + 128 * h, QKV + VB_O + (size_t)h * 128 * RA, row); }
        else if (task == 32) { norm_task<256, 256, 0>(z + 2304, z, p.in[15] + l * 256, 1.f, CQN + (size_t)row * 256, 0.f, 0.f); }
        else { norm_task<128, 128, 0>(z + 2560, z, p.in[17] + l * 128, 1.f, CKVN + (size_t)row * 128, 0.f, 0.f);
#pragma unroll
            for (int c = 0; c < 8; ++c) *(u32x4*)(KPE + (size_t)row * 64 + 8 * c) = *(const u32x4*)(z + 2688 + 8 * c); }
    }
}
DI void ew2_phase(const Params& p, const Chunk& ck, int l, int gw, int NGW, int lane) {
    unsigned char* ws = p.ws; asm volatile("" : "+s"(ws));
    const bf16_t* QCR = (const bf16_t*)(ws + WS_ZM + OFF_QCR); const bf16_t* KVR = (const bf16_t*)(ws + WS_ZM + OFF_KVR); const bf16_t* KPE = (const bf16_t*)(ws + WS_SM + SM_KPE);
    bf16_t* QKV = (bf16_t*)(ws + WS_QKV);
    const int nrb = ck.rows() / 64; const float QS = 0.07216878364870322f * LOG2E;
    for (int w = gw; w < nrb * 12; w += NGW) {
        const int rb = w / 12, task = w % 12, row = rb * 64 + lane; const RowPos ps = row_pos(ck, row);
        if (task < 4) { const int h = task; norm_task<192, 192, 2>(QCR + (size_t)row * 768 + 192 * h, QCR, p.in[19] + l * 192, QS, QKV + QC_O + ((size_t)h * RA + row) * 192, ps.lin, 0.f); }
        else if (task < 8) { const int h = task - 4; norm_task<192, 128, 2>(KVR + (size_t)row * 1024 + 256 * h, KPE + (size_t)row * 64, p.in[20] + l * 192, 1.f, QKV + KC_O + ((size_t)h * RA + row) * 192, ps.lin, 0.f); }
        else { const int h = task - 8; transpose_task<128>(KVR + (size_t)row * 1024 + 256 * h + 128, QKV + VC_O + (size_t)h * 128 * RA, row); }
    }
}
DI void ew3_phase(const Params& p, const Chunk& ck, int l, bool last, int gw, int NGW, int lane) {
    unsigned char* ws = p.ws; asm volatile("" : "+s"(ws));
    bf16_t* O1 = (bf16_t*)(ws + WS_ZM) + 1 * OSLOT; const bf16_t* O2 = (const bf16_t*)(ws + WS_ZM) + 3 * OSLOT;
    const float d1 = wave_sum(p.in[10][l * 64 + lane] * p.in[11][l * 64 + lane], lane), d2 = wave_sum(p.in[12][l * 64 + lane] * p.in[13][l * 64 + lane], lane);
    int lz = l; asm volatile("" : "+s"(lz));
    const float lam_init = __uint_as_float(lz == 0 ? 0x3e4ccccdu : 0x3eb60549u)  , lam = expf(d1) - expf(d2) + lam_init, osc = 1.f - lam_init;
    const float* gs = p.in[14] + l * 128;
    const int nrb = ck.rows() / 64;
    for (int w = gw; w < nrb * 4; w += NGW) {
        const int rb = w >> 2, h = w & 3, row = rb * 64 + lane;
        if (last && (row >= ck.rows_per_seq() ? row - ck.rows_per_seq() : row) >= (ck.tps - 1) * 256) continue;
        bf16_t* a = O1 + (size_t)row * 512 + 128 * h; const bf16_t* b = O2 + (size_t)row * 512 + 128 * h;
        float ss = 0.f;
#pragma unroll 2
        for (int c = 0; c < 16; ++c) { float x[8], y[8]; ld8(a + 8 * c, x); ld8(b + 8 * c, y);
#pragma unroll
            for (int e = 0; e < 8; ++e) { const float d = x[e] - lam * y[e]; ss += d * d; } }
        const float rs = rsqrtf(ss * (1.f / 128.f) + 1e-6f) * osc;
#pragma unroll 2
        for (int c = 0; c < 16; ++c) { float x[8], y[8]; ld8(a + 8 * c, x); ld8(b + 8 * c, y);
#pragma unroll
            for (int e = 0; e < 8; ++e) x[e] = (x[e] - lam * y[e]) * rs * gs[8 * c + e];
            st8(a + 8 * c, x); }
    }
}

template <int DQK, int DV, bool ALIBI, bool PIPE>
DI void attn_unit(LAS unsigned char* lds, const bf16_t* __restrict__ Q, const bf16_t* __restrict__ K, const bf16_t* __restrict__ Vt, bf16_t* __restrict__ O, int r0, int qb, int n, float sl, const int wid, const int dkeys = 0x3fffffff, const float mref = 0.f) {
    constexpr bool FIXEDREF = !PIPE;
    constexpr bool EARLYV = true;
    constexpr bool NEGM = true;
    constexpr int KROW = DQK * 2 + 16, KT = 64 * KROW, VROW = 144, VT = DV * VROW, KCH = DQK / 8, NKC = 64 * KCH / 512, NVC = DV * 8 / 512, NKS = DQK / 16, NDB = DV / 32, VB0 = 2 * KT;
    typedef const __attribute__((address_space(1))) u32x4* gptr;
    const int lane = lane_fresh(), tid = wid * 64 + lane, r = lane & 31, h = lane >> 5;
    const int nk = n + 16, NT = (nk + 63) >> 6;
    const int li = qb * 256 + wid * 32 + r;
    const int tq = ALIBI ? ((4 * qb + 3 < NT - 1) ? 4 * qb + 3 : NT - 1) : -1;
    int tlo = 0, thi = NT - 2, NIT = NT;
    if (ALIBI && qb * 256 < n) {
        const int x = qb * 256 + 16 - dkeys - 79, y = qb * 256 + 255 + 16 + dkeys - 16;
        tlo = x > 0 ? (x + 63) >> 6 : 0; if (tlo > tq) tlo = tq;
        thi = (y >> 6) < NT - 2 ? (y >> 6) : NT - 2; if (thi < tq) thi = tq;
        NIT = (tq - tlo + 1) + (thi - tq) + 1;
    }
    const int nleft = tq - tlo + 1;
#define TILE(j) (ALIBI ? ((j) < nleft ? tq - (j) : (tq + 1 + (j) - nleft <= thi ? tq + 1 + (j) - nleft : NT - 1)) : (j))
    const bool active = (qb * 256 + wid * 32) < nk;
    const bool wreal = (qb * 256 + wid * 32 + 31) < n;
    const int qminw = qb * 256 + wid * 32 + 16;
    const int qrow = r0 + li;
    const float qlin = (li < n) ? (float)(li + 16) : (li < nk ? (float)(li - n) : 0.f);
    bf16x8 qf[NKS];
#pragma unroll
    for (int ks = 0; ks < NKS; ++ks) qf[ks] = *(const bf16x8*)(Q + (size_t)qrow * DQK + ks * 16 + h * 8);
    f32x16 o[NDB];
#pragma unroll
    for (int d = 0; d < NDB; ++d)
#pragma unroll
        for (int i = 0; i < 16; ++i) o[d][i] = 0.f;
    float m = FIXEDREF ? mref : 0.f, l = 0.f; f32x16 negm, zero16;
#pragma unroll
    for (int i = 0; i < 16; ++i) { negm[i] = FIXEDREF ? -mref : 0.f; zero16[i] = 0.f; }
    const bf16_t* kg0 = K + (size_t)r0 * DQK + tid * 8; const bf16_t* vg0 = Vt + (size_t)(tid >> 3) * RA + r0 + (tid & 7) * 8; const int vl0 = VB0 + (tid >> 3) * VROW + (tid & 7) * 16;
#define KL(i) ((((tid + 512 * (i)) / KCH) * KROW) + ((tid + 512 * (i)) % KCH) * 16)
#define KG(i, t) ((gptr)(kg0 + (i) * 4096 + (size_t)(t) * 64 * DQK))
#define VG(i, t) ((gptr)(vg0 + (size_t)(i) * 64 * RA + (size_t)(t) * 64))
#define VL(i) (vl0 + (i) * 64 * VROW)
    const int pr = (r & ~12) | ((r & 4) << 1) | ((r & 8) >> 1);
    const int kaddr = pr * KROW + h * 16, vaddr = VB0 + r * VROW + h * 16;
    u32x4 kst[NKC], vst[NVC], kstn[NKC], vstn[NVC];
#define QK_TILE(A0, A1, kb_) do { const int ko_ = (kb_) * KT + kaddr; \
        _Pragma("unroll") for (int kb4 = 0; kb4 < NKS; kb4 += 4) { bf16x8 kq[8]; \
            _Pragma("unroll") for (int j = 0; j < 4; ++j) { kq[2 * j] = *(const LAS bf16x8*)(lds + ko_ + (kb4 + j) * 32); kq[2 * j + 1] = *(const LAS bf16x8*)(lds + ko_ + 32 * KROW + (kb4 + j) * 32); } \
            asm volatile("" : "+v"(kq[0]), "+v"(kq[1]), "+v"(kq[2]), "+v"(kq[3]), "+v"(kq[4]), "+v"(kq[5]), "+v"(kq[6]), "+v"(kq[7]));     \
            _Pragma("unroll") for (int j = 0; j < 4; ++j) { \
                if (kb4 + j == 0) { A0 = __builtin_amdgcn_mfma_f32_32x32x16_bf16(kq[0], qf[0], ct0, 0, 0, 0); A1 = __builtin_amdgcn_mfma_f32_32x32x16_bf16(kq[1], qf[0], ct1, 0, 0, 0); } \
                else { A0 = __builtin_amdgcn_mfma_f32_32x32x16_bf16(kq[2 * j], qf[kb4 + j], A0, 0, 0, 0); A1 = __builtin_amdgcn_mfma_f32_32x32x16_bf16(kq[2 * j + 1], qf[kb4 + j], A1, 0, 0, 0); } } \
            __builtin_amdgcn_sched_barrier(0); } } while (0)
#pragma unroll
    for (int i = 0; i < NKC; ++i) kst[i] = *KG(i, TILE(0));
#pragma unroll
    for (int i = 0; i < NVC; ++i) vst[i] = *VG(i, TILE(0));
#pragma unroll
    for (int i = 0; i < NKC; ++i) *(LAS u32x4*)(lds + KL(i)) = kst[i];
#pragma unroll
    for (int i = 0; i < NVC; ++i) *(LAS u32x4*)(lds + VL(i)) = vst[i];
    if constexpr (PIPE) {
#pragma unroll
        for (int i = 0; i < NKC; ++i) kst[i] = *KG(i, 1);
#pragma unroll
        for (int i = 0; i < NKC; ++i) *(LAS u32x4*)(lds + KT + KL(i)) = kst[i];
#pragma unroll
        for (int i = 0; i < NKC; ++i) kst[i] = *KG(i, 2);
#pragma unroll
        for (int i = 0; i < NVC; ++i) vst[i] = *VG(i, 1);
    }
    __syncthreads();
    f32x16 s0, s1, n0, n1;
    if constexpr (PIPE) { f32x16 ct0 = negm, ct1 = negm; QK_TILE(s0, s1, 0); __syncthreads(); }
    for (int jt = 0; jt < NIT; ++jt) {
        const int t = PIPE ? jt : TILE(jt), tn = TILE(jt + 1);
        const int cb = jt & 1;
        const bool moreV = (jt + 1 < NIT), moreK = PIPE ? (jt + 2 < NIT) : moreV;
        if constexpr (PIPE) {
            if (t + 3 < NT) {
#pragma unroll
                for (int i = 0; i < NKC; ++i) kstn[i] = *KG(i, t + 3);
            }
            if (t + 2 < NT) {
#pragma unroll
                for (int i = 0; i < NVC; ++i) vstn[i] = *VG(i, t + 2);
            }
        } else {
            if (moreK) {
#pragma unroll
                for (int i = 0; i < NKC; ++i) kst[i] = *KG(i, tn);
            }
            if (moreV) {
#pragma unroll
                for (int i = 0; i < NVC; ++i) vst[i] = *VG(i, tn);
            }
#ifdef PROBE_MEM2
            { int zo = 0; asm volatile("" : "+v"(zo));
              if (moreK) {
#pragma unroll
                for (int i = 0; i < NKC; ++i) { u32x4 d = *(KG(i, t + 1) + zo); asm volatile("" :: "v"(d)); } }
              if (moreV) {
#pragma unroll
                for (int i = 0; i < NVC; ++i) { u32x4 d = *(VG(i, t + 1) + zo); asm volatile("" :: "v"(d)); } } }
#endif
        }
        if (active) {
        f32x16 ct0 = negm, ct1 = negm; int side = 0;
        if constexpr (ALIBI) {
            if (t < NT - 1 && wreal) { if (t * 64 + 79 <= qminw) side = 1; else if (t * 64 + 16 >= qminw + 31) side = -1; }
            if (side != 0) { const float ssl = side > 0 ? sl : -sl, A_ = ssl * ((float)(t * 64 + 16 + 8 * h) - qlin) - mref;
#pragma unroll
                for (int i = 0; i < 16; ++i) { ct0[i] = __builtin_fmaf(ssl, (float)(16 * (i >> 3) + (i & 7)), A_); ct1[i] = ct0[i] + 32.f * ssl; } }
        }
        if constexpr (PIPE) { if (moreV) QK_TILE(n0, n1, cb ^ 1); }
        else QK_TILE(s0, s1, cb);
        bf16x8 vf0[8];
        if constexpr (EARLYV) {
#pragma unroll
            for (int j = 0; j < 8; ++j) vf0[j] = *(const LAS bf16x8*)(lds + cb * VT + vaddr + (j >> 2) * 32 * VROW + (j & 3) * 32);
        }
        if (t < NT - 1) {
            if constexpr (ALIBI) if (side == 0) {
                const float qo = qlin - (float)(16 + 8 * h + t * 64);
#pragma unroll
                for (int i = 0; i < 16; ++i) { const float ci = (float)(16 * (i >> 3) + (i & 7)); s0[i] = __builtin_fmaf(-sl, __builtin_fabsf(qo - ci), s0[i]); s1[i] = __builtin_fmaf(-sl, __builtin_fabsf(qo - 32.f - ci), s1[i]); }
            }
        } else {
#pragma unroll
            for (int i = 0; i < 16; ++i) { const int kk = 16 * (i >> 3) + 8 * h + (i & 7);
                if (kk < 16) { if constexpr (ALIBI) s0[i] = __builtin_fmaf(-sl, __builtin_fabsf(qlin - (float)kk), s0[i]); } else s0[i] = -1e30f;
                s1[i] = -1e30f; }
        }
        if constexpr (!FIXEDREF) {
        float mx;
        { float a = MX2(s0[0], s1[0]), b = MX2(s0[1], s1[1]);
#pragma unroll
          for (int i = 2; i < 16; i += 2) { a = MX2(a, MX2(s0[i], s1[i])); b = MX2(b, MX2(s0[i + 1], s1[i + 1])); }
          mx = swap32_max(MX2(a, b)); }
        if constexpr (!NEGM) mx -= m;
        if (__builtin_expect(jt == 0 || __builtin_amdgcn_ballot_w64(mx > 8.f) != 0ull, 0)) {
            const float dl = (jt == 0) ? mx : fmaxf(mx, 0.f);
            m += dl;
            if constexpr (NEGM) {
#pragma unroll
                for (int i = 0; i < 16; ++i) { s0[i] -= dl; s1[i] -= dl; negm[i] = -m; } }
            if constexpr (PIPE) {
#pragma unroll
                for (int i = 0; i < 16; ++i) { n0[i] -= dl; n1[i] -= dl; } }
            if (jt != 0) { const float f = __builtin_amdgcn_exp2f(-dl); l *= f;
#pragma unroll
                for (int d = 0; d < NDB; ++d)
#pragma unroll
                    for (int i = 0; i < 16; ++i) o[d][i] *= f; }
            asm volatile("" ::: "memory");
        }
        }
        float ra = 0.f, rb = 0.f;
#pragma unroll
        for (int i = 0; i < 16; ++i) { s0[i] = __builtin_amdgcn_exp2f(NEGM ? s0[i] : s0[i] - m); s1[i] = __builtin_amdgcn_exp2f(NEGM ? s1[i] : s1[i] - m); ra += s0[i]; rb += s1[i]; }
        l += ra + rb;
        bf16x8 pf[4];
        { u32x4 w;
          w.x = pk2(s0[0], s0[1]); w.y = pk2(s0[2], s0[3]); w.z = pk2(s0[4], s0[5]); w.w = pk2(s0[6], s0[7]); pf[0] = __builtin_bit_cast(bf16x8, w);
          w.x = pk2(s0[8], s0[9]); w.y = pk2(s0[10], s0[11]); w.z = pk2(s0[12], s0[13]); w.w = pk2(s0[14], s0[15]); pf[1] = __builtin_bit_cast(bf16x8, w);
          w.x = pk2(s1[0], s1[1]); w.y = pk2(s1[2], s1[3]); w.z = pk2(s1[4], s1[5]); w.w = pk2(s1[6], s1[7]); pf[2] = __builtin_bit_cast(bf16x8, w);
          w.x = pk2(s1[8], s1[9]); w.y = pk2(s1[10], s1[11]); w.z = pk2(s1[12], s1[13]); w.w = pk2(s1[14], s1[15]); pf[3] = __builtin_bit_cast(bf16x8, w); }
#pragma unroll
        for (int d0 = 0; d0 < NDB; d0 += 2) { bf16x8 vf[8];
#pragma unroll
            for (int j = 0; j < 8; ++j) { if (EARLYV && d0 == 0) vf[j] = vf0[j]; else vf[j] = *(const LAS bf16x8*)(lds + cb * VT + vaddr + (d0 + (j >> 2)) * 32 * VROW + (j & 3) * 32); }
            asm volatile("" : "+v"(vf[0]), "+v"(vf[1]), "+v"(vf[2]), "+v"(vf[3]), "+v"(vf[4]), "+v"(vf[5]), "+v"(vf[6]), "+v"(vf[7]));
#pragma unroll
            for (int j = 0; j < 8; ++j) o[d0 + (j >> 2)] = __builtin_amdgcn_mfma_f32_32x32x16_bf16(vf[j], pf[j & 3], o[d0 + (j >> 2)], 0, 0, 0);
            __builtin_amdgcn_sched_barrier(0); }
        }
        if (moreK) {
#pragma unroll
            for (int i = 0; i < NKC; ++i) *(LAS u32x4*)(lds + (PIPE ? cb : (cb ^ 1)) * KT + KL(i)) = kst[i];
        }
        if (moreV) {
#pragma unroll
            for (int i = 0; i < NVC; ++i) *(LAS u32x4*)(lds + (cb ^ 1) * VT + VL(i)) = vst[i];
        }
        asm volatile("s_waitcnt lgkmcnt(0)" ::: "memory"); __builtin_amdgcn_s_barrier(); asm volatile("" ::: "memory");
        if constexpr (PIPE) { s0 = n0; s1 = n1;
#pragma unroll
            for (int i = 0; i < NKC; ++i) kst[i] = kstn[i];
#pragma unroll
            for (int i = 0; i < NVC; ++i) vst[i] = vstn[i]; }
    }
    l = swap32_add(l);
    const float il = 1.f / l;
    bf16_t* orow = O + (size_t)qrow * 512;
    if (active)
#pragma unroll
    for (int d = 0; d < NDB; ++d)
#pragma unroll
        for (int g = 0; g < 4; ++g) { u32x2 w; w.x = pk2(o[d][4 * g] * il, o[d][4 * g + 1] * il); w.y = pk2(o[d][4 * g + 2] * il, o[d][4 * g + 3] * il);
            *(u32x2*)(orow + 32 * d + 8 * g + 4 * h) = w; }
#undef KG
#undef KL
#undef VG
#undef VL
#undef QK_TILE
#undef TILE
}

template <int DV, bool ALIBI>
DI void attn_unit2(LAS unsigned char* lds, const bf16_t* __restrict__ Q, const bf16_t* __restrict__ K, const bf16_t* __restrict__ Vt, bf16_t* __restrict__ O, int r0, int qb, int n, float sl, const int wid) {
    constexpr int DQK = 64, KROW = DQK * 2 + 16, KT = 64 * KROW, VROW = 144, VT = DV * VROW, NVC = DV * 8 / 512, NKS = 4, NDB = DV / 32, VB0 = 2 * KT;
    typedef const __attribute__((address_space(1))) u32x4* gptr;
    const int lane = lane_fresh(), tid = wid * 64 + lane, r = lane & 31, h = lane >> 5;
    const int nk = n + 16, NT = (nk + 63) >> 6;
    const int li = qb * 256 + wid * 32 + r;
    const int qrow = r0 + li;
    const float qlin = (li < n) ? (float)(li + 16) : (li < nk ? (float)(li - n) : 0.f);
    bf16x8 qf[NKS];
#pragma unroll
    for (int ks = 0; ks < NKS; ++ks) qf[ks] = *(const bf16x8*)(Q + (size_t)qrow * DQK + ks * 16 + h * 8);
    f32x16 o[NDB];
#pragma unroll
    for (int d = 0; d < NDB; ++d)
#pragma unroll
        for (int i = 0; i < 16; ++i) o[d][i] = 0.f;
    float m = 0.f, l = 0.f; f32x16 negm;
#pragma unroll
    for (int i = 0; i < 16; ++i) negm[i] = 0.f;
    const bf16_t* kg0 = K + (size_t)r0 * DQK + tid * 8; const bf16_t* vg0 = Vt + (size_t)(tid >> 3) * RA + r0 + (tid & 7) * 8;
    const int kl0 = (tid >> 3) * KROW + (tid & 7) * 16, vl0 = VB0 + (tid >> 3) * VROW + (tid & 7) * 16;
#define KG2(t) ((gptr)(kg0 + (size_t)(t) * 64 * DQK))
#define VG2(i, t) ((gptr)(vg0 + (size_t)(i) * 64 * RA + (size_t)(t) * 64))
    const int pr = (r & ~12) | ((r & 4) << 1) | ((r & 8) >> 1);
    const int kaddr = pr * KROW + h * 16, vaddr = VB0 + r * VROW + h * 16;
    u32x4 kst, vst[NVC];
    bf16x8 kf[8];
#define LDK(kb_) do { _Pragma("unroll") for (int ks = 0; ks < 4; ++ks) { kf[2 * ks] = *(const LAS bf16x8*)(lds + (kb_) * KT + kaddr + ks * 32); kf[2 * ks + 1] = *(const LAS bf16x8*)(lds + (kb_) * KT + kaddr + 32 * KROW + ks * 32); } \
        asm volatile("" : "+v"(kf[0]), "+v"(kf[1]), "+v"(kf[2]), "+v"(kf[3]), "+v"(kf[4]), "+v"(kf[5]), "+v"(kf[6]), "+v"(kf[7])); } while (0)
#define QKM(A0, A1) do { A0 = __builtin_amdgcn_mfma_f32_32x32x16_bf16(kf[0], qf[0], negm, 0, 0, 0); A1 = __builtin_amdgcn_mfma_f32_32x32x16_bf16(kf[1], qf[0], negm, 0, 0, 0); \
        _Pragma("unroll") for (int ks = 1; ks < 4; ++ks) { A0 = __builtin_amdgcn_mfma_f32_32x32x16_bf16(kf[2 * ks], qf[ks], A0, 0, 0, 0); A1 = __builtin_amdgcn_mfma_f32_32x32x16_bf16(kf[2 * ks + 1], qf[ks], A1, 0, 0, 0); } } while (0)
#define PV2(vb_, d0_) do { bf16x8 vf[8]; \
        _Pragma("unroll") for (int j = 0; j < 8; ++j) vf[j] = *(const LAS bf16x8*)(lds + (vb_) * VT + vaddr + ((d0_) + (j >> 2)) * 32 * VROW + (j & 3) * 32); \
        asm volatile("" : "+v"(vf[0]), "+v"(vf[1]), "+v"(vf[2]), "+v"(vf[3]), "+v"(vf[4]), "+v"(vf[5]), "+v"(vf[6]), "+v"(vf[7])); \
        _Pragma("unroll") for (int j = 0; j < 8; ++j) o[(d0_) + (j >> 2)] = __builtin_amdgcn_mfma_f32_32x32x16_bf16(vf[j], pf[j & 3], o[(d0_) + (j >> 2)], 0, 0, 0); } while (0)
    kst = *KG2(0);
#pragma unroll
    for (int i = 0; i < NVC; ++i) vst[i] = *VG2(i, 0);
    *(LAS u32x4*)(lds + kl0) = kst;
#pragma unroll
    for (int i = 0; i < NVC; ++i) *(LAS u32x4*)(lds + vl0 + i * 64 * VROW) = vst[i];
    kst = *KG2(1);
    *(LAS u32x4*)(lds + KT + kl0) = kst;
    __syncthreads();
    f32x16 s0, s1, n0, n1;
    bf16x8 pf[4];
    LDK(0); QKM(s0, s1);
    __syncthreads();
    int vcur = 0;
    for (int t = 0; t < NT; ++t) {
        const int cb = t & 1;
        const bool moreV = (t + 1 < NT), moreK = (t + 2 < NT);
        const int vprev = (vcur == 0) ? 2 : vcur - 1, vnext = (vcur == 2) ? 0 : vcur + 1;
        if (moreK) kst = *KG2(t + 2);
        if (moreV) {
#pragma unroll
            for (int i = 0; i < NVC; ++i) vst[i] = *VG2(i, t + 1);
        }
#ifdef PROBE_MEM2
        { int zo = 0; asm volatile("" : "+v"(zo));
          if (moreK) { u32x4 d = *(KG2(t + 2) + zo); asm volatile("" :: "v"(d)); }
          if (moreV) {
#pragma unroll
            for (int i = 0; i < NVC; ++i) { u32x4 d = *(VG2(i, t + 1) + zo); asm volatile("" :: "v"(d)); } } }
#endif
        __builtin_amdgcn_s_setprio(1);
        if (moreV) { LDK(cb ^ 1); QKM(n0, n1); }
        if (t > 0) { PV2(vprev, 0); if constexpr (NDB == 4) PV2(vprev, 2); }
        __builtin_amdgcn_s_setprio(0);
        if (t < NT - 1) {
            if constexpr (ALIBI) {
                const float qo = qlin - (float)(16 + 8 * h + t * 64);
#pragma unroll
                for (int i = 0; i < 16; ++i) { const float ci = (float)(16 * (i >> 3) + (i & 7)); s0[i] = __builtin_fmaf(-sl, __builtin_fabsf(qo - ci), s0[i]); s1[i] = __builtin_fmaf(-sl, __builtin_fabsf(qo - 32.f - ci), s1[i]); }
            }
        } else {
#pragma unroll
            for (int i = 0; i < 16; ++i) { const int kk = 16 * (i >> 3) + 8 * h + (i & 7);
                if (kk < 16) { if constexpr (ALIBI) s0[i] = __builtin_fmaf(-sl, __builtin_fabsf(qlin - (float)kk), s0[i]); } else s0[i] = -1e30f;
                s1[i] = -1e30f; }
        }
        float mx;
        { float a = MX2(s0[0], s1[0]), b = MX2(s0[1], s1[1]);
#pragma unroll
          for (int i = 2; i < 16; i += 2) { a = MX2(a, MX2(s0[i], s1[i])); b = MX2(b, MX2(s0[i + 1], s1[i + 1])); }
          mx = swap32_max(MX2(a, b)); }
        if (__builtin_expect(t == 0 || __builtin_amdgcn_ballot_w64(mx > 8.f) != 0ull, 0)) {
            const float dl = (t == 0) ? mx : fmaxf(mx, 0.f);
            m += dl;
#pragma unroll
            for (int i = 0; i < 16; ++i) { s0[i] -= dl; s1[i] -= dl; n0[i] -= dl; n1[i] -= dl; negm[i] = -m; }
            if (t != 0) { const float f = __builtin_amdgcn_exp2f(-dl); l *= f;
#pragma unroll
                for (int d = 0; d < NDB; ++d)
#pragma unroll
                    for (int i = 0; i < 16; ++i) o[d][i] *= f; }
            asm volatile("" ::: "memory");
        }
        float ra = 0.f, rb = 0.f;
#pragma unroll
        for (int i = 0; i < 16; ++i) { s0[i] = __builtin_amdgcn_exp2f(s0[i]); s1[i] = __builtin_amdgcn_exp2f(s1[i]); ra += s0[i]; rb += s1[i]; }
        l += ra + rb;
        { u32x4 w;
          w.x = pk2(s0[0], s0[1]); w.y = pk2(s0[2], s0[3]); w.z = pk2(s0[4], s0[5]); w.w = pk2(s0[6], s0[7]); pf[0] = __builtin_bit_cast(bf16x8, w);
          w.x = pk2(s0[8], s0[9]); w.y = pk2(s0[10], s0[11]); w.z = pk2(s0[12], s0[13]); w.w = pk2(s0[14], s0[15]); pf[1] = __builtin_bit_cast(bf16x8, w);
          w.x = pk2(s1[0], s1[1]); w.y = pk2(s1[2], s1[3]); w.z = pk2(s1[4], s1[5]); w.w = pk2(s1[6], s1[7]); pf[2] = __builtin_bit_cast(bf16x8, w);
          w.x = pk2(s1[8], s1[9]); w.y = pk2(s1[10], s1[11]); w.z = pk2(s1[12], s1[13]); w.w = pk2(s1[14], s1[15]); pf[3] = __builtin_bit_cast(bf16x8, w); }
        if (moreK) *(LAS u32x4*)(lds + cb * KT + kl0) = kst;
        if (moreV) {
#pragma unroll
            for (int i = 0; i < NVC; ++i) *(LAS u32x4*)(lds + vnext * VT + vl0 + i * 64 * VROW) = vst[i];
        }
        asm volatile("s_waitcnt lgkmcnt(0)" ::: "memory"); __builtin_amdgcn_s_barrier(); asm volatile("" ::: "memory");
        s0 = n0; s1 = n1; vcur = vnext;
    }
    { const int vlast = (vcur == 0) ? 2 : vcur - 1; PV2(vlast, 0); if constexpr (NDB == 4) PV2(vlast, 2); }
    asm volatile("s_waitcnt lgkmcnt(0)" ::: "memory"); __builtin_amdgcn_s_barrier(); asm volatile("" ::: "memory");
    l = swap32_add(l);
    const float il = 1.f / l;
    bf16_t* orow = O + (size_t)qrow * 512;
#pragma unroll
    for (int d = 0; d < NDB; ++d)
#pragma unroll
        for (int g = 0; g < 4; ++g) { u32x2 w; w.x = pk2(o[d][4 * g] * il, o[d][4 * g + 1] * il); w.y = pk2(o[d][4 * g + 2] * il, o[d][4 * g + 3] * il);
            *(u32x2*)(orow + 32 * d + 8 * g + 4 * h) = w; }
#undef KG2
#undef VG2
#undef LDK
#undef QKM
#undef PV2
}


template <int DQK, int DV, bool ALIBI>
DI void attn_unit_s(LAS unsigned char* lds, const bf16_t* __restrict__ Q, const bf16_t* __restrict__ K, const bf16_t* __restrict__ Vt, bf16_t* __restrict__ O, int r0, int qb, int n, float sl, const int wid) {
    constexpr bool NEGM = (DQK == 64);
    constexpr int KROW = DQK * 2 + 16, KT = 64 * KROW, VROW = 144, VT = DV * VROW, KCH = DQK / 8, NKC = 64 * KCH / 512, NVC = DV * 8 / 512, NKS = DQK / 16, NDB = DV / 32, VB0 = 2 * KT;
    typedef const __attribute__((address_space(1))) u32x4* gptr;
#define LBAR() do { asm volatile("s_waitcnt lgkmcnt(0)" ::: "memory"); __builtin_amdgcn_s_barrier(); asm volatile("" ::: "memory"); } while (0)
#ifdef GRP_ODD
    const int grp_ = wid & 1;
#else
    const int grp_ = wid >> 2;
#endif
    const int lane = lane_fresh(), tid = wid * 64 + lane, r = lane & 31, h = lane >> 5, grp = grp_;
    const int nk = n + 16, NT = (nk + 63) >> 6;
    const int li = qb * 256 + wid * 32 + r;
    const int qrow = r0 + li;
    const float qlin = (li < n) ? (float)(li + 16) : (li < nk ? (float)(li - n) : 0.f);
    bf16x8 qf[NKS];
#pragma unroll
    for (int ks = 0; ks < NKS; ++ks) qf[ks] = *(const bf16x8*)(Q + (size_t)qrow * DQK + ks * 16 + h * 8);
    f32x16 o[NDB];
#pragma unroll
    for (int d = 0; d < NDB; ++d)
#pragma unroll
        for (int i = 0; i < 16; ++i) o[d][i] = 0.f;
    float m = 0.f, l = 0.f; f32x16 negm, zero16;
#pragma unroll
    for (int i = 0; i < 16; ++i) { negm[i] = 0.f; zero16[i] = 0.f; }
    const bf16_t* kg0 = K + (size_t)r0 * DQK + tid * 8; const bf16_t* vg0 = Vt + (size_t)(tid >> 3) * RA + r0 + (tid & 7) * 8; const int vl0 = VB0 + (tid >> 3) * VROW + (tid & 7) * 16;
#define KL(i) ((((tid + 512 * (i)) / KCH) * KROW) + ((tid + 512 * (i)) % KCH) * 16)
#define KG(i, t) ((gptr)(kg0 + (i) * 4096 + (size_t)(t) * 64 * DQK))
#define VG(i, t) ((gptr)(vg0 + (size_t)(i) * 64 * RA + (size_t)(t) * 64))
#define VL(i) (vl0 + (i) * 64 * VROW)
    const int pr = (r & ~12) | ((r & 4) << 1) | ((r & 8) >> 1);
    const int kaddr = pr * KROW + h * 16, vaddr = VB0 + r * VROW + h * 16;
    u32x4 kst[NKC], vst[NVC];
#pragma unroll
    for (int i = 0; i < NKC; ++i) kst[i] = *KG(i, 0);
#pragma unroll
    for (int i = 0; i < NKC; ++i) *(LAS u32x4*)(lds + KL(i)) = kst[i];
#pragma unroll
    for (int i = 0; i < NKC; ++i) kst[i] = *KG(i, 1);
#pragma unroll
    for (int i = 0; i < NVC; ++i) vst[i] = *VG(i, 0);
    __syncthreads();
    if (grp == 1) LBAR();
    f32x16 s0, s1; bf16x8 pf[4];
    for (int t = 0; t < NT; ++t) {
        const int cb = t & 1;
        { const int ko_ = cb * KT + kaddr;
#pragma unroll
          for (int kb4 = 0; kb4 < NKS; kb4 += 4) { bf16x8 kq[8];
#pragma unroll
            for (int j = 0; j < 4; ++j) { kq[2 * j] = *(const LAS bf16x8*)(lds + ko_ + (kb4 + j) * 32); kq[2 * j + 1] = *(const LAS bf16x8*)(lds + ko_ + 32 * KROW + (kb4 + j) * 32); }
            asm volatile("" : "+v"(kq[0]), "+v"(kq[1]), "+v"(kq[2]), "+v"(kq[3]), "+v"(kq[4]), "+v"(kq[5]), "+v"(kq[6]), "+v"(kq[7]));
#pragma unroll
            for (int j = 0; j < 4; ++j) {
                if (kb4 + j == 0) { s0 = __builtin_amdgcn_mfma_f32_32x32x16_bf16(kq[0], qf[0], NEGM ? negm : zero16, 0, 0, 0); s1 = __builtin_amdgcn_mfma_f32_32x32x16_bf16(kq[1], qf[0], NEGM ? negm : zero16, 0, 0, 0); }
                else { s0 = __builtin_amdgcn_mfma_f32_32x32x16_bf16(kq[2 * j], qf[kb4 + j], s0, 0, 0, 0); s1 = __builtin_amdgcn_mfma_f32_32x32x16_bf16(kq[2 * j + 1], qf[kb4 + j], s1, 0, 0, 0); } }
            __builtin_amdgcn_sched_barrier(0); } }
        if (t > 0) {
#pragma unroll
            for (int d0 = 0; d0 < NDB; d0 += 2) { bf16x8 vf[8];
#pragma unroll
                for (int j = 0; j < 8; ++j) vf[j] = *(const LAS bf16x8*)(lds + (cb ^ 1) * VT + vaddr + (d0 + (j >> 2)) * 32 * VROW + (j & 3) * 32);
                asm volatile("" : "+v"(vf[0]), "+v"(vf[1]), "+v"(vf[2]), "+v"(vf[3]), "+v"(vf[4]), "+v"(vf[5]), "+v"(vf[6]), "+v"(vf[7]));
#pragma unroll
                for (int j = 0; j < 8; ++j) o[d0 + (j >> 2)] = __builtin_amdgcn_mfma_f32_32x32x16_bf16(vf[j], pf[j & 3], o[d0 + (j >> 2)], 0, 0, 0);
                __builtin_amdgcn_sched_barrier(0); }
        }
        if (t + 1 < NT) {
#pragma unroll
            for (int i = 0; i < NKC; ++i) *(LAS u32x4*)(lds + (cb ^ 1) * KT + KL(i)) = kst[i];
        }
#pragma unroll
        for (int i = 0; i < NVC; ++i) *(LAS u32x4*)(lds + cb * VT + VL(i)) = vst[i];
        LBAR();
        if (t + 2 < NT) {
#pragma unroll
            for (int i = 0; i < NKC; ++i) kst[i] = *KG(i, t + 2);
        }
        if (t + 1 < NT) {
#pragma unroll
            for (int i = 0; i < NVC; ++i) vst[i] = *VG(i, t + 1);
        }
        if (t < NT - 1) {
            if constexpr (ALIBI) {
                const float qo = qlin - (float)(16 + 8 * h + t * 64);
#pragma unroll
                for (int i = 0; i < 16; ++i) { const float ci = (float)(16 * (i >> 3) + (i & 7)); s0[i] = __builtin_fmaf(-sl, __builtin_fabsf(qo - ci), s0[i]); s1[i] = __builtin_fmaf(-sl, __builtin_fabsf(qo - 32.f - ci), s1[i]); }
            }
        } else {
#pragma unroll
            for (int i = 0; i < 16; ++i) { const int kk = 16 * (i >> 3) + 8 * h + (i & 7);
                if (kk < 16) { if constexpr (ALIBI) s0[i] = __builtin_fmaf(-sl, __builtin_fabsf(qlin - (float)kk), s0[i]); } else s0[i] = -1e30f;
                s1[i] = -1e30f; }
        }
        float mx;
        { float a = MX2(s0[0], s1[0]), b = MX2(s0[1], s1[1]);
#pragma unroll
          for (int i = 2; i < 16; i += 2) { a = MX2(a, MX2(s0[i], s1[i])); b = MX2(b, MX2(s0[i + 1], s1[i + 1])); }
          mx = swap32_max(MX2(a, b)); }
        if constexpr (!NEGM) mx -= m;
        if (__builtin_expect(t == 0 || __builtin_amdgcn_ballot_w64(mx > 8.f) != 0ull, 0)) {
            const float dl = (t == 0) ? mx : fmaxf(mx, 0.f);
            m += dl;
            if constexpr (NEGM) {
#pragma unroll
                for (int i = 0; i < 16; ++i) { s0[i] -= dl; s1[i] -= dl; negm[i] = -m; } }
            if (t != 0) { const float f = __builtin_amdgcn_exp2f(-dl); l *= f;
#pragma unroll
                for (int d = 0; d < NDB; ++d)
#pragma unroll
                    for (int i = 0; i < 16; ++i) o[d][i] *= f; }
            asm volatile("" ::: "memory");
        }
        float ra = 0.f, rb = 0.f;
#pragma unroll
        for (int i = 0; i < 16; ++i) { s0[i] = __builtin_amdgcn_exp2f(NEGM ? s0[i] : s0[i] - m); s1[i] = __builtin_amdgcn_exp2f(NEGM ? s1[i] : s1[i] - m); ra += s0[i]; rb += s1[i]; }
        l += ra + rb;
        { u32x4 w;
          w.x = pk2(s0[0], s0[1]); w.y = pk2(s0[2], s0[3]); w.z = pk2(s0[4], s0[5]); w.w = pk2(s0[6], s0[7]); pf[0] = __builtin_bit_cast(bf16x8, w);
          w.x = pk2(s0[8], s0[9]); w.y = pk2(s0[10], s0[11]); w.z = pk2(s0[12], s0[13]); w.w = pk2(s0[14], s0[15]); pf[1] = __builtin_bit_cast(bf16x8, w);
          w.x = pk2(s1[0], s1[1]); w.y = pk2(s1[2], s1[3]); w.z = pk2(s1[4], s1[5]); w.w = pk2(s1[6], s1[7]); pf[2] = __builtin_bit_cast(bf16x8, w);
          w.x = pk2(s1[8], s1[9]); w.y = pk2(s1[10], s1[11]); w.z = pk2(s1[12], s1[13]); w.w = pk2(s1[14], s1[15]); pf[3] = __builtin_bit_cast(bf16x8, w); }
        LBAR();
    }
    { const int vb = (NT - 1) & 1;
#pragma unroll
      for (int d0 = 0; d0 < NDB; d0 += 2) { bf16x8 vf[8];
#pragma unroll
        for (int j = 0; j < 8; ++j) vf[j] = *(const LAS bf16x8*)(lds + vb * VT + vaddr + (d0 + (j >> 2)) * 32 * VROW + (j & 3) * 32);
        asm volatile("" : "+v"(vf[0]), "+v"(vf[1]), "+v"(vf[2]), "+v"(vf[3]), "+v"(vf[4]), "+v"(vf[5]), "+v"(vf[6]), "+v"(vf[7]));
#pragma unroll
        for (int j = 0; j < 8; ++j) o[d0 + (j >> 2)] = __builtin_amdgcn_mfma_f32_32x32x16_bf16(vf[j], pf[j & 3], o[d0 + (j >> 2)], 0, 0, 0); } }
    if (grp == 0) LBAR();
    LBAR();
    l = swap32_add(l);
    const float il = 1.f / l;
    bf16_t* orow = O + (size_t)qrow * 512;
#pragma unroll
    for (int d = 0; d < NDB; ++d)
#pragma unroll
        for (int g = 0; g < 4; ++g) { u32x2 w; w.x = pk2(o[d][4 * g] * il, o[d][4 * g + 1] * il); w.y = pk2(o[d][4 * g + 2] * il, o[d][4 * g + 3] * il);
            *(u32x2*)(orow + 32 * d + 8 * g + 4 * h) = w; }
#undef KG
#undef KL
#undef VG
#undef VL
#undef LBAR
}

DI void attn_unit_a64(LAS unsigned char* lds, const bf16_t* __restrict__ Q, const bf16_t* __restrict__ K, const bf16_t* __restrict__ Vt, bf16_t* __restrict__ O, int r0, int qb, int n, int seqrows, const int wid) {
    constexpr int DQK = 64, KROW = 144, KT = 64 * KROW, VROW = 144, VT = 64 * VROW, VB0 = 2 * KT;
    typedef const __attribute__((address_space(1))) u32x4* gptr;
    const int lane = lane_fresh(), tid = wid * 64 + lane, r = lane & 31, h = lane >> 5;
    const int nk = n + 16, NT = (nk + 63) >> 6;
    const int li0 = qb * 512 + wid * 64 + r, li1 = li0 + 32;
    bf16x8 qf0[4], qf1[4];
#pragma unroll
    for (int ks = 0; ks < 4; ++ks) { qf0[ks] = *(const bf16x8*)(Q + (size_t)(r0 + li0) * DQK + ks * 16 + h * 8); qf1[ks] = *(const bf16x8*)(Q + (size_t)(r0 + li1) * DQK + ks * 16 + h * 8); }
    f32x16 oa0, oa1, ob0, ob1, zero16;
#pragma unroll
    for (int i = 0; i < 16; ++i) { oa0[i] = 0.f; oa1[i] = 0.f; ob0[i] = 0.f; ob1[i] = 0.f; zero16[i] = 0.f; }
    float ma = 0.f, mb = 0.f, la = 0.f, lb = 0.f;
    const bf16_t* kg0 = K + (size_t)r0 * DQK + tid * 8; const bf16_t* vg0 = Vt + (size_t)(tid >> 3) * RA + r0 + (tid & 7) * 8;
    const int kl0 = (tid >> 3) * KROW + (tid & 7) * 16, vl0 = VB0 + (tid >> 3) * VROW + (tid & 7) * 16;
    const int pr = (r & ~12) | ((r & 4) << 1) | ((r & 8) >> 1);
    const int kaddr = pr * KROW + h * 16, vaddr = VB0 + r * VROW + h * 16;
    u32x4 kst, vst;
    kst = *(gptr)kg0; vst = *(gptr)vg0;
    *(LAS u32x4*)(lds + kl0) = kst; *(LAS u32x4*)(lds + vl0) = vst;
    __syncthreads();
#define SOFTMAX64(S0, S1, M, L, OX0, OX1) do { \
        if (t == NT - 1) { _Pragma("unroll") for (int i = 0; i < 16; ++i) { if (i >= 8) S0[i] = -1e30f; S1[i] = -1e30f; } } \
        float a_ = MX2(S0[0], S1[0]), b_ = MX2(S0[1], S1[1]); \
        _Pragma("unroll") for (int i = 2; i < 16; i += 2) { a_ = MX2(a_, MX2(S0[i], S1[i])); b_ = MX2(b_, MX2(S0[i + 1], S1[i + 1])); } \
        const float mx_ = swap32_max(MX2(a_, b_)) - M; \
        if (__builtin_expect(t == 0 || __builtin_amdgcn_ballot_w64(mx_ > 8.f) != 0ull, 0)) { \
            const float dl_ = (t == 0) ? mx_ : fmaxf(mx_, 0.f); M += dl_; \
            if (t != 0) { const float f_ = __builtin_amdgcn_exp2f(-dl_); L *= f_; _Pragma("unroll") for (int i = 0; i < 16; ++i) { OX0[i] *= f_; OX1[i] *= f_; } } \
            asm volatile("" ::: "memory"); } \
        float ra_ = 0.f, rb_ = 0.f; \
        _Pragma("unroll") for (int i = 0; i < 16; ++i) { S0[i] = __builtin_amdgcn_exp2f(S0[i] - M); S1[i] = __builtin_amdgcn_exp2f(S1[i] - M); ra_ += S0[i]; rb_ += S1[i]; } \
        L += ra_ + rb_; \
        u32x4 w_; \
        w_.x = pk2(S0[0], S0[1]); w_.y = pk2(S0[2], S0[3]); w_.z = pk2(S0[4], S0[5]); w_.w = pk2(S0[6], S0[7]); pf[0] = __builtin_bit_cast(bf16x8, w_); \
        w_.x = pk2(S0[8], S0[9]); w_.y = pk2(S0[10], S0[11]); w_.z = pk2(S0[12], S0[13]); w_.w = pk2(S0[14], S0[15]); pf[1] = __builtin_bit_cast(bf16x8, w_); \
        w_.x = pk2(S1[0], S1[1]); w_.y = pk2(S1[2], S1[3]); w_.z = pk2(S1[4], S1[5]); w_.w = pk2(S1[6], S1[7]); pf[2] = __builtin_bit_cast(bf16x8, w_); \
        w_.x = pk2(S1[8], S1[9]); w_.y = pk2(S1[10], S1[11]); w_.z = pk2(S1[12], S1[13]); w_.w = pk2(S1[14], S1[15]); pf[3] = __builtin_bit_cast(bf16x8, w_); } while (0)
    for (int t = 0; t < NT; ++t) {
        const int cb = t & 1; const bool more = (t + 1 < NT);
        if (more) { kst = *(gptr)(kg0 + (size_t)(t + 1) * 64 * DQK); vst = *(gptr)(vg0 + (size_t)(t + 1) * 64); }
        bf16x8 kq[8];
#pragma unroll
        for (int j = 0; j < 4; ++j) { kq[2 * j] = *(const LAS bf16x8*)(lds + cb * KT + kaddr + j * 32); kq[2 * j + 1] = *(const LAS bf16x8*)(lds + cb * KT + kaddr + 32 * KROW + j * 32); }
        asm volatile("" : "+v"(kq[0]), "+v"(kq[1]), "+v"(kq[2]), "+v"(kq[3]), "+v"(kq[4]), "+v"(kq[5]), "+v"(kq[6]), "+v"(kq[7]));
        f32x16 sa0, sa1, sb0, sb1;
        sa0 = __builtin_amdgcn_mfma_f32_32x32x16_bf16(kq[0], qf0[0], zero16, 0, 0, 0); sa1 = __builtin_amdgcn_mfma_f32_32x32x16_bf16(kq[1], qf0[0], zero16, 0, 0, 0);
#pragma unroll
        for (int j = 1; j < 4; ++j) { sa0 = __builtin_amdgcn_mfma_f32_32x32x16_bf16(kq[2 * j], qf0[j], sa0, 0, 0, 0); sa1 = __builtin_amdgcn_mfma_f32_32x32x16_bf16(kq[2 * j + 1], qf0[j], sa1, 0, 0, 0); }
        sb0 = __builtin_amdgcn_mfma_f32_32x32x16_bf16(kq[0], qf1[0], zero16, 0, 0, 0); sb1 = __builtin_amdgcn_mfma_f32_32x32x16_bf16(kq[1], qf1[0], zero16, 0, 0, 0);
#pragma unroll
        for (int j = 1; j < 4; ++j) { sb0 = __builtin_amdgcn_mfma_f32_32x32x16_bf16(kq[2 * j], qf1[j], sb0, 0, 0, 0); sb1 = __builtin_amdgcn_mfma_f32_32x32x16_bf16(kq[2 * j + 1], qf1[j], sb1, 0, 0, 0); }
        bf16x8 vf[8];
#pragma unroll
        for (int j = 0; j < 8; ++j) vf[j] = *(const LAS bf16x8*)(lds + cb * VT + vaddr + (j >> 2) * 32 * VROW + (j & 3) * 32);
        bf16x8 pf[4];
        SOFTMAX64(sa0, sa1, ma, la, oa0, oa1);
        asm volatile("" : "+v"(vf[0]), "+v"(vf[1]), "+v"(vf[2]), "+v"(vf[3]), "+v"(vf[4]), "+v"(vf[5]), "+v"(vf[6]), "+v"(vf[7]));
#pragma unroll
        for (int j = 0; j < 4; ++j) { oa0 = __builtin_amdgcn_mfma_f32_32x32x16_bf16(vf[j], pf[j], oa0, 0, 0, 0); oa1 = __builtin_amdgcn_mfma_f32_32x32x16_bf16(vf[4 + j], pf[j], oa1, 0, 0, 0); }
        SOFTMAX64(sb0, sb1, mb, lb, ob0, ob1);
#pragma unroll
        for (int j = 0; j < 4; ++j) { ob0 = __builtin_amdgcn_mfma_f32_32x32x16_bf16(vf[j], pf[j], ob0, 0, 0, 0); ob1 = __builtin_amdgcn_mfma_f32_32x32x16_bf16(vf[4 + j], pf[j], ob1, 0, 0, 0); }
        if (more) { *(LAS u32x4*)(lds + (cb ^ 1) * KT + kl0) = kst; *(LAS u32x4*)(lds + (cb ^ 1) * VT + vl0) = vst; }
        asm volatile("s_waitcnt lgkmcnt(0)" ::: "memory"); __builtin_amdgcn_s_barrier(); asm volatile("" ::: "memory");
    }
#undef SOFTMAX64
    la = swap32_add(la); lb = swap32_add(lb);
    const float ia = 1.f / la, ib = 1.f / lb;
    if (li0 < seqrows) { bf16_t* orow = O + (size_t)(r0 + li0) * 512;
#pragma unroll
        for (int g = 0; g < 4; ++g) { u32x2 w; w.x = pk2(oa0[4 * g] * ia, oa0[4 * g + 1] * ia); w.y = pk2(oa0[4 * g + 2] * ia, oa0[4 * g + 3] * ia); *(u32x2*)(orow + 8 * g + 4 * h) = w;
            w.x = pk2(oa1[4 * g] * ia, oa1[4 * g + 1] * ia); w.y = pk2(oa1[4 * g + 2] * ia, oa1[4 * g + 3] * ia); *(u32x2*)(orow + 32 + 8 * g + 4 * h) = w; } }
    if (li1 < seqrows) { bf16_t* orow = O + (size_t)(r0 + li1) * 512;
#pragma unroll
        for (int g = 0; g < 4; ++g) { u32x2 w; w.x = pk2(ob0[4 * g] * ib, ob0[4 * g + 1] * ib); w.y = pk2(ob0[4 * g + 2] * ib, ob0[4 * g + 3] * ib); *(u32x2*)(orow + 8 * g + 4 * h) = w;
            w.x = pk2(ob1[4 * g] * ib, ob1[4 * g + 1] * ib); w.y = pk2(ob1[4 * g + 2] * ib, ob1[4 * g + 3] * ib); *(u32x2*)(orow + 32 + 8 * g + 4 * h) = w; } }
}

#if defined(STAGGER) && !defined(STAGGER_NOC)
#define ATTN_C attn_unit_s<192, 128, false>
#else
#define ATTN_C attn_unit<192, 128, false, false>
#endif
#if defined(STAGGER)
#define ATTN_B attn_unit_s<64, 128, true>
#define ATTN_A attn_unit_s<64, 64, false>
#elif defined(NOPIPE_AB)
#define ATTN_B attn_unit<64, 128, true, false>
#define ATTN_A attn_unit<64, 64, false, false>
#else
#define ATTN_B attn_unit<64, 128, true, false>
#define ATTN_A attn_unit2<64, false>
#endif
DI void attn_phase(const Params& p, const Chunk& ck, bool last, const int lidx, LAS unsigned char* lds, unsigned* q  , const int wave) {
    unsigned char* ws = p.ws; asm volatile("" : "+s"(ws));
    const bf16_t* QKV = (const bf16_t*)(ws + WS_QKV); bf16_t* OB = (bf16_t*)(ws + WS_ZM);
#if defined(PROBE_DUPC)
    constexpr int NDUP = 8, DUP0 = 0;
#elif defined(PROBE_DUPB)
    constexpr int NDUP = 16, DUP0 = 8;
#elif defined(PROBE_DUPA)
    constexpr int NDUP = 16, DUP0 = 24;
#else
    constexpr int NDUP = 0, DUP0 = 0;
#endif
    const int nmeta = last ? 0 : 20 * ck.nseq, nms = (nmeta + 7) >> 3, nsuper = nms + 40 + NDUP;
    volatile LAS int* su = (volatile LAS int*)(lds + LDS_MISC);
    float qkb, qka, qkc, qkb_excess;
    { const int ln = lane_fresh();
      float g0 = fabsf(p.in[8][lidx * 64 + ln]), g1 = fabsf(p.in[9][lidx * 64 + ln]), g2 = fabsf(p.in[6][lidx * 64 + ln]), g3 = fabsf(p.in[7][lidx * 64 + ln]);
      float g4 = fmaxf(fmaxf(fabsf(p.in[19][lidx * 192 + ln]), fabsf(p.in[19][lidx * 192 + 64 + ln])), fabsf(p.in[19][lidx * 192 + 128 + ln]));
      float g5 = fmaxf(fmaxf(fabsf(p.in[20][lidx * 192 + ln]), fabsf(p.in[20][lidx * 192 + 64 + ln])), fabsf(p.in[20][lidx * 192 + 128 + ln]));
#pragma unroll
      for (int o = 1; o < 64; o <<= 1) {
#define WMAX_(g) g = fmaxf(g, __int_as_float(__builtin_amdgcn_ds_bpermute((ln ^ o) << 2, __float_as_int(g))))
          WMAX_(g0); WMAX_(g1); WMAX_(g2); WMAX_(g3); WMAX_(g4); WMAX_(g5);
#undef WMAX_
      }
      qkb = 1.05f * 64.f * 0.125f * LOG2E * g0 * g1; qka = 1.05f * 64.f * 0.125f * LOG2E * g2 * g3; qkc = 1.05f * 192.f * 0.07216878364870322f * LOG2E * g4 * g5;
      qkb_excess = fmaxf(qkb - 40.f, 0.f); qkb = fminf(qkb, 40.f); qka = fminf(qka, 40.f); qkc = fminf(qkc, 40.f);
      qkb_excess = __uint_as_float(__builtin_amdgcn_readfirstlane(__float_as_uint(qkb_excess)));
      qkb = __uint_as_float(__builtin_amdgcn_readfirstlane(__float_as_uint(qkb))); qka = __uint_as_float(__builtin_amdgcn_readfirstlane(__float_as_uint(qka))); qkc = __uint_as_float(__builtin_amdgcn_readfirstlane(__float_as_uint(qkc))); }

    for (;;) {
        if (wave == 0 && lane_fresh() == 0) {
#ifdef FLATQ
            const unsigned x = 0u;
#else
            const unsigned x = (unsigned)__builtin_amdgcn_s_getreg((3 << 11) | 20) & 0xFu;
#endif
            int res = -1, lin = 0;
            for (;;) {
                const unsigned idx = __hip_atomic_fetch_add(q + 64 + 16 * x, 1u, __ATOMIC_RELAXED, __HIP_MEMORY_SCOPE_AGENT);
                const unsigned slot = (idx >> 5) & 63u; lin = (int)(idx & 31u);
                unsigned* te = q + 512 + x * 64 + slot; unsigned g;
                if (lin == 0) { g = __hip_atomic_fetch_add(q, 1u, __ATOMIC_RELAXED, __HIP_MEMORY_SCOPE_AGENT); __hip_atomic_store(te, g + 1u, __ATOMIC_RELAXED, __HIP_MEMORY_SCOPE_AGENT); }
                else { while ((g = __hip_atomic_load(te, __ATOMIC_RELAXED, __HIP_MEMORY_SCOPE_AGENT)) == 0u) __builtin_amdgcn_s_sleep(2); g -= 1u; }
                if ((int)g >= nsuper) { res = -1; break; }
                if ((int)g < nms && (lin >= 8 || (int)g * 8 + lin >= nmeta)) continue;
#ifdef A64
                if ((int)g >= nms + 24) {
                    const int sub_ = ((int)g - nms) & 1;
                    if (ck.nseq == 1 ? (sub_ == 1) : (lin >= 16)) continue; }
#endif
                res = (int)g; break;
            }
            su[0] = res; su[1] = lin;
        }
        __syncthreads();
        const int g = su[0], lin = su[1];
        __syncthreads();
        if (g < 0) break;
        int type, hd, s, qb;
        int sh = ck.nseq - 1; asm volatile("" : "+s"(sh));
        if (g < nms) { const int mu = g * 8 + lin, jh = mu >> sh; s = mu & sh; qb = ck.tps - 1;
            if (jh < 4) { type = 0; hd = jh; } else if (jh < 12) { type = 1; hd = jh - 4; } else { type = 2; hd = jh - 12; } }
        else { const int gr0 = g - nms, gr = gr0 >= 40 ? gr0 - 40 + DUP0 : gr0, sub = gr & 1;
            if (gr < 8) { type = 0; hd = gr >> 1; } else if (gr < 16) { type = 1; hd = 7 - ((gr - 8) >> 1); } else if (gr < 32) { type = 2; hd = (gr - 16) >> 1; } else { type = 1; hd = 3 - ((gr - 32) >> 1); }
            s = sub * sh; qb = lin + (sub * 32) * (1 - sh); }
        const int r0 = s * ck.rows_per_seq();
        if (type == 0) {
            ATTN_C(lds, QKV + QC_O + (size_t)hd * RA * 192, QKV + KC_O + (size_t)hd * RA * 192, QKV + VC_O + (size_t)hd * 128 * RA, OB + 2 * OSLOT + 128 * hd, r0, qb, ck.n, 0.f, wave, 0x3fffffff, qkc);
        } else if (type == 1) { const int hh = hd >> 1;
            const float sl = LOG2E * (hh == 0 ? 0.25f : hh == 1 ? 0.0625f : hh == 2 ? 0.015625f : 0.00390625f);
            const float dkf = (152.f + qkb_excess) / sl + 2.f; const int dkeys = dkf < 1.0e9f ? (int)dkf : 0x3fffffff;
            ATTN_B(lds, QKV + QB_O + (size_t)hd * RA * 64, QKV + KB_O + (size_t)hd * RA * 64, QKV + VB_O + (size_t)hh * 128 * RA, OB + ((hd & 1) ? 3 : 1) * OSLOT + 128 * hh, r0, qb, ck.n, sl, wave, dkeys, qkb);
        } else { const int kv = hd >> 2;
#ifdef A64
            const int qb5 = (g < nms) ? (ck.n >> 9) : lin;
            attn_unit_a64(lds, QKV + QA_O + (size_t)hd * RA * 64, QKV + KA_O + (size_t)kv * RA * 64, QKV + VA_O + (size_t)kv * 64 * RA, OB + 64 * hd, r0, qb5, ck.n, ck.rows_per_seq(), wave);
#else
            ATTN_A(lds, QKV + QA_O + (size_t)hd * RA * 64, QKV + KA_O + (size_t)kv * RA * 64, QKV + VA_O + (size_t)kv * 64 * RA, OB + 64 * hd, r0, qb, ck.n, 0.f, wave, 0x3fffffff, qka);
#endif
        }
    }
}

#define XB_TMO      128
#define XB_XCNT(j)  (256  + 64 * (j))
#define XB_XSUB(j)  (1280 + 64 * (j))
#define XB_XGEN(j)  (2304 + 64 * (j))
#define XB_TOP      3328
#define XB_TOPGEN   3392
#define XCD_BAR_WORDS 3456
#define XB_SPIN_CAP (1u << 22)
DI unsigned xb_ld(unsigned* p)              { return __hip_atomic_load(p, __ATOMIC_RELAXED, __HIP_MEMORY_SCOPE_AGENT); }
DI unsigned xb_add(unsigned* p, unsigned v) { return __hip_atomic_fetch_add(p, v, __ATOMIC_RELAXED, __HIP_MEMORY_SCOPE_AGENT); }
DI unsigned xb_xcc_id() { return (unsigned)__builtin_amdgcn_s_getreg((3 << 11) | 20) & 0xFu; }
#define XB_SPIN(cond, bar) do { unsigned _sp = 0; while (cond) { __builtin_amdgcn_s_sleep(1); \
    if ((++_sp & 255u) == 0u) { if (xb_ld(&(bar)[XB_TMO])) break; if (_sp > XB_SPIN_CAP) { atomicAdd(&(bar)[XB_TMO], 1u); break; } } } } while (0)
DI void xcd_barrier_complete(unsigned* bar, unsigned x, unsigned G, unsigned& nloc, unsigned& nx) {
    unsigned sum, cnt, mine, sp = 0u;
    for (;;) {
        sum = 0u; cnt = 0u; mine = 0u;
#pragma unroll
        for (unsigned j = 0; j < 16; ++j) { const unsigned c = xb_ld(&bar[XB_XCNT(j)]); sum += c; cnt += (c > 0u) ? 1u : 0u; mine = (j == x) ? c : mine; }
        if (sum == G) break;
        __builtin_amdgcn_s_sleep(1);
        if ((++sp & 255u) == 0u) { if (xb_ld(&bar[XB_TMO])) break; if (sp > XB_SPIN_CAP) { atomicAdd(&bar[XB_TMO], 1u); break; } }
    }
    nloc = mine > 0u ? mine : 1u; nx = cnt > 0u ? cnt : 1u;
}
DI void xcd_barrier(unsigned* bar, volatile LAS unsigned* st, const int wave) {
    asm volatile("s_waitcnt vmcnt(0)" ::: "memory");
    __syncthreads();
    if (wave == 0 && lane_fresh() == 0) {
        __builtin_amdgcn_s_waitcnt(0);
        const unsigned x = xb_xcc_id();
        unsigned nloc = st[0], nx = st[1];
        if (nloc == 0u) { xcd_barrier_complete(bar, x, gridDim.x, nloc, nx); st[0] = nloc; st[1] = nx; }
        const unsigned old = xb_add(&bar[XB_XSUB(x)], 1u);
        const unsigned gen = old / nloc;
        if (old + 1u == (gen + 1u) * nloc) {
            __builtin_amdgcn_fence(__ATOMIC_RELEASE, "agent");
            asm volatile("s_waitcnt vmcnt(0)" ::: "memory");
            const unsigned og = xb_add(&bar[XB_TOP], 1u);
            const unsigned tg = og / nx;
            if (og + 1u == (tg + 1u) * nx) xb_add(&bar[XB_TOPGEN], 1u);
            else XB_SPIN(xb_ld(&bar[XB_TOPGEN]) == tg, bar);
            __builtin_amdgcn_fence(__ATOMIC_ACQUIRE, "agent");
            xb_add(&bar[XB_XGEN(x)], 1u);
            asm volatile("s_waitcnt vmcnt(0)" ::: "memory");
        } else {
            XB_SPIN(xb_ld(&bar[XB_XGEN(x)]) == gen, bar);
            __builtin_amdgcn_fence(__ATOMIC_ACQUIRE, "agent");
            asm volatile("s_waitcnt vmcnt(0)" ::: "memory");
        }
    }
    __syncthreads();
}


#define SK_LOOP(ACC, AP, BP, KK) do { _Pragma("unroll") for (int k0_ = 0; k0_ < (KK); k0_ += 32) { \
        const bf16x8 a_ = *(const bf16x8*)((AP) + k0_), b_ = *(const bf16x8*)((BP) + k0_); ACC = __builtin_amdgcn_mfma_f32_16x16x32_bf16(a_, b_, ACC, 0, 0, 0); } } while (0)
DI void skinny_phase(int which  , const Params& p, const Chunk& ck, const XMap& xm, const unsigned char* wbl, int gw, int NGW, int lane) {
    unsigned char* ws = p.ws; asm volatile("" : "+s"(ws));
    const int row = lane & 15, quad = lane >> 4;
    if (which == 0) {
        const bf16_t* OB = (const bf16_t*)(ws + WS_ZM); const bf16_t* G = (const bf16_t*)(ws + WS_G); bf16_t* MGb = (bf16_t*)(ws + WS_XN);
        for (int it = gw; it < ck.nseq * 64; it += NGW) {
            const int s = it >> 6, tile = it & 63, R0 = (s * ck.tps + ck.tps - 1) * 256, col = tile * 16 + row;
            f32x4 sum = {0.f, 0.f, 0.f, 0.f};
#pragma unroll 1
            for (int z = 0; z < 3; ++z) { f32x4 a = {0.f, 0.f, 0.f, 0.f};
                const bf16_t* ap = OB + (size_t)z * OSLOT + (size_t)(R0 + row) * 512 + quad * 8; const bf16_t* bp = (const bf16_t*)(wbl + W_BR) + (size_t)z * 1024 * 512 + (size_t)col * 512 + quad * 8;
                SK_LOOP(a, ap, bp, 512);
#pragma unroll
                for (int j = 0; j < 4; ++j) { const float g = __uint_as_float((unsigned)G[(size_t)(R0 + quad * 4 + j) * G_LD + z * 1024 + col] << 16); sum[j] += g * a[j]; } }
#pragma unroll
            for (int j = 0; j < 4; ++j) MGb[(size_t)(R0 + quad * 4 + j) * DM + col] = (bf16_t)(pk2(sum[j], 0.f) & 0xffffu);
        }
    } else if (which == 2) {
        const bf16_t* XNp = (const bf16_t*)(ws + WS_XN); bf16_t* U_ = (bf16_t*)(ws + WS_G);
        for (int it = gw; it < ck.nseq * 256; it += NGW) {
            const int s = it >> 8, tile = it & 255, R0 = (s * ck.tps + ck.tps - 1) * 256, col = tile * 16 + row;
            f32x4 acc = {0.f, 0.f, 0.f, 0.f};
            const bf16_t* ap = XNp + (size_t)(R0 + row) * 1024 + quad * 8; const bf16_t* bp = (const bf16_t*)(wbl + W_UP) + (size_t)col * 1024 + quad * 8;
#pragma unroll 1
            for (int kh = 0; kh < 2; ++kh) SK_LOOP(acc, ap + kh * 512, bp + kh * 512, 512);
#pragma unroll
            for (int j = 0; j < 4; ++j) { const float v = fmaxf(acc[j], 0.f); U_[(size_t)(R0 + quad * 4 + j) * 4096 + col] = (bf16_t)(pk2(v * v, 0.f) & 0xffffu); }
        }
    } else {
        const int K = (which == 1) ? 1024 : 4096, nkc = K >> 9;
        const bf16_t* A = (which == 1) ? (const bf16_t*)(ws + WS_XN) : (const bf16_t*)(ws + WS_G);
        const bf16_t* W = (const bf16_t*)(wbl + (which == 1 ? W_OUT : W_DOWN));
        for (int it = gw; it < ck.nseq * 64 * nkc; it += NGW) {
            const int kc = it % nkc, rem = it / nkc, s = rem >> 6, tile = rem & 63, pt = s * ck.tps + ck.tps - 1, R0 = pt * 256, col = tile * 16 + row;
            f32x4 acc = {0.f, 0.f, 0.f, 0.f};
            const bf16_t* ap = A + (size_t)(R0 + row) * K + kc * 512 + quad * 8; const bf16_t* bp = W + (size_t)col * K + kc * 512 + quad * 8;
            SK_LOOP(acc, ap, bp, 512);
            float* wp = xm.xw(pt);
#pragma unroll
            for (int j = 0; j < 4; ++j) atomicAdd(wp + (size_t)(quad * 4 + j) * DM + col, acc[j]);
        }
    }
}

#define GSYNC() xcd_barrier(xbar, xst, wave)
__global__ void __launch_bounds__(512) fwd_kernel(Params p) {
    extern __shared__ __attribute__((aligned(16))) unsigned char lds_raw[];
    LAS unsigned char* lds = (LAS unsigned char*)lds_raw;
    cg::grid_group grid = cg::this_grid();
    const int wave = __builtin_amdgcn_readfirstlane((int)threadIdx.x >> 6); int lane = lane_fresh();
    const int G = gridDim.x, bx = blockIdx.x, NGW = G * 8, gw = bx * 8 + wave;
#define WSP(off) ({ unsigned char* w_ = p.ws; asm volatile("" : "+s"(w_)); w_ + (off); })
#define ctl ((unsigned*)WSP(WS_CTL))
#define xbar (ctl + 1024)
    volatile LAS unsigned* xst = (volatile LAS unsigned*)(lds + LDS_MISC + 16);
    if (wave == 0 && lane == 0) { xst[0] = 0u; xst[1] = 0u; (void)xb_add(&xbar[XB_XCNT(xb_xcc_id())], 1u); }
    __syncthreads();
#define XN ((bf16_t*)WSP(WS_XN))
#define ZM ((bf16_t*)WSP(WS_ZM))
#define GB ((bf16_t*)WSP(WS_G))
#define CQN ((bf16_t*)WSP(WS_SM + SM_CQN))
#define CKVN ((bf16_t*)WSP(WS_SM + SM_CKVN))
#define QCR ((bf16_t*)WSP(WS_ZM + OFF_QCR))
#define KVR ((bf16_t*)WSP(WS_ZM + OFF_KVR))
#define MG ((float*)WSP(WS_QKV))
#define U ((bf16_t*)WSP(WS_G))

#if !defined(PH) || (PH & 1)
    prologue(p, lds, gw, NGW, wave, lane);
#ifdef PROBE_PRO2
    prologue(p, lds, gw, NGW, wave, lane);
#endif
#endif
    grid.sync();
    for (int l = 0; l < 2; ++l) {
        const bool last = (l == 1);
#define wb (WSP(WS_W) + (size_t)l * LW_STRIDE)
        for (int c = 0; c < 3; ++c) {
            const Chunk ck = make_chunk(c);
            const int ta = ck.tps - 1;
            XMap xm; xm.out = p.out; xm.metax = (float*)WSP(WS_METAX); xm.xp = p.in[0]; xm.xs = p.in[1]; xm.meta0 = (const float*)WSP(WS_META0); xm.seq0 = ck.seq0; xm.tps = ck.tps; xm.first = (l == 0);
#define RELAUNDER() do { lane = lane_fresh(); } while (0)
            RELAUNDER();
#if !defined(PH) || (PH & 2)
            norm_phase(xm, ck.rows(), p.in[3] + l * DM, XN, gw, NGW, lane);
#ifdef PROBE_EW2
            RELAUNDER(); norm_phase(xm, ck.rows(), p.in[3] + l * DM, XN, gw, NGW, lane);
#endif
#endif
            GSYNC();
            { pg8::Gemm g{XN, (const bf16_t*)(wb + W_IN), 1024, 0, 0}; Sched S; S.init(ck.nseq, ck.tps, ck.tps, IN_N / 256, 1, G, bx);
              EpiIn E{ZM, GB, p.in[5] + l * 3072};
#if !defined(PH) || (PH & 4)
              pg8::gemm_phase<EpiIn, Sched, true, true>(lds, g, S, E, wave);
#ifdef PROBE_IN2
              pg8::gemm_phase<EpiIn, Sched, true, true>(lds, g, S, E, wave);
#endif
#endif
 }
            GSYNC();
            RELAUNDER();
#if !defined(PH) || (PH & 128)
            ew1_phase(p, ck, l, gw, NGW, lane);
#ifdef PROBE_EW2
            RELAUNDER(); ew1_phase(p, ck, l, gw, NGW, lane);
#endif
#endif
            GSYNC();
            { pg8::Gemm g{CQN, (const bf16_t*)(wb + W_QB), 256, 0, 0}; Sched S; S.init(ck.nseq, ck.tps, ck.tps, 3, 1, G, bx); EpiBf16<0> E{QCR, 768};
#if !defined(PH) || (PH & 8)
              pg8::gemm_phase<EpiBf16<0>, Sched, true, true>(lds, g, S, E, wave);
#endif
 }
            { pg8::Gemm g{CKVN, (const bf16_t*)(wb + W_KVB), 128, 0, 0}; Sched S; S.init(ck.nseq, ck.tps, ck.tps, 4, 1, G, bx); EpiBf16<0> E{KVR, 1024};
#if !defined(PH) || (PH & 8)
              pg8::gemm_phase<EpiBf16<0>, Sched, true, true>(lds, g, S, E, wave);
#endif
 }
            GSYNC();
            RELAUNDER();
#if !defined(PH) || (PH & 256)
            ew2_phase(p, ck, l, gw, NGW, lane);
#ifdef PROBE_EW2
            RELAUNDER(); ew2_phase(p, ck, l, gw, NGW, lane);
#endif
#endif
            GSYNC();
#if !defined(PH) || (PH & 1024)
            attn_phase(p, ck, last, l, lds, ctl + 8192 + 2048 * (l * 3 + c), wave);
#ifdef PROBE_ATTN2
            GSYNC();
            attn_phase(p, ck, last, l, lds, ctl + 8192 + 2048 * (6 + l * 3 + c), wave);
#endif
#endif
            GSYNC();
            RELAUNDER();
#if !defined(PH) || (PH & 512)
            ew3_phase(p, ck, l, last, gw, NGW, lane);
#endif
            GSYNC();
            { pg8::Gemm g{ZM, (const bf16_t*)(wb + W_BR), 512, OSLOT, (size_t)1024 * 512}; Sched S; S.init(ck.nseq, ta, ck.tps, 4, 3, G, bx); EpiBranch E{GB, MG, XN};
#if !defined(PH) || (PH & 16)
              pg8::gemm_phase<EpiBranch, Sched, true, true>(lds, g, S, E, wave);
#ifdef PROBE_BR2
              pg8::gemm_phase<EpiBranch, Sched, true, true>(lds, g, S, E, wave);
#endif
#endif
 }
            if (!last) { RELAUNDER(); skinny_phase(0, p, ck, xm, wb, gw, NGW, lane); }
            GSYNC();
            { pg8::Gemm g{XN, (const bf16_t*)(wb + W_OUT), 1024, 0, 0}; Sched S; S.init(ck.nseq, ta, ck.tps, 4, 1, G, bx); EpiResid E{xm};
#if !defined(PH) || (PH & 32)
              pg8::gemm_phase<EpiResid, Sched, true, true>(lds, g, S, E, wave);
#endif
 }
            if (!last) { RELAUNDER(); skinny_phase(1, p, ck, xm, wb, gw, NGW, lane); }
            GSYNC();
            xm.first = 0;
            RELAUNDER();
#if !defined(PH) || (PH & 2)
            norm_phase(xm, ck.rows(), p.in[25] + l * DM, XN, gw, NGW, lane);
#ifdef PROBE_EW2
            RELAUNDER(); norm_phase(xm, ck.rows(), p.in[25] + l * DM, XN, gw, NGW, lane);
#endif
#endif
            GSYNC();
            { pg8::Gemm g{XN, (const bf16_t*)(wb + W_UP), 1024, 0, 0}; Sched S; S.init(ck.nseq, ta, ck.tps, 16, 1, G, bx); EpiBf16<2> E{U, 4096};
#if !defined(PH) || (PH & 64)
              pg8::gemm_phase<EpiBf16<2>, Sched, true, true>(lds, g, S, E, wave);
#ifdef PROBE_UP2
              pg8::gemm_phase<EpiBf16<2>, Sched, true, true>(lds, g, S, E, wave);
#endif
#endif
 }
            if (!last) { RELAUNDER(); skinny_phase(2, p, ck, xm, wb, gw, NGW, lane); }
            GSYNC();
            { pg8::Gemm g{U, (const bf16_t*)(wb + W_DOWN), 4096, 0, 0}; Sched S; S.init(ck.nseq, ta, ck.tps, 4, 1, G, bx); EpiResid E{xm};
#if !defined(PH) || (PH & 32)
              pg8::gemm_phase<EpiResid, Sched, true, true>(lds, g, S, E, wave);
#endif
 }
            if (!last) { RELAUNDER(); skinny_phase(3, p, ck, xm, wb, gw, NGW, lane); }
        }
    }
}

extern "C" void kernel_launch(void* const* d_in, const int* in_sizes, int n_in, void* d_out, int out_size, void* d_ws, size_t ws_size, hipStream_t stream) {
    static int grid_blocks = 0;
    if (grid_blocks == 0) {
        if (n_in != 28 || ws_size < WS_END) { fprintf(stderr, "kernel_launch: unexpected n_in %d / ws_size %zu (need %zu)\n", n_in, ws_size, (size_t)WS_END); grid_blocks = -1; return; }
        int dev = 0, cus = 0, per_cu = 0;
        hipGetDevice(&dev); hipDeviceGetAttribute(&cus, hipDeviceAttributeMultiprocessorCount, dev);
        hipFuncSetAttribute((const void*)fwd_kernel, hipFuncAttributeMaxDynamicSharedMemorySize, LDS_BYTES);
        hipOccupancyMaxActiveBlocksPerMultiprocessor(&per_cu, (const void*)fwd_kernel, 512, LDS_BYTES);
        if (per_cu < 1) { fprintf(stderr, "kernel_launch: occupancy query says %d blocks/CU\n", per_cu); per_cu = 1; }
        grid_blocks = cus * 1;
        (void)hipGetLastError();
    }
    if (grid_blocks < 0) return;
    hipMemsetAsync((char*)d_ws + WS_CTL, 0, CTL_BYTES, stream);
    Params p{};
    for (int i = 0; i < 28; ++i) p.in[i] = (const float*)d_in[i];
    p.out = (float*)d_out; p.ws = (unsigned char*)d_ws;
    void* args[] = {&p};
    hipError_t e = hipLaunchCooperativeKernel((const void*)fwd_kernel, dim3(grid_blocks), dim3(512), args, LDS_BYTES, stream);
    if (e != hipSuccess) fprintf(stderr, "cooperative launch failed: %s (grid %d)\n", hipGetErrorString(e), grid_blocks);
}
```
